# Optimizing an MI355X kernel written in HIP

```python
import jax, jax.numpy as jnp
from jax import lax
import numpy as np

D_MODEL = 1024
BATCH = 8
SEQ = 4096
DEPTH = 4

HEAD_DIM = 64
MEM_DIM = D_MODEL // 4
MEM_HEADS = MEM_DIM // HEAD_DIM
MEM_LEN = 256
FOX_DIM = D_MODEL - MEM_DIM
FOX_HEADS = FOX_DIM // HEAD_DIM
CONV_DIM = D_MODEL - MEM_DIM
CONV_WIDTH = 31
Q_BLOCK = 128
D_FF = ((8 * D_MODEL // 3 + 127) // 128) * 128
N_EXPERTS = 8
TOP_K = 2
EXPERT_FF = 7 * D_MODEL // 2
EXPERT_BLOCK = 128
N_FOX = (DEPTH + 1) // 2
N_CONV = DEPTH // 2
EPS = 1e-6
NEG_INF = -1e30

kernel_name = "fox_conformer_memory_moe_hybrid"


def rms_norm(x, g):
    xf = x.astype(jnp.float32)
    y = xf * lax.rsqrt(jnp.mean(xf * xf, axis=-1, keepdims=True) + EPS)
    return (y * g.astype(jnp.float32)).astype(x.dtype)


def layer_norm(x, g, b):
    xf = x.astype(jnp.float32)
    mu = jnp.mean(xf, axis=-1, keepdims=True)
    var = jnp.mean(jnp.square(xf - mu), axis=-1, keepdims=True)
    y = (xf - mu) * lax.rsqrt(var + EPS)
    return (y * g.astype(jnp.float32) + b.astype(jnp.float32)).astype(x.dtype)


def forget_attention(q, k, v, log_f):
    B, S, H, hd = q.shape
    nb = S // Q_BLOCK
    c = jnp.cumsum(log_f, axis=1).transpose(0, 2, 1)
    q_blocks = q.reshape(B, nb, Q_BLOCK, H, hd).transpose(1, 0, 2, 3, 4)
    c_blocks = c.reshape(B, H, nb, Q_BLOCK).transpose(2, 0, 1, 3)
    k_pos = jnp.arange(S)
    scale = hd ** -0.5

    def one_block(args):
        q_b, c_b, blk = args
        s = jnp.einsum('bqhd,bkhd->bhqk', q_b, k, preferred_element_type=jnp.float32) * scale
        s = s + (c_b[..., :, None] - c[:, :, None, :])
        q_pos = blk * Q_BLOCK + jnp.arange(Q_BLOCK)
        s = jnp.where(k_pos[None, :] <= q_pos[:, None], s, NEG_INF)
        p = jax.nn.softmax(s, axis=-1).astype(v.dtype)
        return jnp.einsum('bhqk,bkhd->bqhd', p, v)

    o = lax.map(one_block, (q_blocks, c_blocks, jnp.arange(nb)))
    return o.transpose(1, 0, 2, 3, 4).reshape(B, S, H * hd)


def memory_attention(xq, mk, mv, g_q, g_k):
    B, S, _ = xq.shape
    M = mk.shape[1]
    q = rms_norm(xq.reshape(B, S, MEM_HEADS, HEAD_DIM), g_q)
    k = rms_norm(mk.reshape(B, M, MEM_HEADS, HEAD_DIM), g_k)
    v = mv.reshape(B, M, MEM_HEADS, HEAD_DIM)
    s = jnp.einsum('bshd,bmhd->bhsm', q, k, preferred_element_type=jnp.float32) * (HEAD_DIM ** -0.5)
    p = jax.nn.softmax(s, axis=-1).astype(v.dtype)
    return jnp.einsum('bhsm,bmhd->bshd', p, v).reshape(B, S, MEM_DIM)


def conformer_conv(glu_in, dw, dw_b, ln_g, ln_b):
    a, gate = jnp.split(glu_in, 2, axis=-1)
    u = a * jax.nn.sigmoid(gate)
    u = lax.conv_general_dilated(
        u, dw[:, None, :].astype(u.dtype), window_strides=(1,),
        padding=[(CONV_WIDTH - 1, 0)], dimension_numbers=('NWC', 'WIO', 'NWC'),
        feature_group_count=CONV_DIM) + dw_b.astype(u.dtype)
    return jax.nn.silu(layer_norm(u, ln_g, ln_b))


def swiglu(h, w_gate, w_up, w_down):
    return (jax.nn.silu(h @ w_gate) * (h @ w_up)) @ w_down


def moe_swiglu(h, w_router, w_gate, w_up, w_down):
    B, S, D = h.shape
    xt = h.reshape(-1, D)
    T = xt.shape[0]
    A = T * TOP_K
    logits = (xt @ w_router).astype(jnp.float32)
    top_logit, top_idx = lax.top_k(logits, TOP_K)
    gates = jax.nn.softmax(top_logit, axis=-1)
    flat_e = top_idx.reshape(-1)
    order = jnp.argsort(flat_e)
    sorted_e = flat_e[order]
    sizes = jnp.bincount(flat_e, length=N_EXPERTS).astype(jnp.int32)
    padded = ((sizes + EXPERT_BLOCK - 1) // EXPERT_BLOCK) * EXPERT_BLOCK
    pad_end = jnp.cumsum(padded)
    pad_start = pad_end - padded
    start = jnp.cumsum(sizes) - sizes
    dest = pad_start[sorted_e] + (jnp.arange(A, dtype=jnp.int32) - start[sorted_e])
    n_blocks = -(-A // EXPERT_BLOCK) + N_EXPERTS
    rows = n_blocks * EXPERT_BLOCK
    tok_buf = jnp.full((rows,), T, jnp.int32).at[dest].set((order // TOP_K).astype(jnp.int32))
    gate_buf = jnp.zeros((rows,), jnp.float32).at[dest].set(gates.reshape(-1)[order])
    block_start = jnp.arange(n_blocks, dtype=jnp.int32) * EXPERT_BLOCK
    block_expert = jnp.minimum(jnp.searchsorted(pad_end, block_start, side='right'), N_EXPERTS - 1)
    xt_pad = jnp.concatenate([xt, jnp.zeros((1, D), xt.dtype)], axis=0)
    xs = xt_pad[tok_buf].reshape(n_blocks, EXPERT_BLOCK, D)

    def expert_block(args):
        xb, e = args
        return swiglu(xb, w_gate[e], w_up[e], w_down[e])

    ys = lax.map(expert_block, (xs, block_expert)).reshape(rows, D)
    ys = ys * gate_buf[:, None].astype(ys.dtype)
    out = jnp.zeros((T + 1, D), ys.dtype).at[tok_buf].add(ys)[:T]
    return out.reshape(B, S, D)


def setup_inputs(seed: int = 0) -> dict:
    key = jax.random.key(seed)
    ks = iter(jax.random.split(key, 40))

    def nrm(shape, scale):
        return jax.random.normal(next(ks), shape, jnp.float32) * scale

    D = D_MODEL
    fox_in = 3 * FOX_DIM + FOX_HEADS + MEM_DIM
    conv_in = 2 * CONV_DIM + MEM_DIM
    return {
        "x": nrm((BATCH, SEQ, D), 1.0),
        "mem": nrm((BATCH, MEM_LEN, D), 1.0),
        "norm_mix": 1.0 + nrm((DEPTH, D), 0.02),
        "norm_mem": 1.0 + nrm((DEPTH, D), 0.02),
        "norm_ffn": 1.0 + nrm((DEPTH, D), 0.02),
        "w_mem_kv": nrm((DEPTH, D, 2 * MEM_DIM), D ** -0.5),
        "g_mq": 1.0 + nrm((DEPTH, HEAD_DIM), 0.02),
        "g_mk": 1.0 + nrm((DEPTH, HEAD_DIM), 0.02),
        "fox_w_in": nrm((N_FOX, D, fox_in), D ** -0.5),
        "fox_b_f": 3.0 + nrm((N_FOX, FOX_HEADS), 0.5),
        "fox_g_q": 1.0 + nrm((N_FOX, HEAD_DIM), 0.02),
        "fox_g_k": 1.0 + nrm((N_FOX, HEAD_DIM), 0.02),
        "fox_w_out": nrm((N_FOX, FOX_DIM + MEM_DIM, D), 0.5 * D ** -0.5),
        "conv_w_in": nrm((N_CONV, D, conv_in), D ** -0.5),
        "conv_b_in": nrm((N_CONV, 2 * CONV_DIM), 0.02),
        "conv_dw": nrm((N_CONV, CONV_WIDTH, CONV_DIM), CONV_WIDTH ** -0.5),
        "conv_dw_b": nrm((N_CONV, CONV_DIM), 0.02),
        "conv_ln_g": 1.0 + nrm((N_CONV, CONV_DIM), 0.02),
        "conv_ln_b": nrm((N_CONV, CONV_DIM), 0.02),
        "conv_w_out": nrm((N_CONV, CONV_DIM + MEM_DIM, D), 0.5 * D ** -0.5),
        "ffn_w_gate": nrm((N_FOX, D, D_FF), D ** -0.5),
        "ffn_w_up": nrm((N_FOX, D, D_FF), D ** -0.5),
        "ffn_w_down": nrm((N_FOX, D_FF, D), 0.5 * D_FF ** -0.5),
        "moe_router": nrm((N_CONV, D, N_EXPERTS), D ** -0.5),
        "moe_w_gate": nrm((N_CONV, N_EXPERTS, D, EXPERT_FF), D ** -0.5),
        "moe_w_up": nrm((N_CONV, N_EXPERTS, D, EXPERT_FF), D ** -0.5),
        "moe_w_down": nrm((N_CONV, N_EXPERTS, EXPERT_FF, D), 0.5 * EXPERT_FF ** -0.5),
    }


def reference(x, mem, norm_mix, norm_mem, norm_ffn, w_mem_kv, g_mq, g_mk,
              fox_w_in, fox_b_f, fox_g_q, fox_g_k, fox_w_out,
              conv_w_in, conv_b_in, conv_dw, conv_dw_b, conv_ln_g, conv_ln_b, conv_w_out,
              ffn_w_gate, ffn_w_up, ffn_w_down,
              moe_router, moe_w_gate, moe_w_up, moe_w_down):
    B, S, D = x.shape
    h = x
    for i in range(DEPTH):
        j = i // 2
        u = rms_norm(h, norm_mix[i])
        m = rms_norm(mem, norm_mem[i])
        mk, mv = jnp.split(m @ w_mem_kv[i], 2, axis=-1)
        if i % 2 == 0:
            proj = u @ fox_w_in[j]
            q, k, v, f_logit, mq = jnp.split(
                proj, [FOX_DIM, 2 * FOX_DIM, 3 * FOX_DIM, 3 * FOX_DIM + FOX_HEADS], axis=-1)
            q = rms_norm(q.reshape(B, S, FOX_HEADS, HEAD_DIM), fox_g_q[j])
            k = rms_norm(k.reshape(B, S, FOX_HEADS, HEAD_DIM), fox_g_k[j])
            v = v.reshape(B, S, FOX_HEADS, HEAD_DIM)
            log_f = jax.nn.log_sigmoid((f_logit + fox_b_f[j]).astype(jnp.float32))
            mix = forget_attention(q, k, v, log_f)
            w_out = fox_w_out[j]
        else:
            proj = u @ conv_w_in[j]
            glu_in, mq = jnp.split(proj, [2 * CONV_DIM], axis=-1)
            mix = conformer_conv(glu_in + conv_b_in[j], conv_dw[j], conv_dw_b[j],
                                 conv_ln_g[j], conv_ln_b[j])
            w_out = conv_w_out[j]
        mem_out = memory_attention(mq, mk, mv, g_mq[i], g_mk[i])
        h = h + jnp.concatenate([mix, mem_out], axis=-1) @ w_out
        z = rms_norm(h, norm_ffn[i])
        if i % 2 == 0:
            h = h + swiglu(z, ffn_w_gate[j], ffn_w_up[j], ffn_w_down[j])
        else:
            h = h + moe_swiglu(z, moe_router[j], moe_w_gate[j], moe_w_up[j], moe_w_down[j])
    return h
```

```cpp
#define BRINGUP 0
#define FASTMASK 0
#include <hip/hip_runtime.h>
#include <hip/hip_bf16.h>
#include <cstdio>
#include <cstdint>
#include <cmath>
#include <utility>

#ifndef BRINGUP
#define BRINGUP 0
#endif
#ifndef DENSE8
#define DENSE8 2
#endif
#ifndef UP8L0
#define UP8L0 0
#endif
#ifndef IN8L2
#define IN8L2 1
#endif
#ifndef IN8L0
#define IN8L0 1
#endif
#ifndef IN8ODD
#define IN8ODD 0
#endif
#ifndef FUSENORM
#define FUSENORM 1
#endif
#ifndef MOEQ
#define MOEQ 1
#endif
#ifndef FASTMASK
#define FASTMASK 0
#endif

__device__ __forceinline__ float lconst(float c) { asm volatile("" : "+s"(c)); return c; }
__device__ __forceinline__ int lconsti(int c) { asm volatile("" : "+s"(c)); return c; }

constexpr int BATCH = 8, SEQ = 4096, DM = 1024, T = BATCH * SEQ, NH = 12, HD = 64, FOXD = 768, MEMD = 256, MEMH = 4, ML = 256;
constexpr int FF = 2816, EFF = 3584, NE = 8, CW = 31, CONVD = 768, FOXIN = 2572, CONVIN = 1792;
constexpr int MAXRT = 264, MAXROWS = MAXRT * 256;
constexpr float RMS_EPS = 1e-6f;
constexpr float LOG2E = 1.4426950408889634f;
constexpr float C2 = 0.125f * 1.4426950408889634f;

constexpr size_t MiB = 1u << 20, KiB = 1u << 10;
constexpr size_t WS_CTL = 0, CTL_ZERO_BYTES = 1 * MiB;
constexpr size_t WS_LOGF = 1 * MiB;
constexpr size_t WS_CB = 3 * MiB;
constexpr size_t WS_RS = 4 * MiB + 512 * KiB;
constexpr size_t WS_TOPE = 5 * MiB;
constexpr size_t WS_TOPG = 5 * MiB + 512 * KiB;
constexpr size_t WS_SLOT = 6 * MiB;
constexpr size_t WS_ROWG = 6 * MiB + 512 * KiB;
constexpr size_t WS_CNT = 7 * MiB;
constexpr size_t WS_TAB = 7 * MiB + 64 * KiB;
constexpr size_t WS_GT = 7 * MiB + 128 * KiB;
constexpr size_t WS_MKV = 8 * MiB;
constexpr size_t WS_MEMN = 16 * MiB;
constexpr size_t WS_WINE = 32 * MiB;
constexpr size_t WS_WOUTE = 42 * MiB;
constexpr size_t WS_WINO = 46 * MiB;
constexpr size_t WS_WOUTO = 53 * MiB;
constexpr size_t WS_WGU = 57 * MiB;
constexpr size_t WS_WD = 79 * MiB;
constexpr size_t WS_WKV = 90 * MiB;
constexpr size_t WS_SSQ = 94 * MiB;
constexpr size_t WS_WMGU = 96 * MiB;
constexpr size_t WS_WMD = 152 * MiB;
constexpr size_t WS_WM_LAYER = 84 * MiB;
constexpr float WSC_GU = 256.f, WSC_D = 1024.f, ASC_Z = 8.f, ASC_H = 8.f;
constexpr size_t WS_R = 264 * MiB;
constexpr size_t WS_QKV = WS_R;
constexpr size_t WS_GLU = WS_R;
constexpr size_t WS_XS = WS_R;
constexpr size_t WS_MQ = WS_R + 144 * MiB;
constexpr size_t WS_MIX = WS_R + 160 * MiB;
constexpr size_t WS_UB = WS_R + 224 * MiB;
constexpr size_t WS_HIDD = WS_R + 288 * MiB;
constexpr size_t WS_HIDM = WS_R + 132 * MiB;
constexpr size_t WS_NTMP = WS_R + 288 * MiB;
constexpr size_t WS_H16 = WS_R + 594 * MiB;
#if BRINGUP
constexpr size_t WS_END = WS_R + 672 * MiB;
#else
constexpr size_t WS_END = WS_R + 658 * MiB;
#endif
static_assert(WS_HIDM + (size_t)MAXROWS * EFF * 2 <= WS_R + 594 * MiB, "ws map");
static_assert(WS_XS + (size_t)MAXROWS * DM * 2 <= WS_HIDM, "ws map");
static_assert(WS_HIDD + (size_t)T * FF * 2 <= WS_R + 594 * MiB, "ws map");
constexpr int CW_TMO = 0, CW_CODE = 1;
constexpr int CW_BAR = 4096;
constexpr int CW_QUEUE = 8192;

constexpr int NPH = 37;
constexpr unsigned C_THIN = 1u, C_PMK = 2u, C_INPROJ = 4u, C_FOX = 8u, C_MEMATT = 16u, C_OUTPROJ = 32u, C_FFNUP = 64u, C_FFNDOWN = 128u, C_ALL = 0xffu;
namespace pg8 {
#define PG8_LAS __attribute__((address_space(3)))
#define PG8_GAS __attribute__((address_space(1)))
typedef unsigned short bf16_t;
typedef short bf16x8 __attribute__((ext_vector_type(8)));
typedef float f32x4 __attribute__((ext_vector_type(4)));
typedef unsigned u32x4 __attribute__((ext_vector_type(4)));
constexpr int BM = 256, BK = 64, HALF = 128, HTB = HALF * BK * 2  , STAGE_BYTES = 8 * HTB, NXCD = 8, WGM = 8;

__host__ __device__ __forceinline__ int lds_byte(int r, int c) { const int st = (r >> 4) * 2 + (c >> 5), rr = r & 15, cc = c & 31, ob = rr * 64 + cc * 2; return st * 1024 + (ob ^ (((ob >> 9) & 1) << 5)); }
__host__ __device__ __forceinline__ void stage_rc(int b, int& R, int& C) { const int st = b / 1024, sb = b % 1024, swz = sb ^ (((sb >> 9) & 1) << 5); R = (st >> 1) * 16 + swz / 64; C = (st & 1) * 32 + (swz % 64) / 2; }
__host__ __device__ __forceinline__ int perm32(int rho) { const int n = rho >> 4, i = rho & 15; return 8 * (i >> 2) + 4 * n + (i & 3); }

typedef int v8i __attribute__((ext_vector_type(8)));
typedef int v4i __attribute__((ext_vector_type(4)));
struct Unit { int pm, pn, g; };
struct Gemm { const void* A; const void* Bt; int Kb; size_t gstride; };

struct Order {
    int nM, nN, nwg, G, c, gdiv; const int* tile_g;
    __device__ __forceinline__ void init(int nM_, int nN_, int G_, int c_, const int* tg, int gd) { nM = nM_; nN = nN_; nwg = nM * nN; G = G_; c = c_; tile_g = tg; gdiv = gd; }
    __device__ __forceinline__ bool next(int i, Unit& u) const {
        const long L = (long)i * G + c; if (L >= nwg) return false;
        int wgid = (int)L; { const int q = nwg / NXCD, r = nwg % NXCD, xcd = wgid % NXCD, off = wgid / NXCD; wgid = (xcd < r ? xcd * (q + 1) : r * (q + 1) + (xcd - r) * q) + off; }
        const int nig = WGM * nN, gid = wgid / nig, fm = gid * WGM, gsz = (nM - fm) < WGM ? (nM - fm) : WGM;
        u.pm = fm + ((wgid % nig) % gsz); u.pn = (wgid % nig) / gsz;
        if (tile_g) { const int* tg = tile_g; asm volatile("" : "+s"(tg)); u.g = __builtin_amdgcn_readfirstlane(tg[u.pm]); }
        else u.g = gdiv ? u.pm / gdiv : 0;
        return true;
    }
    __device__ __forceinline__ bool next_lane(int i, Unit& u) const {
        const long L = (long)i * G + c; if (L >= nwg) return false;
        int wgid = (int)L; { const int q = nwg / NXCD, r = nwg % NXCD, xcd = wgid % NXCD, off = wgid / NXCD; wgid = (xcd < r ? xcd * (q + 1) : r * (q + 1) + (xcd - r) * q) + off; }
        const int nig = WGM * nN, gid = wgid / nig, fm = gid * WGM, gsz = (nM - fm) < WGM ? (nM - fm) : WGM;
        u.pm = fm + ((wgid % nig) % gsz); u.pn = (wgid % nig) / gsz;
        if (tile_g) u.g = ((const PG8_GAS int*)tile_g)[u.pm]; else u.g = gdiv ? u.pm / gdiv : 0;
        return true;
    }
};
constexpr int ORD_ENT = 48;
struct OrderT {
    const PG8_LAS v4i* tab;
    __device__ __forceinline__ bool next(int i, Unit& u) const {
        const v4i e = tab[i < ORD_ENT - 1 ? i : ORD_ENT - 1];
        u.pm = __builtin_amdgcn_readfirstlane(e.x); u.pn = __builtin_amdgcn_readfirstlane(e.y); u.g = __builtin_amdgcn_readfirstlane(e.z);
        return __builtin_amdgcn_readfirstlane(e.w) != 0;
    }
};
__device__ __forceinline__ OrderT order_table(const Order& S, PG8_LAS unsigned char* lds_tab, int tid) {
    PG8_LAS v4i* t = (PG8_LAS v4i*)lds_tab;
    if (tid < ORD_ENT) { Unit u; u.pm = 0; u.pn = 0; u.g = 0; const bool ok = (tid < ORD_ENT - 1) && S.next_lane(tid, u); v4i e; e.x = u.pm; e.y = u.pn; e.z = u.g; e.w = ok ? 1 : 0; t[tid] = e; }
    __syncthreads();
    OrderT r; r.tab = t; return r;
}

__device__ __forceinline__ unsigned cvt_pk_bf16(float lo, float hi) { unsigned r; asm volatile("v_cvt_pk_bf16_f32 %0, %1, %2" : "=v"(r) : "v"(lo), "v"(hi)); return r; }
__device__ __forceinline__ u32x4 pack8(const f32x4 a, const f32x4 b) { u32x4 w; w.x = cvt_pk_bf16(a[0], a[1]); w.y = cvt_pk_bf16(a[2], a[3]); w.z = cvt_pk_bf16(b[0], b[1]); w.w = cvt_pk_bf16(b[2], b[3]); return w; }
__device__ __forceinline__ float sigmoidf_fast(float x) { return __builtin_amdgcn_rcpf(1.0f + __builtin_amdgcn_exp2f(-1.4426950408889634f * x)); }
__device__ __forceinline__ f32x4 sig4(const f32x4 x) { f32x4 r; r[0] = sigmoidf_fast(x[0]); r[1] = sigmoidf_fast(x[1]); r[2] = sigmoidf_fast(x[2]); r[3] = sigmoidf_fast(x[3]); return r; }

__device__ __forceinline__ f32x4 swiglu4(const f32x4 a, const f32x4 b, const float rt, const float irq  ) {
    const f32x4 t = a * rt; f32x4 r;
#pragma unroll
    for (int i = 0; i < 4; ++i) { const float e = __builtin_amdgcn_exp2f(t[i]); r[i] = __builtin_amdgcn_rcpf(__builtin_fmaf(e, irq, irq)); }
    return (a * b) * r;
}

__device__ __forceinline__ float fq_sum(float ss) {
    { const auto r = __builtin_amdgcn_permlane16_swap(__builtin_bit_cast(unsigned, ss), __builtin_bit_cast(unsigned, ss), false, false); ss = __builtin_bit_cast(float, (unsigned)r[0]) + __builtin_bit_cast(float, (unsigned)r[1]); }
    { const auto r = __builtin_amdgcn_permlane32_swap(__builtin_bit_cast(unsigned, ss), __builtin_bit_cast(unsigned, ss), false, false); ss = __builtin_bit_cast(float, (unsigned)r[0]) + __builtin_bit_cast(float, (unsigned)r[1]); }
    return ss;
}
struct Gain16 { f32x4 a, b, c, d; };
__device__ __forceinline__ Gain16 load_gain16(const float* gl  ) { Gain16 g; g.a = *(const PG8_GAS f32x4*)(gl); g.b = *(const PG8_GAS f32x4*)(gl + 4); g.c = *(const PG8_GAS f32x4*)(gl + 32); g.d = *(const PG8_GAS f32x4*)(gl + 36); return g; }
__device__ __forceinline__ void headnorm_store(const f32x4 (&acc)[2][2][4][2], int ai, int m, bool norm, const Gain16& gn, float sc, bf16_t* rowp  , int lane, float pre = 1.0f  ) {
    f32x4 v00 = acc[ai][0][m][0] * pre, v01 = acc[ai][0][m][1] * pre, v10 = acc[ai][1][m][0] * pre, v11 = acc[ai][1][m][1] * pre;
    if (norm) {
        const f32x4 q = v00 * v00 + v01 * v01 + v10 * v10 + v11 * v11;
        float ss = (q[0] + q[1]) + (q[2] + q[3]);
        ss += __builtin_bit_cast(float, __builtin_amdgcn_ds_bpermute((lane ^ 16) << 2, __builtin_bit_cast(int, ss))); ss += __builtin_bit_cast(float, __builtin_amdgcn_ds_bpermute((lane ^ 32) << 2, __builtin_bit_cast(int, ss)));
        const float r = __builtin_amdgcn_rsqf(ss * (1.0f / 64.0f) + lconst(1e-6f)) * sc;
        v00 = v00 * r * gn.a; v01 = v01 * r * gn.b; v10 = v10 * r * gn.c; v11 = v11 * r * gn.d;
    }
    *(PG8_GAS u32x4*)(rowp) = pack8(v00, v01);
    *(PG8_GAS u32x4*)(rowp + 32) = pack8(v10, v11);
}
__device__ __forceinline__ float row_rs(const float* ssq, int row) {
    const f32x4 a = *(const PG8_GAS f32x4*)(ssq + (size_t)row * 16), b = *(const PG8_GAS f32x4*)(ssq + (size_t)row * 16 + 4), c = *(const PG8_GAS f32x4*)(ssq + (size_t)row * 16 + 8), d = *(const PG8_GAS f32x4*)(ssq + (size_t)row * 16 + 12);
    const f32x4 t = (a + b) + (c + d); return __builtin_amdgcn_rsqf(((t[0] + t[1]) + (t[2] + t[3])) * (1.0f / 1024.0f) + 1e-6f);
}
__device__ __forceinline__ void row_scales(float (&rsv)[2][4], const float* ssq, int row0, int fr, int fq) {
    f32x4 t[2][4]; const int lane = fq * 16 + fr; const float eps_ = lconst(1e-6f);
#pragma unroll
    for (int ai = 0; ai < 2; ++ai)
#pragma unroll
        for (int m = 0; m < 4; ++m) t[ai][m] = *(const PG8_GAS f32x4*)(ssq + (size_t)(row0 + ai * HALF + m * 16) * 16 + 4 * fq);
#pragma unroll
    for (int ai = 0; ai < 2; ++ai)
#pragma unroll
        for (int m = 0; m < 4; ++m) { float ss = (t[ai][m][0] + t[ai][m][1]) + (t[ai][m][2] + t[ai][m][3]);
            ss += __builtin_bit_cast(float, __builtin_amdgcn_ds_bpermute((lane ^ 16) << 2, __builtin_bit_cast(int, ss))); ss += __builtin_bit_cast(float, __builtin_amdgcn_ds_bpermute((lane ^ 32) << 2, __builtin_bit_cast(int, ss)));
            rsv[ai][m] = __builtin_amdgcn_rsqf(ss * (1.0f / 1024.0f) + eps_); }
}
struct EpiInEven {
    static constexpr bool PERM = true, AFTER_DRAIN = false;
    bf16_t* QKV; bf16_t* MQ; const float* gt; float isc = 1.0f;
    __device__ __forceinline__ void operator()(const f32x4 (&acc)[2][2][4][2], const Unit& u, int wr, int wc, int fr, int fq) const {
        const int row0 = u.pm * BM + wr * 64 + fr; const int pn = u.pn;
        float isc_ = isc; asm volatile("" : "+v"(isc_));
        const bool norm = (pn < 6) || (pn == 9);
        const int sel = pn < 3 ? 0 : (pn < 6 ? 1 : 2);
        const Gain16 gn = load_gain16(gt + 64 * sel + 8 * fq);
        const int ld = (pn == 9) ? MEMD : 3 * FOXD;
        const size_t dofs = (pn == 9) ? (size_t)((const char*)MQ - (const char*)QKV) / 2 : (size_t)256 * pn;
        bf16_t* dst = QKV + dofs + 64 * wc + 8 * fq;
#pragma unroll
        for (int ai = 0; ai < 2; ++ai)
#pragma unroll
            for (int m = 0; m < 4; ++m) headnorm_store(acc, ai, m, norm, gn, 1.0f, dst + (size_t)(row0 + ai * HALF + m * 16) * ld, fq * 16 + fr, isc_);
    }
};
struct EpiMemKV {
    static constexpr bool PERM = true, AFTER_DRAIN = false;
    bf16_t* MKV; const float* gmk;
    __device__ __forceinline__ void operator()(const f32x4 (&acc)[2][2][4][2], const Unit& u, int wr, int wc, int fr, int fq) const {
        const int row0 = u.pm * BM + wr * 64 + fr;
        const Gain16 gn = load_gain16(gmk + 64 * u.g + 8 * fq);
        bf16_t* dst = MKV + 256 * u.pn + 64 * wc + 8 * fq;
#pragma unroll
        for (int ai = 0; ai < 2; ++ai)
#pragma unroll
            for (int m = 0; m < 4; ++m) headnorm_store(acc, ai, m, u.pn == 0, gn, 1.0f, dst + (size_t)(row0 + ai * HALF + m * 16) * 512, fq * 16 + fr);
    }
};
struct EpiInOdd {
    static constexpr bool PERM = true, AFTER_DRAIN = false;
    bf16_t* GLU; bf16_t* MQ; const float* bias; const float* gmq; const float* ssq; float isc = 1.0f;
    __device__ __forceinline__ void operator()(f32x4 (&acc)[2][2][4][2], const Unit& u, int wr, int wc, int fr, int fq) const {
        const int row0 = u.pm * BM + wr * 64 + fr;
        if (ssq) { float rsv[2][4]; row_scales(rsv, ssq, row0, fr, fq); float isc_ = isc; asm volatile("" : "+v"(isc_));
#pragma unroll
            for (int ai = 0; ai < 2; ++ai)
#pragma unroll
                for (int m = 0; m < 4; ++m) { const float rs = rsv[ai][m] * isc_;
#pragma unroll
                    for (int bj = 0; bj < 2; ++bj)
#pragma unroll
                        for (int n = 0; n < 2; ++n) acc[ai][bj][m][n] = acc[ai][bj][m][n] * rs; }
        }
        if (u.pn == 6) {
            const Gain16 gn = load_gain16(gmq + 8 * fq);
            bf16_t* dst = MQ + 64 * wc + 8 * fq;
#pragma unroll
            for (int ai = 0; ai < 2; ++ai)
#pragma unroll
                for (int m = 0; m < 4; ++m) headnorm_store(acc, ai, m, true, gn, 1.0f, dst + (size_t)(row0 + ai * HALF + m * 16) * MEMD, fq * 16 + fr);
        } else {
            const int col0 = u.pn * 128 + wc * 32 + 8 * fq;
            const f32x4 ba0 = *(const PG8_GAS f32x4*)(bias + col0), ba1 = *(const PG8_GAS f32x4*)(bias + col0 + 4), bg0 = *(const PG8_GAS f32x4*)(bias + CONVD + col0), bg1 = *(const PG8_GAS f32x4*)(bias + CONVD + col0 + 4);
#pragma unroll
            for (int ai = 0; ai < 2; ++ai)
#pragma unroll
                for (int m = 0; m < 4; ++m) {
                    const f32x4 o0 = (acc[ai][0][m][0] + ba0) * sig4(acc[ai][1][m][0] + bg0), o1 = (acc[ai][0][m][1] + ba1) * sig4(acc[ai][1][m][1] + bg1);
                    *(PG8_GAS u32x4*)(GLU + (size_t)(row0 + ai * HALF + m * 16) * CONVD + col0) = pack8(o0, o1);
                }
        }
    }
};
struct EpiSwiGLU {
    static constexpr bool PERM = true, AFTER_DRAIN = false;
    bf16_t* O; int ldc; const float* ssq;
    __device__ __forceinline__ void operator()(const f32x4 (&acc)[2][2][4][2], const Unit& u, int wr, int wc, int fr, int fq) const {
        const int row0 = u.pm * BM + wr * 64 + fr; const int col0 = u.pn * 128 + wc * 32 + 8 * fq;
        float rsv[2][4]; float nl2 = -1.4426950408889634f; asm volatile("" : "+v"(nl2));
        if (ssq) row_scales(rsv, ssq, row0, fr, fq);
        else {
#pragma unroll
            for (int ai = 0; ai < 2; ++ai)
#pragma unroll
                for (int m = 0; m < 4; ++m) rsv[ai][m] = 1.0f; }
#pragma unroll
        for (int ai = 0; ai < 2; ++ai)
#pragma unroll
            for (int m = 0; m < 4; ++m) {
                const float rs = rsv[ai][m], rt = rs * nl2, rq = __builtin_amdgcn_rcpf(rs * rs);
                const f32x4 o0 = swiglu4(acc[ai][0][m][0], acc[ai][1][m][0], rt, rq), o1 = swiglu4(acc[ai][0][m][1], acc[ai][1][m][1], rt, rq);
                *(PG8_GAS u32x4*)(O + (size_t)(row0 + ai * HALF + m * 16) * ldc + col0) = pack8(o0, o1);
            }
    }
};
__device__ __forceinline__ unsigned pk4_fp8(const f32x4 v) { int p = __builtin_amdgcn_cvt_pk_fp8_f32(v[0], v[1], __builtin_bit_cast(int, v[0])  , false); p = __builtin_amdgcn_cvt_pk_fp8_f32(v[2], v[3], p, true); return (unsigned)p; }
__device__ __forceinline__ f32x4 clamp8(const f32x4 v, const float c) { f32x4 r; r[0] = __builtin_amdgcn_fmed3f(v[0], -c, c); r[1] = __builtin_amdgcn_fmed3f(v[1], -c, c); r[2] = __builtin_amdgcn_fmed3f(v[2], -c, c); r[3] = __builtin_amdgcn_fmed3f(v[3], -c, c); return r; }
template <bool OUT16> struct EpiSwiGLU8T {
    static constexpr bool PERM = true, AFTER_DRAIN = false;
    unsigned char* O; int ldc; float isc, osc; const float* ssq;
    __device__ __forceinline__ void operator()(const f32x4 (&acc)[2][2][4][2], const Unit& u, int wr, int wc, int fr, int fq) const {
#ifdef PROBE_EPI2
        for (int rp_ = 0; rp_ < 2; ++rp_) { asm volatile("" ::: "memory");
#endif
        const int row0 = u.pm * BM + wr * 64 + fr; const int col0 = u.pn * 128 + wc * 32 + 8 * fq;
        float isc_ = isc, uo = OUT16 ? isc : isc * osc, c448 = 448.f, nl2 = -1.4426950408889634f; asm volatile("" : "+v"(isc_), "+v"(uo), "+v"(c448), "+v"(nl2));
        float rsv[2][4];
        if (ssq) row_scales(rsv, ssq, row0, fr, fq);
        else {
#pragma unroll
            for (int ai = 0; ai < 2; ++ai)
#pragma unroll
                for (int m = 0; m < 4; ++m) rsv[ai][m] = 1.0f; }
#pragma unroll
        for (int ai = 0; ai < 2; ++ai)
#pragma unroll
            for (int m = 0; m < 4; ++m) {
                const float ri = rsv[ai][m] * isc_, rt = ri * nl2, rq = __builtin_amdgcn_rcpf(ri * (rsv[ai][m] * uo));
                const f32x4 o0 = swiglu4(acc[ai][0][m][0], acc[ai][1][m][0], rt, rq), o1 = swiglu4(acc[ai][0][m][1], acc[ai][1][m][1], rt, rq);
                if constexpr (OUT16) *(PG8_GAS u32x4*)((bf16_t*)O + (size_t)(row0 + ai * HALF + m * 16) * ldc + col0) = pack8(o0, o1);
                else { typedef unsigned u32x2 __attribute__((ext_vector_type(2)));
                u32x2 w; w.x = pk4_fp8(clamp8(o0, c448)); w.y = pk4_fp8(clamp8(o1, c448));
                *(PG8_GAS u32x2*)(O + (size_t)(row0 + ai * HALF + m * 16) * ldc + col0) = w; }
                __builtin_amdgcn_sched_barrier(0);
            }
#ifdef PROBE_EPI2
        }
#endif
    }
};
typedef EpiSwiGLU8T<false> EpiSwiGLU8;
typedef EpiSwiGLU8T<true> EpiSwiGLU8B;
struct EpiResid {
    static constexpr bool PERM = true, AFTER_DRAIN = false;
    const float* base32; bf16_t* h16; float isc; float* ssq; unsigned char* h8;
    __device__ __forceinline__ void operator()(const f32x4 (&acc)[2][2][4][2], const Unit& u, int wr, int wc, int fr, int fq) const {
        const int row0 = u.pm * BM + wr * 64 + fr; const int col0 = u.pn * BM + wc * 32 + 8 * fq;
        float isc_ = isc, c448 = 448.f; asm volatile("" : "+v"(isc_), "+v"(c448)); const int lane = fq * 16 + fr;
        auto rowof = [&](int gi) { return row0 + (gi >> 2) * HALF + (gi & 3) * 16; };
        auto finish = [&](int gi, const f32x4 (&cu)[2][2]) { const int ai = gi >> 2, m = gi & 3; const int row = rowof(gi);
            float ss = 0.f;
#pragma unroll
            for (int bj = 0; bj < 2; ++bj) { const f32x4 o0 = cu[bj][0] + acc[ai][bj][m][0] * isc_, o1 = cu[bj][1] + acc[ai][bj][m][1] * isc_;
                *(PG8_GAS u32x4*)(h16 + (size_t)row * DM + col0 + bj * HALF) = pack8(o0, o1);
                if (ssq) { const f32x4 q = o0 * o0 + o1 * o1; ss += (q[0] + q[1]) + (q[2] + q[3]); }
                if (h8) { typedef unsigned u32x2 __attribute__((ext_vector_type(2))); u32x2 w; w.x = pk4_fp8(clamp8(o0 * ASC_Z, c448)); w.y = pk4_fp8(clamp8(o1 * ASC_Z, c448)); *(PG8_GAS u32x2*)(h8 + (size_t)row * DM + col0 + bj * HALF) = w; } }
            if (ssq) { ss += __builtin_bit_cast(float, __builtin_amdgcn_ds_bpermute((lane ^ 16) << 2, __builtin_bit_cast(int, ss))); ss += __builtin_bit_cast(float, __builtin_amdgcn_ds_bpermute((lane ^ 32) << 2, __builtin_bit_cast(int, ss)));
                if (fq == 0) *(PG8_GAS float*)(ssq + (size_t)row * 16 + u.pn * 4 + wc) = ss; }
            __builtin_amdgcn_sched_barrier(0); };
        if (base32) {
#pragma unroll
            for (int hb = 0; hb < 2; ++hb) { f32x4 rf[4][2][2];
#pragma unroll
                for (int g = 0; g < 4; ++g)
#pragma unroll
                    for (int bj = 0; bj < 2; ++bj) { const size_t p = (size_t)rowof(4 * hb + g) * DM + col0 + bj * HALF; rf[g][bj][0] = *(const PG8_GAS f32x4*)(base32 + p); rf[g][bj][1] = *(const PG8_GAS f32x4*)(base32 + p + 4); }
                __builtin_amdgcn_sched_barrier(0);
#pragma unroll
                for (int g = 0; g < 4; ++g) finish(4 * hb + g, rf[g]); }
        } else {
            u32x4 rw[8][2];
#pragma unroll
            for (int gi = 0; gi < 8; ++gi)
#pragma unroll
                for (int bj = 0; bj < 2; ++bj) rw[gi][bj] = *(const PG8_GAS u32x4*)(h16 + (size_t)rowof(gi) * DM + col0 + bj * HALF);
            __builtin_amdgcn_sched_barrier(0);
#pragma unroll
            for (int gi = 0; gi < 8; ++gi) { f32x4 cu[2][2];
#pragma unroll
                for (int bj = 0; bj < 2; ++bj) { const u32x4 w = rw[gi][bj];
                    cu[bj][0] = (f32x4){__builtin_bit_cast(float, w.x << 16), __builtin_bit_cast(float, w.x & 0xffff0000u), __builtin_bit_cast(float, w.y << 16), __builtin_bit_cast(float, w.y & 0xffff0000u)};
                    cu[bj][1] = (f32x4){__builtin_bit_cast(float, w.z << 16), __builtin_bit_cast(float, w.z & 0xffff0000u), __builtin_bit_cast(float, w.w << 16), __builtin_bit_cast(float, w.w & 0xffff0000u)}; }
                finish(gi, cu); }
        }
    }
};
struct EpiRowGate {
    static constexpr bool PERM = true, AFTER_DRAIN = false;
    bf16_t* Y; const float* rowg; int ldc; float isc;
    __device__ __forceinline__ void operator()(const f32x4 (&acc)[2][2][4][2], const Unit& u, int wr, int wc, int fr, int fq) const {
        const int row0 = u.pm * BM + wr * 64 + fr; const int col0 = u.pn * BM + wc * 32 + 8 * fq;
        float isc_ = isc; asm volatile("" : "+v"(isc_));
        float rgv[2][4];
#pragma unroll
        for (int ai = 0; ai < 2; ++ai)
#pragma unroll
            for (int m = 0; m < 4; ++m) rgv[ai][m] = *(const PG8_GAS float*)(rowg + row0 + ai * HALF + m * 16);
#pragma unroll
        for (int ai = 0; ai < 2; ++ai)
#pragma unroll
            for (int m = 0; m < 4; ++m) { const int row = row0 + ai * HALF + m * 16; const float rg = rgv[ai][m] * isc_;
#pragma unroll
                for (int bj = 0; bj < 2; ++bj) *(PG8_GAS u32x4*)(Y + (size_t)row * ldc + col0 + bj * HALF) = pack8(acc[ai][bj][m][0] * rg, acc[ai][bj][m][1] * rg);
                __builtin_amdgcn_sched_barrier(0); }
    }
};

template <class Epi, class Sched, bool ALIGN_EPI = false, bool SP2 = false, bool F8 = false>
__device__ __forceinline__ void gemm_phase(PG8_LAS unsigned char* lds, const Gemm g, const Sched& S, const Epi& E, const int wave_in  ) {
    int lane; asm volatile("v_mbcnt_lo_u32_b32 %0, -1, 0\n\tv_mbcnt_hi_u32_b32 %0, -1, %0" : "=v"(lane));
    const int wid = wave_in, tid = wave_in * 64 + lane, wr = wid >> 2, wc = wid & 3, fr = lane & 15, fq = lane >> 4;
    const int Kb = g.Kb, nt = Kb / (BK * 2);
    unsigned voffA, voffB;
    { int R, C; stage_rc(tid * 16, R, C); const int Rb = Epi::PERM ? ((R & ~31) + perm32(R & 31)) : R; voffA = (unsigned)(R * Kb + C * 2); voffB = (unsigned)(Rb * Kb + C * 2); }
    const size_t pstep = (size_t)64 * Kb;
    const size_t kstep = (size_t)(BK * 2);
    const size_t hstep = (size_t)HALF * Kb;
    const size_t tstep = 2 * hstep;
    const unsigned ldsw = (unsigned)wid * 1024u;
    const unsigned lds0 = (unsigned)(uintptr_t)lds;
    const int aoff = lds_byte(wr * 64 + fr, fq * 8), boff = lds_byte(wc * 32 + fr, fq * 8);
    PG8_LAS unsigned char* pa = lds + aoff; PG8_LAS unsigned char* pb = lds + 4 * HTB + boff; asm volatile("" : "+v"(pa), "+v"(pb));
#define PG8_SA(b, h) (((b) * 2 + (h)) * HTB)
#define PG8_SB(b, h) ((4 + (b) * 2 + (h)) * HTB)
#define PG8_GLDS(voff32, gbase, ldsdst) do { unsigned keep_; asm volatile("s_mov_b32 %0, m0\n\ts_mov_b32 m0, %3\n\ts_nop 0\n\tglobal_load_lds_dwordx4 %1, %2\n\ts_mov_b32 m0, %0" \
        : "=&s"(keep_) : "v"(voff32), "s"(gbase), "s"(ldsdst) : "memory"); } while (0)
#define PG8_STAGE(bufoff, gbase, voff) do { _Pragma("unroll") for (int _i = 0; _i < 2; ++_i) \
        PG8_GLDS((voff), (const char*)(gbase) + _i * pstep, (unsigned)__builtin_amdgcn_readfirstlane((int)(lds0 + (unsigned)(bufoff) + ldsw + (unsigned)(_i * 8192)))); } while (0)
#define PG8_RDA(off) (*(const PG8_LAS v4i*)(pa + (off)))
#define PG8_RDB(off) (*(const PG8_LAS v4i*)(pb + (off)))
#define PG8_LDA(dst, b, h) do { _Pragma("unroll") for (int m = 0; m < 4; ++m) { \
        if constexpr (F8) dst##8[m] = __builtin_shufflevector(PG8_RDA(PG8_SA(b, h) + m * 2048), PG8_RDA(PG8_SA(b, h) + m * 2048 + 1024), 0, 1, 2, 3, 4, 5, 6, 7); \
        else { _Pragma("unroll") for (int k = 0; k < 2; ++k) dst[m][k] = *(const PG8_LAS bf16x8*)(pa + PG8_SA(b, h) + m * 2048 + k * 1024); } } } while (0)
#define PG8_LDB(dst, b, h) do { _Pragma("unroll") for (int n = 0; n < 2; ++n) { \
        if constexpr (F8) dst##8[n] = __builtin_shufflevector(PG8_RDB(PG8_SB(b, h) - 4 * HTB + n * 2048), PG8_RDB(PG8_SB(b, h) - 4 * HTB + n * 2048 + 1024), 0, 1, 2, 3, 4, 5, 6, 7); \
        else { _Pragma("unroll") for (int k = 0; k < 2; ++k) dst[n][k] = *(const PG8_LAS bf16x8*)(pb + PG8_SB(b, h) - 4 * HTB + n * 2048 + k * 1024); } } } while (0)
#define PG8_MMA(ai, bj, Af, Bf) do { __builtin_amdgcn_s_setprio(1); _Pragma("unroll") for (int m = 0; m < 4; ++m) _Pragma("unroll") for (int n = 0; n < 2; ++n) { \
        if constexpr (F8) acc[ai][bj][m][n] = __builtin_amdgcn_mfma_scale_f32_16x16x128_f8f6f4(Bf##8[n], Af##8[m], acc[ai][bj][m][n], 0, 0, 0, sc1_, 0, sc1_); \
        else { _Pragma("unroll") for (int k = 0; k < 2; ++k) acc[ai][bj][m][n] = __builtin_amdgcn_mfma_f32_16x16x32_bf16(Bf[n][k], Af[m][k], acc[ai][bj][m][n], 0, 0, 0); } } \
        __builtin_amdgcn_s_setprio(0); } while (0)
#define PG8_WAIT_V(n) asm volatile("s_waitcnt vmcnt(" #n ")" ::: "memory")
#define PG8_WAIT_L(n) asm volatile("s_waitcnt lgkmcnt(" #n ")" ::: "memory")
#define PG8_BAR __builtin_amdgcn_s_barrier()
#define PG8_SCHED __builtin_amdgcn_sched_barrier(0)
    int sc1_ = 0x7f7f7f7f; asm volatile("" : "+v"(sc1_));
    Unit cur, nxt; int ui = 0;
    if (!S.next(0, cur)) return;
    f32x4 acc[2][2][4][2];
#pragma unroll
    for (int a = 0; a < 2; ++a)
#pragma unroll
        for (int b = 0; b < 2; ++b)
#pragma unroll
            for (int m = 0; m < 4; ++m)
#pragma unroll
                for (int n = 0; n < 2; ++n) acc[a][b][m][n] = (f32x4){0.f, 0.f, 0.f, 0.f};
    bf16x8 At[4][2], B0[2][2], B1[2][2]; v8i At8[4], B08[2], B18[2];
    const char* cA = (const char*)g.A + (size_t)cur.pm * tstep; const char* cB = (const char*)g.Bt + (size_t)cur.g * g.gstride + (size_t)cur.pn * tstep;
    if constexpr (SP2) {
        PG8_STAGE(PG8_SB(0, 0), cB, voffB); PG8_STAGE(PG8_SB(0, 1), cB + hstep, voffB); PG8_STAGE(PG8_SA(0, 0), cA, voffA); PG8_STAGE(PG8_SA(0, 1), cA + hstep, voffA);
        if (wr == 1) PG8_BAR;
        PG8_WAIT_V(2); PG8_BAR;
        PG8_STAGE(PG8_SB(1, 0), cB + kstep, voffB); PG8_STAGE(PG8_SA(1, 0), cA + kstep, voffA); PG8_STAGE(PG8_SB(1, 1), cB + hstep + kstep, voffB);
        PG8_WAIT_V(6); PG8_BAR;
    } else {
        PG8_STAGE(PG8_SB(0, 0), cB, voffB); PG8_STAGE(PG8_SA(0, 0), cA, voffA); PG8_STAGE(PG8_SB(0, 1), cB + hstep, voffB); PG8_STAGE(PG8_SA(0, 1), cA + hstep, voffA);
        if (wr == 1) PG8_BAR;
        PG8_WAIT_V(4); PG8_BAR;
        PG8_STAGE(PG8_SB(1, 0), cB + kstep, voffB); PG8_STAGE(PG8_SA(1, 0), cA + kstep, voffA); PG8_STAGE(PG8_SB(1, 1), cB + hstep + kstep, voffB);
        PG8_WAIT_V(6); PG8_BAR;
    }
    for (;;) {
        const bool has_next = S.next(ui + 1, nxt);
        const char* nA = has_next ? (const char*)g.A + (size_t)nxt.pm * tstep : cA; const char* nB = has_next ? (const char*)g.Bt + (size_t)nxt.g * g.gstride + (size_t)nxt.pn * tstep : cB;
#pragma unroll 1
        for (int t = 0; t < nt; t += 2) {
            const bool last = (t == nt - 2);
            const char* a1 = cA + (size_t)(t + 1) * kstep;
            const char* a2 = last ? nA : cA + (size_t)(t + 2) * kstep; const char* b2 = last ? nB : cB + (size_t)(t + 2) * kstep;
            const char* a3 = a2 + kstep; const char* b3 = b2 + kstep;
            if constexpr (SP2) {
            PG8_LDB(B0, 0, 0); PG8_LDB(B1, 0, 1); PG8_SCHED; PG8_LDA(At, 0, 0); PG8_STAGE(PG8_SA(1, 1), a1 + hstep, voffA);
            PG8_WAIT_V(8); PG8_WAIT_L(0); PG8_BAR; PG8_MMA(0, 0, At, B0); PG8_MMA(0, 1, At, B1); PG8_BAR; PG8_SCHED;
            PG8_LDA(At, 0, 1); PG8_STAGE(PG8_SB(0, 0), b2, voffB); PG8_STAGE(PG8_SB(0, 1), b2 + hstep, voffB); PG8_STAGE(PG8_SA(0, 0), a2, voffA);
            PG8_WAIT_V(8); PG8_WAIT_L(0); PG8_BAR; PG8_MMA(1, 0, At, B0); PG8_MMA(1, 1, At, B1); PG8_BAR; PG8_SCHED;
            PG8_LDB(B0, 1, 0); PG8_LDB(B1, 1, 1); PG8_SCHED; PG8_LDA(At, 1, 0); PG8_STAGE(PG8_SA(0, 1), a2 + hstep, voffA);
            PG8_WAIT_V(8); PG8_WAIT_L(0); PG8_BAR; PG8_MMA(0, 0, At, B0); PG8_MMA(0, 1, At, B1); PG8_BAR; PG8_SCHED;
            PG8_LDA(At, 1, 1); PG8_STAGE(PG8_SB(1, 0), b3, voffB); PG8_STAGE(PG8_SB(1, 1), b3 + hstep, voffB); PG8_STAGE(PG8_SA(1, 0), a3, voffA);
            PG8_WAIT_V(8); PG8_WAIT_L(0); PG8_BAR; PG8_MMA(1, 0, At, B0); PG8_MMA(1, 1, At, B1); PG8_BAR; PG8_SCHED;
            } else {
            PG8_LDB(B0, 0, 0); PG8_SCHED; PG8_LDA(At, 0, 0); PG8_STAGE(PG8_SA(1, 1), a1 + hstep, voffA);
            PG8_WAIT_L(8); PG8_BAR; PG8_WAIT_L(0); PG8_MMA(0, 0, At, B0); PG8_BAR; PG8_SCHED;
            PG8_LDB(B1, 0, 1); PG8_STAGE(PG8_SB(0, 0), b2, voffB);
            PG8_BAR; PG8_WAIT_L(0); PG8_MMA(0, 1, At, B1); PG8_BAR;
            PG8_LDA(At, 0, 1); PG8_STAGE(PG8_SA(0, 0), a2, voffA);
            PG8_BAR; PG8_WAIT_L(0); PG8_MMA(1, 0, At, B0); PG8_BAR; PG8_SCHED;
            PG8_STAGE(PG8_SB(0, 1), b2 + hstep, voffB);
            PG8_WAIT_V(6); PG8_BAR; PG8_MMA(1, 1, At, B1); PG8_BAR;
            PG8_LDB(B0, 1, 0); PG8_SCHED; PG8_LDA(At, 1, 0); PG8_STAGE(PG8_SA(0, 1), a2 + hstep, voffA);
            PG8_WAIT_L(8); PG8_BAR; PG8_WAIT_L(0); PG8_MMA(0, 0, At, B0); PG8_BAR; PG8_SCHED;
            PG8_LDB(B1, 1, 1); PG8_STAGE(PG8_SB(1, 0), b3, voffB);
            PG8_BAR; PG8_WAIT_L(0); PG8_MMA(0, 1, At, B1); PG8_BAR;
            PG8_LDA(At, 1, 1); PG8_STAGE(PG8_SA(1, 0), a3, voffA);
            PG8_BAR; PG8_WAIT_L(0); PG8_MMA(1, 0, At, B0); PG8_BAR; PG8_SCHED;
            PG8_STAGE(PG8_SB(1, 1), b3 + hstep, voffB);
            PG8_WAIT_V(6); PG8_BAR; PG8_MMA(1, 1, At, B1); PG8_BAR;
            }
        }
        if constexpr (ALIGN_EPI) { if (wr == 0) PG8_BAR; }
        { int lz; asm volatile("v_mbcnt_lo_u32_b32 %0, -1, 0\n\tv_mbcnt_hi_u32_b32 %0, -1, %0" : "=v"(lz));
          E(acc, cur, wr, wc, lz & 15, lz >> 4); }
        if (!has_next) break;
#pragma unroll
        for (int a = 0; a < 2; ++a)
#pragma unroll
            for (int b = 0; b < 2; ++b)
#pragma unroll
                for (int m = 0; m < 4; ++m)
#pragma unroll
                    for (int n = 0; n < 2; ++n) { typedef double d2_t __attribute__((ext_vector_type(2))); d2_t z_;
                        asm volatile("v_mov_b64 %0, 0" : "=v"(z_.x)); asm volatile("v_mov_b64 %0, 0" : "=v"(z_.y)); acc[a][b][m][n] = __builtin_bit_cast(f32x4, z_); }
        cur = nxt; cA = nA; cB = nB; ++ui;
        if constexpr (ALIGN_EPI) { if (wr == 1) PG8_BAR; }
    }
    PG8_WAIT_V(0);
    if constexpr (!ALIGN_EPI) { if (wr == 0) PG8_BAR; }
    PG8_BAR;
#undef PG8_SA
#undef PG8_SB
#undef PG8_STAGE
#undef PG8_GLDS
#undef PG8_LDA
#undef PG8_LDB
#undef PG8_MMA
#undef PG8_RDA
#undef PG8_RDB
#undef PG8_WAIT_V
#undef PG8_WAIT_L
#undef PG8_BAR
#undef PG8_SCHED
}
}
namespace attn_body {
using bf16=__hip_bfloat16;
using bf16x8=__attribute__((ext_vector_type(8)))short;
using s16x4=__attribute__((ext_vector_type(4)))short;
using f32x16=__attribute__((ext_vector_type(16)))float;
using f32x4=__attribute__((ext_vector_type(4)))float;
using u32x4=__attribute__((ext_vector_type(4)))unsigned;
constexpr int D=64;
constexpr int NW=8,QBLK=32,QB=QBLK*NW,KVBLK=64;
__device__ __forceinline__ int crow(int r,int hi){return (r&3)+8*(r>>2)+4*hi;}
#define SBAR() __builtin_amdgcn_sched_barrier(0)
__device__ __forceinline__ void cmask(f32x16&p0,f32x16&p1,int jb,int qrel,int hi){
  const float NEG=lconst(-INFINITY); int kb=64*jb+4*hi;
  #pragma unroll
  for(int r=0;r<16;++r){int kv=kb+(r&3)+8*(r>>2); if(kv>qrel)p0[r]=NEG; if(kv+32>qrel)p1[r]=NEG;}
}
constexpr int NSLOT=3, SLOTB=8192;
constexpr int LDS_K=0, LDS_V=NSLOT*SLOTB, LDS_WS=2*NSLOT*SLOTB, LDS_OST=LDS_WS+NW*64*4, LDS_CB=LDS_OST+NW*4096, LDS_BYTES=LDS_CB+16384;
__device__ __forceinline__ void glds16(const void*gsrc,unsigned lds_dst){unsigned keep;
  asm volatile("s_mov_b32 %0, m0\n\ts_mov_b32 m0, %2\n\ts_nop 0\n\tglobal_load_lds_dwordx4 %1, off\n\ts_mov_b32 m0, %0":"=&s"(keep):"v"(gsrc),"s"(lds_dst):"memory");}
__device__ __forceinline__ float max3f(float a,float b,float c){float r;asm("v_max3_f32 %0, %1, %2, %3":"=v"(r):"v"(a),"v"(b),"v"(c));return r;}
__device__ __forceinline__ float max2f(float a,float b){float r;asm("v_max_f32_e32 %0, %1, %2":"=v"(r):"v"(a),"v"(b));return r;}
__device__ __forceinline__ float fadd_s(float a,float b){float r;asm("v_add_f32_e32 %0, %1, %2":"=v"(r):"v"(a),"v"(b));return r;}
__device__ __forceinline__ float fsub_s(float a,float b){float r;asm("v_sub_f32_e32 %0, %1, %2":"=v"(r):"v"(a),"v"(b));return r;}
typedef float f32x2_t __attribute__((ext_vector_type(2))); typedef __bf16 bf16x2_t __attribute__((ext_vector_type(2)));
__device__ __forceinline__ unsigned cvtpk_s(float lo,float hi){f32x2_t v={lo,hi};bf16x2_t b=__builtin_convertvector(v,bf16x2_t);return __builtin_bit_cast(unsigned,b);}
#define WAIT_BAR(N) asm volatile("s_waitcnt vmcnt(" #N ") lgkmcnt(0)\n\ts_barrier":::"memory")

__device__ __forceinline__ void qkt(f32x16&p0,f32x16&p1,const char*Kslot,const bf16x8*qr,int r32,int hi){
  const char*kb=Kslot+hi*1024+r32*16;
  #pragma unroll
  for(int d0=0;d0<4;++d0){
    const bf16x8 b0=*reinterpret_cast<const bf16x8*>(kb+d0*2048);
    const bf16x8 b1=*reinterpret_cast<const bf16x8*>(kb+d0*2048+512);
    p0=__builtin_amdgcn_mfma_f32_32x32x16_bf16(b0,qr[d0],p0,0,0,0);p1=__builtin_amdgcn_mfma_f32_32x32x16_bf16(b1,qr[d0],p1,0,0,0);}
}
typedef __attribute__((address_space(3))) const char* lds_cptr;
typedef short v4i16_t __attribute__((ext_vector_type(4)));
__device__ __forceinline__ void kload8(bf16x8*kf,lds_cptr kp){
  kf[0]=*(const __attribute__((address_space(3))) bf16x8*)(kp);      kf[1]=*(const __attribute__((address_space(3))) bf16x8*)(kp+512);
  kf[2]=*(const __attribute__((address_space(3))) bf16x8*)(kp+2048); kf[3]=*(const __attribute__((address_space(3))) bf16x8*)(kp+2560);
  kf[4]=*(const __attribute__((address_space(3))) bf16x8*)(kp+4096); kf[5]=*(const __attribute__((address_space(3))) bf16x8*)(kp+4608);
  kf[6]=*(const __attribute__((address_space(3))) bf16x8*)(kp+6144); kf[7]=*(const __attribute__((address_space(3))) bf16x8*)(kp+6656);
}
__device__ __forceinline__ void kload2(bf16x8*kf,lds_cptr kp,int j){ kf[2*j]=*(const __attribute__((address_space(3))) bf16x8*)(kp+j*2048); kf[2*j+1]=*(const __attribute__((address_space(3))) bf16x8*)(kp+j*2048+512); }
__device__ __forceinline__ s16x4 vtr(lds_cptr p){ return __builtin_bit_cast(s16x4,__builtin_amdgcn_ds_read_tr16_b64_v4i16((__attribute__((address_space(3))) v4i16_t*)p)); }
__device__ __forceinline__ float rowmax(const f32x16&p0,const f32x16&p1){
  float a=max3f(p0[0],p0[1],p1[0]),b=max3f(p0[2],p0[3],p1[1]);a=max3f(a,p1[2],p1[3]);
  #pragma unroll
  for(int r=4;r<16;r+=4){a=max3f(a,p0[r],p0[r+1]);b=max3f(b,p0[r+2],p0[r+3]);a=max3f(a,p1[r],p1[r+1]);b=max3f(b,p1[r+2],p1[r+3]);}
  const float m=max2f(a,b);
  auto rr=__builtin_amdgcn_permlane32_swap(__float_as_uint(m),__float_as_uint(m),false,false);
  return max2f(__uint_as_float(rr[0]),__uint_as_float(rr[1]));
}
__device__ __forceinline__ void pv(f32x16*o,int vb,bf16x8 pa0,bf16x8 pa1,bf16x8 pa2,bf16x8 pa3){
  #pragma unroll
  for(int d0=0;d0<2;++d0){s16x4 lo[4],hi[4];
    #pragma unroll
    for(int ks=0;ks<4;++ks){
      asm volatile("ds_read_b64_tr_b16 %0,%1 offset:%c2":"=&v"(lo[ks]):"v"(vb),"i"(d0*4096+ks*1024):"memory");
      asm volatile("ds_read_b64_tr_b16 %0,%1 offset:%c2":"=&v"(hi[ks]):"v"(vb),"i"(d0*4096+ks*1024+512):"memory");}
    asm volatile("s_waitcnt lgkmcnt(0)":::"memory");SBAR();
    #define PK(k) (bf16x8){lo[k][0],lo[k][1],lo[k][2],lo[k][3],hi[k][0],hi[k][1],hi[k][2],hi[k][3]}
    o[d0]=__builtin_amdgcn_mfma_f32_32x32x16_bf16(pa0,PK(0),o[d0],0,0,0);
    o[d0]=__builtin_amdgcn_mfma_f32_32x32x16_bf16(pa1,PK(1),o[d0],0,0,0);
    o[d0]=__builtin_amdgcn_mfma_f32_32x32x16_bf16(pa2,PK(2),o[d0],0,0,0);
    o[d0]=__builtin_amdgcn_mfma_f32_32x32x16_bf16(pa3,PK(3),o[d0],0,0,0);
    #undef PK
  }
}
template<bool BIAS> __device__ __forceinline__ void cinit(f32x16&c0,f32x16&c1,lds_cptr shm3,int t,int hi,float nmh){
  if constexpr(BIAS){
    const __attribute__((address_space(3))) f32x4* cb4=(const __attribute__((address_space(3))) f32x4*)(shm3+LDS_CB)+t*16+hi;
    #pragma unroll
    for(int g=0;g<4;++g){ const f32x4 b0=cb4[2*g], b1=cb4[8+2*g]; SBAR();
      c0[4*g]=nmh-b0[0]; c0[4*g+1]=nmh-b0[1]; c0[4*g+2]=nmh-b0[2]; c0[4*g+3]=nmh-b0[3];
      c1[4*g]=nmh-b1[0]; c1[4*g+1]=nmh-b1[1]; c1[4*g+2]=nmh-b1[2]; c1[4*g+3]=nmh-b1[3]; SBAR(); }
  } else {
    #pragma unroll
    for(int r=0;r<16;++r){c0[r]=nmh;c1[r]=nmh;}
  }
}
template<int THRL,bool CAUSAL,bool BIAS,int QP,int KP,int OP,bool FIXM=false> __device__ __forceinline__ void attn_unit(const bf16*Qu,const bf16*__restrict__ Ku,const bf16*__restrict__ Vu,bf16*Ou,const float*cbu,const int NT,char*shm,const int tid,const float mfix=0.f){
  const int lane=tid&63,r32=lane&31,hi=lane>>5; const int wid=__builtin_amdgcn_readfirstlane(tid>>6);
  const bf16*Qw=Qu+(long)(wid*QBLK)*QP;
  const unsigned lds0=(unsigned)(uintptr_t)shm;
  float*wsf=(float*)(shm+LDS_WS)+wid*64;
  const bf16*ksrc=Ku+(long)lane*KP+wid*8;
  const bf16*vsrc=Vu+(long)(16*(wid&3)+(lane>>2))*KP+(wid>>2)*32+(lane&3)*8;
  const unsigned kdst=lds0+LDS_K+wid*1024, vdst=lds0+LDS_V+wid*1024;
  #define DMA_K(t,slot) glds16(ksrc+(long)(t)*KVBLK*KP,(unsigned)__builtin_amdgcn_readfirstlane(kdst+(slot)))
  #define DMA_V(t,slot) glds16(vsrc+(long)(t)*KVBLK*KP,(unsigned)__builtin_amdgcn_readfirstlane(vdst+(slot)))
  const int vb0=(int)(lds0+LDS_V)+((lane>>4)&1)*32+(lane&3)*8+(4*hi+((lane&15)>>2))*64;
  const char*Kbase=shm+LDS_K; bf16x8 kf[8];
  const lds_cptr shm3=(lds_cptr)shm; const lds_cptr kp0=shm3+LDS_K+hi*1024+r32*16; const lds_cptr vp0=shm3+LDS_V+((lane>>4)&1)*32+(lane&3)*8+(4*hi+((lane&15)>>2))*64;
  f32x4 cbv0=(f32x4){0.f,0.f,0.f,0.f},cbv1=cbv0;
  if constexpr(BIAS){ const int ncb=NT*16; if(tid<ncb)cbv0=((const f32x4*)cbu)[tid]; if(tid+512<ncb)cbv1=((const f32x4*)cbu)[tid+512]; }
  float cbi_=0.f; if constexpr(BIAS&&FIXM) cbi_=cbu[NT*64-256+wid*QBLK+r32];
  DMA_K(0,0);DMA_V(0,0);DMA_K(1,SLOTB);
  bf16x8 qr[4];
  #pragma unroll
  for(int d0=0;d0<4;++d0)qr[d0]=*reinterpret_cast<const bf16x8*>(&Qw[(long)r32*QP+d0*16+hi*8]);
  { __attribute__((address_space(3))) bf16x8* qw_=(__attribute__((address_space(3))) bf16x8*)((__attribute__((address_space(3))) char*)shm+LDS_OST+wid*4096)+lane;
    qw_[0]=qr[0]; qw_[64]=qr[1]; qw_[128]=qr[2]; qw_[192]=qr[3]; }
  const __attribute__((address_space(3))) bf16x8* qst=(const __attribute__((address_space(3))) bf16x8*)(shm3+LDS_OST+wid*4096)+lane;
  #define QLD(d) qst[(d)*64]
  if constexpr(BIAS){ __attribute__((address_space(3))) f32x4* cbl=(__attribute__((address_space(3))) f32x4*)((__attribute__((address_space(3))) char*)shm+LDS_CB); const int ncb=NT*16; if(tid<ncb)cbl[tid]=cbv0; if(tid+512<ncb)cbl[tid+512]=cbv1; }
  float mhat,nmh,l_reg; asm volatile("v_mov_b32 %0, 0\n\tv_mov_b32 %1, 0\n\tv_mov_b32 %2, 0":"=v"(mhat),"=v"(nmh),"=v"(l_reg));
  if constexpr(FIXM){ mhat=mfix-cbi_; nmh=-mhat; }
  f32x16 o[2];o[0]=f32x16{};o[1]=f32x16{};
  const int qrel=wid*QBLK+r32;
  #define CMASK(P0,P1,t) do{ if(CAUSAL){int jb_=(t)-(NT-4); if(jb_>=0)cmask(P0,P1,jb_,qrel,hi);} }while(0)
  bool resc=false;
  #define START(P0,P1) do{ resc=false; if constexpr(!FIXM){ const float rm=rowmax(P0,P1); \
    { const float dl=rm; mhat=fadd_s(mhat,dl); \
      _Pragma("unroll") for(int r=0;r<16;++r){P0[r]=fsub_s(P0[r],dl);P1[r]=fsub_s(P1[r],dl);} \
      nmh=-mhat; } } \
    _Pragma("unroll") for(int r=0;r<16;++r)P0[r]=__builtin_amdgcn_exp2f(P0[r]); }while(0)
  #define RESC() do{ if(resc){ asm volatile("s_waitcnt lgkmcnt(0)":::"memory"); \
      _Pragma("unroll") for(int d_=0;d_<2;++d_) _Pragma("unroll") for(int r=0;r<16;++r)o[d_][r]*=wsf[crow(r,hi)]; } }while(0)
  f32x16 pA0,pA1,pB0,pB1;
  int sl_prev=0,sl_cur=0,sl_next=SLOTB;
  #define ROT() do{sl_prev=sl_cur;sl_cur=sl_next;sl_next=(sl_next==(NSLOT-1)*SLOTB)?0:sl_next+SLOTB;}while(0)
  DMA_K(2,2*SLOTB);
  WAIT_BAR(3);
  cinit<BIAS>(pA0,pA1,shm3,0,hi,nmh);qkt(pA0,pA1,Kbase,qr,r32,hi);asm volatile("s_nop 15\n\ts_nop 7":"+v"(pA0),"+v"(pA1));CMASK(pA0,pA1,0);
  START(pA0,pA1);
  _Pragma("unroll") for(int r=0;r<16;++r)pA1[r]=__builtin_amdgcn_exp2f(pA1[r]);
  WAIT_BAR(0);
  DMA_K(3,0);DMA_V(1,SLOTB);
  ROT();
  kload8(kf,kp0+sl_cur);
  WAIT_BAR(2);
  s16x4 vlo[8],vhi[8]; u32x4 pw0,pw1,pw2,pw3;
  #define PKW(P,B) cvtpk_s(P[B],P[B+1])
  #define PAF(k) __builtin_bit_cast(bf16x8,pw##k)
  #define VFR(i) (bf16x8){vlo[i][0],vlo[i][1],vlo[i][2],vlo[i][3],vhi[i][0],vhi[i][1],vhi[i][2],vhi[i][3]}
  #define PIN(x) asm volatile("":"+v"(x))
  #define MX3(a,b,c) __builtin_fmaxf(__builtin_fmaxf((a),(b)),(c))
  #define GAPA(MF,A0,A1,A2,A3,W0,W1,PW) do{ MF; sacc+=A0; sacc+=A1; sacc+=A2; sacc+=A3; PIN(sacc); W0; W1; PIN(PW); SBAR(); }while(0)
  #define EX(v) __builtin_amdgcn_exp2f(v)
  #define GAPB(MF,X,B) do{ MF; X[B]=EX(X[B]); X[B+1]=EX(X[B+1]); X[B+2]=EX(X[B+2]); X[B+3]=EX(X[B+3]); PIN(X); SBAR(); }while(0)
  #define VRD(i) do{ vlo[i]=vtr(vp_+(((i)>>2)*4096+((i)&3)*1024)); vhi[i]=vtr(vp_+(((i)>>2)*4096+((i)&3)*1024+512)); }while(0)
  #define KRD(G,j) do{ if(G){ kload2(kf,kp0+sl_next,j); SBAR(); } }while(0)
  #define STEP(C0,C1,P0,P1,t,GK,GV,GL) do{ SBAR(); \
    cinit<BIAS>(C0,C1,shm3,(t),hi,nmh); SBAR(); \
    const lds_cptr vp_=vp0+sl_prev; \
    bf16x8 qa_=QLD(0), qb_=QLD(1); \
    VRD(0); SBAR(); float sacc=(P0[0]+P0[1]); \
    GAPA(C0=__builtin_amdgcn_mfma_f32_32x32x16_bf16(kf[0],qa_,C0,0,0,0), P0[2],P0[3],P0[4],P0[5],     pw0[0]=PKW(P0,0), pw0[1]=PKW(P0,2), pw0); \
    VRD(4); SBAR(); GAPA(C1=__builtin_amdgcn_mfma_f32_32x32x16_bf16(kf[1],qa_,C1,0,0,0), P0[6],P0[7],P0[8],P0[9],     pw0[2]=PKW(P0,4), pw0[3]=PKW(P0,6), pw0); \
    qa_=QLD(2); VRD(1); SBAR(); GAPA(C0=__builtin_amdgcn_mfma_f32_32x32x16_bf16(kf[2],qb_,C0,0,0,0),   P0[10],P0[11],P0[12],P0[13], pw1[0]=PKW(P0,8), pw1[1]=PKW(P0,10), pw1); \
    VRD(5); SBAR(); GAPA(C1=__builtin_amdgcn_mfma_f32_32x32x16_bf16(kf[3],qb_,C1,0,0,0),   P0[14],P0[15],P1[0],P1[1],   pw1[2]=PKW(P0,12),pw1[3]=PKW(P0,14), pw1); \
    qb_=QLD(3); VRD(2); SBAR(); GAPA(C0=__builtin_amdgcn_mfma_f32_32x32x16_bf16(kf[4],qa_,C0,0,0,0),   P1[2],P1[3],P1[4],P1[5],     pw2[0]=PKW(P1,0), pw2[1]=PKW(P1,2), pw2); \
    VRD(6); SBAR(); GAPA(C1=__builtin_amdgcn_mfma_f32_32x32x16_bf16(kf[5],qa_,C1,0,0,0),   P1[6],P1[7],P1[8],P1[9],     pw2[2]=PKW(P1,4), pw2[3]=PKW(P1,6), pw2); \
    VRD(3); SBAR(); GAPA(C0=__builtin_amdgcn_mfma_f32_32x32x16_bf16(kf[6],qb_,C0,0,0,0),   P1[10],P1[11],P1[12],P1[13], pw3[0]=PKW(P1,8), pw3[1]=PKW(P1,10), pw3); \
    VRD(7); SBAR(); GAPA(C1=__builtin_amdgcn_mfma_f32_32x32x16_bf16(kf[7],qb_,C1,0,0,0),   P1[14],P1[15],0.f,0.f,       pw3[2]=PKW(P1,12),pw3[3]=PKW(P1,14), pw3); \
    l_reg+=sacc; \
    if(GK){DMA_K((t)+3,sl_cur);} if(GV){DMA_V((t)+1,sl_next);} \
    CMASK(C0,C1,t); \
    if constexpr(!FIXM) { float a=MX3(C0[0],C0[1],C1[0]),b=MX3(C0[2],C0[3],C1[1]); a=MX3(a,C1[2],C1[3]); \
      _Pragma("unroll") for(int r=4;r<16;r+=4){a=MX3(a,C0[r],C0[r+1]);b=MX3(b,C0[r+2],C0[r+3]);a=MX3(a,C1[r],C1[r+1]);b=MX3(b,C1[r+2],C1[r+3]);} \
      float rm=__builtin_fmaxf(a,b); { auto rr=__builtin_amdgcn_permlane32_swap(__float_as_uint(rm),__float_as_uint(rm),false,false); rm=__builtin_fmaxf(__uint_as_float(rr[0]),__uint_as_float(rr[1])); } \
      resc=false; \
      if(__builtin_expect(__any(rm>(float)THRL),0)){ const float dl=__builtin_fmaxf(rm,0.f); mhat+=dl; \
        _Pragma("unroll") for(int r=0;r<16;++r){C0[r]-=dl;C1[r]-=dl;} \
        nmh=-mhat; \
        const float f=__builtin_amdgcn_exp2f(-dl); l_reg*=f; if(hi==0)wsf[r32]=f; resc=true; } } \
    SBAR(); \
    GAPB(o[0]=__builtin_amdgcn_mfma_f32_32x32x16_bf16(PAF(0),VFR(0),o[0],0,0,0), C0,0); \
    GAPB(o[1]=__builtin_amdgcn_mfma_f32_32x32x16_bf16(PAF(0),VFR(4),o[1],0,0,0), C0,4); \
    KRD(GL,0); GAPB(o[0]=__builtin_amdgcn_mfma_f32_32x32x16_bf16(PAF(1),VFR(1),o[0],0,0,0), C0,8); \
    KRD(GL,1); GAPB(o[1]=__builtin_amdgcn_mfma_f32_32x32x16_bf16(PAF(1),VFR(5),o[1],0,0,0), C0,12); \
    KRD(GL,2); GAPB(o[0]=__builtin_amdgcn_mfma_f32_32x32x16_bf16(PAF(2),VFR(2),o[0],0,0,0), C1,0); \
    KRD(GL,3); GAPB(o[1]=__builtin_amdgcn_mfma_f32_32x32x16_bf16(PAF(2),VFR(6),o[1],0,0,0), C1,4); \
    GAPB(o[0]=__builtin_amdgcn_mfma_f32_32x32x16_bf16(PAF(3),VFR(3),o[0],0,0,0), C1,8); \
    GAPB(o[1]=__builtin_amdgcn_mfma_f32_32x32x16_bf16(PAF(3),VFR(7),o[1],0,0,0), C1,12); \
    }while(0)
  int t=1;
  #undef CMASK
  #define CMASK(P0,P1,t) do{}while(0)
  for(;t+5<NT;t+=2){
    STEP(pB0,pB1,pA0,pA1,t,true,true,true);     WAIT_BAR(2); RESC(); ROT();
    STEP(pA0,pA1,pB0,pB1,t+1,true,true,true);   WAIT_BAR(2); RESC(); ROT();
  }
  #undef CMASK
  #define CMASK(P0,P1,t) do{ if(CAUSAL){int jb_=(t)-(NT-4); if(jb_>=0)cmask(P0,P1,jb_,qrel,hi);} }while(0)
  #define ENDW(tt) do{ if((tt)+3<NT){WAIT_BAR(2);} else if((tt)+2<NT){WAIT_BAR(1);} else {WAIT_BAR(0);} }while(0)
  for(;t+1<NT;t+=2){
    STEP(pB0,pB1,pA0,pA1,t,(t+3<NT),(t+1<NT),(t+1<NT));       ENDW(t);   RESC(); ROT();
    STEP(pA0,pA1,pB0,pB1,t+1,(t+4<NT),(t+2<NT),(t+2<NT));     ENDW(t+1); RESC(); ROT();
  }
  STEP(pB0,pB1,pA0,pA1,NT-1,false,false,false); RESC();
  { float sacc=pB0[0]+pB0[1]; _Pragma("unroll") for(int r=2;r<16;++r)sacc+=pB0[r]; _Pragma("unroll") for(int r=0;r<16;++r)sacc+=pB1[r]; l_reg+=sacc;
    pw0=(u32x4){PKW(pB0,0),PKW(pB0,2),PKW(pB0,4),PKW(pB0,6)};pw1=(u32x4){PKW(pB0,8),PKW(pB0,10),PKW(pB0,12),PKW(pB0,14)};pw2=(u32x4){PKW(pB1,0),PKW(pB1,2),PKW(pB1,4),PKW(pB1,6)};pw3=(u32x4){PKW(pB1,8),PKW(pB1,10),PKW(pB1,12),PKW(pB1,14)};
    SBAR(); pv(o,vb0+sl_cur,PAF(0),PAF(1),PAF(2),PAF(3)); }
  #undef PKW
  #undef PAF
  #undef VFR
  #undef PIN
  #undef MX3
  #undef GAPA
  #undef GAPB
  #undef EX
  #undef VRD
  #undef KRD
  #undef STEP
  #undef ENDW
  {auto rr=__builtin_amdgcn_permlane32_swap(__float_as_uint(l_reg),__float_as_uint(l_reg),false,false);l_reg=__uint_as_float(rr[0])+__uint_as_float(rr[1]);}
  if(hi==0)wsf[32+r32]=l_reg;asm volatile("s_waitcnt lgkmcnt(0)":::"memory");
  float rli[16];
  #pragma unroll
  for(int r=0;r<16;++r)rli[r]=__builtin_amdgcn_rcpf(wsf[32+crow(r,hi)]);
  bf16*Ow=Ou+(long)(wid*QBLK)*OP;
  { bf16*stg=(bf16*)(shm+LDS_OST)+wid*2048;
    #pragma unroll
    for(int r=0;r<16;++r){const int orow=crow(r,hi);
      #pragma unroll
      for(int d0=0;d0<2;++d0)stg[orow*64+d0*32+r32]=__float2bfloat16(o[d0][r]*rli[r]);}
    asm volatile("s_waitcnt lgkmcnt(0)":::"memory");
    #pragma unroll
    for(int i=0;i<4;++i){const int row=i*8+(lane>>3),ch=lane&7; const u32x4 v=*(const u32x4*)(stg+row*64+ch*8); *(u32x4*)(Ow+(long)row*OP+ch*8)=v;} }
  asm volatile("s_waitcnt lgkmcnt(0)\n\ts_barrier":::"memory");
  #undef QLD
  #undef DMA_K
  #undef DMA_V
  #undef CMASK
  #undef START
  #undef RESC
  #undef ROT
}
#undef SBAR
#undef WAIT_BAR
}
constexpr int NWAVES = 8;
constexpr int RING_OFF = 0, RING_BYTES = 131072;
constexpr int LDSCTL_OFF = RING_BYTES, MISC_OFF = LDSCTL_OFF + 320;
constexpr int LDS_BYTES = 147456;
constexpr int ORDTAB_OFF = LDSCTL_OFF + 1024;
static_assert(MISC_OFF + 128 <= LDS_BYTES, "LDS map");
static_assert(attn_body::LDS_BYTES <= RING_BYTES && pg8::STAGE_BYTES <= RING_BYTES, "LDS map");

#define GAS __attribute__((address_space(1)))
#define LAS __attribute__((address_space(3)))
typedef unsigned short bf16;
typedef unsigned v4u __attribute__((ext_vector_type(4)));
typedef unsigned v2u __attribute__((ext_vector_type(2)));
typedef float f32x4 __attribute__((ext_vector_type(4)));
typedef GAS unsigned gu32;
#define RLX_AGENT __ATOMIC_RELAXED, __HIP_MEMORY_SCOPE_AGENT
#define LDS_WAIT() asm volatile("s_waitcnt lgkmcnt(0)" ::: "memory")
#define VM_WAIT() asm volatile("s_waitcnt vmcnt(0)" ::: "memory")
__device__ __forceinline__ unsigned f2bf(float f) { unsigned u = __builtin_bit_cast(unsigned, f); return (u + 0x7fffu + ((u >> 16) & 1u)) >> 16; }
__device__ __forceinline__ unsigned pk2(float lo, float hi) { unsigned r; asm volatile("v_cvt_pk_bf16_f32 %0, %1, %2" : "=v"(r) : "v"(lo), "v"(hi)); return r; }
__device__ __forceinline__ float bflo(unsigned w) { return __builtin_bit_cast(float, w << 16); }
__device__ __forceinline__ float bfhi(unsigned w) { return __builtin_bit_cast(float, w & 0xffff0000u); }

__device__ __forceinline__ unsigned pk4f8(float a, float b, float c, float d) { int p = __builtin_amdgcn_cvt_pk_fp8_f32(a, b, __builtin_bit_cast(int, a), false); p = __builtin_amdgcn_cvt_pk_fp8_f32(c, d, p, true); return (unsigned)p; }
__device__ __forceinline__ float clampf8(float x) { const float c = lconst(448.f); return __builtin_amdgcn_fmed3f(x, -c, c); }

#define XB_TMO      128
#define XB_XCNT(j)  (256  + 64 * (j))
#define XB_XSUB(j)  (1280 + 64 * (j))
#define XB_XGEN(j)  (2304 + 64 * (j))
#define XB_TOP      3328
#define XB_TOPGEN   3392
#define XCD_BAR_WORDS 3456
#define XB_SPIN_CAP (1u << 18)
__device__ __forceinline__ unsigned xb_ld(unsigned* p)              { return __hip_atomic_load(p, __ATOMIC_RELAXED, __HIP_MEMORY_SCOPE_AGENT); }
__device__ __forceinline__ unsigned xb_add(unsigned* p, unsigned v) { unsigned one_; asm volatile("v_mov_b32 %0, 1" : "=v"(one_)); (void)v;
    return __hip_atomic_fetch_add(p, one_, __ATOMIC_RELAXED, __HIP_MEMORY_SCOPE_AGENT); }
__device__ __forceinline__ unsigned ticket_take(gu32* ctr) { unsigned one_, z_; asm volatile("v_mov_b32 %0, 1\n\tv_mov_b32 %1, 0" : "=v"(one_), "=v"(z_));
    return __hip_atomic_fetch_add((gu32*)((GAS char*)ctr + z_), one_, RLX_AGENT); }
__device__ __forceinline__ unsigned xb_xcc_id() { return (unsigned)__builtin_amdgcn_s_getreg((3 << 11) | 20) & 0xFu; }
#define XB_SPIN(cond, bar) do { unsigned _sp = 0; while (cond) { __builtin_amdgcn_s_sleep(1); \
    if ((++_sp & 255u) == 0u) { if (xb_ld(&(bar)[XB_TMO])) break; if (_sp > XB_SPIN_CAP) { atomicAdd(&(bar)[XB_TMO], 1u); break; } } } } while (0)
struct XcdBarrier { unsigned* bar; unsigned x; volatile LAS unsigned* st; };
__device__ __forceinline__ XcdBarrier xcd_barrier_post(unsigned* bar, volatile LAS unsigned* st, const int tid) {
    XcdBarrier b; b.bar = bar; b.x = xb_xcc_id(); b.st = st;
    if (tid == 0) (void)xb_add(&bar[XB_XCNT(b.x)], 1u);
    return b;
}
__device__ __forceinline__ void xcd_barrier_complete(unsigned* bar, unsigned x, unsigned& nloc, unsigned& nx) {
    const unsigned G = gridDim.x * gridDim.y * gridDim.z;
    unsigned sum, cnt, mine, sp = 0u;
    for (;;) {
        sum = 0u; cnt = 0u; mine = 0u;
#pragma unroll
        for (unsigned j = 0; j < 16; ++j) { const unsigned c = xb_ld(&bar[XB_XCNT(j)]); sum += c; cnt += (c > 0u) ? 1u : 0u; }
        mine = xb_ld(&bar[XB_XCNT(x)]);
        if (sum == G) break;
        __builtin_amdgcn_s_sleep(1);
        if ((++sp & 255u) == 0u) { if (xb_ld(&bar[XB_TMO])) break; if (sp > XB_SPIN_CAP) { atomicAdd(&bar[XB_TMO], 1u); break; } }
    }
    nloc = mine > 0u ? mine : 1u; nx = cnt > 0u ? cnt : 1u;
}
__device__ __forceinline__ void xcd_barrier(const XcdBarrier& b, const int tid  ) {
    asm volatile("s_waitcnt vmcnt(0)" ::: "memory");
    __syncthreads();
    if (tid == 0) {
        unsigned* bar = b.bar;
        __builtin_amdgcn_s_waitcnt(0);
        unsigned nloc = b.st[0], nx = b.st[1];
        if (nloc == 0u) { xcd_barrier_complete(bar, b.x, nloc, nx); b.st[0] = nloc; b.st[1] = nx; }
        const unsigned old = xb_add(&bar[XB_XSUB(b.x)], 1u);
        const unsigned gen = old / nloc;
        if (old + 1u == (gen + 1u) * nloc) {
            __builtin_amdgcn_fence(__ATOMIC_RELEASE, "agent");
            asm volatile("s_waitcnt vmcnt(0)" ::: "memory");
            const unsigned og = xb_add(&bar[XB_TOP], 1u);
            const unsigned tg = og / nx;
            if (og + 1u == (tg + 1u) * nx) xb_add(&bar[XB_TOPGEN], 1u);
            else XB_SPIN(xb_ld(&bar[XB_TOPGEN]) == tg, bar);
            __builtin_amdgcn_fence(__ATOMIC_ACQUIRE, "agent");
            xb_add(&bar[XB_XGEN(b.x)], 1u);
            asm volatile("s_waitcnt vmcnt(0)" ::: "memory");
        } else {
            XB_SPIN(xb_ld(&bar[XB_XGEN(b.x)]) == gen, bar);
            __builtin_amdgcn_fence(__ATOMIC_ACQUIRE, "agent");
            asm volatile("s_waitcnt vmcnt(0)" ::: "memory");
        }
    }
    __syncthreads();
}

struct Args { const float* in[27]; float* out; unsigned char* ws; int ph_lo, ph_hi; unsigned mask; int pad; };
struct Frame {
    LAS unsigned char* lds;
    volatile LAS unsigned* MISC;
    gu32* ctl;
    int tid, lane, wave, vcu, G;
    unsigned char* ws;
    const __attribute__((address_space(4))) struct Args* A;
    float* out;
};
__device__ __forceinline__ float lane_xor_f(float v, int m, int lane) { return __builtin_bit_cast(float, __builtin_amdgcn_ds_bpermute((lane ^ m) << 2, __builtin_bit_cast(int, v))); }
__device__ __forceinline__ int lane_up_i(int v, int o, int lane) { return __builtin_amdgcn_ds_bpermute((lane >= o ? lane - o : lane) << 2, v); }
__device__ __forceinline__ double lane_up_d(double v, int o, int lane) { const unsigned long long u = __builtin_bit_cast(unsigned long long, v); const int a = (lane >= o ? lane - o : lane) << 2;
    const unsigned lo = (unsigned)__builtin_amdgcn_ds_bpermute(a, (int)(unsigned)u), hi = (unsigned)__builtin_amdgcn_ds_bpermute(a, (int)(unsigned)(u >> 32)); return __builtin_bit_cast(double, ((unsigned long long)hi << 32) | lo); }
__device__ __forceinline__ double lane_get_d(double v, int src) { const unsigned long long u = __builtin_bit_cast(unsigned long long, v);
    const unsigned lo = (unsigned)__builtin_amdgcn_readlane((int)(unsigned)u, src), hi = (unsigned)__builtin_amdgcn_readlane((int)(unsigned)(u >> 32), src); return __builtin_bit_cast(double, ((unsigned long long)hi << 32) | lo); }
#define DPP_ADD(v, ctrl) ((v) + __builtin_bit_cast(float, __builtin_amdgcn_update_dpp(__builtin_bit_cast(int, (v)), __builtin_bit_cast(int, (v)), (ctrl), 0xf, 0xf, false)))
__device__ __forceinline__ float wave_sum_l(float v, int  ) {
    v = DPP_ADD(v, 0xB1);
    v = DPP_ADD(v, 0x4E);
    v = DPP_ADD(v, 0x141);
    v = DPP_ADD(v, 0x140);
    const float r0 = __builtin_bit_cast(float, __builtin_amdgcn_readlane(__builtin_bit_cast(int, v), 0)), r1 = __builtin_bit_cast(float, __builtin_amdgcn_readlane(__builtin_bit_cast(int, v), 16));
    const float r2 = __builtin_bit_cast(float, __builtin_amdgcn_readlane(__builtin_bit_cast(int, v), 32)), r3 = __builtin_bit_cast(float, __builtin_amdgcn_readlane(__builtin_bit_cast(int, v), 48));
    return (r0 + r1) + (r2 + r3);
}
#define DPP_GET(v, ctrl) __builtin_bit_cast(float, __builtin_amdgcn_update_dpp(__builtin_bit_cast(int, (v)), __builtin_bit_cast(int, (v)), (ctrl), 0xf, 0xf, false))
__device__ __forceinline__ float wave_reduce32(const float (&v)[32], int lane) {
    float u[16], w[8], x[4], y[2];
#pragma unroll
    for (int i = 0; i < 16; ++i) { const auto rr = __builtin_amdgcn_permlane32_swap(__builtin_bit_cast(unsigned, v[i]), __builtin_bit_cast(unsigned, v[i + 16]), false, false);
        u[i] = __builtin_bit_cast(float, (unsigned)rr[0]) + __builtin_bit_cast(float, (unsigned)rr[1]); }
#pragma unroll
    for (int i = 0; i < 8; ++i) { const auto rr = __builtin_amdgcn_permlane16_swap(__builtin_bit_cast(unsigned, u[i]), __builtin_bit_cast(unsigned, u[i + 8]), false, false);
        w[i] = __builtin_bit_cast(float, (unsigned)rr[0]) + __builtin_bit_cast(float, (unsigned)rr[1]); }
    const bool b3 = (lane & 8) != 0, b2 = (lane & 4) != 0, b1 = (lane & 2) != 0;
#pragma unroll
    for (int i = 0; i < 4; ++i) { const float keep = b3 ? w[i + 4] : w[i], give = b3 ? w[i] : w[i + 4]; x[i] = keep + DPP_GET(give, 0x140); }
#pragma unroll
    for (int i = 0; i < 2; ++i) { const float keep = b2 ? x[i + 2] : x[i], give = b2 ? x[i] : x[i + 2]; y[i] = keep + DPP_GET(give, 0x141); }
    float z; { const float keep = b1 ? y[1] : y[0], give = b1 ? y[0] : y[1]; z = keep + DPP_GET(give, 0x4E); }
    z = z + DPP_GET(z, 0xB1);
    return z;
}
#define SWAP32_ADD(a, b) ([&]() { const auto rr_ = __builtin_amdgcn_permlane32_swap(__builtin_bit_cast(unsigned, (a)), __builtin_bit_cast(unsigned, (b)), false, false); return __builtin_bit_cast(float, (unsigned)rr_[0]) + __builtin_bit_cast(float, (unsigned)rr_[1]); }())
#define SWAP16_ADD(a, b) ([&]() { const auto rr_ = __builtin_amdgcn_permlane16_swap(__builtin_bit_cast(unsigned, (a)), __builtin_bit_cast(unsigned, (b)), false, false); return __builtin_bit_cast(float, (unsigned)rr_[0]) + __builtin_bit_cast(float, (unsigned)rr_[1]); }())
__device__ __forceinline__ float wave_reduce16(const float (&v)[16], int lane) {
    float u[8], w[4], x[2];
#pragma unroll
    for (int i = 0; i < 8; ++i) u[i] = SWAP32_ADD(v[i], v[i + 8]);
#pragma unroll
    for (int i = 0; i < 4; ++i) w[i] = SWAP16_ADD(u[i], u[i + 4]);
    const bool b3 = (lane & 8) != 0, b2 = (lane & 4) != 0;
#pragma unroll
    for (int i = 0; i < 2; ++i) { const float keep = b3 ? w[i + 2] : w[i], give = b3 ? w[i] : w[i + 2]; x[i] = keep + DPP_GET(give, 0x140); }
    float z; { const float keep = b2 ? x[1] : x[0], give = b2 ? x[0] : x[1]; z = keep + DPP_GET(give, 0x141); }
    z = z + DPP_GET(z, 0x4E); z = z + DPP_GET(z, 0xB1);
    return z;
}
__device__ __forceinline__ float wave_reduce8(const float (&v)[8], int lane) {
    float u[4], w[2];
#pragma unroll
    for (int i = 0; i < 4; ++i) u[i] = SWAP32_ADD(v[i], v[i + 4]);
#pragma unroll
    for (int i = 0; i < 2; ++i) w[i] = SWAP16_ADD(u[i], u[i + 2]);
    const bool b3 = (lane & 8) != 0;
    float z; { const float keep = b3 ? w[1] : w[0], give = b3 ? w[0] : w[1]; z = keep + DPP_GET(give, 0x140); }
    z = z + DPP_GET(z, 0x141); z = z + DPP_GET(z, 0x4E); z = z + DPP_GET(z, 0xB1);
    return z;
}
#if BRINGUP
__device__ __forceinline__ float wave_sum(float v) {
#pragma unroll
    for (int o = 1; o < 64; o <<= 1) v += __shfl_xor(v, o);
    return v;
}
#endif

__device__ __forceinline__ void cvt_finish16(const f32x4 (&t)[8], bf16* dst, int K, LAS float* scr, int lane, const float* gk  ) {
    { const int kr = lane >> 3, c4 = (lane & 7) * 4;
#pragma unroll
      for (int i = 0; i < 8; ++i) { const int kk = 8 * i + kr; const float gg = gk ? gk[kk] : 1.0f; LAS float* d = scr + kk * 33 + c4; d[0] = t[i].x * gg; d[1] = t[i].y * gg; d[2] = t[i].z * gg; d[3] = t[i].w * gg; } }
    LDS_WAIT(); asm volatile("" ::: "memory");
    const int c = lane & 7;
#pragma unroll
    for (int j = 0; j < 4; ++j) { const int n = (lane >> 3) + 8 * j; const LAS float* s = scr + (8 * c) * 33 + n;
        v4u o; o.x = pk2(s[0 * 33], s[1 * 33]); o.y = pk2(s[2 * 33], s[3 * 33]); o.z = pk2(s[4 * 33], s[5 * 33]); o.w = pk2(s[6 * 33], s[7 * 33]);
        *(GAS v4u*)(dst + (size_t)n * K + 8 * c) = o; }
    LDS_WAIT(); asm volatile("" ::: "memory");
}
__device__ __forceinline__ void cvt8_finish_g(const f32x4 (&t)[8], unsigned char* dst, int Kb, LAS float* scr, int lane, float qs, const float* gk) {
    { const int kr = lane >> 3, c4 = (lane & 7) * 4;
#pragma unroll
      for (int i = 0; i < 8; ++i) { const float gg = gk ? gk[8 * i + kr] : 1.0f; LAS float* d = scr + (8 * i + kr) * 33 + c4; d[0] = t[i].x * gg; d[1] = t[i].y * gg; d[2] = t[i].z * gg; d[3] = t[i].w * gg; } }
    LDS_WAIT(); asm volatile("" ::: "memory");
    const int n = lane >> 1, h = lane & 1; const LAS float* s = scr + (32 * h) * 33 + n;
    v4u o0, o1;
    o0.x = pk4f8(s[0 * 33] * qs, s[1 * 33] * qs, s[2 * 33] * qs, s[3 * 33] * qs);     o0.y = pk4f8(s[4 * 33] * qs, s[5 * 33] * qs, s[6 * 33] * qs, s[7 * 33] * qs);
    o0.z = pk4f8(s[8 * 33] * qs, s[9 * 33] * qs, s[10 * 33] * qs, s[11 * 33] * qs);   o0.w = pk4f8(s[12 * 33] * qs, s[13 * 33] * qs, s[14 * 33] * qs, s[15 * 33] * qs);
    o1.x = pk4f8(s[16 * 33] * qs, s[17 * 33] * qs, s[18 * 33] * qs, s[19 * 33] * qs); o1.y = pk4f8(s[20 * 33] * qs, s[21 * 33] * qs, s[22 * 33] * qs, s[23 * 33] * qs);
    o1.z = pk4f8(s[24 * 33] * qs, s[25 * 33] * qs, s[26 * 33] * qs, s[27 * 33] * qs); o1.w = pk4f8(s[28 * 33] * qs, s[29 * 33] * qs, s[30 * 33] * qs, s[31 * 33] * qs);
    GAS v4u* d = (GAS v4u*)(dst + (size_t)n * Kb + 32 * h); d[0] = o0; d[1] = o1;
    LDS_WAIT(); asm volatile("" ::: "memory");
}
__device__ __forceinline__ void cvt_block(const float* src, int ldw, bf16* dst, int K, LAS float* scr, int lane, const float* gk  ) {
    { const int kr = lane >> 3, c4 = (lane & 7) * 4; f32x4 t[8];
#pragma unroll
      for (int i = 0; i < 8; ++i) t[i] = *(const GAS f32x4*)(src + (size_t)(8 * i + kr) * ldw + c4);
#pragma unroll
      for (int i = 0; i < 8; ++i) { const int kk = 8 * i + kr; const float gg = gk ? gk[kk] : 1.0f; LAS float* d = scr + kk * 33 + c4; d[0] = t[i].x * gg; d[1] = t[i].y * gg; d[2] = t[i].z * gg; d[3] = t[i].w * gg; } }
    LDS_WAIT(); asm volatile("" ::: "memory");
    const int c = lane & 7;
#pragma unroll
    for (int j = 0; j < 4; ++j) { const int n = (lane >> 3) + 8 * j; const LAS float* s = scr + (8 * c) * 33 + n;
        v4u o; o.x = pk2(s[0 * 33], s[1 * 33]); o.y = pk2(s[2 * 33], s[3 * 33]); o.z = pk2(s[4 * 33], s[5 * 33]); o.w = pk2(s[6 * 33], s[7 * 33]);
        *(GAS v4u*)(dst + (size_t)n * K + 8 * c) = o; }
    LDS_WAIT(); asm volatile("" ::: "memory");
}
__device__ __forceinline__ void cvt_block8(const float* src, int ldw, unsigned char* dst, int Kb, LAS float* scr, int lane, float qs, const float* gk) {
    { const int kr = lane >> 3, c4 = (lane & 7) * 4; f32x4 t[8];
#pragma unroll
      for (int i = 0; i < 8; ++i) t[i] = *(const GAS f32x4*)(src + (size_t)(8 * i + kr) * ldw + c4);
#pragma unroll
      for (int i = 0; i < 8; ++i) { const float gg = gk ? gk[8 * i + kr] : 1.0f; LAS float* d = scr + (8 * i + kr) * 33 + c4; d[0] = t[i].x * gg; d[1] = t[i].y * gg; d[2] = t[i].z * gg; d[3] = t[i].w * gg; } }
    LDS_WAIT(); asm volatile("" ::: "memory");
    const int n = lane >> 1, h = lane & 1; const LAS float* s = scr + (32 * h) * 33 + n;
    v4u o0, o1;
    o0.x = pk4f8(s[0 * 33] * qs, s[1 * 33] * qs, s[2 * 33] * qs, s[3 * 33] * qs);     o0.y = pk4f8(s[4 * 33] * qs, s[5 * 33] * qs, s[6 * 33] * qs, s[7 * 33] * qs);
    o0.z = pk4f8(s[8 * 33] * qs, s[9 * 33] * qs, s[10 * 33] * qs, s[11 * 33] * qs);   o0.w = pk4f8(s[12 * 33] * qs, s[13 * 33] * qs, s[14 * 33] * qs, s[15 * 33] * qs);
    o1.x = pk4f8(s[16 * 33] * qs, s[17 * 33] * qs, s[18 * 33] * qs, s[19 * 33] * qs); o1.y = pk4f8(s[20 * 33] * qs, s[21 * 33] * qs, s[22 * 33] * qs, s[23 * 33] * qs);
    o1.z = pk4f8(s[24 * 33] * qs, s[25 * 33] * qs, s[26 * 33] * qs, s[27 * 33] * qs); o1.w = pk4f8(s[28 * 33] * qs, s[29 * 33] * qs, s[30 * 33] * qs, s[31 * 33] * qs);
    GAS v4u* d = (GAS v4u*)(dst + (size_t)n * Kb + 32 * h); d[0] = o0; d[1] = o1;
    LDS_WAIT(); asm volatile("" ::: "memory");
}
__device__ __forceinline__ void cvt8_load(f32x4 (&t)[8], const float* src, int ldw, int lane) {
    const int kr = lane >> 3, c4 = (lane & 7) * 4;
    const unsigned voff = (unsigned)(kr * ldw + c4) * 4u;
#pragma unroll
    for (int i = 0; i < 8; ++i) t[i] = *(const GAS f32x4*)((const GAS char*)(src + (size_t)(8 * i) * ldw) + voff);
}
__device__ __forceinline__ void cvt8_finish(const f32x4 (&t)[8], unsigned char* dst, int Kb, LAS float* scr, int lane, float qs) {
    { const int kr = lane >> 3, c4 = (lane & 7) * 4;
#pragma unroll
      for (int i = 0; i < 8; ++i) { LAS float* d = scr + (8 * i + kr) * 33 + c4; d[0] = t[i].x; d[1] = t[i].y; d[2] = t[i].z; d[3] = t[i].w; } }
    LDS_WAIT(); asm volatile("" ::: "memory");
    const int n = lane >> 1, h = lane & 1; const LAS float* s = scr + (32 * h) * 33 + n;
    v4u o0, o1;
    o0.x = pk4f8(s[0 * 33] * qs, s[1 * 33] * qs, s[2 * 33] * qs, s[3 * 33] * qs);     o0.y = pk4f8(s[4 * 33] * qs, s[5 * 33] * qs, s[6 * 33] * qs, s[7 * 33] * qs);
    o0.z = pk4f8(s[8 * 33] * qs, s[9 * 33] * qs, s[10 * 33] * qs, s[11 * 33] * qs);   o0.w = pk4f8(s[12 * 33] * qs, s[13 * 33] * qs, s[14 * 33] * qs, s[15 * 33] * qs);
    o1.x = pk4f8(s[16 * 33] * qs, s[17 * 33] * qs, s[18 * 33] * qs, s[19 * 33] * qs); o1.y = pk4f8(s[20 * 33] * qs, s[21 * 33] * qs, s[22 * 33] * qs, s[23 * 33] * qs);
    o1.z = pk4f8(s[24 * 33] * qs, s[25 * 33] * qs, s[26 * 33] * qs, s[27 * 33] * qs); o1.w = pk4f8(s[28 * 33] * qs, s[29 * 33] * qs, s[30 * 33] * qs, s[31 * 33] * qs);
    GAS v4u* d = (GAS v4u*)(dst + (size_t)n * Kb + 32 * h); d[0] = o0; d[1] = o1;
    LDS_WAIT(); asm volatile("" ::: "memory");
}
__device__ __forceinline__ void cvt_matrix(Frame& F, const float* src, const float* src2, int ldw, bf16* dst, int K, int N, int kind, int nrep, size_t sstride, size_t dstride, float qs = 0.f  , const float* gain = nullptr  ) {
    LAS float* scr = (LAS float*)(F.lds + RING_OFF + F.wave * 16384);
    const int gw = F.vcu * NWAVES + F.wave, NGW = F.G * NWAVES;
    const int nb_n = N / 32, per = nb_n * (K / 64), total = per * nrep;
    auto locate = [&](int it, const float*& sp, size_t& doff, int& kbo) {
        const int rep = it / per, loc = it - rep * per, kb = loc / nb_n, nb = loc - kb * nb_n;
        const int n0 = 32 * nb, pn = n0 >> 8, rho = n0 & 255, bj = rho >> 7, wc = (rho & 127) >> 5;
        const float* s = src; int col;
        if (kind == 0) col = n0;
        else if (kind == 1) { const int L = 256 * pn + 64 * wc + 32 * bj; col = L < 3 * FOXD ? L : L + NH; }
        else if (kind == 2) col = 256 * pn + 64 * wc + 32 * bj;
        else if (kind == 3) { col = 128 * pn + (rho & 127); if (bj) s = src2; }
        else { col = pn < 6 ? 128 * pn + (rho & 127) + (bj ? CONVD : 0) : 2 * CONVD + 64 * wc + 32 * bj; }
        sp = s + (size_t)rep * sstride + (size_t)(64 * kb) * ldw + col; doff = (size_t)rep * dstride + (size_t)n0 * K + 64 * kb; kbo = kb; };
    auto finish = [&](const f32x4 (&t)[8], size_t doff, int kb) {
        if (qs != 0.f) cvt8_finish_g(t, (unsigned char*)dst + doff, K, scr, F.lane, qs, gain ? gain + 64 * kb : nullptr);
        else cvt_finish16(t, dst + doff, K, scr, F.lane, gain ? gain + 64 * kb : nullptr); };
    for (int it = gw; it < total; it += 2 * NGW) {
        const int it2 = it + NGW; const bool two = it2 < total;
        const float* sA; size_t dA; int kA; locate(it, sA, dA, kA);
        const float* sB = sA; size_t dB = dA; int kB = kA; if (two) locate(it2, sB, dB, kB);
        f32x4 tA[8], tB[8]; cvt8_load(tA, sA, ldw, F.lane); cvt8_load(tB, sB, ldw, F.lane);
        finish(tA, dA, kA); if (two) finish(tB, dB, kB);
    }
}
__device__ __forceinline__ void convert_moe(Frame& F, int j) {
    cvt_matrix(F, F.A->in[24] + (size_t)j * NE * DM * EFF, F.A->in[25] + (size_t)j * NE * DM * EFF, EFF, (bf16*)(F.ws + WS_WMGU + (size_t)j * WS_WM_LAYER), DM, 2 * EFF, 3, NE, (size_t)DM * EFF, (size_t)2 * EFF * DM, WSC_GU);
    cvt_matrix(F, F.A->in[26] + (size_t)j * NE * EFF * DM, nullptr, DM, (bf16*)(F.ws + WS_WMD + (size_t)j * WS_WM_LAYER), EFF, DM, 0, NE, (size_t)EFF * DM, (size_t)DM * EFF, WSC_D);
}
constexpr int MOE_GU_ITEMS = NE * (2 * EFF / 32) * (DM / 64), MOE_D_ITEMS = NE * (DM / 32) * (EFF / 64), MOE_BATCH = 4;
__device__ __forceinline__ void convert_moe_queue(Frame& F, int j, gu32* ctr, int maxr = 1 << 30  ) {
    LAS float* scr = (LAS float*)(F.lds + RING_OFF + F.wave * 16384);
    const float* wg = F.A->in[24] + (size_t)j * NE * DM * EFF; const float* wu = F.A->in[25] + (size_t)j * NE * DM * EFF; const float* wd = F.A->in[26] + (size_t)j * NE * EFF * DM;
    unsigned char* dgu = F.ws + WS_WMGU + (size_t)j * WS_WM_LAYER; unsigned char* dd = F.ws + WS_WMD + (size_t)j * WS_WM_LAYER;
    LAS unsigned* tk = (LAS unsigned*)(F.lds + RING_OFF + 12288);
    constexpr unsigned NBATCH = (MOE_GU_ITEMS + MOE_D_ITEMS) / MOE_BATCH; static_assert(NBATCH % NWAVES == 0, "ticket shape");
    if (F.tid == 0) tk[0] = ticket_take(ctr);
    __syncthreads();
    for (int r = 0; r < maxr; ++r) {
        const unsigned t8 = (unsigned)__builtin_amdgcn_readfirstlane((int)tk[r & 1]);
        if (t8 * NWAVES >= NBATCH) break;
        unsigned nxt_ = 0; if (F.tid == 0 && r + 1 < maxr) nxt_ = ticket_take(ctr);
        const unsigned bt = t8 * NWAVES + (unsigned)F.wave;
        f32x4 tb[MOE_BATCH][8]; unsigned char* dp[MOE_BATCH]; int kbt[MOE_BATCH]; float qsb[MOE_BATCH];
        static_assert(MOE_BATCH == 4 && MOE_GU_ITEMS % 4 == 0 && MOE_D_ITEMS % 4 == 0, "batch shape");
#pragma unroll
        for (int k = 0; k < MOE_BATCH; ++k) { int b = (int)bt;
            if (b < MOE_GU_ITEMS / 4) {
                constexpr int nb_n = 2 * EFF / 32, perb = (nb_n / 2) * (DM / 128);
                const int rep = b / perb, loc = b - rep * perb, kb2 = loc / (nb_n / 2), nb2 = loc - kb2 * (nb_n / 2), kb = 2 * kb2 + (k >> 1), nb = 2 * nb2 + (k & 1), n0 = 32 * nb, pn = n0 >> 8, rho = n0 & 255, bj = rho >> 7;
                cvt8_load(tb[k], (bj ? wu : wg) + (size_t)rep * DM * EFF + (size_t)(64 * kb) * EFF + 128 * pn + (rho & 127), EFF, F.lane);
                dp[k] = dgu + (size_t)rep * (2 * EFF * DM) + (size_t)n0 * DM + 64 * kb; kbt[k] = DM; qsb[k] = WSC_GU;
            } else { b -= MOE_GU_ITEMS / 4;
                constexpr int nb_n = DM / 32, perb = (nb_n / 2) * (EFF / 128);
                const int rep = b / perb, loc = b - rep * perb, kb2 = loc / (nb_n / 2), nb2 = loc - kb2 * (nb_n / 2), kb = 2 * kb2 + (k >> 1), nb = 2 * nb2 + (k & 1), n0 = 32 * nb;
                cvt8_load(tb[k], wd + (size_t)rep * EFF * DM + (size_t)(64 * kb) * DM + n0, DM, F.lane);
                dp[k] = dd + (size_t)rep * (DM * EFF) + (size_t)n0 * EFF + 64 * kb; kbt[k] = EFF; qsb[k] = WSC_D; }
        }
        if (F.tid == 0) tk[(r + 1) & 1] = nxt_;
#pragma unroll
        for (int k = 0; k < MOE_BATCH; ++k) cvt8_finish(tb[k], dp[k], kbt[k], scr, F.lane, qsb[k]);
        __syncthreads();
    }
}
__device__ __forceinline__ void phase_prologue(Frame& F) {
#pragma unroll 1
    for (int jq = 0; jq < 2; ++jq) { int j = jq; asm volatile("" : "+s"(j));
        if ((IN8L2 && j == 1) || (IN8L0 && j == 0)) cvt_matrix(F, F.A->in[8] + (size_t)j * DM * FOXIN, nullptr, FOXIN, (bf16*)(F.ws + WS_WINE + (size_t)j * 2560 * DM * 2), DM, 2560, 1, 1, 0, 0, WSC_GU);
        else cvt_matrix(F, F.A->in[8] + (size_t)j * DM * FOXIN, nullptr, FOXIN, (bf16*)(F.ws + WS_WINE) + (size_t)j * 2560 * DM, DM, 2560, 1, 1, 0, 0);
        cvt_matrix(F, F.A->in[12] + (size_t)j * DM * DM, nullptr, DM, (bf16*)(F.ws + WS_WOUTE) + (size_t)j * DM * DM, DM, DM, 0, 1, 0, 0);
        if ((IN8ODD >> j) & 1) cvt_matrix(F, F.A->in[13] + (size_t)j * DM * CONVIN, nullptr, CONVIN, (bf16*)(F.ws + WS_WINO + (size_t)j * CONVIN * DM * 2), DM, CONVIN, 4, 1, 0, 0, WSC_GU, F.A->in[2] + (size_t)(2 * j + 1) * DM);
        else cvt_matrix(F, F.A->in[13] + (size_t)j * DM * CONVIN, nullptr, CONVIN, (bf16*)(F.ws + WS_WINO) + (size_t)j * CONVIN * DM, DM, CONVIN, 4, 1, 0, 0, 0.f, (FUSENORM && !BRINGUP) ? F.A->in[2] + (size_t)(2 * j + 1) * DM : nullptr);
        cvt_matrix(F, F.A->in[19] + (size_t)j * DM * DM, nullptr, DM, (bf16*)(F.ws + WS_WOUTO) + (size_t)j * DM * DM, DM, DM, 0, 1, 0, 0);
        const bool d8_ = DENSE8 == 1 || (DENSE8 == 2 && j == 1), u8_ = d8_ || (UP8L0 && j == 0);
        if (u8_) cvt_matrix(F, F.A->in[20] + (size_t)j * DM * FF, F.A->in[21] + (size_t)j * DM * FF, FF, (bf16*)(F.ws + WS_WGU + (size_t)j * 2 * FF * DM * 2), DM, 2 * FF, 3, 1, 0, 0, WSC_GU, (FUSENORM && !BRINGUP) ? F.A->in[4] + (size_t)(2 * j) * DM : nullptr);
        else cvt_matrix(F, F.A->in[20] + (size_t)j * DM * FF, F.A->in[21] + (size_t)j * DM * FF, FF, (bf16*)(F.ws + WS_WGU) + (size_t)j * 2 * FF * DM, DM, 2 * FF, 3, 1, 0, 0, 0.f, (FUSENORM && !BRINGUP) ? F.A->in[4] + (size_t)(2 * j) * DM : nullptr);
        if (d8_) cvt_matrix(F, F.A->in[22] + (size_t)j * FF * DM, nullptr, DM, (bf16*)(F.ws + WS_WD + (size_t)j * DM * FF * 2), FF, DM, 0, 1, 0, 0, WSC_D);
        else cvt_matrix(F, F.A->in[22] + (size_t)j * FF * DM, nullptr, DM, (bf16*)(F.ws + WS_WD) + (size_t)j * DM * FF, FF, DM, 0, 1, 0, 0);
    }
    cvt_matrix(F, F.A->in[5], nullptr, 2 * MEMD, (bf16*)(F.ws + WS_WKV), DM, 2 * MEMD, 2, 4, (size_t)DM * 2 * MEMD, (size_t)2 * MEMD * DM);
#if !MOEQ
    convert_moe(F, 0); convert_moe(F, 1);
#endif
    if (F.vcu == 0) { float* gt = (float*)(F.ws + WS_GT);
        for (int idx = F.tid; idx < 4 * 3 * 64; idx += NWAVES * 64) { const int L = idx / 192, r = (idx / 64) % 3, c = idx & 63, jj = L >> 1;
            gt[idx] = r == 0 ? F.A->in[10][jj * HD + c] * C2 : (r == 1 ? F.A->in[11][jj * HD + c] : F.A->in[6][L * HD + c] * C2); }
        if (F.wave == 0) for (int jj = 0; jj < 2; ++jj) { float mq = fabsf(F.A->in[10][jj * HD + F.lane]), mk = fabsf(F.A->in[11][jj * HD + F.lane]);
#pragma unroll
            for (int o = 1; o < 64; o <<= 1) { mq = fmaxf(mq, lane_xor_f(mq, o, F.lane)); mk = fmaxf(mk, lane_xor_f(mk, o, F.lane)); }
            if (F.lane == 0) gt[1024 + jj] = 2.0f * (64.0f * C2 * mq * mk) + 40.0f; } }
    const int gw = F.vcu * NWAVES + F.wave, NGW = F.G * NWAVES;
    for (int r = gw; r < BATCH * ML; r += NGW) {
        const GAS f32x4* xr = (const GAS f32x4*)(F.A->in[1] + (size_t)r * DM) + F.lane;
        f32x4 v[4]; float ss = 0.f;
#pragma unroll
        for (int j = 0; j < 4; ++j) { v[j] = xr[64 * j]; ss += (v[j].x * v[j].x + v[j].y * v[j].y) + (v[j].z * v[j].z + v[j].w * v[j].w); }
        const float rs = __builtin_amdgcn_rsqf(wave_sum_l(ss, F.lane) * (1.0f / DM) + lconst(RMS_EPS));
        f32x4 gg[4][4];
#pragma unroll
        for (int i = 0; i < 4; ++i) { const GAS f32x4* gp = (const GAS f32x4*)(F.A->in[3] + (size_t)i * DM) + F.lane;
#pragma unroll
            for (int j = 0; j < 4; ++j) gg[i][j] = gp[64 * j]; }
#pragma unroll
        for (int i = 0; i < 4; ++i) {
            GAS v2u* o8 = (GAS v2u*)((bf16*)(F.ws + WS_MEMN) + ((size_t)i * BATCH * ML + r) * DM) + F.lane;
#pragma unroll
            for (int j = 0; j < 4; ++j) { const f32x4 g = gg[i][j]; v2u w; w.x = pk2(v[j].x * rs * g.x, v[j].y * rs * g.y); w.y = pk2(v[j].z * rs * g.z, v[j].w * rs * g.w); o8[64 * j] = w; }
        }
    }
}

__device__ __forceinline__ void phase_norm(Frame& F, const float* src32  , bf16* h16, const float* gain, int kind, bool combine, const float* wx  , const float* bf  , bool f8out = false) {
    LAS float* wl = (LAS float*)(F.lds + RING_OFF);
    LAS int* wcnt = (LAS int*)(F.lds + RING_OFF + 65536);
    __syncthreads();
    static_assert(DM == 2 * NWAVES * 64 && NH == 12 && NE == 8 && (FOXIN * 4) % 16 == 0 && (3 * FOXD * 4) % 16 == 0, "weight staging shape");
    if (kind == 1) { f32x4 r[2][3];
#pragma unroll
        for (int q = 0; q < 2; ++q) { const GAS f32x4* src = (const GAS f32x4*)(wx + (size_t)(F.tid + 512 * q) * FOXIN + 3 * FOXD);
#pragma unroll
            for (int c = 0; c < 3; ++c) r[q][c] = src[c]; }
#pragma unroll
        for (int q = 0; q < 2; ++q)
#pragma unroll
            for (int c = 0; c < 3; ++c)
#pragma unroll
                for (int e = 0; e < 4; ++e) wl[(4 * c + e) * DM + F.tid + 512 * q] = r[q][c][e]; }
    if (kind == 2) { f32x4 r[2][2];
#pragma unroll
        for (int q = 0; q < 2; ++q) { const GAS f32x4* src = (const GAS f32x4*)(wx + (size_t)(F.tid + 512 * q) * NE); r[q][0] = src[0]; r[q][1] = src[1]; }
#pragma unroll
        for (int q = 0; q < 2; ++q)
#pragma unroll
            for (int c = 0; c < 2; ++c)
#pragma unroll
                for (int e = 0; e < 4; ++e) wl[(4 * c + e) * DM + F.tid + 512 * q] = r[q][c][e]; }
    __syncthreads();
    f32x4 g[4];
#pragma unroll
    for (int j = 0; j < 4; ++j) g[j] = ((const f32x4*)gain)[64 * j + F.lane];
    bf16* UB = (bf16*)(F.ws + WS_UB);
    const bf16* Y = (const bf16*)(F.ws + WS_XS);
    const int* SLOT = (const int*)(F.ws + WS_SLOT);
    for (int chunk = F.vcu; chunk < T / 128; chunk += F.G) {
        int cnt[NE];
#pragma unroll
        for (int e = 0; e < NE; ++e) cnt[e] = 0;
        const int mb = chunk * 128 + F.wave * 16;
        f32x4 n32[4]; v2u n16[4], na[4], nb[4];
        auto issue = [&](int m, int s0, int s1) {
            if (src32) { const GAS f32x4* xr = (const GAS f32x4*)(src32 + (size_t)m * DM) + F.lane;
#pragma unroll
                for (int j = 0; j < 4; ++j) n32[j] = xr[64 * j]; }
            else { const GAS v2u* hr = (const GAS v2u*)(h16 + (size_t)m * DM) + F.lane;
#pragma unroll
                for (int j = 0; j < 4; ++j) n16[j] = hr[64 * j]; }
            if (combine) { const GAS v2u* y0 = (const GAS v2u*)(Y + (size_t)s0 * DM) + F.lane; const GAS v2u* y1 = (const GAS v2u*)(Y + (size_t)s1 * DM) + F.lane;
#pragma unroll
                for (int j = 0; j < 4; ++j) { na[j] = y0[64 * j]; nb[j] = y1[64 * j]; } } };
        const int l1 = F.lane & 1; int fv = 0;
        { int v0 = 0; if (combine) { v0 = ((const GAS int*)SLOT)[2 * mb + l1]; fv = ((const GAS int*)SLOT)[2 * mb + 2 + l1]; }
          issue(mb, __builtin_amdgcn_readlane(v0, 0), __builtin_amdgcn_readlane(v0, 1)); }
#pragma unroll 1
        for (int i = 0; i < 16; ++i) {
            const int m = mb + i;
            f32x4 v[4];
            if (src32) {
#pragma unroll
                for (int j = 0; j < 4; ++j) v[j] = n32[j]; }
            else {
#pragma unroll
                for (int j = 0; j < 4; ++j) v[j] = (f32x4){bflo(n16[j].x), bfhi(n16[j].x), bflo(n16[j].y), bfhi(n16[j].y)}; }
            v2u ca[4], cb_[4];
            if (combine) {
#pragma unroll
                for (int j = 0; j < 4; ++j) { ca[j] = na[j]; cb_[j] = nb[j]; } }
            if (i + 1 < 16) { const int vc = fv;
                if (combine && i + 2 < 16) fv = ((const GAS int*)SLOT)[2 * m + 4 + l1];
                issue(m + 1, __builtin_amdgcn_readlane(vc, 0), __builtin_amdgcn_readlane(vc, 1)); }
            if (combine) {
                GAS v2u* ho = (GAS v2u*)(h16 + (size_t)m * DM) + F.lane;
#pragma unroll
                for (int j = 0; j < 4; ++j) { const v2u a = ca[j], b = cb_[j];
                    v[j].x += bflo(a.x) + bflo(b.x); v[j].y += bfhi(a.x) + bfhi(b.x); v[j].z += bflo(a.y) + bflo(b.y); v[j].w += bfhi(a.y) + bfhi(b.y);
                    v2u w; w.x = pk2(v[j].x, v[j].y); w.y = pk2(v[j].z, v[j].w); ho[64 * j] = w;
                    v[j] = (f32x4){bflo(w.x), bfhi(w.x), bflo(w.y), bfhi(w.y)}; }
            }
            float ss = 0.f;
#pragma unroll
            for (int j = 0; j < 4; ++j) ss += (v[j].x * v[j].x + v[j].y * v[j].y) + (v[j].z * v[j].z + v[j].w * v[j].w);
            const float rs = __builtin_amdgcn_rsqf(wave_sum_l(ss, F.lane) * (1.0f / DM) + lconst(RMS_EPS));
            GAS v2u* o8 = (GAS v2u*)(UB + (size_t)m * DM) + F.lane; GAS unsigned* o4 = (GAS unsigned*)((unsigned char*)UB + (size_t)m * DM) + F.lane;
#pragma unroll
            for (int j = 0; j < 4; ++j) { v[j] = v[j] * rs * g[j];
                if (kind == 2 || f8out) o4[64 * j] = pk4f8(clampf8(v[j].x * ASC_Z), clampf8(v[j].y * ASC_Z), clampf8(v[j].z * ASC_Z), clampf8(v[j].w * ASC_Z));
                else { v2u w; w.x = pk2(v[j].x, v[j].y); w.y = pk2(v[j].z, v[j].w); o8[64 * j] = w; } }
            if (kind == 1) {
                float pv[16];
#pragma unroll
                for (int h = 0; h < NH; ++h) { float p = 0.f;
#pragma unroll
                    for (int j = 0; j < 4; ++j) { const f32x4 w = ((const LAS f32x4*)(wl + h * DM))[64 * j + F.lane]; p += (v[j].x * w.x + v[j].y * w.y) + (v[j].z * w.z + v[j].w * w.w); }
                    pv[h] = p; }
#pragma unroll
                for (int h = NH; h < 16; ++h) pv[h] = pv[h - NH];
                const float z = wave_reduce16(pv, F.lane); const int hh = F.lane >> 2;
                if ((F.lane & 3) == 0 && hh < NH) { const float x = z + bf[hh]; const float lf = fminf(x, 0.f) - 0.6931471805599453f * __builtin_amdgcn_logf(1.0f + __builtin_amdgcn_exp2f(-1.4426950408889634f * fabsf(x))); ((float*)(F.ws + WS_LOGF))[(size_t)m * NH + hh] = lf; }
            }
            if (kind == 2) {
                float lg[NE];
                { float pv[NE];
#pragma unroll
                  for (int e = 0; e < NE; ++e) { float p = 0.f;
#pragma unroll
                    for (int j = 0; j < 4; ++j) { const f32x4 w = ((const LAS f32x4*)(wl + e * DM))[64 * j + F.lane]; p += (v[j].x * w.x + v[j].y * w.y) + (v[j].z * w.z + v[j].w * w.w); }
                    pv[e] = p; }
                  const float z = wave_reduce8(pv, F.lane);
#pragma unroll
                  for (int e = 0; e < NE; ++e) lg[e] = __builtin_bit_cast(float, __builtin_amdgcn_readlane(__builtin_bit_cast(int, z), 8 * e)); }
                int e1 = 0; float l1 = lg[0];
#pragma unroll
                for (int e = 1; e < NE; ++e) if (lg[e] > l1) { l1 = lg[e]; e1 = e; }
                int e2 = -1; float l2 = -INFINITY;
#pragma unroll
                for (int e = 0; e < NE; ++e) if (e != e1 && lg[e] > l2) { l2 = lg[e]; e2 = e; }
                const float ex = __builtin_amdgcn_exp2f(1.4426950408889634f * (l2 - l1)), g1 = __builtin_amdgcn_rcpf(1.0f + ex), g2 = ex * g1;
                if (F.lane == 0) { int* te = (int*)(F.ws + WS_TOPE) + 2 * m; float* tg = (float*)(F.ws + WS_TOPG) + 2 * m; te[0] = e1; te[1] = e2; tg[0] = g1; tg[1] = g2; }
#pragma unroll
                for (int e = 0; e < NE; ++e) cnt[e] += (e == e1) + (e == e2);
            }
        }
        if (kind == 2) {
            __syncthreads();
            if (F.lane == 0) {
#pragma unroll
                for (int e = 0; e < NE; ++e) wcnt[F.wave * NE + e] = cnt[e];
            }
            __syncthreads();
            if (F.tid < NE) { int s = 0; for (int w = 0; w < NWAVES; ++w) s += wcnt[w * NE + F.tid]; ((int*)(F.ws + WS_CNT))[chunk * NE + F.tid] = s; }
        }
    }
}

__device__ __forceinline__ void phase_cumsum(Frame& F) {
    const float* LOGF = (const float*)(F.ws + WS_LOGF); float* CB = (float*)(F.ws + WS_CB);
    LAS double* wtot = (LAS double*)(F.lds + RING_OFF);
    for (int sq = F.vcu; sq < BATCH * NH; sq += F.G) {
        const int b = sq / NH, h = sq - b * NH; const int t0 = F.wave * 512;
        float x[8];
#pragma unroll
        for (int k = 0; k < 8; ++k) x[k] = LOGF[((size_t)b * SEQ + t0 + k * 64 + F.lane) * NH + h];
        double sc[8]; double carry = 0.0;
#pragma unroll
        for (int k = 0; k < 8; ++k) {
            double v = (double)x[k];
#pragma unroll
            for (int o = 1; o < 64; o <<= 1) { const double n = lane_up_d(v, o, F.lane); if (F.lane >= o) v += n; }
            v += carry; sc[k] = v; carry = lane_get_d(v, 63);
        }
        __syncthreads();
        if (F.lane == 0) wtot[F.wave] = carry;
        __syncthreads();
        double base = 0.0; for (int w = 0; w < F.wave; ++w) base += wtot[w];
#pragma unroll
        for (int k = 0; k < 8; ++k) CB[(size_t)sq * SEQ + t0 + k * 64 + F.lane] = (float)((sc[k] + base) * 1.4426950408889634);
    }
    __syncthreads();
}

__device__ __forceinline__ void glds16_s(unsigned voff32, const void* sbase, unsigned ldsdst) { unsigned keep_;
    asm volatile("s_mov_b32 %0, m0\n\ts_mov_b32 m0, %3\n\ts_nop 0\n\tglobal_load_lds_dwordx4 %1, %2\n\ts_mov_b32 m0, %0" : "=&s"(keep_) : "v"(voff32), "s"(sbase), "s"(ldsdst) : "memory"); }
__device__ __forceinline__ void gstore32_s(unsigned voff32, unsigned data, const void* sbase) { asm volatile("global_store_dword %0, %1, %2" :: "v"(voff32), "v"(data), "s"(sbase) : "memory"); }
typedef float f32x2p __attribute__((ext_vector_type(2)));
template <int R> __device__ __forceinline__ void conv_row(f32x2p (&o)[16], const f32x2p (&w)[CW], const unsigned (&xr)[46]) {
    const unsigned x = xr[R]; const f32x2p xv = {bflo(x), bfhi(x)};
#pragma unroll
    for (int j = 0; j < CW; ++j) { const int tt = R - j; if (tt >= 0 && tt < 16) o[tt] = __builtin_elementwise_fma(w[j], xv, o[tt]); }
    __builtin_amdgcn_sched_barrier(0);
}
template <int... Rs> __device__ __forceinline__ void conv_rows(std::integer_sequence<int, Rs...>, f32x2p (&o)[16], const f32x2p (&w)[CW], const LAS unsigned* p0, const LAS unsigned* p1, const LAS unsigned* p2) {
    unsigned xr[46];
    ((xr[Rs] = (((Rs + 2) >> 4) == 0 ? p0 : ((Rs + 2) >> 4) == 1 ? p1 : p2)[((Rs + 2) & 15) * 384]), ...);
    __builtin_amdgcn_sched_barrier(0);
    (conv_row<Rs>(o, w, xr), ...);
}
#ifndef CONV_LN_OLD
#define CONV_LN_OLD 0
#endif
__device__ __forceinline__ void phase_conv(Frame& F, const float* dw, const float* dwb, const float* lng, const float* lnb) {
    const bf16* GLU = (const bf16*)(F.ws + WS_GLU); bf16* MIX = (bf16*)(F.ws + WS_MIX);
    LAS unsigned* tile = (LAS unsigned*)(F.lds + RING_OFF);
    LAS float* red = (LAS float*)(F.lds + RING_OFF + 4 * 24576);
    const int tid = F.tid; const bool act = tid < 384; const int ct = act ? tid : tid - 128; const int c0 = 2 * ct;
    f32x2p w[CW]; float b0, b1, g0, g1, lb0, lb1; const unsigned co4 = (unsigned)c0 * 4u;
#pragma unroll
    for (int j = 0; j < CW; ++j) w[j] = *(const GAS f32x2p*)((const GAS char*)(dw + j * CONVD) + co4);
    { const f32x2p bb = *(const GAS f32x2p*)((const GAS char*)dwb + co4), gg = *(const GAS f32x2p*)((const GAS char*)lng + co4), ll = *(const GAS f32x2p*)((const GAS char*)lnb + co4); b0 = bb.x; b1 = bb.y; g0 = gg.x; g1 = gg.y; lb0 = ll.x; lb1 = ll.y; }
    const unsigned tile0 = (unsigned)(uintptr_t)tile;
    auto dma_block = [&](int b, int B) { const char* gb = (const char*)(GLU + ((size_t)b * SEQ + (size_t)B * 16) * CONVD); const unsigned dst = tile0 + (unsigned)(B & 3) * 24576u;
#pragma unroll
        for (int i = 0; i < 3; ++i) { const int c = F.wave + 8 * i; glds16_s((unsigned)(c * 1024 + F.lane * 16), gb, (unsigned)__builtin_amdgcn_readfirstlane((int)(dst + (unsigned)c * 1024u))); } };
    for (int run = F.vcu; run < T / 128; run += F.G) {
        const int b = run >> 5, B0 = (run & 31) * 8;
        __syncthreads();
        if (B0 == 0) {
            unsigned zz; asm volatile("v_mov_b32 %0, 0" : "=v"(zz));
#pragma unroll
            for (int i = 0; i < 6; ++i) { const int c = F.wave + 8 * i; *(LAS v4u*)((LAS unsigned char*)tile + 2 * 24576 + c * 1024 + F.lane * 16) = (v4u){zz, zz, zz, zz}; }
        } else { dma_block(b, B0 - 2); dma_block(b, B0 - 1); }
        dma_block(b, B0);
#pragma unroll 1
        for (int it = 0; it < 8; ++it) {
            const int B = B0 + it, t0 = B * 16;
            asm volatile("s_waitcnt vmcnt(0)" ::: "memory");
            __syncthreads();
            if (it < 7) dma_block(b, B + 1);
            f32x2p o[16];
#pragma unroll
            for (int tt = 0; tt < 16; ++tt) o[tt] = (f32x2p){b0, b1};
            conv_rows(std::make_integer_sequence<int, 46>{}, o, w, tile + ((B - 2) & 3) * 6144 + ct, tile + ((B - 1) & 3) * 6144 + ct, tile + (B & 3) * 6144 + ct);
            { float pv[32];
#pragma unroll
              for (int tt = 0; tt < 16; ++tt) { pv[2 * tt] = o[tt].x + o[tt].y; pv[2 * tt + 1] = o[tt].x * o[tt].x + o[tt].y * o[tt].y; }
              const float z = wave_reduce32(pv, F.lane);
              if ((F.lane & 1) == 0 && F.wave < 6) red[F.wave * 32 + (F.lane >> 1)] = z; }
            __syncthreads();
#if !CONV_LN_OLD
#ifndef CONV_VAR
#define CONV_VAR 0
#endif
            { const int tk = F.lane & 15; float s1, s2;
              { const f32x2p r2 = *(const LAS f32x2p*)(red + tk * 2); s1 = r2.x; s2 = r2.y; }
#pragma unroll
              for (int w6 = 1; w6 < 6; ++w6) { const f32x2p r2 = *(const LAS f32x2p*)(red + (w6 * 16 + tk) * 2); s1 += r2.x; s2 += r2.y; }
              const float mean = s1 * (1.0f / CONVD), var = fmaxf(s2 * (1.0f / CONVD) - mean * mean, 0.f), rstd = __builtin_amdgcn_rsqf(var + lconst(RMS_EPS));
              LAS f32x2p* st = (LAS f32x2p*)(red + 192) + F.wave * 16;
#if CONV_VAR == 3
              st[tk] = (f32x2p){rstd, -mean * rstd};
#else
              if (F.lane < 16) st[tk] = (f32x2p){rstd, -mean * rstd};
#endif
              asm volatile("s_waitcnt lgkmcnt(0)" ::: "memory");
#if CONV_VAR == 1
#pragma unroll 4
#elif CONV_VAR == 2
#pragma unroll 1
#else
#pragma unroll
#endif
              for (int tt = 0; tt < 16; ++tt) {
#if CONV_VAR == 4
                float a_ = ((const LAS float*)st)[2 * tt], b_ = ((const LAS float*)st)[2 * tt + 1]; asm volatile("" : "+v"(a_), "+v"(b_)); const f32x2p ab = {a_, b_};
#else
                const f32x2p ab = st[tt];
#endif
                const float y0 = (o[tt].x * ab.x + ab.y) * g0 + lb0, y1 = (o[tt].y * ab.x + ab.y) * g1 + lb1;
                const float z0 = y0 * __builtin_amdgcn_rcpf(1.0f + __builtin_amdgcn_exp2f(-1.4426950408889634f * y0)), z1 = y1 * __builtin_amdgcn_rcpf(1.0f + __builtin_amdgcn_exp2f(-1.4426950408889634f * y1));
                if (act) *(GAS unsigned*)((GAS char*)(MIX + ((size_t)b * SEQ + t0 + tt) * DM) + (co4 >> 1)) = pk2(z0, z1);
#if CONV_VAR == 5
                __builtin_amdgcn_sched_barrier(0);
#endif
              } }
#else
#pragma unroll
            for (int tt = 0; tt < 16; ++tt) { float s1 = 0.f, s2 = 0.f;
#pragma unroll
                for (int w6 = 0; w6 < 6; ++w6) { s1 += red[(w6 * 16 + tt) * 2]; s2 += red[(w6 * 16 + tt) * 2 + 1]; }
                const float mean = s1 * (1.0f / CONVD), var = fmaxf(s2 * (1.0f / CONVD) - mean * mean, 0.f), rstd = __builtin_amdgcn_rsqf(var + lconst(RMS_EPS));
                const float y0 = (o[tt].x - mean) * rstd * g0 + lb0, y1 = (o[tt].y - mean) * rstd * g1 + lb1;
                const float z0 = y0 * __builtin_amdgcn_rcpf(1.0f + __builtin_amdgcn_exp2f(-1.4426950408889634f * y0)), z1 = y1 * __builtin_amdgcn_rcpf(1.0f + __builtin_amdgcn_exp2f(-1.4426950408889634f * y1));
                if (act) *(GAS unsigned*)((GAS char*)(MIX + ((size_t)b * SEQ + t0 + tt) * DM) + (co4 >> 1)) = pk2(z0, z1); }
#endif
        }
    }
    __syncthreads();
}

__device__ __forceinline__ void phase_scatter(Frame& F) {
    LAS int* pre = (LAS int*)(F.lds + RING_OFF);
    LAS int* wtot = pre + 2048;
    LAS int* tot = wtot + 32;
    LAS int* wc2 = tot + 16;
    LAS int* rowl = wc2 + 32;
    const int* CNT = (const int*)(F.ws + WS_CNT); const int* TOPE = (const int*)(F.ws + WS_TOPE); const float* TOPG = (const float*)(F.ws + WS_TOPG);
    int* SLOT = (int*)(F.ws + WS_SLOT); float* ROWG = (float*)(F.ws + WS_ROWG); int* TAB = (int*)(F.ws + WS_TAB);
    const unsigned char* UB = (const unsigned char*)(F.ws + WS_UB); unsigned char* XS = (unsigned char*)(F.ws + WS_XS);
    const int tid = F.tid, lane = F.lane, wave = F.wave;
    int v[NE];
    if (tid < 256) {
#pragma unroll
        for (int e = 0; e < NE; ++e) v[e] = CNT[tid * NE + e];
        int inc[NE];
#pragma unroll
        for (int e = 0; e < NE; ++e) { int x = v[e];
#pragma unroll
            for (int o = 1; o < 64; o <<= 1) { const int n = lane_up_i(x, o, lane); if (lane >= o) x += n; }
            inc[e] = x; }
        if (lane == 63) {
#pragma unroll
            for (int e = 0; e < NE; ++e) wtot[wave * NE + e] = inc[e];
        }
#pragma unroll
        for (int e = 0; e < NE; ++e) v[e] = inc[e] - v[e];
    }
    __syncthreads();
    if (tid < 256) {
#pragma unroll
        for (int e = 0; e < NE; ++e) { int add = 0; for (int w = 0; w < wave; ++w) add += wtot[w * NE + e]; pre[tid * NE + e] = v[e] + add; }
    }
    if (tid < NE) { int s = 0; for (int w = 0; w < 4; ++w) s += wtot[w * NE + tid]; tot[tid] = s; }
    __syncthreads();
    if (tid == 0) { int ps; asm volatile("v_mov_b32 %0, 0" : "=v"(ps)); for (int e = 0; e < NE; ++e) { tot[8 + e] = ps; ps += (tot[e] + 255) & ~255; } }
    __syncthreads();
    for (int chunk = F.vcu; chunk < T / 128; chunk += F.G) {
        int e = 0, rank = 0; const int f = chunk * 256 + tid;
        if (tid < 256) {
            e = TOPE[f];
#pragma unroll
            for (int x = 0; x < NE; ++x) { const unsigned long long mask = __ballot(e == x); if (e == x) rank = __popcll(mask & ((1ull << lane) - 1ull)); if (lane == 0) wc2[wave * NE + x] = __popcll(mask); }
        }
        __syncthreads();
        if (tid < 256) {
            int base = tot[8 + e] + pre[chunk * NE + e]; for (int w = 0; w < wave; ++w) base += wc2[w * NE + e];
            const int row = base + rank; SLOT[f] = row; ROWG[row] = TOPG[f]; rowl[tid] = row;
        }
        __syncthreads();
        { v4u rw[16];
#pragma unroll
          for (int q = 0; q < 16; ++q) { const int tok = chunk * 128 + wave * 16 + q; rw[q] = ((const GAS v4u*)(UB + (size_t)tok * DM) + lane)[0]; }
#pragma unroll
          for (int q = 0; q < 32; ++q) { const int row = rowl[wave * 32 + q]; ((GAS v4u*)(XS + (size_t)row * DM) + lane)[0] = rw[q >> 1]; } }
        __syncthreads();
    }
    for (int e = F.vcu; e < NE; e += F.G) { const int lo = tot[8 + e] + tot[e], hi = tot[8 + e] + ((tot[e] + 255) & ~255);
        unsigned zz; asm volatile("v_mov_b32 %0, 0" : "=v"(zz));
        for (int r = lo + wave; r < hi; r += NWAVES) { GAS v4u* d = (GAS v4u*)(XS + (size_t)r * DM) + lane; d[0] = (v4u){zz, zz, zz, zz}; if (lane == 0) ROWG[r] = 0.f; } }
    if (F.vcu == 0) {
        if (tid == 0) { int nrt = 0; for (int e = 0; e < NE; ++e) nrt += (tot[e] + 255) >> 8; TAB[0] = nrt; }
        if (tid < MAXRT) { int ex = NE - 1; for (int e = NE - 1; e >= 0; --e) if (tid * 256 < tot[8 + e] + ((tot[e] + 255) & ~255)) ex = e; TAB[16 + tid] = ex; }
    }
}

__device__ __forceinline__ void phase_final(Frame& F) {
    const bf16* Y = (const bf16*)(F.ws + WS_XS); const GAS int* SLOT = (const GAS int*)(F.ws + WS_SLOT); const bf16* H16 = (const bf16*)(F.ws + WS_H16);
    const int gw = F.vcu * NWAVES + F.wave, NGW = F.G * NWAVES;
    v2u nh[4], na[4], nb[4];
    auto issue = [&](int m, int s0, int s1) {
        const GAS v2u* hr = (const GAS v2u*)(H16 + (size_t)m * DM) + F.lane; const GAS v2u* y0 = (const GAS v2u*)(Y + (size_t)s0 * DM) + F.lane; const GAS v2u* y1 = (const GAS v2u*)(Y + (size_t)s1 * DM) + F.lane;
#pragma unroll
        for (int j = 0; j < 4; ++j) { nh[j] = hr[64 * j]; na[j] = y0[64 * j]; nb[j] = y1[64 * j]; } };
    const int l1 = F.lane & 1; int fv = 0;
#define SLOT2(v) __builtin_amdgcn_readlane((v), 0), __builtin_amdgcn_readlane((v), 1)
    if (gw < T) { const int v0 = SLOT[2 * gw + l1]; if (gw + NGW < T) fv = SLOT[2 * (gw + NGW) + l1]; issue(gw, SLOT2(v0)); }
#pragma unroll 1
    for (int m = gw; m < T; m += NGW) {
        GAS f32x4* xr = (GAS f32x4*)(F.out + (size_t)m * DM) + F.lane;
        v2u ch[4], ca[4], cb_[4];
#pragma unroll
        for (int j = 0; j < 4; ++j) { ch[j] = nh[j]; ca[j] = na[j]; cb_[j] = nb[j]; }
        if (m + NGW < T) { const int vc = fv; if (m + 2 * NGW < T) fv = SLOT[2 * (m + 2 * NGW) + l1]; issue(m + NGW, SLOT2(vc)); }
#pragma unroll
        for (int j = 0; j < 4; ++j) { const v2u h = ch[j], a = ca[j], b = cb_[j]; f32x4 v;
            v.x = bflo(h.x) + (bflo(a.x) + bflo(b.x)); v.y = bfhi(h.x) + (bfhi(a.x) + bfhi(b.x)); v.z = bflo(h.y) + (bflo(a.y) + bflo(b.y)); v.w = bfhi(h.y) + (bfhi(a.y) + bfhi(b.y)); xr[64 * j] = v; }
    }
}
#ifndef DIS_PRO
#define DIS_PRO 0
#endif
#ifndef DIS_NORM
#define DIS_NORM 0
#endif
#ifndef DIS_PMK
#define DIS_PMK 0
#endif
#ifndef DIS_CUM
#define DIS_CUM 0
#endif
#ifndef DIS_INE
#define DIS_INE 0
#endif
#ifndef DIS_INO
#define DIS_INO 0
#endif
#ifndef DIS_FOX
#define DIS_FOX 0
#endif
#ifndef DIS_CONV
#define DIS_CONV 0
#endif
#ifndef DIS_MEM
#define DIS_MEM 0
#endif
#ifndef DIS_OUT
#define DIS_OUT 0
#endif
#ifndef DIS_SCAT
#define DIS_SCAT 0
#endif
#ifndef DIS_UP
#define DIS_UP 0
#endif
#ifndef DIS_DOWN
#define DIS_DOWN 0
#endif
#ifndef DIS_FIN
#define DIS_FIN 0
#endif
#ifndef DIS_UPD
#define DIS_UPD 0
#endif
#ifndef DIS_UPM
#define DIS_UPM 0
#endif
#ifndef REP_GIN
#define REP_GIN 1
#endif
#ifndef REP_GOUT
#define REP_GOUT 1
#endif
#ifndef REP_GDENSE
#define REP_GDENSE 1
#endif
#ifndef REP_GMOE
#define REP_GMOE 1
#endif
#ifndef REP_N0C
#define REP_N0C 1
#endif
#ifndef REP_CONV
#define REP_CONV 1
#endif
#ifndef REP_PRO
#define REP_PRO 1
#endif
#ifndef REP_ATT
#define REP_ATT 1
#endif
#ifndef REP_THIN
#define REP_THIN 1
#endif
#ifndef REP_MEM
#define REP_MEM 1
#endif
struct AttnUnitId { int bh, qb; };
struct FoxOrder { int vcu, G;
    __device__ __forceinline__ bool next(int i, AttnUnitId& u) const { const int p = vcu + G * (i >> 1); if (p >= BATCH * NH * 8) return false; const int s = p & 7; u.bh = p >> 3; u.qb = (i & 1) ? 15 - s : s; return true; } };
struct MemOrder { int vcu, G;
    __device__ __forceinline__ bool next(int i, AttnUnitId& u) const { const int p = vcu + G * i; if (p >= BATCH * MEMH * 16) return false; u.bh = p >> 4; u.qb = p & 15; return true; } };

__global__ void __launch_bounds__(NWAVES * 64, 2) mega_fwd(Args args) {
    extern __shared__ __attribute__((aligned(16))) unsigned char lds[];
    Frame F;
    F.lds = (LAS unsigned char*)lds;
    F.MISC = (volatile LAS unsigned*)(F.lds + MISC_OFF);
    const int wave0 = __builtin_amdgcn_readfirstlane((int)threadIdx.x >> 6);
    F.tid = threadIdx.x; F.lane = F.tid & 63; F.wave = wave0;
    F.G = gridDim.x; { const int bx = blockIdx.x; F.vcu = (F.G % 8 == 0) ? (bx % 8) * (F.G / 8) + bx / 8 : bx; }
    const int vcu0 = F.vcu;
    F.ws = args.ws; F.out = args.out; F.ctl = (gu32*)(args.ws + WS_CTL);
    F.A = (const __attribute__((address_space(4))) Args*)__builtin_amdgcn_kernarg_segment_ptr();
    { unsigned z0_; asm volatile("v_mov_b32 %0, 0" : "=v"(z0_)); for (int u = F.tid; u < (LDS_BYTES - LDSCTL_OFF) / 4; u += NWAVES * 64) ((LAS unsigned*)(F.lds + LDSCTL_OFF))[u] = z0_; }
    __syncthreads();
#if BRINGUP
    const int lo = args.ph_lo, hi = args.ph_hi; const unsigned mask = args.mask;
#else
    constexpr int lo = 0, hi = NPH; constexpr unsigned mask = C_ALL;
#endif
    XcdBarrier bar; bar.bar = (unsigned*)(F.ctl + CW_BAR); bar.x = 0; bar.st = nullptr;
    if (hi - lo > 1) bar = xcd_barrier_post((unsigned*)(F.ctl + CW_BAR), F.MISC + 8, F.tid);
#define IN(k) (lo <= (k) && (k) < hi)
#define SLOT_VARS int Lq = L; asm volatile("" : "+s"(Lq)); const int pb = 1 + 9 * Lq, j = Lq >> 1; const bool odd = (Lq & 1) != 0; const float* hsrc = (Lq == 0) ? F.A->in[0] : nullptr; bf16* H16 = (bf16*)(F.ws + WS_H16); (void)j; (void)hsrc; (void)odd; (void)H16
#ifndef REP_BAR
#define REP_BAR 1
#endif
#define SEAM(k) do { if ((k) + 1 < hi) for (int rb_ = 0; rb_ < REP_BAR; ++rb_) { XcdBarrier bz_ = bar; { unsigned pl_ = (unsigned)(unsigned long long)bz_.bar, ph_ = (unsigned)((unsigned long long)bz_.bar >> 32); asm volatile("" : "+v"(pl_), "+v"(ph_)); bz_.bar = (unsigned*)(((unsigned long long)(unsigned)__builtin_amdgcn_readfirstlane((int)ph_) << 32) | (unsigned)__builtin_amdgcn_readfirstlane((int)pl_)); } int tb_; asm volatile("v_mbcnt_lo_u32_b32 %0, -1, 0\n\tv_mbcnt_hi_u32_b32 %0, -1, %0" : "=v"(tb_)); xcd_barrier(bz_, wave0 * 64 + tb_); } } while (0)
    unsigned char* ws = args.ws; bf16 *UB, *MIX, *MQ, *QKV;
#define RS_FINISH() do { const int gt_ = F.vcu * (NWAVES * 64) + F.tid; if (gt_ < T) ((float*)(ws + WS_RS))[gt_] = pg8::row_rs((const float*)(ws + WS_SSQ), gt_); \
        XcdBarrier bz_ = bar; { unsigned long long pz_ = (unsigned long long)bz_.bar; asm volatile("" : "+s"(pz_)); bz_.bar = (unsigned*)pz_; } xcd_barrier(bz_, F.tid); } while (0)
#define PHASE_BEGIN() do { int tz_; asm volatile("v_mbcnt_lo_u32_b32 %0, -1, 0\n\tv_mbcnt_hi_u32_b32 %0, -1, %0" : "=v"(tz_)); { int w_ = wave0, c_ = vcu0, g_ = (int)gridDim.x; asm volatile("" : "+s"(w_), "+s"(c_), "+s"(g_)); F.lane = tz_; F.wave = w_; F.tid = w_ * 64 + tz_; F.vcu = c_; F.G = g_; }   \
        { unsigned wl_ = (unsigned)(unsigned long long)args.ws, wh_ = (unsigned)((unsigned long long)args.ws >> 32); asm volatile("" : "+v"(wl_), "+v"(wh_)); \
          ws = (unsigned char*)(((unsigned long long)(unsigned)__builtin_amdgcn_readfirstlane((int)wh_) << 32) | (unsigned)__builtin_amdgcn_readfirstlane((int)wl_)); F.ws = ws; } \
        { unsigned la_ = (unsigned)(uintptr_t)(LAS unsigned char*)lds; asm volatile("" : "+s"(la_)); LAS unsigned char* lp_ = (LAS unsigned char*)(uintptr_t)la_; F.lds = lp_; F.MISC = (volatile LAS unsigned*)(lp_ + MISC_OFF); } \
        { unsigned long long ka_ = (unsigned long long)__builtin_amdgcn_kernarg_segment_ptr(); asm volatile("" : "+s"(ka_)); F.A = (const __attribute__((address_space(4))) Args*)ka_; } \
        UB = (bf16*)(ws + WS_UB); MIX = (bf16*)(ws + WS_MIX); MQ = (bf16*)(ws + WS_MQ); QKV = (bf16*)(ws + WS_QKV); } while (0)

    if (IN(0)) { PHASE_BEGIN(); if ((mask & C_THIN) && !DIS_PRO) for (int rep_ = 0; rep_ < REP_PRO; ++rep_) { phase_prologue(F); __syncthreads(); } }

    for (int L = 0; L < 4; ++L) {
        { SLOT_VARS;
        if (IN(pb + 0) && !(FUSENORM && !BRINGUP && odd)) {
            PHASE_BEGIN();
            if (mask & C_THIN) {
                if (!DIS_NORM) for (int rn_ = 0; rn_ < ((Lq == 2) ? 1 : REP_N0C); ++rn_) phase_norm(F, hsrc, H16, F.A->in[2] + (size_t)Lq * DM, odd ? 0 : 1, (Lq == 2), odd ? nullptr : F.A->in[8] + (size_t)j * DM * FOXIN, odd ? nullptr : F.A->in[9] + (size_t)j * NH, (IN8L2 && Lq == 2) || (IN8L0 && Lq == 0));
            }
            SEAM(pb + 0);
        } }
        { SLOT_VARS;
        if (IN(pb + 1)) {
            PHASE_BEGIN();
            if (!odd) {
                if (Lq == 0 && (mask & C_PMK) && !DIS_PMK) {
                    pg8::Gemm g{ws + WS_MEMN, ws + WS_WKV, DM * 2, (size_t)2 * MEMD * DM * 2};
                    pg8::Order S; S.init(4 * BATCH * ML / 256, 2, F.G, (int)blockIdx.x, nullptr, BATCH * ML / 256); const pg8::OrderT ST = pg8::order_table(S, F.lds + ORDTAB_OFF, F.tid);
                    pg8::EpiMemKV E{(pg8::bf16_t*)(ws + WS_MKV), F.A->in[7]};
                    pg8::gemm_phase<pg8::EpiMemKV, pg8::OrderT, true, true>(F.lds + RING_OFF, g, ST, E, F.wave);
                }
                if ((mask & C_THIN) && !DIS_CUM) phase_cumsum(F);
                if ((mask & C_INPROJ) && !DIS_INE && ((IN8L2 && Lq == 2) || (IN8L0 && Lq == 0))) {
                    pg8::Gemm g{UB, ws + WS_WINE + (size_t)j * 2560 * DM * 2, DM, 0};
                    pg8::Order S; S.init(T / 256, 10, F.G, (int)blockIdx.x, nullptr, 0); const pg8::OrderT ST = pg8::order_table(S, F.lds + ORDTAB_OFF, F.tid);
                    pg8::EpiInEven E{QKV, MQ, (const float*)(ws + WS_GT) + Lq * 192, 1.0f / (ASC_Z * WSC_GU)};
                    for (int rg_ = 0; rg_ < REP_GIN; ++rg_) pg8::gemm_phase<pg8::EpiInEven, pg8::OrderT, true, true, true>(F.lds + RING_OFF, g, ST, E, F.wave);
                } else if ((mask & C_INPROJ) && !DIS_INE) {
                    pg8::Gemm g{UB, (const pg8::bf16_t*)(ws + WS_WINE) + (size_t)j * 2560 * DM, DM * 2, 0};
                    pg8::Order S; S.init(T / 256, 10, F.G, (int)blockIdx.x, nullptr, 0); const pg8::OrderT ST = pg8::order_table(S, F.lds + ORDTAB_OFF, F.tid);
                    pg8::EpiInEven E{QKV, MQ, (const float*)(ws + WS_GT) + Lq * 192};
                    for (int rg_ = 0; rg_ < REP_GIN; ++rg_) pg8::gemm_phase<pg8::EpiInEven, pg8::OrderT, true, true>(F.lds + RING_OFF, g, ST, E, F.wave);
#if MOEQ
                    if (Lq == 0 && (mask & C_THIN)) { pg8::Order Sp; Sp.init(4 * BATCH * ML / 256, 2, F.G, (int)blockIdx.x, nullptr, BATCH * ML / 256); pg8::Unit up_; if (!Sp.next(0, up_)) { __syncthreads(); convert_moe_queue(F, 0, (gu32*)(ws + WS_CTL) + CW_QUEUE, 2); } }
#endif
                }
            } else if ((mask & C_INPROJ) && !DIS_INO && ((IN8ODD >> j) & 1)) {
                pg8::Gemm g{UB, ws + WS_WINO + (size_t)j * CONVIN * DM * 2, DM, 0};
                pg8::Order S; S.init(T / 256, 7, F.G, (int)blockIdx.x, nullptr, 0); const pg8::OrderT ST = pg8::order_table(S, F.lds + ORDTAB_OFF, F.tid);
                pg8::EpiInOdd E{(pg8::bf16_t*)(ws + WS_GLU), MQ, F.A->in[14] + (size_t)j * 2 * CONVD, (const float*)(ws + WS_GT) + Lq * 192 + 128, (const float*)(ws + WS_SSQ), 1.0f / (ASC_Z * WSC_GU)};
                for (int rg_ = 0; rg_ < REP_GIN; ++rg_) pg8::gemm_phase<pg8::EpiInOdd, pg8::OrderT, true, true, true>(F.lds + RING_OFF, g, ST, E, F.wave);
            } else if ((mask & C_INPROJ) && !DIS_INO) {
                pg8::Gemm g{(FUSENORM && !BRINGUP) ? (const void*)(ws + WS_H16) : (const void*)UB, (const pg8::bf16_t*)(ws + WS_WINO) + (size_t)j * CONVIN * DM, DM * 2, 0};
                pg8::Order S; S.init(T / 256, 7, F.G, (int)blockIdx.x, nullptr, 0); const pg8::OrderT ST = pg8::order_table(S, F.lds + ORDTAB_OFF, F.tid);
                pg8::EpiInOdd E{(pg8::bf16_t*)(ws + WS_GLU), MQ, F.A->in[14] + (size_t)j * 2 * CONVD, (const float*)(ws + WS_GT) + Lq * 192 + 128, (FUSENORM && !BRINGUP) ? (const float*)(ws + WS_SSQ) : nullptr};
                for (int rg_ = 0; rg_ < REP_GIN; ++rg_) pg8::gemm_phase<pg8::EpiInOdd, pg8::OrderT, true, true>(F.lds + RING_OFF, g, ST, E, F.wave);
            }
            SEAM(pb + 1);
        } }
        { SLOT_VARS;
        if (IN(pb + 2)) {
            PHASE_BEGIN();
            if (!odd) {
                if ((mask & C_FOX) && !DIS_FOX) for (int rep_ = 0; rep_ < REP_ATT; ++rep_) {
                    const FoxOrder S{F.vcu, F.G}; AttnUnitId u;
                    int tfx_; asm volatile("v_mbcnt_lo_u32_b32 %0, -1, 0\n\tv_mbcnt_hi_u32_b32 %0, -1, %0" : "=v"(tfx_)); const int tidf = F.wave * 64 + tfx_;
                    const float xskip = ((const float*)(ws + WS_GT))[1024 + j];
                    float cqn = 0.f, ckn = 0.f; AttnUnitId un; bool hn = S.next(0, un);
                    auto bias_req = [&](const AttnUnitId& q) { const float* cbq = (const float*)(ws + WS_CB) + (size_t)q.bh * SEQ; const int NT = 4 * (q.qb + 1); const int jt = tfx_; cqn = ((const GAS float*)cbq)[q.qb * 256]; ckn = ((const GAS float*)cbq)[(jt < NT ? jt : NT - 1) * 64 + 63]; };
                    if (hn) bias_req(un);
                    for (int i = 0; hn; ++i) {
                        u = un; const float cq = cqn, ck = ckn;
                        hn = S.next(i + 1, un); if (hn) bias_req(un);
                        const int b = u.bh / NH, h = u.bh - b * NH; const size_t r0 = (size_t)b * SEQ;
                        const float* cbq = (const float*)(ws + WS_CB) + (size_t)u.bh * SEQ; const int NT = 4 * (u.qb + 1);
                        int j0; { const int jt = tfx_;
                            const unsigned long long live = __builtin_amdgcn_ballot_w64(jt < NT && (cq - ck >= -xskip));
                            j0 = live ? (int)__builtin_ctzll(live) : NT - 4; j0 = __builtin_amdgcn_readfirstlane(j0); if (j0 > NT - 4) j0 = NT - 4; j0 &= ~1; }
                        attn_body::attn_unit<24, true, true, 3 * FOXD, 3 * FOXD, DM, true>((const attn_body::bf16*)QKV + (r0 + (size_t)u.qb * 256) * (3 * FOXD) + h * HD,
                            (const attn_body::bf16*)QKV + (r0 + (size_t)j0 * 64) * (3 * FOXD) + FOXD + h * HD, (const attn_body::bf16*)QKV + (r0 + (size_t)j0 * 64) * (3 * FOXD) + 2 * FOXD + h * HD,
                            (attn_body::bf16*)MIX + (r0 + (size_t)u.qb * 256) * DM + h * HD, cbq + j0 * 64, NT - j0, (char*)lds + RING_OFF, tidf, fminf((xskip - 40.0f) * 0.505f + 0.25f, 60.0f));
                    }
                }
            } else if ((mask & C_THIN) && !DIS_CONV) for (int rn_ = 0; rn_ < REP_CONV; ++rn_) {
                phase_conv(F, F.A->in[15] + (size_t)j * CW * CONVD, F.A->in[16] + (size_t)j * CONVD, F.A->in[17] + (size_t)j * CONVD, F.A->in[18] + (size_t)j * CONVD);
            }
            if ((mask & C_MEMATT) && !DIS_MEM) for (int rep_ = 0; rep_ < REP_MEM; ++rep_) {
                int tmx_; asm volatile("v_mbcnt_lo_u32_b32 %0, -1, 0\n\tv_mbcnt_hi_u32_b32 %0, -1, %0" : "=v"(tmx_)); const int tidm = F.wave * 64 + tmx_;
                const MemOrder S{F.vcu, F.G}; AttnUnitId u; const attn_body::bf16* MKVL = (const attn_body::bf16*)(ws + WS_MKV) + (size_t)Lq * BATCH * ML * 2 * MEMD;
                for (int i = 0; S.next(i, u); ++i) {
                    const int b = u.bh / MEMH, h = u.bh - b * MEMH; const size_t r0 = (size_t)b * SEQ + (size_t)u.qb * 256;
                    attn_body::attn_unit<8, false, false, MEMD, 2 * MEMD, DM>((const attn_body::bf16*)MQ + r0 * MEMD + h * HD, MKVL + (size_t)b * ML * (2 * MEMD) + h * HD, MKVL + (size_t)b * ML * (2 * MEMD) + MEMD + h * HD,
                        (attn_body::bf16*)MIX + r0 * DM + FOXD + h * HD, nullptr, ML / 64, (char*)lds + RING_OFF, tidm);
                }
            }
#if MOEQ
#ifndef REP_MOEQ
#define REP_MOEQ 1
#endif
            if (!odd && (mask & C_THIN)) { for (int rq_ = 0; rq_ < REP_MOEQ; ++rq_) { __syncthreads(); convert_moe_queue(F, j, (gu32*)(ws + WS_CTL) + CW_QUEUE + 64 * j + 256 * rq_); } }
#endif
            SEAM(pb + 2);
        } }
        { SLOT_VARS;
        if (IN(pb + 3)) {
            PHASE_BEGIN();
            if ((mask & C_OUTPROJ) && !DIS_OUT) {
                pg8::Gemm g{MIX, (const pg8::bf16_t*)(ws + (odd ? WS_WOUTO : WS_WOUTE)) + (size_t)j * DM * DM, DM * 2, 0};
                pg8::Order S; S.init(T / 256, 4, F.G, (int)blockIdx.x, nullptr, 0); const pg8::OrderT ST = pg8::order_table(S, F.lds + ORDTAB_OFF, F.tid);
                pg8::EpiResid E{hsrc, (pg8::bf16_t*)(ws + WS_H16), 1.0f, (FUSENORM && !BRINGUP && !odd) ? (float*)(ws + WS_SSQ) : nullptr, (FUSENORM && !BRINGUP && !odd && (DENSE8 == 1 || (DENSE8 == 2 && Lq == 2) || (UP8L0 && Lq == 0))) ? (unsigned char*)UB : nullptr};
                for (int rg_ = 0; rg_ < REP_GOUT; ++rg_) { if (rg_) { E.isc = 0.f; E.base32 = nullptr; } pg8::gemm_phase<pg8::EpiResid, pg8::OrderT, true, true>(F.lds + RING_OFF, g, ST, E, F.wave); }
            }
            SEAM(pb + 3);
        } }
        { SLOT_VARS;
        if (IN(pb + 4) && !(FUSENORM && !BRINGUP && !odd)) {
            PHASE_BEGIN();
            if ((mask & C_THIN) && !DIS_NORM) for (int rep_ = 0; rep_ < REP_THIN; ++rep_) phase_norm(F, nullptr, H16, F.A->in[4] + (size_t)Lq * DM, odd ? 2 : 0, false, odd ? F.A->in[23] + (size_t)j * DM * NE : nullptr, nullptr, DENSE8 == 1 || (DENSE8 == 2 && Lq == 2));
            SEAM(pb + 4);
        } }
        { SLOT_VARS;
        if (odd && IN(pb + 5)) {
            PHASE_BEGIN();
            if ((mask & C_THIN) && !DIS_SCAT) for (int rep_ = 0; rep_ < REP_THIN; ++rep_) { phase_scatter(F); __syncthreads(); }
            SEAM(pb + 5);
        } }
        { SLOT_VARS;
        if (IN(pb + 6)) {
            PHASE_BEGIN();
            if ((mask & C_FFNUP) && !DIS_UP) {
                const bool d8 = DENSE8 == 1 || (DENSE8 == 2 && Lq == 2), u8 = d8 || (UP8L0 && Lq == 0);
                if (!odd && !u8 && !DIS_UPD) {
                    pg8::Gemm g{(FUSENORM && !BRINGUP) ? (const void*)(ws + WS_H16) : (const void*)UB, (const pg8::bf16_t*)(ws + WS_WGU) + (size_t)j * 2 * FF * DM, DM * 2, 0};
                    pg8::Order S; S.init(T / 256, 2 * FF / 256, F.G, (int)blockIdx.x, nullptr, 0); const pg8::OrderT ST = pg8::order_table(S, F.lds + ORDTAB_OFF, F.tid);
                    pg8::EpiSwiGLU E{(pg8::bf16_t*)(ws + WS_HIDD), FF, (FUSENORM && !BRINGUP) ? (const float*)(ws + WS_SSQ) : nullptr};
                    for (int rg_ = 0; rg_ < REP_GDENSE; ++rg_) pg8::gemm_phase<pg8::EpiSwiGLU, pg8::OrderT, true, true, false>(F.lds + RING_OFF, g, ST, E, F.wave);
                } else if (!odd && u8 && !d8) {
                    pg8::Gemm g{UB, ws + WS_WGU + (size_t)j * 2 * FF * DM * 2, DM, 0};
                    pg8::Order S; S.init(T / 256, 2 * FF / 256, F.G, (int)blockIdx.x, nullptr, 0); const pg8::OrderT ST = pg8::order_table(S, F.lds + ORDTAB_OFF, F.tid);
                    pg8::EpiSwiGLU8B E{ws + WS_HIDD, FF, 1.0f / (ASC_Z * WSC_GU), 1.0f, (FUSENORM && !BRINGUP) ? (const float*)(ws + WS_SSQ) : nullptr};
                    for (int rg_ = 0; rg_ < REP_GDENSE; ++rg_) pg8::gemm_phase<pg8::EpiSwiGLU8B, pg8::OrderT, true, true, true>(F.lds + RING_OFF, g, ST, E, F.wave);
                } else if (!odd && d8) {
                    pg8::Gemm g{UB, ws + WS_WGU + (size_t)j * 2 * FF * DM * 2, DM, 0};
                    pg8::Order S; S.init(T / 256, 2 * FF / 256, F.G, (int)blockIdx.x, nullptr, 0); const pg8::OrderT ST = pg8::order_table(S, F.lds + ORDTAB_OFF, F.tid);
                    pg8::EpiSwiGLU8 E{ws + WS_HIDD, FF, 1.0f / (ASC_Z * WSC_GU), ASC_H, (FUSENORM && !BRINGUP) ? (const float*)(ws + WS_SSQ) : nullptr};
                    for (int rg_ = 0; rg_ < REP_GDENSE; ++rg_) pg8::gemm_phase<pg8::EpiSwiGLU8, pg8::OrderT, true, true, true>(F.lds + RING_OFF, g, ST, E, F.wave);
                } else if (odd && !DIS_UPM) {
                    const int* TAB = (const int*)(ws + WS_TAB);
                    pg8::Gemm g{ws + WS_XS, ws + WS_WMGU + (size_t)j * WS_WM_LAYER, DM, (size_t)2 * EFF * DM};
                    pg8::Order S; S.init(__builtin_amdgcn_readfirstlane(TAB[0]), 2 * EFF / 256, F.G, (int)blockIdx.x, TAB + 16, 0); const pg8::OrderT ST = pg8::order_table(S, F.lds + ORDTAB_OFF, F.tid);
                    pg8::EpiSwiGLU8 E{ws + WS_HIDM, EFF, 1.0f / (ASC_Z * WSC_GU), ASC_H, nullptr};
                    for (int rg_ = 0; rg_ < REP_GMOE; ++rg_) pg8::gemm_phase<pg8::EpiSwiGLU8, pg8::OrderT, true, true, true>(F.lds + RING_OFF, g, ST, E, F.wave);
#if MOEQ
                    if (Lq == 1 && (mask & C_THIN)) { const int nu_ = __builtin_amdgcn_readfirstlane(TAB[0]) * (2 * EFF / 256); pg8::Unit ux_; if (!S.next(nu_ / F.G, ux_)) { __syncthreads(); convert_moe_queue(F, 1, (gu32*)(ws + WS_CTL) + CW_QUEUE + 64, 1); } }
#endif
                }
            }
            SEAM(pb + 6);
        } }
        { SLOT_VARS;
        if (IN(pb + 7)) {
            PHASE_BEGIN();
            if ((mask & C_FFNDOWN) && !DIS_DOWN) {
                if (!odd) {
                    const bool d8 = DENSE8 == 1 || (DENSE8 == 2 && Lq == 2);
                    if (d8) {
                    pg8::Gemm g{ws + WS_HIDD, ws + WS_WD + (size_t)j * DM * FF * 2, FF, 0};
                    pg8::Order S; S.init(T / 256, 4, F.G, (int)blockIdx.x, nullptr, 0); const pg8::OrderT ST = pg8::order_table(S, F.lds + ORDTAB_OFF, F.tid);
                    pg8::EpiResid E{nullptr, (pg8::bf16_t*)(ws + WS_H16), 1.0f / (ASC_H * WSC_D), (FUSENORM && !BRINGUP) ? (float*)(ws + WS_SSQ) : nullptr, ((IN8ODD >> j) & 1) ? (unsigned char*)UB : nullptr};
                    for (int rg_ = 0; rg_ < REP_GDENSE; ++rg_) { if (rg_) { E.isc = 0.f; E.base32 = nullptr; } pg8::gemm_phase<pg8::EpiResid, pg8::OrderT, true, true, true>(F.lds + RING_OFF, g, ST, E, F.wave); }
                    } else {
                    pg8::Gemm g{ws + WS_HIDD, (const pg8::bf16_t*)(ws + WS_WD) + (size_t)j * DM * FF, FF * 2, 0};
                    pg8::Order S; S.init(T / 256, 4, F.G, (int)blockIdx.x, nullptr, 0); const pg8::OrderT ST = pg8::order_table(S, F.lds + ORDTAB_OFF, F.tid);
                    pg8::EpiResid E{nullptr, (pg8::bf16_t*)(ws + WS_H16), 1.0f, (FUSENORM && !BRINGUP) ? (float*)(ws + WS_SSQ) : nullptr, ((IN8ODD >> j) & 1) ? (unsigned char*)UB : nullptr};
                    for (int rg_ = 0; rg_ < REP_GDENSE; ++rg_) { if (rg_) { E.isc = 0.f; E.base32 = nullptr; } pg8::gemm_phase<pg8::EpiResid, pg8::OrderT, true, true>(F.lds + RING_OFF, g, ST, E, F.wave); }
                    }
                } else {
                    const int* TAB = (const int*)(ws + WS_TAB);
                    pg8::Gemm g{ws + WS_HIDM, ws + WS_WMD + (size_t)j * WS_WM_LAYER, EFF, (size_t)DM * EFF};
                    pg8::Order S; S.init(__builtin_amdgcn_readfirstlane(TAB[0]), 4, F.G, (int)blockIdx.x, TAB + 16, 0); const pg8::OrderT ST = pg8::order_table(S, F.lds + ORDTAB_OFF, F.tid);
                    pg8::EpiRowGate E{(pg8::bf16_t*)(ws + WS_XS), (const float*)(ws + WS_ROWG), DM, 1.0f / (ASC_H * WSC_D)};
                    for (int rg_ = 0; rg_ < REP_GMOE; ++rg_) pg8::gemm_phase<pg8::EpiRowGate, pg8::OrderT, true, true, true>(F.lds + RING_OFF, g, ST, E, F.wave);
#if MOEQ
                    if (Lq == 1 && (mask & C_THIN)) { pg8::Unit u5_; if (!S.next(4, u5_)) { __syncthreads(); convert_moe_queue(F, 1, (gu32*)(ws + WS_CTL) + CW_QUEUE + 64, 3); } }
#endif
                }
            }
            SEAM(pb + 7);
        } }
        { SLOT_VARS;
        if (Lq == 3 && IN(pb + 8)) { PHASE_BEGIN(); if ((mask & C_THIN) && !DIS_FIN) phase_final(F); } }
    }
#undef IN
#undef SEAM
}
#if BRINGUP
namespace naive {
typedef short bf16x8 __attribute__((ext_vector_type(8)));
typedef float f32x4 __attribute__((ext_vector_type(4)));
struct NG { const bf16* A; int lda; const float* W; const float* W2; int ldw; int wcol0, w2col0; int N, K; int mode;
            float* Cf; bf16* Cb; int ldc; int ccol0; const float* base; const float* bias1; const float* bias2; const float* rowg; const int* tab; size_t wstride; };
__global__ __launch_bounds__(256) void gemm(NG g) {
    __shared__ __attribute__((aligned(16))) bf16 sA[64][40];
    __shared__ __attribute__((aligned(16))) bf16 sB[64][40];
    __shared__ __attribute__((aligned(16))) bf16 sB2[64][40];
    const int ntn = g.N / 64, tn = blockIdx.x % ntn, tm = blockIdx.x / ntn;
    const float* W = g.W; const float* W2 = g.W2;
    if (g.tab) { const int rt = tm / 4; if (rt >= g.tab[0]) return; const int e = g.tab[16 + rt]; W += (size_t)e * g.wstride; if (W2) W2 += (size_t)e * g.wstride; }
    const int tid = threadIdx.x, wave = tid >> 6, lane = tid & 63, wr = wave >> 1, wc = wave & 1, fr = lane & 15, fq = lane >> 4;
    const bool dual = (g.mode == 2 || g.mode == 3);
    f32x4 acc[2][2], acc2[2][2];
    for (int a = 0; a < 2; ++a) for (int b = 0; b < 2; ++b) { acc[a][b] = (f32x4){0.f, 0.f, 0.f, 0.f}; acc2[a][b] = (f32x4){0.f, 0.f, 0.f, 0.f}; }
    for (int k0 = 0; k0 < g.K; k0 += 32) {
        { const int r = tid >> 2, kc = (tid & 3) * 8; *(v4u*)&sA[r][kc] = *(const v4u*)(g.A + (size_t)(tm * 64 + r) * g.lda + k0 + kc); }
        { const int k = tid >> 3, nc = (tid & 7) * 8; const float* p = W + (size_t)(k0 + k) * g.ldw + g.wcol0 + tn * 64 + nc;
          for (int i = 0; i < 8; ++i) sB[nc + i][k] = (bf16)f2bf(p[i]);
          if (dual) { const float* p2 = W2 + (size_t)(k0 + k) * g.ldw + g.w2col0 + tn * 64 + nc; for (int i = 0; i < 8; ++i) sB2[nc + i][k] = (bf16)f2bf(p2[i]); } }
        __syncthreads();
        bf16x8 a[2], b[2], b2[2];
        for (int i = 0; i < 2; ++i) { a[i] = *(const bf16x8*)&sA[wr * 32 + i * 16 + fr][fq * 8]; b[i] = *(const bf16x8*)&sB[wc * 32 + i * 16 + fr][fq * 8]; if (dual) b2[i] = *(const bf16x8*)&sB2[wc * 32 + i * 16 + fr][fq * 8]; }
        for (int mi = 0; mi < 2; ++mi) for (int ni = 0; ni < 2; ++ni) { acc[mi][ni] = __builtin_amdgcn_mfma_f32_16x16x32_bf16(a[mi], b[ni], acc[mi][ni], 0, 0, 0);
            if (dual) acc2[mi][ni] = __builtin_amdgcn_mfma_f32_16x16x32_bf16(a[mi], b2[ni], acc2[mi][ni], 0, 0, 0); }
        __syncthreads();
    }
    for (int mi = 0; mi < 2; ++mi) for (int ni = 0; ni < 2; ++ni) for (int jj = 0; jj < 4; ++jj) {
        const int row = tm * 64 + wr * 32 + mi * 16 + fq * 4 + jj, col = tn * 64 + wc * 32 + ni * 16 + fr; const float v = acc[mi][ni][jj], v2 = acc2[mi][ni][jj];
        const size_t o = (size_t)row * g.ldc + g.ccol0 + col;
        if (g.mode == 0) g.Cf[o] = v;
        else if (g.mode == 1) g.Cf[o] = g.base[o] + v;
        else if (g.mode == 2) g.Cb[o] = (bf16)f2bf(v / (1.0f + expf(-v)) * v2);
        else if (g.mode == 3) g.Cb[o] = (bf16)f2bf((v + g.bias1[col]) / (1.0f + expf(-(v2 + g.bias2[col]))));
        else g.Cb[o] = (bf16)f2bf(v * g.rowg[row]);
    }
}
__global__ void headnorm(const float* P, int ldp, int pcol0, int nheads, const float* gain, float sc, int norm, bf16* dst, int ldd, int dcol0, int rows) {
    const int idx = blockIdx.x * blockDim.x + threadIdx.x; if (idx >= rows * nheads) return;
    const int row = idx / nheads, h = idx - row * nheads; const float* p = P + (size_t)row * ldp + pcol0 + h * 64; bf16* d = dst + (size_t)row * ldd + dcol0 + h * 64;
    float r = 1.f;
    if (norm) { float ss = 0.f; for (int i = 0; i < 64; ++i) ss += p[i] * p[i]; r = sc / sqrtf(ss * (1.0f / 64.0f) + 1e-6f); }
    for (int i = 0; i < 64; ++i) d[i] = (bf16)f2bf(norm ? p[i] * r * gain[i] : p[i]);
}
__global__ __launch_bounds__(256) void attn(const bf16* Q, int qp, const bf16* K, const bf16* V, int kp, bf16* O, int op, const float* CB, int nheads, int sq, int skv, int causal) {
    const int lane = threadIdx.x & 63; const long gw = (long)blockIdx.x * 4 + (threadIdx.x >> 6);
    const int t = (int)(gw % sq); const int bh = (int)(gw / sq), h = bh % nheads, b = bh / nheads;
    float qf[64]; { const bf16* qrow = Q + ((size_t)b * sq + t) * qp + h * 64;
#pragma unroll
        for (int d = 0; d < 64; ++d) qf[d] = bflo((unsigned)qrow[d]); }
    const int nk = causal ? t + 1 : skv; float m = -INFINITY, l = 0.f, o = 0.f;
    for (int s0 = 0; s0 < nk; s0 += 64) {
        const int s = s0 + lane; float sc = -INFINITY;
        if (s < nk) { const bf16* krow = K + ((size_t)b * skv + s) * kp + h * 64; float dot = 0.f;
#pragma unroll
            for (int d = 0; d < 64; d += 2) { const unsigned w = *(const unsigned*)(krow + d); dot += qf[d] * bflo(w) + qf[d + 1] * bfhi(w); }
            sc = dot - (CB ? CB[(size_t)bh * skv + s] : 0.f); }
        float tm = sc; for (int x = 1; x < 64; x <<= 1) tm = fmaxf(tm, __shfl_xor(tm, x));
        const float mn = fmaxf(m, tm), alpha = exp2f(m - mn), p = (s < nk) ? exp2f(sc - mn) : 0.f;
        l = l * alpha + wave_sum(p); o *= alpha;
        const int lim = (nk - s0) < 64 ? (nk - s0) : 64;
        for (int jj = 0; jj < lim; ++jj) { const float pj = __shfl(p, jj); o += pj * bflo((unsigned)V[((size_t)b * skv + s0 + jj) * kp + h * 64 + lane]); }
        m = mn;
    }
    O[((size_t)b * sq + t) * op + h * 64 + lane] = (bf16)f2bf(o / l);
}
}
#endif

static void launch_mega(int grid, hipStream_t stream, Args a, int lo, int hi, unsigned mask) {
    a.ph_lo = lo; a.ph_hi = hi; a.mask = mask;
    hipLaunchKernelGGL(mega_fwd, dim3(grid), dim3(NWAVES * 64), LDS_BYTES, stream, a);
}
extern "C" void kernel_launch(void* const* d_in, const int* in_sizes, int n_in, void* d_out, int out_size, void* d_ws, size_t ws_size, hipStream_t stream) {
    static int grid = 0;
    if (grid == 0) {
        if (n_in != 27 || in_sizes[0] != T * DM || out_size != T * DM || ws_size < WS_END) { fprintf(stderr, "kernel_launch: unexpected shapes or workspace (n_in %d, ws %zu < %zu); nothing launched\n", n_in, ws_size, (size_t)WS_END); grid = -1; return; }
        int dev = 0, cus = 0, per_cu = 0;
        if (hipGetDevice(&dev) != hipSuccess || hipDeviceGetAttribute(&cus, hipDeviceAttributeMultiprocessorCount, dev) != hipSuccess) { grid = -1; return; }
        if (hipFuncSetAttribute((const void*)mega_fwd, hipFuncAttributeMaxDynamicSharedMemorySize, LDS_BYTES) != hipSuccess) { fprintf(stderr, "kernel_launch: hipFuncSetAttribute failed\n"); grid = -1; return; }
        if (hipOccupancyMaxActiveBlocksPerMultiprocessor(&per_cu, (const void*)mega_fwd, NWAVES * 64, LDS_BYTES) != hipSuccess || per_cu < 1) { fprintf(stderr, "kernel_launch: occupancy query reports %d\n", per_cu); }
        (void)hipGetLastError();
        grid = cus;
    }
    if (grid < 0) return;
#ifdef DIAG_ZERO_WS
    if (hipMemsetAsync((char*)d_ws, 0, WS_END, stream) != hipSuccess) return;
#endif
    if (hipMemsetAsync((char*)d_ws + WS_CTL, 0, CTL_ZERO_BYTES, stream) != hipSuccess) return;
    Args a{};
    for (int i = 0; i < 27; ++i) a.in[i] = (const float*)d_in[i];
    a.out = (float*)d_out; a.ws = (unsigned char*)d_ws;
#if !BRINGUP
    launch_mega(grid, stream, a, 0, NPH, C_ALL);
#else
    unsigned char* ws = (unsigned char*)d_ws; const float* const* in = a.in;
    const unsigned fast = FASTMASK;
    bf16* UB = (bf16*)(ws + WS_UB); bf16* MIX = (bf16*)(ws + WS_MIX); bf16* MQ = (bf16*)(ws + WS_MQ); bf16* QKV = (bf16*)(ws + WS_QKV); float* NT_ = (float*)(ws + WS_NTMP);
    auto ngemm = [&](naive::NG g, int rows) { hipLaunchKernelGGL(naive::gemm, dim3((rows / 64) * (g.N / 64)), dim3(256), 0, stream, g); };
    auto nhead = [&](const float* P, int ldp, int pcol0, int nheads, const float* gain, float sc, int norm, bf16* dst, int ldd, int dcol0, int rows) {
        hipLaunchKernelGGL(naive::headnorm, dim3((rows * nheads + 255) / 256), dim3(256), 0, stream, P, ldp, pcol0, nheads, gain, sc, norm, dst, ldd, dcol0, rows); };
    launch_mega(grid, stream, a, 0, 1, C_THIN);
#ifndef NLAYERS
#define NLAYERS 4
#endif
    for (int L = 0; L < NLAYERS; ++L) {
        const int pb = 1 + 9 * L, j = L >> 1; const bool odd = L & 1; const float* hsrc = L == 0 ? in[0] : (const float*)d_out;
        launch_mega(grid, stream, a, pb, pb + 1, C_THIN);
        if (!odd) {
            if (L == 0) {
                if (fast & C_PMK) launch_mega(grid, stream, a, pb + 1, pb + 2, C_PMK);
                else for (int i = 0; i < 4; ++i) {
                    naive::NG g{}; g.A = (const bf16*)(ws + WS_MEMN) + (size_t)i * 2048 * DM; g.lda = DM; g.W = in[5] + (size_t)i * DM * 512; g.ldw = 512; g.N = 512; g.K = DM; g.mode = 0; g.Cf = NT_; g.ldc = 512; ngemm(g, 2048);
                    nhead(NT_, 512, 0, 4, in[7] + i * 64, 1.0f, 1, (bf16*)(ws + WS_MKV) + (size_t)i * 2048 * 512, 512, 0, 2048);
                    nhead(NT_, 512, 256, 4, in[7], 1.0f, 0, (bf16*)(ws + WS_MKV) + (size_t)i * 2048 * 512, 512, 256, 2048);
                }
            }
            launch_mega(grid, stream, a, pb + 1, pb + 2, C_THIN);
            if (fast & C_INPROJ) launch_mega(grid, stream, a, pb + 1, pb + 2, C_INPROJ);
            else {
                naive::NG g{}; g.A = UB; g.lda = DM; g.W = in[8] + (size_t)j * DM * FOXIN; g.ldw = FOXIN; g.K = DM; g.mode = 0; g.Cf = NT_; g.ldc = 2560;
                g.wcol0 = 0; g.N = 2304; g.ccol0 = 0; ngemm(g, T);
                g.wcol0 = 2316; g.N = 256; g.ccol0 = 2304; ngemm(g, T);
                nhead(NT_, 2560, 0, 12, in[10] + j * 64, C2, 1, QKV, 2304, 0, T);
                nhead(NT_, 2560, 768, 12, in[11] + j * 64, 1.0f, 1, QKV, 2304, 768, T);
                nhead(NT_, 2560, 1536, 12, in[11], 1.0f, 0, QKV, 2304, 1536, T);
                nhead(NT_, 2560, 2304, 4, in[6] + L * 64, C2, 1, MQ, 256, 0, T);
            }
        } else {
            if (fast & C_INPROJ) launch_mega(grid, stream, a, pb + 1, pb + 2, C_INPROJ);
            else {
                naive::NG g{}; g.A = UB; g.lda = DM; g.W = in[13] + (size_t)j * DM * CONVIN; g.W2 = g.W; g.ldw = CONVIN; g.K = DM;
                g.mode = 3; g.wcol0 = 0; g.w2col0 = 768; g.N = 768; g.Cb = (bf16*)(ws + WS_GLU); g.ldc = 768; g.bias1 = in[14] + (size_t)j * 1536; g.bias2 = g.bias1 + 768; ngemm(g, T);
                naive::NG h{}; h.A = UB; h.lda = DM; h.W = g.W; h.ldw = CONVIN; h.K = DM; h.mode = 0; h.wcol0 = 1536; h.N = 256; h.Cf = NT_; h.ldc = 256; ngemm(h, T);
                nhead(NT_, 256, 0, 4, in[6] + L * 64, C2, 1, MQ, 256, 0, T);
            }
        }
        if (!odd) {
            if (fast & C_FOX) launch_mega(grid, stream, a, pb + 2, pb + 3, C_FOX);
            else hipLaunchKernelGGL(naive::attn, dim3(BATCH * NH * SEQ / 4), dim3(256), 0, stream, (const bf16*)QKV, 2304, (const bf16*)QKV + 768, (const bf16*)QKV + 1536, 2304, MIX, DM, (const float*)(ws + WS_CB), NH, SEQ, SEQ, 1);
        } else launch_mega(grid, stream, a, pb + 2, pb + 3, C_THIN);
        if (fast & C_MEMATT) launch_mega(grid, stream, a, pb + 2, pb + 3, C_MEMATT);
        else { const bf16* mkv = (const bf16*)(ws + WS_MKV) + (size_t)L * 2048 * 512;
            hipLaunchKernelGGL(naive::attn, dim3(BATCH * MEMH * SEQ / 4), dim3(256), 0, stream, (const bf16*)MQ, 256, mkv, mkv + 256, 512, MIX + 768, DM, (const float*)nullptr, MEMH, SEQ, ML, 0); }
        if (fast & C_OUTPROJ) launch_mega(grid, stream, a, pb + 3, pb + 4, C_OUTPROJ);
        else { naive::NG g{}; g.A = MIX; g.lda = DM; g.W = in[odd ? 19 : 12] + (size_t)j * DM * DM; g.ldw = DM; g.N = DM; g.K = DM; g.mode = 1; g.Cf = (float*)d_out; g.ldc = DM; g.base = hsrc; ngemm(g, T); }
        launch_mega(grid, stream, a, pb + 4, pb + 5, C_THIN);
        if (odd) launch_mega(grid, stream, a, pb + 5, pb + 6, C_THIN);
        if (fast & C_FFNUP) launch_mega(grid, stream, a, pb + 6, pb + 7, C_FFNUP);
        else if (!odd) { naive::NG g{}; g.A = UB; g.lda = DM; g.W = in[20] + (size_t)j * DM * FF; g.W2 = in[21] + (size_t)j * DM * FF; g.ldw = FF; g.N = FF; g.K = DM; g.mode = 2; g.Cb = (bf16*)(ws + WS_HIDD); g.ldc = FF; ngemm(g, T); }
        else { naive::NG g{}; g.A = (const bf16*)(ws + WS_XS); g.lda = DM; g.W = in[24] + (size_t)j * NE * DM * EFF; g.W2 = in[25] + (size_t)j * NE * DM * EFF; g.ldw = EFF; g.N = EFF; g.K = DM; g.mode = 2; g.Cb = (bf16*)(ws + WS_HIDM); g.ldc = EFF;
               g.tab = (const int*)(ws + WS_TAB); g.wstride = (size_t)DM * EFF; ngemm(g, MAXROWS); }
        if (fast & C_FFNDOWN) launch_mega(grid, stream, a, pb + 7, pb + 8, C_FFNDOWN);
        else if (!odd) { naive::NG g{}; g.A = (const bf16*)(ws + WS_HIDD); g.lda = FF; g.W = in[22] + (size_t)j * FF * DM; g.ldw = DM; g.N = DM; g.K = FF; g.mode = 1; g.Cf = (float*)d_out; g.ldc = DM; g.base = (const float*)d_out; ngemm(g, T); }
        else { naive::NG g{}; g.A = (const bf16*)(ws + WS_HIDM); g.lda = EFF; g.W = in[26] + (size_t)j * NE * EFF * DM; g.ldw = DM; g.N = DM; g.K = EFF; g.mode = 4; g.Cb = (bf16*)(ws + WS_XS); g.ldc = DM; g.rowg = (const float*)(ws + WS_ROWG);
               g.tab = (const int*)(ws + WS_TAB); g.wstride = (size_t)EFF * DM; ngemm(g, MAXROWS); }
        if (L == 3 || (odd && L == NLAYERS - 1)) launch_mega(grid, stream, a, 1 + 27 + 8, 1 + 27 + 9, C_THIN);
    }
#endif
}
```

```cpp
#define BRINGUP 0
#define FASTMASK 0
#include <hip/hip_runtime.h>
#include <hip/hip_bf16.h>
#include <cstdio>
#include <cstdint>
#include <cmath>
#include <utility>

#ifndef BRINGUP
#define BRINGUP 0
#endif
#ifndef DENSE8
#define DENSE8 2
#endif
#ifndef UP8L0
#define UP8L0 0
#endif
#ifndef IN8L2
#define IN8L2 1
#endif
#ifndef IN8L0
#define IN8L0 1
#endif
#ifndef IN8ODD
#define IN8ODD 0
#endif
#ifndef FUSENORM
#define FUSENORM 1
#endif
#ifndef MOEQ
#define MOEQ 1
#endif
#ifndef FASTMASK
#define FASTMASK 0
#endif

__device__ __forceinline__ float lconst(float c) { asm volatile("" : "+s"(c)); return c; }
__device__ __forceinline__ int lconsti(int c) { asm volatile("" : "+s"(c)); return c; }

constexpr int BATCH = 8, SEQ = 4096, DM = 1024, T = BATCH * SEQ, NH = 12, HD = 64, FOXD = 768, MEMD = 256, MEMH = 4, ML = 256;
constexpr int FF = 2816, EFF = 3584, NE = 8, CW = 31, CONVD = 768, FOXIN = 2572, CONVIN = 1792;
constexpr int MAXRT = 264, MAXROWS = MAXRT * 256;
constexpr float RMS_EPS = 1e-6f;
constexpr float LOG2E = 1.4426950408889634f;
constexpr float C2 = 0.125f * 1.4426950408889634f;

constexpr size_t MiB = 1u << 20, KiB = 1u << 10;
constexpr size_t WS_CTL = 0, CTL_ZERO_BYTES = 1 * MiB;
constexpr size_t WS_LOGF = 1 * MiB;
constexpr size_t WS_CB = 3 * MiB;
constexpr size_t WS_RS = 4 * MiB + 512 * KiB;
constexpr size_t WS_TOPE = 5 * MiB;
constexpr size_t WS_TOPG = 5 * MiB + 512 * KiB;
constexpr size_t WS_SLOT = 6 * MiB;
constexpr size_t WS_ROWG = 6 * MiB + 512 * KiB;
constexpr size_t WS_CNT = 7 * MiB;
constexpr size_t WS_TAB = 7 * MiB + 64 * KiB;
constexpr size_t WS_GT = 7 * MiB + 128 * KiB;
constexpr size_t WS_MKV = 8 * MiB;
constexpr size_t WS_MEMN = 16 * MiB;
constexpr size_t WS_WINE = 32 * MiB;
constexpr size_t WS_WOUTE = 42 * MiB;
constexpr size_t WS_WINO = 46 * MiB;
constexpr size_t WS_WOUTO = 53 * MiB;
constexpr size_t WS_WGU = 57 * MiB;
constexpr size_t WS_WD = 79 * MiB;
constexpr size_t WS_WKV = 90 * MiB;
constexpr size_t WS_SSQ = 94 * MiB;
constexpr size_t WS_WMGU = 96 * MiB;
constexpr size_t WS_WMD = 152 * MiB;
constexpr size_t WS_WM_LAYER = 84 * MiB;
constexpr float WSC_GU = 256.f, WSC_D = 1024.f, ASC_Z = 8.f, ASC_H = 8.f;
constexpr size_t WS_R = 264 * MiB;
constexpr size_t WS_QKV = WS_R;
constexpr size_t WS_GLU = WS_R;
constexpr size_t WS_XS = WS_R;
constexpr size_t WS_MQ = WS_R + 144 * MiB;
constexpr size_t WS_MIX = WS_R + 160 * MiB;
constexpr size_t WS_UB = WS_R + 224 * MiB;
constexpr size_t WS_HIDD = WS_R + 288 * MiB;
constexpr size_t WS_HIDM = WS_R + 132 * MiB;
constexpr size_t WS_NTMP = WS_R + 288 * MiB;
constexpr size_t WS_H16 = WS_R + 594 * MiB;
#if BRINGUP
constexpr size_t WS_END = WS_R + 672 * MiB;
#else
constexpr size_t WS_END = WS_R + 658 * MiB;
#endif
static_assert(WS_HIDM + (size_t)MAXROWS * EFF * 2 <= WS_R + 594 * MiB, "ws map");
static_assert(WS_XS + (size_t)MAXROWS * DM * 2 <= WS_HIDM, "ws map");
static_assert(WS_HIDD + (size_t)T * FF * 2 <= WS_R + 594 * MiB, "ws map");
constexpr int CW_TMO = 0, CW_CODE = 1;
constexpr int CW_BAR = 4096;
constexpr int CW_QUEUE = 8192;

constexpr int NPH = 37;
constexpr unsigned C_THIN = 1u, C_PMK = 2u, C_INPROJ = 4u, C_FOX = 8u, C_MEMATT = 16u, C_OUTPROJ = 32u, C_FFNUP = 64u, C_FFNDOWN = 128u, C_ALL = 0xffu;
namespace pg8 {
#define PG8_LAS __attribute__((address_space(3)))
#define PG8_GAS __attribute__((address_space(1)))
typedef unsigned short bf16_t;
typedef short bf16x8 __attribute__((ext_vector_type(8)));
typedef float f32x4 __attribute__((ext_vector_type(4)));
typedef unsigned u32x4 __attribute__((ext_vector_type(4)));
constexpr int BM = 256, BK = 64, HALF = 128, HTB = HALF * BK * 2  , STAGE_BYTES = 8 * HTB, NXCD = 8, WGM = 8;

__host__ __device__ __forceinline__ int lds_byte(int r, int c) { const int st = (r >> 4) * 2 + (c >> 5), rr = r & 15, cc = c & 31, ob = rr * 64 + cc * 2; return st * 1024 + (ob ^ (((ob >> 9) & 1) << 5)); }
__host__ __device__ __forceinline__ void stage_rc(int b, int& R, int& C) { const int st = b / 1024, sb = b % 1024, swz = sb ^ (((sb >> 9) & 1) << 5); R = (st >> 1) * 16 + swz / 64; C = (st & 1) * 32 + (swz % 64) / 2; }
__host__ __device__ __forceinline__ int perm32(int rho) { const int n = rho >> 4, i = rho & 15; return 8 * (i >> 2) + 4 * n + (i & 3); }

typedef int v8i __attribute__((ext_vector_type(8)));
typedef int v4i __attribute__((ext_vector_type(4)));
struct Unit { int pm, pn, g; };
struct Gemm { const void* A; const void* Bt; int Kb; size_t gstride; };

struct Order {
    int nM, nN, nwg, G, c, gdiv; const int* tile_g;
    __device__ __forceinline__ void init(int nM_, int nN_, int G_, int c_, const int* tg, int gd) { nM = nM_; nN = nN_; nwg = nM * nN; G = G_; c = c_; tile_g = tg; gdiv = gd; }
    __device__ __forceinline__ bool next(int i, Unit& u) const {
        const long L = (long)i * G + c; if (L >= nwg) return false;
        int wgid = (int)L; { const int q = nwg / NXCD, r = nwg % NXCD, xcd = wgid % NXCD, off = wgid / NXCD; wgid = (xcd < r ? xcd * (q + 1) : r * (q + 1) + (xcd - r) * q) + off; }
        const int nig = WGM * nN, gid = wgid / nig, fm = gid * WGM, gsz = (nM - fm) < WGM ? (nM - fm) : WGM;
        u.pm = fm + ((wgid % nig) % gsz); u.pn = (wgid % nig) / gsz;
        if (tile_g) { const int* tg = tile_g; asm volatile("" : "+s"(tg)); u.g = __builtin_amdgcn_readfirstlane(tg[u.pm]); }
        else u.g = gdiv ? u.pm / gdiv : 0;
        return true;
    }
    __device__ __forceinline__ bool next_lane(int i, Unit& u) const {
        const long L = (long)i * G + c; if (L >= nwg) return false;
        int wgid = (int)L; { const int q = nwg / NXCD, r = nwg % NXCD, xcd = wgid % NXCD, off = wgid / NXCD; wgid = (xcd < r ? xcd * (q + 1) : r * (q + 1) + (xcd - r) * q) + off; }
        const int nig = WGM * nN, gid = wgid / nig, fm = gid * WGM, gsz = (nM - fm) < WGM ? (nM - fm) : WGM;
        u.pm = fm + ((wgid % nig) % gsz); u.pn = (wgid % nig) / gsz;
        if (tile_g) u.g = ((const PG8_GAS int*)tile_g)[u.pm]; else u.g = gdiv ? u.pm / gdiv : 0;
        return true;
    }
};
constexpr int ORD_ENT = 48;
struct OrderT {
    const PG8_LAS v4i* tab;
    __device__ __forceinline__ bool next(int i, Unit& u) const {
        const v4i e = tab[i < ORD_ENT - 1 ? i : ORD_ENT - 1];
        u.pm = __builtin_amdgcn_readfirstlane(e.x); u.pn = __builtin_amdgcn_readfirstlane(e.y); u.g = __builtin_amdgcn_readfirstlane(e.z);
        return __builtin_amdgcn_readfirstlane(e.w) != 0;
    }
};
__device__ __forceinline__ OrderT order_table(const Order& S, PG8_LAS unsigned char* lds_tab, int tid) {
    PG8_LAS v4i* t = (PG8_LAS v4i*)lds_tab;
    if (tid < ORD_ENT) { Unit u; u.pm = 0; u.pn = 0; u.g = 0; const bool ok = (tid < ORD_ENT - 1) && S.next_lane(tid, u); v4i e; e.x = u.pm; e.y = u.pn; e.z = u.g; e.w = ok ? 1 : 0; t[tid] = e; }
    __syncthreads();
    OrderT r; r.tab = t; return r;
}

__device__ __forceinline__ unsigned cvt_pk_bf16(float lo, float hi) { unsigned r; asm volatile("v_cvt_pk_bf16_f32 %0, %1, %2" : "=v"(r) : "v"(lo), "v"(hi)); return r; }
__device__ __forceinline__ u32x4 pack8(const f32x4 a, const f32x4 b) { u32x4 w; w.x = cvt_pk_bf16(a[0], a[1]); w.y = cvt_pk_bf16(a[2], a[3]); w.z = cvt_pk_bf16(b[0], b[1]); w.w = cvt_pk_bf16(b[2], b[3]); return w; }
__device__ __forceinline__ float sigmoidf_fast(float x) { return __builtin_amdgcn_rcpf(1.0f + __builtin_amdgcn_exp2f(-1.4426950408889634f * x)); }
__device__ __forceinline__ f32x4 sig4(const f32x4 x) { f32x4 r; r[0] = sigmoidf_fast(x[0]); r[1] = sigmoidf_fast(x[1]); r[2] = sigmoidf_fast(x[2]); r[3] = sigmoidf_fast(x[3]); return r; }

__device__ __forceinline__ f32x4 swiglu4(const f32x4 a, const f32x4 b, const float rt, const float irq  ) {
    const f32x4 t = a * rt; f32x4 r;
#pragma unroll
    for (int i = 0; i < 4; ++i) { const float e = __builtin_amdgcn_exp2f(t[i]); r[i] = __builtin_amdgcn_rcpf(__builtin_fmaf(e, irq, irq)); }
    return (a * b) * r;
}

__device__ __forceinline__ float fq_sum(float ss) {
    { const auto r = __builtin_amdgcn_permlane16_swap(__builtin_bit_cast(unsigned, ss), __builtin_bit_cast(unsigned, ss), false, false); ss = __builtin_bit_cast(float, (unsigned)r[0]) + __builtin_bit_cast(float, (unsigned)r[1]); }
    { const auto r = __builtin_amdgcn_permlane32_swap(__builtin_bit_cast(unsigned, ss), __builtin_bit_cast(unsigned, ss), false, false); ss = __builtin_bit_cast(float, (unsigned)r[0]) + __builtin_bit_cast(float, (unsigned)r[1]); }
    return ss;
}
struct Gain16 { f32x4 a, b, c, d; };
__device__ __forceinline__ Gain16 load_gain16(const float* gl  ) { Gain16 g; g.a = *(const PG8_GAS f32x4*)(gl); g.b = *(const PG8_GAS f32x4*)(gl + 4); g.c = *(const PG8_GAS f32x4*)(gl + 32); g.d = *(const PG8_GAS f32x4*)(gl + 36); return g; }
__device__ __forceinline__ void headnorm_store(const f32x4 (&acc)[2][2][4][2], int ai, int m, bool norm, const Gain16& gn, float sc, bf16_t* rowp  , int lane, float pre = 1.0f  ) {
    f32x4 v00 = acc[ai][0][m][0] * pre, v01 = acc[ai][0][m][1] * pre, v10 = acc[ai][1][m][0] * pre, v11 = acc[ai][1][m][1] * pre;
    if (norm) {
        const f32x4 q = v00 * v00 + v01 * v01 + v10 * v10 + v11 * v11;
        float ss = (q[0] + q[1]) + (q[2] + q[3]);
        ss += __builtin_bit_cast(float, __builtin_amdgcn_ds_bpermute((lane ^ 16) << 2, __builtin_bit_cast(int, ss))); ss += __builtin_bit_cast(float, __builtin_amdgcn_ds_bpermute((lane ^ 32) << 2, __builtin_bit_cast(int, ss)));
        const float r = __builtin_amdgcn_rsqf(ss * (1.0f / 64.0f) + lconst(1e-6f)) * sc;
        v00 = v00 * r * gn.a; v01 = v01 * r * gn.b; v10 = v10 * r * gn.c; v11 = v11 * r * gn.d;
    }
    *(PG8_GAS u32x4*)(rowp) = pack8(v00, v01);
    *(PG8_GAS u32x4*)(rowp + 32) = pack8(v10, v11);
}
__device__ __forceinline__ float row_rs(const float* ssq, int row) {
    const f32x4 a = *(const PG8_GAS f32x4*)(ssq + (size_t)row * 16), b = *(const PG8_GAS f32x4*)(ssq + (size_t)row * 16 + 4), c = *(const PG8_GAS f32x4*)(ssq + (size_t)row * 16 + 8), d = *(const PG8_GAS f32x4*)(ssq + (size_t)row * 16 + 12);
    const f32x4 t = (a + b) + (c + d); return __builtin_amdgcn_rsqf(((t[0] + t[1]) + (t[2] + t[3])) * (1.0f / 1024.0f) + 1e-6f);
}
__device__ __forceinline__ void row_scales(float (&rsv)[2][4], const float* ssq, int row0, int fr, int fq) {
    f32x4 t[2][4]; const int lane = fq * 16 + fr; const float eps_ = lconst(1e-6f);
#pragma unroll
    for (int ai = 0; ai < 2; ++ai)
#pragma unroll
        for (int m = 0; m < 4; ++m) t[ai][m] = *(const PG8_GAS f32x4*)(ssq + (size_t)(row0 + ai * HALF + m * 16) * 16 + 4 * fq);
#pragma unroll
    for (int ai = 0; ai < 2; ++ai)
#pragma unroll
        for (int m = 0; m < 4; ++m) { float ss = (t[ai][m][0] + t[ai][m][1]) + (t[ai][m][2] + t[ai][m][3]);
            ss += __builtin_bit_cast(float, __builtin_amdgcn_ds_bpermute((lane ^ 16) << 2, __builtin_bit_cast(int, ss))); ss += __builtin_bit_cast(float, __builtin_amdgcn_ds_bpermute((lane ^ 32) << 2, __builtin_bit_cast(int, ss)));
            rsv[ai][m] = __builtin_amdgcn_rsqf(ss * (1.0f / 1024.0f) + eps_); }
}
struct EpiInEven {
    static constexpr bool PERM = true, AFTER_DRAIN = false;
    bf16_t* QKV; bf16_t* MQ; const float* gt; float isc = 1.0f;
    __device__ __forceinline__ void operator()(const f32x4 (&acc)[2][2][4][2], const Unit& u, int wr, int wc, int fr, int fq) const {
        const int row0 = u.pm * BM + wr * 64 + fr; const int pn = u.pn;
        float isc_ = isc; asm volatile("" : "+v"(isc_));
        const bool norm = (pn < 6) || (pn == 9);
        const int sel = pn < 3 ? 0 : (pn < 6 ? 1 : 2);
        const Gain16 gn = load_gain16(gt + 64 * sel + 8 * fq);
        const int ld = (pn == 9) ? MEMD : 3 * FOXD;
        const size_t dofs = (pn == 9) ? (size_t)((const char*)MQ - (const char*)QKV) / 2 : (size_t)256 * pn;
        bf16_t* dst = QKV + dofs + 64 * wc + 8 * fq;
#pragma unroll
        for (int ai = 0; ai < 2; ++ai)
#pragma unroll
            for (int m = 0; m < 4; ++m) headnorm_store(acc, ai, m, norm, gn, 1.0f, dst + (size_t)(row0 + ai * HALF + m * 16) * ld, fq * 16 + fr, isc_);
    }
};
struct EpiMemKV {
    static constexpr bool PERM = true, AFTER_DRAIN = false;
    bf16_t* MKV; const float* gmk;
    __device__ __forceinline__ void operator()(const f32x4 (&acc)[2][2][4][2], const Unit& u, int wr, int wc, int fr, int fq) const {
        const int row0 = u.pm * BM + wr * 64 + fr;
        const Gain16 gn = load_gain16(gmk + 64 * u.g + 8 * fq);
        bf16_t* dst = MKV + 256 * u.pn + 64 * wc + 8 * fq;
#pragma unroll
        for (int ai = 0; ai < 2; ++ai)
#pragma unroll
            for (int m = 0; m < 4; ++m) headnorm_store(acc, ai, m, u.pn == 0, gn, 1.0f, dst + (size_t)(row0 + ai * HALF + m * 16) * 512, fq * 16 + fr);
    }
};
struct EpiInOdd {
    static constexpr bool PERM = true, AFTER_DRAIN = false;
    bf16_t* GLU; bf16_t* MQ; const float* bias; const float* gmq; const float* ssq; float isc = 1.0f;
    __device__ __forceinline__ void operator()(f32x4 (&acc)[2][2][4][2], const Unit& u, int wr, int wc, int fr, int fq) const {
        const int row0 = u.pm * BM + wr * 64 + fr;
        if (ssq) { float rsv[2][4]; row_scales(rsv, ssq, row0, fr, fq); float isc_ = isc; asm volatile("" : "+v"(isc_));
#pragma unroll
            for (int ai = 0; ai < 2; ++ai)
#pragma unroll
                for (int m = 0; m < 4; ++m) { const float rs = rsv[ai][m] * isc_;
#pragma unroll
                    for (int bj = 0; bj < 2; ++bj)
#pragma unroll
                        for (int n = 0; n < 2; ++n) acc[ai][bj][m][n] = acc[ai][bj][m][n] * rs; }
        }
        if (u.pn == 6) {
            const Gain16 gn = load_gain16(gmq + 8 * fq);
            bf16_t* dst = MQ + 64 * wc + 8 * fq;
#pragma unroll
            for (int ai = 0; ai < 2; ++ai)
#pragma unroll
                for (int m = 0; m < 4; ++m) headnorm_store(acc, ai, m, true, gn, 1.0f, dst + (size_t)(row0 + ai * HALF + m * 16) * MEMD, fq * 16 + fr);
        } else {
            const int col0 = u.pn * 128 + wc * 32 + 8 * fq;
            const f32x4 ba0 = *(const PG8_GAS f32x4*)(bias + col0), ba1 = *(const PG8_GAS f32x4*)(bias + col0 + 4), bg0 = *(const PG8_GAS f32x4*)(bias + CONVD + col0), bg1 = *(const PG8_GAS f32x4*)(bias + CONVD + col0 + 4);
#pragma unroll
            for (int ai = 0; ai < 2; ++ai)
#pragma unroll
                for (int m = 0; m < 4; ++m) {
                    const f32x4 o0 = (acc[ai][0][m][0] + ba0) * sig4(acc[ai][1][m][0] + bg0), o1 = (acc[ai][0][m][1] + ba1) * sig4(acc[ai][1][m][1] + bg1);
                    *(PG8_GAS u32x4*)(GLU + (size_t)(row0 + ai * HALF + m * 16) * CONVD + col0) = pack8(o0, o1);
                }
        }
    }
};
struct EpiSwiGLU {
    static constexpr bool PERM = true, AFTER_DRAIN = false;
    bf16_t* O; int ldc; const float* ssq;
    __device__ __forceinline__ void operator()(const f32x4 (&acc)[2][2][4][2], const Unit& u, int wr, int wc, int fr, int fq) const {
        const int row0 = u.pm * BM + wr * 64 + fr; const int col0 = u.pn * 128 + wc * 32 + 8 * fq;
        float rsv[2][4]; float nl2 = -1.4426950408889634f; asm volatile("" : "+v"(nl2));
        if (ssq) row_scales(rsv, ssq, row0, fr, fq);
        else {
#pragma unroll
            for (int ai = 0; ai < 2; ++ai)
#pragma unroll
                for (int m = 0; m < 4; ++m) rsv[ai][m] = 1.0f; }
#pragma unroll
        for (int ai = 0; ai < 2; ++ai)
#pragma unroll
            for (int m = 0; m < 4; ++m) {
                const float rs = rsv[ai][m], rt = rs * nl2, rq = __builtin_amdgcn_rcpf(rs * rs);
                const f32x4 o0 = swiglu4(acc[ai][0][m][0], acc[ai][1][m][0], rt, rq), o1 = swiglu4(acc[ai][0][m][1], acc[ai][1][m][1], rt, rq);
                *(PG8_GAS u32x4*)(O + (size_t)(row0 + ai * HALF + m * 16) * ldc + col0) = pack8(o0, o1);
            }
    }
};
__device__ __forceinline__ unsigned pk4_fp8(const f32x4 v) { int p = __builtin_amdgcn_cvt_pk_fp8_f32(v[0], v[1], __builtin_bit_cast(int, v[0])  , false); p = __builtin_amdgcn_cvt_pk_fp8_f32(v[2], v[3], p, true); return (unsigned)p; }
__device__ __forceinline__ f32x4 clamp8(const f32x4 v, const float c) { f32x4 r; r[0] = __builtin_amdgcn_fmed3f(v[0], -c, c); r[1] = __builtin_amdgcn_fmed3f(v[1], -c, c); r[2] = __builtin_amdgcn_fmed3f(v[2], -c, c); r[3] = __builtin_amdgcn_fmed3f(v[3], -c, c); return r; }
template <bool OUT16> struct EpiSwiGLU8T {
    static constexpr bool PERM = true, AFTER_DRAIN = false;
    unsigned char* O; int ldc; float isc, osc; const float* ssq;
    __device__ __forceinline__ void operator()(const f32x4 (&acc)[2][2][4][2], const Unit& u, int wr, int wc, int fr, int fq) const {
#ifdef PROBE_EPI2
        for (int rp_ = 0; rp_ < 2; ++rp_) { asm volatile("" ::: "memory");
#endif
        const int row0 = u.pm * BM + wr * 64 + fr; const int col0 = u.pn * 128 + wc * 32 + 8 * fq;
        float isc_ = isc, uo = OUT16 ? isc : isc * osc, c448 = 448.f, nl2 = -1.4426950408889634f; asm volatile("" : "+v"(isc_), "+v"(uo), "+v"(c448), "+v"(nl2));
        float rsv[2][4];
        if (ssq) row_scales(rsv, ssq, row0, fr, fq);
        else {
#pragma unroll
            for (int ai = 0; ai < 2; ++ai)
#pragma unroll
                for (int m = 0; m < 4; ++m) rsv[ai][m] = 1.0f; }
#pragma unroll
        for (int ai = 0; ai < 2; ++ai)
#pragma unroll
            for (int m = 0; m < 4; ++m) {
                const float ri = rsv[ai][m] * isc_, rt = ri * nl2, rq = __builtin_amdgcn_rcpf(ri * (rsv[ai][m] * uo));
                const f32x4 o0 = swiglu4(acc[ai][0][m][0], acc[ai][1][m][0], rt, rq), o1 = swiglu4(acc[ai][0][m][1], acc[ai][1][m][1], rt, rq);
                if constexpr (OUT16) *(PG8_GAS u32x4*)((bf16_t*)O + (size_t)(row0 + ai * HALF + m * 16) * ldc + col0) = pack8(o0, o1);
                else { typedef unsigned u32x2 __attribute__((ext_vector_type(2)));
                u32x2 w; w.x = pk4_fp8(clamp8(o0, c448)); w.y = pk4_fp8(clamp8(o1, c448));
                *(PG8_GAS u32x2*)(O + (size_t)(row0 + ai * HALF + m * 16) * ldc + col0) = w; }
                __builtin_amdgcn_sched_barrier(0);
            }
#ifdef PROBE_EPI2
        }
#endif
    }
};
typedef EpiSwiGLU8T<false> EpiSwiGLU8;
typedef EpiSwiGLU8T<true> EpiSwiGLU8B;
struct EpiResid {
    static constexpr bool PERM = true, AFTER_DRAIN = false;
    const float* base32; bf16_t* h16; float isc; float* ssq; unsigned char* h8;
    __device__ __forceinline__ void operator()(const f32x4 (&acc)[2][2][4][2], const Unit& u, int wr, int wc, int fr, int fq) const {
        const int row0 = u.pm * BM + wr * 64 + fr; const int col0 = u.pn * BM + wc * 32 + 8 * fq;
        float isc_ = isc, c448 = 448.f; asm volatile("" : "+v"(isc_), "+v"(c448)); const int lane = fq * 16 + fr;
        auto rowof = [&](int gi) { return row0 + (gi >> 2) * HALF + (gi & 3) * 16; };
        auto finish = [&](int gi, const f32x4 (&cu)[2][2]) { const int ai = gi >> 2, m = gi & 3; const int row = rowof(gi);
            float ss = 0.f;
#pragma unroll
            for (int bj = 0; bj < 2; ++bj) { const f32x4 o0 = cu[bj][0] + acc[ai][bj][m][0] * isc_, o1 = cu[bj][1] + acc[ai][bj][m][1] * isc_;
                *(PG8_GAS u32x4*)(h16 + (size_t)row * DM + col0 + bj * HALF) = pack8(o0, o1);
                if (ssq) { const f32x4 q = o0 * o0 + o1 * o1; ss += (q[0] + q[1]) + (q[2] + q[3]); }
                if (h8) { typedef unsigned u32x2 __attribute__((ext_vector_type(2))); u32x2 w; w.x = pk4_fp8(clamp8(o0 * ASC_Z, c448)); w.y = pk4_fp8(clamp8(o1 * ASC_Z, c448)); *(PG8_GAS u32x2*)(h8 + (size_t)row * DM + col0 + bj * HALF) = w; } }
            if (ssq) { ss += __builtin_bit_cast(float, __builtin_amdgcn_ds_bpermute((lane ^ 16) << 2, __builtin_bit_cast(int, ss))); ss += __builtin_bit_cast(float, __builtin_amdgcn_ds_bpermute((lane ^ 32) << 2, __builtin_bit_cast(int, ss)));
                if (fq == 0) *(PG8_GAS float*)(ssq + (size_t)row * 16 + u.pn * 4 + wc) = ss; }
            __builtin_amdgcn_sched_barrier(0); };
        if (base32) {
#pragma unroll
            for (int hb = 0; hb < 2; ++hb) { f32x4 rf[4][2][2];
#pragma unroll
                for (int g = 0; g < 4; ++g)
#pragma unroll
                    for (int bj = 0; bj < 2; ++bj) { const size_t p = (size_t)rowof(4 * hb + g) * DM + col0 + bj * HALF; rf[g][bj][0] = *(const PG8_GAS f32x4*)(base32 + p); rf[g][bj][1] = *(const PG8_GAS f32x4*)(base32 + p + 4); }
                __builtin_amdgcn_sched_barrier(0);
#pragma unroll
                for (int g = 0; g < 4; ++g) finish(4 * hb + g, rf[g]); }
        } else {
            u32x4 rw[8][2];
#pragma unroll
            for (int gi = 0; gi < 8; ++gi)
#pragma unroll
                for (int bj = 0; bj < 2; ++bj) rw[gi][bj] = *(const PG8_GAS u32x4*)(h16 + (size_t)rowof(gi) * DM + col0 + bj * HALF);
            __builtin_amdgcn_sched_barrier(0);
#pragma unroll
            for (int gi = 0; gi < 8; ++gi) { f32x4 cu[2][2];
#pragma unroll
                for (int bj = 0; bj < 2; ++bj) { const u32x4 w = rw[gi][bj];
                    cu[bj][0] = (f32x4){__builtin_bit_cast(float, w.x << 16), __builtin_bit_cast(float, w.x & 0xffff0000u), __builtin_bit_cast(float, w.y << 16), __builtin_bit_cast(float, w.y & 0xffff0000u)};
                    cu[bj][1] = (f32x4){__builtin_bit_cast(float, w.z << 16), __builtin_bit_cast(float, w.z & 0xffff0000u), __builtin_bit_cast(float, w.w << 16), __builtin_bit_cast(float, w.w & 0xffff0000u)}; }
                finish(gi, cu); }
        }
    }
};
struct EpiRowGate {
    static constexpr bool PERM = true, AFTER_DRAIN = false;
    bf16_t* Y; const float* rowg; int ldc; float isc;
    __device__ __forceinline__ void operator()(const f32x4 (&acc)[2][2][4][2], const Unit& u, int wr, int wc, int fr, int fq) const {
        const int row0 = u.pm * BM + wr * 64 + fr; const int col0 = u.pn * BM + wc * 32 + 8 * fq;
        float isc_ = isc; asm volatile("" : "+v"(isc_));
        float rgv[2][4];
#pragma unroll
        for (int ai = 0; ai < 2; ++ai)
#pragma unroll
            for (int m = 0; m < 4; ++m) rgv[ai][m] = *(const PG8_GAS float*)(rowg + row0 + ai * HALF + m * 16);
#pragma unroll
        for (int ai = 0; ai < 2; ++ai)
#pragma unroll
            for (int m = 0; m < 4; ++m) { const int row = row0 + ai * HALF + m * 16; const float rg = rgv[ai][m] * isc_;
#pragma unroll
                for (int bj = 0; bj < 2; ++bj) *(PG8_GAS u32x4*)(Y + (size_t)row * ldc + col0 + bj * HALF) = pack8(acc[ai][bj][m][0] * rg, acc[ai][bj][m][1] * rg);
                __builtin_amdgcn_sched_barrier(0); }
    }
};

template <class Epi, class Sched, bool ALIGN_EPI = false, bool SP2 = false, bool F8 = false>
__device__ __forceinline__ void gemm_phase(PG8_LAS unsigned char* lds, const Gemm g, const Sched& S, const Epi& E, const int wave_in  ) {
    int lane; asm volatile("v_mbcnt_lo_u32_b32 %0, -1, 0\n\tv_mbcnt_hi_u32_b32 %0, -1, %0" : "=v"(lane));
    const int wid = wave_in, tid = wave_in * 64 + lane, wr = wid >> 2, wc = wid & 3, fr = lane & 15, fq = lane >> 4;
    const int Kb = g.Kb, nt = Kb / (BK * 2);
    unsigned voffA, voffB;
    { int R, C; stage_rc(tid * 16, R, C); const int Rb = Epi::PERM ? ((R & ~31) + perm32(R & 31)) : R; voffA = (unsigned)(R * Kb + C * 2); voffB = (unsigned)(Rb * Kb + C * 2); }
    const size_t pstep = (size_t)64 * Kb;
    const size_t kstep = (size_t)(BK * 2);
    const size_t hstep = (size_t)HALF * Kb;
    const size_t tstep = 2 * hstep;
    const unsigned ldsw = (unsigned)wid * 1024u;
    const unsigned lds0 = (unsigned)(uintptr_t)lds;
    const int aoff = lds_byte(wr * 64 + fr, fq * 8), boff = lds_byte(wc * 32 + fr, fq * 8);
    PG8_LAS unsigned char* pa = lds + aoff; PG8_LAS unsigned char* pb = lds + 4 * HTB + boff; asm volatile("" : "+v"(pa), "+v"(pb));
#define PG8_SA(b, h) (((b) * 2 + (h)) * HTB)
#define PG8_SB(b, h) ((4 + (b) * 2 + (h)) * HTB)
#define PG8_GLDS(voff32, gbase, ldsdst) do { unsigned keep_; asm volatile("s_mov_b32 %0, m0\n\ts_mov_b32 m0, %3\n\ts_nop 0\n\tglobal_load_lds_dwordx4 %1, %2\n\ts_mov_b32 m0, %0" \
        : "=&s"(keep_) : "v"(voff32), "s"(gbase), "s"(ldsdst) : "memory"); } while (0)
#define PG8_STAGE(bufoff, gbase, voff) do { _Pragma("unroll") for (int _i = 0; _i < 2; ++_i) \
        PG8_GLDS((voff), (const char*)(gbase) + _i * pstep, (unsigned)__builtin_amdgcn_readfirstlane((int)(lds0 + (unsigned)(bufoff) + ldsw + (unsigned)(_i * 8192)))); } while (0)
#define PG8_RDA(off) (*(const PG8_LAS v4i*)(pa + (off)))
#define PG8_RDB(off) (*(const PG8_LAS v4i*)(pb + (off)))
#define PG8_LDA(dst, b, h) do { _Pragma("unroll") for (int m = 0; m < 4; ++m) { \
        if constexpr (F8) dst##8[m] = __builtin_shufflevector(PG8_RDA(PG8_SA(b, h) + m * 2048), PG8_RDA(PG8_SA(b, h) + m * 2048 + 1024), 0, 1, 2, 3, 4, 5, 6, 7); \
        else { _Pragma("unroll") for (int k = 0; k < 2; ++k) dst[m][k] = *(const PG8_LAS bf16x8*)(pa + PG8_SA(b, h) + m * 2048 + k * 1024); } } } while (0)
#define PG8_LDB(dst, b, h) do { _Pragma("unroll") for (int n = 0; n < 2; ++n) { \
        if constexpr (F8) dst##8[n] = __builtin_shufflevector(PG8_RDB(PG8_SB(b, h) - 4 * HTB + n * 2048), PG8_RDB(PG8_SB(b, h) - 4 * HTB + n * 2048 + 1024), 0, 1, 2, 3, 4, 5, 6, 7); \
        else { _Pragma("unroll") for (int k = 0; k < 2; ++k) dst[n][k] = *(const PG8_LAS bf16x8*)(pb + PG8_SB(b, h) - 4 * HTB + n * 2048 + k * 1024); } } } while (0)
#define PG8_MMA(ai, bj, Af, Bf) do { __builtin_amdgcn_s_setprio(1); _Pragma("unroll") for (int m = 0; m < 4; ++m) _Pragma("unroll") for (int n = 0; n < 2; ++n) { \
        if constexpr (F8) acc[ai][bj][m][n] = __builtin_amdgcn_mfma_scale_f32_16x16x128_f8f6f4(Bf##8[n], Af##8[m], acc[ai][bj][m][n], 0, 0, 0, sc1_, 0, sc1_); \
        else { _Pragma("unroll") for (int k = 0; k < 2; ++k) acc[ai][bj][m][n] = __builtin_amdgcn_mfma_f32_16x16x32_bf16(Bf[n][k], Af[m][k], acc[ai][bj][m][n], 0, 0, 0); } } \
        __builtin_amdgcn_s_setprio(0); } while (0)
#define PG8_WAIT_V(n) asm volatile("s_waitcnt vmcnt(" #n ")" ::: "memory")
#define PG8_WAIT_L(n) asm volatile("s_waitcnt lgkmcnt(" #n ")" ::: "memory")
#define PG8_BAR __builtin_amdgcn_s_barrier()
#define PG8_SCHED __builtin_amdgcn_sched_barrier(0)
    int sc1_ = 0x7f7f7f7f; asm volatile("" : "+v"(sc1_));
    Unit cur, nxt; int ui = 0;
    if (!S.next(0, cur)) return;
    f32x4 acc[2][2][4][2];
#pragma unroll
    for (int a = 0; a < 2; ++a)
#pragma unroll
        for (int b = 0; b < 2; ++b)
#pragma unroll
            for (int m = 0; m < 4; ++m)
#pragma unroll
                for (int n = 0; n < 2; ++n) acc[a][b][m][n] = (f32x4){0.f, 0.f, 0.f, 0.f};
    bf16x8 At[4][2], B0[2][2], B1[2][2]; v8i At8[4], B08[2], B18[2];
    const char* cA = (const char*)g.A + (size_t)cur.pm * tstep; const char* cB = (const char*)g.Bt + (size_t)cur.g * g.gstride + (size_t)cur.pn * tstep;
    if constexpr (SP2) {
        PG8_STAGE(PG8_SB(0, 0), cB, voffB); PG8_STAGE(PG8_SB(0, 1), cB + hstep, voffB); PG8_STAGE(PG8_SA(0, 0), cA, voffA); PG8_STAGE(PG8_SA(0, 1), cA + hstep, voffA);
        if (wr == 1) PG8_BAR;
        PG8_WAIT_V(2); PG8_BAR;
        PG8_STAGE(PG8_SB(1, 0), cB + kstep, voffB); PG8_STAGE(PG8_SA(1, 0), cA + kstep, voffA); PG8_STAGE(PG8_SB(1, 1), cB + hstep + kstep, voffB);
        PG8_WAIT_V(6); PG8_BAR;
    } else {
        PG8_STAGE(PG8_SB(0, 0), cB, voffB); PG8_STAGE(PG8_SA(0, 0), cA, voffA); PG8_STAGE(PG8_SB(0, 1), cB + hstep, voffB); PG8_STAGE(PG8_SA(0, 1), cA + hstep, voffA);
        if (wr == 1) PG8_BAR;
        PG8_WAIT_V(4); PG8_BAR;
        PG8_STAGE(PG8_SB(1, 0), cB + kstep, voffB); PG8_STAGE(PG8_SA(1, 0), cA + kstep, voffA); PG8_STAGE(PG8_SB(1, 1), cB + hstep + kstep, voffB);
        PG8_WAIT_V(6); PG8_BAR;
    }
    for (;;) {
        const bool has_next = S.next(ui + 1, nxt);
        const char* nA = has_next ? (const char*)g.A + (size_t)nxt.pm * tstep : cA; const char* nB = has_next ? (const char*)g.Bt + (size_t)nxt.g * g.gstride + (size_t)nxt.pn * tstep : cB;
#pragma unroll 1
        for (int t = 0; t < nt; t += 2) {
            const bool last = (t == nt - 2);
            const char* a1 = cA + (size_t)(t + 1) * kstep;
            const char* a2 = last ? nA : cA + (size_t)(t + 2) * kstep; const char* b2 = last ? nB : cB + (size_t)(t + 2) * kstep;
            const char* a3 = a2 + kstep; const char* b3 = b2 + kstep;
            if constexpr (SP2) {
            PG8_LDB(B0, 0, 0); PG8_LDB(B1, 0, 1); PG8_SCHED; PG8_LDA(At, 0, 0); PG8_STAGE(PG8_SA(1, 1), a1 + hstep, voffA);
            PG8_WAIT_V(8); PG8_WAIT_L(0); PG8_BAR; PG8_MMA(0, 0, At, B0); PG8_MMA(0, 1, At, B1); PG8_BAR; PG8_SCHED;
            PG8_LDA(At, 0, 1); PG8_STAGE(PG8_SB(0, 0), b2, voffB); PG8_STAGE(PG8_SB(0, 1), b2 + hstep, voffB); PG8_STAGE(PG8_SA(0, 0), a2, voffA);
            PG8_WAIT_V(8); PG8_WAIT_L(0); PG8_BAR; PG8_MMA(1, 0, At, B0); PG8_MMA(1, 1, At, B1); PG8_BAR; PG8_SCHED;
            PG8_LDB(B0, 1, 0); PG8_LDB(B1, 1, 1); PG8_SCHED; PG8_LDA(At, 1, 0); PG8_STAGE(PG8_SA(0, 1), a2 + hstep, voffA);
            PG8_WAIT_V(8); PG8_WAIT_L(0); PG8_BAR; PG8_MMA(0, 0, At, B0); PG8_MMA(0, 1, At, B1); PG8_BAR; PG8_SCHED;
            PG8_LDA(At, 1, 1); PG8_STAGE(PG8_SB(1, 0), b3, voffB); PG8_STAGE(PG8_SB(1, 1), b3 + hstep, voffB); PG8_STAGE(PG8_SA(1, 0), a3, voffA);
            PG8_WAIT_V(8); PG8_WAIT_L(0); PG8_BAR; PG8_MMA(1, 0, At, B0); PG8_MMA(1, 1, At, B1); PG8_BAR; PG8_SCHED;
            } else {
            PG8_LDB(B0, 0, 0); PG8_SCHED; PG8_LDA(At, 0, 0); PG8_STAGE(PG8_SA(1, 1), a1 + hstep, voffA);
            PG8_WAIT_L(8); PG8_BAR; PG8_WAIT_L(0); PG8_MMA(0, 0, At, B0); PG8_BAR; PG8_SCHED;
            PG8_LDB(B1, 0, 1); PG8_STAGE(PG8_SB(0, 0), b2, voffB);
            PG8_BAR; PG8_WAIT_L(0); PG8_MMA(0, 1, At, B1); PG8_BAR;
            PG8_LDA(At, 0, 1); PG8_STAGE(PG8_SA(0, 0), a2, voffA);
            PG8_BAR; PG8_WAIT_L(0); PG8_MMA(1, 0, At, B0); PG8_BAR; PG8_SCHED;
            PG8_STAGE(PG8_SB(0, 1), b2 + hstep, voffB);
            PG8_WAIT_V(6); PG8_BAR; PG8_MMA(1, 1, At, B1); PG8_BAR;
            PG8_LDB(B0, 1, 0); PG8_SCHED; PG8_LDA(At, 1, 0); PG8_STAGE(PG8_SA(0, 1), a2 + hstep, voffA);
            PG8_WAIT_L(8); PG8_BAR; PG8_WAIT_L(0); PG8_MMA(0, 0, At, B0); PG8_BAR; PG8_SCHED;
            PG8_LDB(B1, 1, 1); PG8_STAGE(PG8_SB(1, 0), b3, voffB);
            PG8_BAR; PG8_WAIT_L(0); PG8_MMA(0, 1, At, B1); PG8_BAR;
            PG8_LDA(At, 1, 1); PG8_STAGE(PG8_SA(1, 0), a3, voffA);
            PG8_BAR; PG8_WAIT_L(0); PG8_MMA(1, 0, At, B0); PG8_BAR; PG8_SCHED;
            PG8_STAGE(PG8_SB(1, 1), b3 + hstep, voffB);
            PG8_WAIT_V(6); PG8_BAR; PG8_MMA(1, 1, At, B1); PG8_BAR;
            }
        }
        if constexpr (ALIGN_EPI) { if (wr == 0) PG8_BAR; }
        { int lz; asm volatile("v_mbcnt_lo_u32_b32 %0, -1, 0\n\tv_mbcnt_hi_u32_b32 %0, -1, %0" : "=v"(lz));
          E(acc, cur, wr, wc, lz & 15, lz >> 4); }
        if (!has_next) break;
#pragma unroll
        for (int a = 0; a < 2; ++a)
#pragma unroll
            for (int b = 0; b < 2; ++b)
#pragma unroll
                for (int m = 0; m < 4; ++m)
#pragma unroll
                    for (int n = 0; n < 2; ++n) { typedef double d2_t __attribute__((ext_vector_type(2))); d2_t z_;
                        asm volatile("v_mov_b64 %0, 0" : "=v"(z_.x)); asm volatile("v_mov_b64 %0, 0" : "=v"(z_.y)); acc[a][b][m][n] = __builtin_bit_cast(f32x4, z_); }
        cur = nxt; cA = nA; cB = nB; ++ui;
        if constexpr (ALIGN_EPI) { if (wr == 1) PG8_BAR; }
    }
    PG8_WAIT_V(0);
    if constexpr (!ALIGN_EPI) { if (wr == 0) PG8_BAR; }
    PG8_BAR;
#undef PG8_SA
#undef PG8_SB
#undef PG8_STAGE
#undef PG8_GLDS
#undef PG8_LDA
#undef PG8_LDB
#undef PG8_MMA
#undef PG8_RDA
#undef PG8_RDB
#undef PG8_WAIT_V
#undef PG8_WAIT_L
#undef PG8_BAR
#undef PG8_SCHED
}
}
namespace attn_body {
using bf16=__hip_bfloat16;
using bf16x8=__attribute__((ext_vector_type(8)))short;
using s16x4=__attribute__((ext_vector_type(4)))short;
using f32x16=__attribute__((ext_vector_type(16)))float;
using f32x4=__attribute__((ext_vector_type(4)))float;
using u32x4=__attribute__((ext_vector_type(4)))unsigned;
constexpr int D=64;
constexpr int NW=8,QBLK=32,QB=QBLK*NW,KVBLK=64;
__device__ __forceinline__ int crow(int r,int hi){return (r&3)+8*(r>>2)+4*hi;}
#define SBAR() __builtin_amdgcn_sched_barrier(0)
__device__ __forceinline__ void cmask(f32x16&p0,f32x16&p1,int jb,int qrel,int hi){
  const float NEG=lconst(-INFINITY); int kb=64*jb+4*hi;
  #pragma unroll
  for(int r=0;r<16;++r){int kv=kb+(r&3)+8*(r>>2); if(kv>qrel)p0[r]=NEG; if(kv+32>qrel)p1[r]=NEG;}
}
constexpr int NSLOT=3, SLOTB=8192;
constexpr int LDS_K=0, LDS_V=NSLOT*SLOTB, LDS_WS=2*NSLOT*SLOTB, LDS_OST=LDS_WS+NW*64*4, LDS_CB=LDS_OST+NW*4096, LDS_BYTES=LDS_CB+16384;
__device__ __forceinline__ void glds16(const void*gsrc,unsigned lds_dst){unsigned keep;
  asm volatile("s_mov_b32 %0, m0\n\ts_mov_b32 m0, %2\n\ts_nop 0\n\tglobal_load_lds_dwordx4 %1, off\n\ts_mov_b32 m0, %0":"=&s"(keep):"v"(gsrc),"s"(lds_dst):"memory");}
__device__ __forceinline__ float max3f(float a,float b,float c){float r;asm("v_max3_f32 %0, %1, %2, %3":"=v"(r):"v"(a),"v"(b),"v"(c));return r;}
__device__ __forceinline__ float max2f(float a,float b){float r;asm("v_max_f32_e32 %0, %1, %2":"=v"(r):"v"(a),"v"(b));return r;}
__device__ __forceinline__ float fadd_s(float a,float b){float r;asm("v_add_f32_e32 %0, %1, %2":"=v"(r):"v"(a),"v"(b));return r;}
__device__ __forceinline__ float fsub_s(float a,float b){float r;asm("v_sub_f32_e32 %0, %1, %2":"=v"(r):"v"(a),"v"(b));return r;}
typedef float f32x2_t __attribute__((ext_vector_type(2))); typedef __bf16 bf16x2_t __attribute__((ext_vector_type(2)));
__device__ __forceinline__ unsigned cvtpk_s(float lo,float hi){f32x2_t v={lo,hi};bf16x2_t b=__builtin_convertvector(v,bf16x2_t);return __builtin_bit_cast(unsigned,b);}
#define WAIT_BAR(N) asm volatile("s_waitcnt vmcnt(" #N ") lgkmcnt(0)\n\ts_barrier":::"memory")

__device__ __forceinline__ void qkt(f32x16&p0,f32x16&p1,const char*Kslot,const bf16x8*qr,int r32,int hi){
  const char*kb=Kslot+hi*1024+r32*16;
  #pragma unroll
  for(int d0=0;d0<4;++d0){
    const bf16x8 b0=*reinterpret_cast<const bf16x8*>(kb+d0*2048);
    const bf16x8 b1=*reinterpret_cast<const bf16x8*>(kb+d0*2048+512);
    p0=__builtin_amdgcn_mfma_f32_32x32x16_bf16(b0,qr[d0],p0,0,0,0);p1=__builtin_amdgcn_mfma_f32_32x32x16_bf16(b1,qr[d0],p1,0,0,0);}
}
typedef __attribute__((address_space(3))) const char* lds_cptr;
typedef short v4i16_t __attribute__((ext_vector_type(4)));
__device__ __forceinline__ void kload8(bf16x8*kf,lds_cptr kp){
  kf[0]=*(const __attribute__((address_space(3))) bf16x8*)(kp);      kf[1]=*(const __attribute__((address_space(3))) bf16x8*)(kp+512);
  kf[2]=*(const __attribute__((address_space(3))) bf16x8*)(kp+2048); kf[3]=*(const __attribute__((address_space(3))) bf16x8*)(kp+2560);
  kf[4]=*(const __attribute__((address_space(3))) bf16x8*)(kp+4096); kf[5]=*(const __attribute__((address_space(3))) bf16x8*)(kp+4608);
  kf[6]=*(const __attribute__((address_space(3))) bf16x8*)(kp+6144); kf[7]=*(const __attribute__((address_space(3))) bf16x8*)(kp+6656);
}
__device__ __forceinline__ void kload2(bf16x8*kf,lds_cptr kp,int j){ kf[2*j]=*(const __attribute__((address_space(3))) bf16x8*)(kp+j*2048); kf[2*j+1]=*(const __attribute__((address_space(3))) bf16x8*)(kp+j*2048+512); }
__device__ __forceinline__ s16x4 vtr(lds_cptr p){ return __builtin_bit_cast(s16x4,__builtin_amdgcn_ds_read_tr16_b64_v4i16((__attribute__((address_space(3))) v4i16_t*)p)); }
__device__ __forceinline__ float rowmax(const f32x16&p0,const f32x16&p1){
  float a=max3f(p0[0],p0[1],p1[0]),b=max3f(p0[2],p0[3],p1[1]);a=max3f(a,p1[2],p1[3]);
  #pragma unroll
  for(int r=4;r<16;r+=4){a=max3f(a,p0[r],p0[r+1]);b=max3f(b,p0[r+2],p0[r+3]);a=max3f(a,p1[r],p1[r+1]);b=max3f(b,p1[r+2],p1[r+3]);}
  const float m=max2f(a,b);
  auto rr=__builtin_amdgcn_permlane32_swap(__float_as_uint(m),__float_as_uint(m),false,false);
  return max2f(__uint_as_float(rr[0]),__uint_as_float(rr[1]));
}
__device__ __forceinline__ void pv(f32x16*o,int vb,bf16x8 pa0,bf16x8 pa1,bf16x8 pa2,bf16x8 pa3){
  #pragma unroll
  for(int d0=0;d0<2;++d0){s16x4 lo[4],hi[4];
    #pragma unroll
    for(int ks=0;ks<4;++ks){
      asm volatile("ds_read_b64_tr_b16 %0,%1 offset:%c2":"=&v"(lo[ks]):"v"(vb),"i"(d0*4096+ks*1024):"memory");
      asm volatile("ds_read_b64_tr_b16 %0,%1 offset:%c2":"=&v"(hi[ks]):"v"(vb),"i"(d0*4096+ks*1024+512):"memory");}
    asm volatile("s_waitcnt lgkmcnt(0)":::"memory");SBAR();
    #define PK(k) (bf16x8){lo[k][0],lo[k][1],lo[k][2],lo[k][3],hi[k][0],hi[k][1],hi[k][2],hi[k][3]}
    o[d0]=__builtin_amdgcn_mfma_f32_32x32x16_bf16(pa0,PK(0),o[d0],0,0,0);
    o[d0]=__builtin_amdgcn_mfma_f32_32x32x16_bf16(pa1,PK(1),o[d0],0,0,0);
    o[d0]=__builtin_amdgcn_mfma_f32_32x32x16_bf16(pa2,PK(2),o[d0],0,0,0);
    o[d0]=__builtin_amdgcn_mfma_f32_32x32x16_bf16(pa3,PK(3),o[d0],0,0,0);
    #undef PK
  }
}
template<bool BIAS> __device__ __forceinline__ void cinit(f32x16&c0,f32x16&c1,lds_cptr shm3,int t,int hi,float nmh){
  if constexpr(BIAS){
    const __attribute__((address_space(3))) f32x4* cb4=(const __attribute__((address_space(3))) f32x4*)(shm3+LDS_CB)+t*16+hi;
    #pragma unroll
    for(int g=0;g<4;++g){ const f32x4 b0=cb4[2*g], b1=cb4[8+2*g]; SBAR();
      c0[4*g]=nmh-b0[0]; c0[4*g+1]=nmh-b0[1]; c0[4*g+2]=nmh-b0[2]; c0[4*g+3]=nmh-b0[3];
      c1[4*g]=nmh-b1[0]; c1[4*g+1]=nmh-b1[1]; c1[4*g+2]=nmh-b1[2]; c1[4*g+3]=nmh-b1[3]; SBAR(); }
  } else {
    #pragma unroll
    for(int r=0;r<16;++r){c0[r]=nmh;c1[r]=nmh;}
  }
}
__device__ __forceinline__ u32x4 bias3(float x, bool keyside){
  const unsigned xb=__builtin_bit_cast(unsigned,x), m=(unsigned)lconsti((int)0xffff0000u), one2=(unsigned)lconsti(0x3F803F80);
  const unsigned h=xb&m; const float r1=x-__builtin_bit_cast(float,h); const unsigned l=__builtin_bit_cast(unsigned,r1)&m; const float r2=r1-__builtin_bit_cast(float,l); const unsigned l2=__builtin_bit_cast(unsigned,r2)&m;
  u32x4 w;
  if(keyside){ w.x=(h>>16)|l; w.y=(l2>>16)|(one2&m); w.z=one2; }
  else       { w.x=one2; w.y=(one2&0xffffu)|h; w.z=(l>>16)|l2; }
  unsigned z; asm volatile("v_mov_b32 %0, 0":"=v"(z)); w.w=z; return w;
}
__device__ __forceinline__ void cinit_m(f32x16&c0,f32x16&c1,lds_cptr shm3,int t,int r32,const u32x4 bq){
  const __attribute__((address_space(3))) float* cbl=(const __attribute__((address_space(3))) float*)(shm3+LDS_CB)+t*64+r32;
  const float x0=-cbl[0], x1=-cbl[32];
  const u32x4 a0=bias3(x0,true), a1=bias3(x1,true);
  c0=__builtin_amdgcn_mfma_f32_32x32x16_bf16(__builtin_bit_cast(bf16x8,a0),__builtin_bit_cast(bf16x8,bq),f32x16{},0,0,0);
  c1=__builtin_amdgcn_mfma_f32_32x32x16_bf16(__builtin_bit_cast(bf16x8,a1),__builtin_bit_cast(bf16x8,bq),f32x16{},0,0,0);
}
#ifndef ATT_CBM
#define ATT_CBM 1
#endif
template<int THRL,bool CAUSAL,bool BIAS,int QP,int KP,int OP,bool FIXM=false> __device__ __forceinline__ void attn_unit(const bf16*Qu,const bf16*__restrict__ Ku,const bf16*__restrict__ Vu,bf16*Ou,const float*cbu,const int NT,char*shm,const int tid,const float mfix=0.f){
  const int lane=tid&63,r32=lane&31,hi=lane>>5; const int wid=__builtin_amdgcn_readfirstlane(tid>>6);
  const bf16*Qw=Qu+(long)(wid*QBLK)*QP;
  const unsigned lds0=(unsigned)(uintptr_t)shm;
  float*wsf=(float*)(shm+LDS_WS)+wid*64;
  const bf16*ksrc=Ku+(long)lane*KP+wid*8;
  const bf16*vsrc=Vu+(long)(16*(wid&3)+(lane>>2))*KP+(wid>>2)*32+(lane&3)*8;
  const unsigned kdst=lds0+LDS_K+wid*1024, vdst=lds0+LDS_V+wid*1024;
  #define DMA_K(t,slot) glds16(ksrc+(long)(t)*KVBLK*KP,(unsigned)__builtin_amdgcn_readfirstlane(kdst+(slot)))
  #define DMA_V(t,slot) glds16(vsrc+(long)(t)*KVBLK*KP,(unsigned)__builtin_amdgcn_readfirstlane(vdst+(slot)))
  const int vb0=(int)(lds0+LDS_V)+((lane>>4)&1)*32+(lane&3)*8+(4*hi+((lane&15)>>2))*64;
  const char*Kbase=shm+LDS_K; bf16x8 kf[8];
  const lds_cptr shm3=(lds_cptr)shm; const lds_cptr kp0=shm3+LDS_K+hi*1024+r32*16; const lds_cptr vp0=shm3+LDS_V+((lane>>4)&1)*32+(lane&3)*8+(4*hi+((lane&15)>>2))*64;
  f32x4 cbv0=(f32x4){0.f,0.f,0.f,0.f},cbv1=cbv0;
  if constexpr(BIAS){ const int ncb=NT*16; if(tid<ncb)cbv0=((const f32x4*)cbu)[tid]; if(tid+512<ncb)cbv1=((const f32x4*)cbu)[tid+512]; }
  float cbi_=0.f; if constexpr(BIAS&&FIXM) cbi_=cbu[NT*64-256+wid*QBLK+r32];
  DMA_K(0,0);DMA_V(0,0);DMA_K(1,SLOTB);
  bf16x8 qr[4];
  #pragma unroll
  for(int d0=0;d0<4;++d0)qr[d0]=*reinterpret_cast<const bf16x8*>(&Qw[(long)r32*QP+d0*16+hi*8]);
  { __attribute__((address_space(3))) bf16x8* qw_=(__attribute__((address_space(3))) bf16x8*)((__attribute__((address_space(3))) char*)shm+LDS_OST+wid*4096)+lane;
    qw_[0]=qr[0]; qw_[64]=qr[1]; qw_[128]=qr[2]; qw_[192]=qr[3]; }
  const __attribute__((address_space(3))) bf16x8* qst=(const __attribute__((address_space(3))) bf16x8*)(shm3+LDS_OST+wid*4096)+lane;
  #define QLD(d) qst[(d)*64]
  if constexpr(BIAS){ __attribute__((address_space(3))) f32x4* cbl=(__attribute__((address_space(3))) f32x4*)((__attribute__((address_space(3))) char*)shm+LDS_CB); const int ncb=NT*16; if(tid<ncb)cbl[tid]=cbv0; if(tid+512<ncb)cbl[tid+512]=cbv1; }
  float mhat,nmh,l_reg; asm volatile("v_mov_b32 %0, 0\n\tv_mov_b32 %1, 0\n\tv_mov_b32 %2, 0":"=v"(mhat),"=v"(nmh),"=v"(l_reg));
  if constexpr(FIXM){ mhat=mfix-cbi_; nmh=-mhat; }
  constexpr bool CBM = FIXM && BIAS && (ATT_CBM != 0);
  u32x4 bq_=(u32x4){0u,0u,0u,0u}; if constexpr(CBM){ bq_=bias3(nmh,false); if(hi){ unsigned z; asm volatile("v_mov_b32 %0, 0":"=v"(z)); bq_=(u32x4){z,z,z,z}; } }
  f32x16 o[2];o[0]=f32x16{};o[1]=f32x16{};
  const int qrel=wid*QBLK+r32;
  #define CMASK(P0,P1,t) do{ if(CAUSAL){int jb_=(t)-(NT-4); if(jb_>=0)cmask(P0,P1,jb_,qrel,hi);} }while(0)
  bool resc=false;
  #define START(P0,P1) do{ resc=false; if constexpr(!FIXM){ const float rm=rowmax(P0,P1); \
    { const float dl=rm; mhat=fadd_s(mhat,dl); \
      _Pragma("unroll") for(int r=0;r<16;++r){P0[r]=fsub_s(P0[r],dl);P1[r]=fsub_s(P1[r],dl);} \
      nmh=-mhat; } } \
    _Pragma("unroll") for(int r=0;r<16;++r)P0[r]=__builtin_amdgcn_exp2f(P0[r]); }while(0)
  #define RESC() do{ if(resc){ asm volatile("s_waitcnt lgkmcnt(0)":::"memory"); \
      _Pragma("unroll") for(int d_=0;d_<2;++d_) _Pragma("unroll") for(int r=0;r<16;++r)o[d_][r]*=wsf[crow(r,hi)]; } }while(0)
  f32x16 pA0,pA1,pB0,pB1;
  int sl_prev=0,sl_cur=0,sl_next=SLOTB;
  #define ROT() do{sl_prev=sl_cur;sl_cur=sl_next;sl_next=(sl_next==(NSLOT-1)*SLOTB)?0:sl_next+SLOTB;}while(0)
  DMA_K(2,2*SLOTB);
  WAIT_BAR(3);
  if constexpr(CBM) cinit_m(pA0,pA1,shm3,0,r32,bq_); else cinit<BIAS>(pA0,pA1,shm3,0,hi,nmh);
  qkt(pA0,pA1,Kbase,qr,r32,hi);asm volatile("s_nop 15\n\ts_nop 7":"+v"(pA0),"+v"(pA1));CMASK(pA0,pA1,0);
  START(pA0,pA1);
  _Pragma("unroll") for(int r=0;r<16;++r)pA1[r]=__builtin_amdgcn_exp2f(pA1[r]);
  WAIT_BAR(0);
  DMA_K(3,0);DMA_V(1,SLOTB);
  ROT();
  kload8(kf,kp0+sl_cur);
  WAIT_BAR(2);
  s16x4 vlo[8],vhi[8]; u32x4 pw0,pw1,pw2,pw3;
  #define PKW(P,B) cvtpk_s(P[B],P[B+1])
  #define PAF(k) __builtin_bit_cast(bf16x8,pw##k)
  #define VFR(i) (bf16x8){vlo[i][0],vlo[i][1],vlo[i][2],vlo[i][3],vhi[i][0],vhi[i][1],vhi[i][2],vhi[i][3]}
  #define PIN(x) asm volatile("":"+v"(x))
  #define MX3(a,b,c) __builtin_fmaxf(__builtin_fmaxf((a),(b)),(c))
  #define GAPA(MF,A0,A1,A2,A3,W0,W1,PW) do{ MF; sacc+=A0; sacc+=A1; sacc+=A2; sacc+=A3; PIN(sacc); W0; W1; PIN(PW); SBAR(); }while(0)
  #define EX(v) __builtin_amdgcn_exp2f(v)
  #define GAPB(MF,X,B) do{ MF; X[B]=EX(X[B]); X[B+1]=EX(X[B+1]); X[B+2]=EX(X[B+2]); X[B+3]=EX(X[B+3]); PIN(X); SBAR(); }while(0)
  #define VRD(i) do{ vlo[i]=vtr(vp_+(((i)>>2)*4096+((i)&3)*1024)); vhi[i]=vtr(vp_+(((i)>>2)*4096+((i)&3)*1024+512)); }while(0)
  #define KRD(G,j) do{ if(G){ kload2(kf,kp0+sl_next,j); SBAR(); } }while(0)
  #define STEP(C0,C1,P0,P1,t,GK,GV,GL) do{ SBAR(); \
    if constexpr(CBM) cinit_m(C0,C1,shm3,(t),r32,bq_); else cinit<BIAS>(C0,C1,shm3,(t),hi,nmh); SBAR(); \
    const lds_cptr vp_=vp0+sl_prev; \
    bf16x8 qa_=QLD(0), qb_=QLD(1); \
    VRD(0); SBAR(); float sacc=(P0[0]+P0[1]); \
    GAPA(C0=__builtin_amdgcn_mfma_f32_32x32x16_bf16(kf[0],qa_,C0,0,0,0), P0[2],P0[3],P0[4],P0[5],     pw0[0]=PKW(P0,0), pw0[1]=PKW(P0,2), pw0); \
    VRD(4); SBAR(); GAPA(C1=__builtin_amdgcn_mfma_f32_32x32x16_bf16(kf[1],qa_,C1,0,0,0), P0[6],P0[7],P0[8],P0[9],     pw0[2]=PKW(P0,4), pw0[3]=PKW(P0,6), pw0); \
    qa_=QLD(2); VRD(1); SBAR(); GAPA(C0=__builtin_amdgcn_mfma_f32_32x32x16_bf16(kf[2],qb_,C0,0,0,0),   P0[10],P0[11],P0[12],P0[13], pw1[0]=PKW(P0,8), pw1[1]=PKW(P0,10), pw1); \
    VRD(5); SBAR(); GAPA(C1=__builtin_amdgcn_mfma_f32_32x32x16_bf16(kf[3],qb_,C1,0,0,0),   P0[14],P0[15],P1[0],P1[1],   pw1[2]=PKW(P0,12),pw1[3]=PKW(P0,14), pw1); \
    qb_=QLD(3); VRD(2); SBAR(); GAPA(C0=__builtin_amdgcn_mfma_f32_32x32x16_bf16(kf[4],qa_,C0,0,0,0),   P1[2],P1[3],P1[4],P1[5],     pw2[0]=PKW(P1,0), pw2[1]=PKW(P1,2), pw2); \
    VRD(6); SBAR(); GAPA(C1=__builtin_amdgcn_mfma_f32_32x32x16_bf16(kf[5],qa_,C1,0,0,0),   P1[6],P1[7],P1[8],P1[9],     pw2[2]=PKW(P1,4), pw2[3]=PKW(P1,6), pw2); \
    VRD(3); SBAR(); GAPA(C0=__builtin_amdgcn_mfma_f32_32x32x16_bf16(kf[6],qb_,C0,0,0,0),   P1[10],P1[11],P1[12],P1[13], pw3[0]=PKW(P1,8), pw3[1]=PKW(P1,10), pw3); \
    VRD(7); SBAR(); GAPA(C1=__builtin_amdgcn_mfma_f32_32x32x16_bf16(kf[7],qb_,C1,0,0,0),   P1[14],P1[15],0.f,0.f,       pw3[2]=PKW(P1,12),pw3[3]=PKW(P1,14), pw3); \
    l_reg+=sacc; \
    if(GK){DMA_K((t)+3,sl_cur);} if(GV){DMA_V((t)+1,sl_next);} \
    CMASK(C0,C1,t); \
    if constexpr(!FIXM) { float a=MX3(C0[0],C0[1],C1[0]),b=MX3(C0[2],C0[3],C1[1]); a=MX3(a,C1[2],C1[3]); \
      _Pragma("unroll") for(int r=4;r<16;r+=4){a=MX3(a,C0[r],C0[r+1]);b=MX3(b,C0[r+2],C0[r+3]);a=MX3(a,C1[r],C1[r+1]);b=MX3(b,C1[r+2],C1[r+3]);} \
      float rm=__builtin_fmaxf(a,b); { auto rr=__builtin_amdgcn_permlane32_swap(__float_as_uint(rm),__float_as_uint(rm),false,false); rm=__builtin_fmaxf(__uint_as_float(rr[0]),__uint_as_float(rr[1])); } \
      resc=false; \
      if(__builtin_expect(__any(rm>(float)THRL),0)){ const float dl=__builtin_fmaxf(rm,0.f); mhat+=dl; \
        _Pragma("unroll") for(int r=0;r<16;++r){C0[r]-=dl;C1[r]-=dl;} \
        nmh=-mhat; \
        const float f=__builtin_amdgcn_exp2f(-dl); l_reg*=f; if(hi==0)wsf[r32]=f; resc=true; } } \
    SBAR(); \
    GAPB(o[0]=__builtin_amdgcn_mfma_f32_32x32x16_bf16(PAF(0),VFR(0),o[0],0,0,0), C0,0); \
    GAPB(o[1]=__builtin_amdgcn_mfma_f32_32x32x16_bf16(PAF(0),VFR(4),o[1],0,0,0), C0,4); \
    KRD(GL,0); GAPB(o[0]=__builtin_amdgcn_mfma_f32_32x32x16_bf16(PAF(1),VFR(1),o[0],0,0,0), C0,8); \
    KRD(GL,1); GAPB(o[1]=__builtin_amdgcn_mfma_f32_32x32x16_bf16(PAF(1),VFR(5),o[1],0,0,0), C0,12); \
    KRD(GL,2); GAPB(o[0]=__builtin_amdgcn_mfma_f32_32x32x16_bf16(PAF(2),VFR(2),o[0],0,0,0), C1,0); \
    KRD(GL,3); GAPB(o[1]=__builtin_amdgcn_mfma_f32_32x32x16_bf16(PAF(2),VFR(6),o[1],0,0,0), C1,4); \
    GAPB(o[0]=__builtin_amdgcn_mfma_f32_32x32x16_bf16(PAF(3),VFR(3),o[0],0,0,0), C1,8); \
    GAPB(o[1]=__builtin_amdgcn_mfma_f32_32x32x16_bf16(PAF(3),VFR(7),o[1],0,0,0), C1,12); \
    }while(0)
  int t=1;
  #undef CMASK
  #define CMASK(P0,P1,t) do{}while(0)
  for(;t+5<NT;t+=2){
    STEP(pB0,pB1,pA0,pA1,t,true,true,true);     WAIT_BAR(2); RESC(); ROT();
    STEP(pA0,pA1,pB0,pB1,t+1,true,true,true);   WAIT_BAR(2); RESC(); ROT();
  }
  #undef CMASK
  #define CMASK(P0,P1,t) do{ if(CAUSAL){int jb_=(t)-(NT-4); if(jb_>=0)cmask(P0,P1,jb_,qrel,hi);} }while(0)
  #define ENDW(tt) do{ if((tt)+3<NT){WAIT_BAR(2);} else if((tt)+2<NT){WAIT_BAR(1);} else {WAIT_BAR(0);} }while(0)
  for(;t+1<NT;t+=2){
    STEP(pB0,pB1,pA0,pA1,t,(t+3<NT),(t+1<NT),(t+1<NT));       ENDW(t);   RESC(); ROT();
    STEP(pA0,pA1,pB0,pB1,t+1,(t+4<NT),(t+2<NT),(t+2<NT));     ENDW(t+1); RESC(); ROT();
  }
  STEP(pB0,pB1,pA0,pA1,NT-1,false,false,false); RESC();
  { float sacc=pB0[0]+pB0[1]; _Pragma("unroll") for(int r=2;r<16;++r)sacc+=pB0[r]; _Pragma("unroll") for(int r=0;r<16;++r)sacc+=pB1[r]; l_reg+=sacc;
    pw0=(u32x4){PKW(pB0,0),PKW(pB0,2),PKW(pB0,4),PKW(pB0,6)};pw1=(u32x4){PKW(pB0,8),PKW(pB0,10),PKW(pB0,12),PKW(pB0,14)};pw2=(u32x4){PKW(pB1,0),PKW(pB1,2),PKW(pB1,4),PKW(pB1,6)};pw3=(u32x4){PKW(pB1,8),PKW(pB1,10),PKW(pB1,12),PKW(pB1,14)};
    SBAR(); pv(o,vb0+sl_cur,PAF(0),PAF(1),PAF(2),PAF(3)); }
  #undef PKW
  #undef PAF
  #undef VFR
  #undef PIN
  #undef MX3
  #undef GAPA
  #undef GAPB
  #undef EX
  #undef VRD
  #undef KRD
  #undef STEP
  #undef ENDW
  {auto rr=__builtin_amdgcn_permlane32_swap(__float_as_uint(l_reg),__float_as_uint(l_reg),false,false);l_reg=__uint_as_float(rr[0])+__uint_as_float(rr[1]);}
  if(hi==0)wsf[32+r32]=l_reg;asm volatile("s_waitcnt lgkmcnt(0)":::"memory");
  float rli[16];
  #pragma unroll
  for(int r=0;r<16;++r)rli[r]=__builtin_amdgcn_rcpf(wsf[32+crow(r,hi)]);
  bf16*Ow=Ou+(long)(wid*QBLK)*OP;
  { bf16*stg=(bf16*)(shm+LDS_OST)+wid*2048;
    #pragma unroll
    for(int r=0;r<16;++r){const int orow=crow(r,hi);
      #pragma unroll
      for(int d0=0;d0<2;++d0)stg[orow*64+d0*32+r32]=__float2bfloat16(o[d0][r]*rli[r]);}
    asm volatile("s_waitcnt lgkmcnt(0)":::"memory");
    #pragma unroll
    for(int i=0;i<4;++i){const int row=i*8+(lane>>3),ch=lane&7; const u32x4 v=*(const u32x4*)(stg+row*64+ch*8); *(u32x4*)(Ow+(long)row*OP+ch*8)=v;} }
  asm volatile("s_waitcnt lgkmcnt(0)\n\ts_barrier":::"memory");
  #undef QLD
  #undef DMA_K
  #undef DMA_V
  #undef CMASK
  #undef START
  #undef RESC
  #undef ROT
}
#undef SBAR
#undef WAIT_BAR
}
constexpr int NWAVES = 8;
constexpr int RING_OFF = 0, RING_BYTES = 131072;
constexpr int LDSCTL_OFF = RING_BYTES, MISC_OFF = LDSCTL_OFF + 320;
constexpr int LDS_BYTES = 147456;
constexpr int ORDTAB_OFF = LDSCTL_OFF + 1024;
static_assert(MISC_OFF + 128 <= LDS_BYTES, "LDS map");
static_assert(attn_body::LDS_BYTES <= RING_BYTES && pg8::STAGE_BYTES <= RING_BYTES, "LDS map");

#define GAS __attribute__((address_space(1)))
#define LAS __attribute__((address_space(3)))
typedef unsigned short bf16;
typedef unsigned v4u __attribute__((ext_vector_type(4)));
typedef unsigned v2u __attribute__((ext_vector_type(2)));
typedef float f32x4 __attribute__((ext_vector_type(4)));
typedef GAS unsigned gu32;
#define RLX_AGENT __ATOMIC_RELAXED, __HIP_MEMORY_SCOPE_AGENT
#define LDS_WAIT() asm volatile("s_waitcnt lgkmcnt(0)" ::: "memory")
#define VM_WAIT() asm volatile("s_waitcnt vmcnt(0)" ::: "memory")
__device__ __forceinline__ unsigned f2bf(float f) { unsigned u = __builtin_bit_cast(unsigned, f); return (u + 0x7fffu + ((u >> 16) & 1u)) >> 16; }
__device__ __forceinline__ unsigned pk2(float lo, float hi) { unsigned r; asm volatile("v_cvt_pk_bf16_f32 %0, %1, %2" : "=v"(r) : "v"(lo), "v"(hi)); return r; }
__device__ __forceinline__ float bflo(unsigned w) { return __builtin_bit_cast(float, w << 16); }
__device__ __forceinline__ float bfhi(unsigned w) { return __builtin_bit_cast(float, w & 0xffff0000u); }

__device__ __forceinline__ unsigned pk4f8(float a, float b, float c, float d) { int p = __builtin_amdgcn_cvt_pk_fp8_f32(a, b, __builtin_bit_cast(int, a), false); p = __builtin_amdgcn_cvt_pk_fp8_f32(c, d, p, true); return (unsigned)p; }
__device__ __forceinline__ float clampf8(float x) { const float c = lconst(448.f); return __builtin_amdgcn_fmed3f(x, -c, c); }

#define XB_TMO      128
#define XB_XCNT(j)  (256  + 64 * (j))
#define XB_XSUB(j)  (1280 + 64 * (j))
#define XB_XGEN(j)  (2304 + 64 * (j))
#define XB_TOP      3328
#define XB_TOPGEN   3392
#define XCD_BAR_WORDS 3456
#define XB_SPIN_CAP (1u << 18)
__device__ __forceinline__ unsigned xb_ld(unsigned* p)              { return __hip_atomic_load(p, __ATOMIC_RELAXED, __HIP_MEMORY_SCOPE_AGENT); }
__device__ __forceinline__ unsigned xb_add(unsigned* p, unsigned v) { unsigned one_; asm volatile("v_mov_b32 %0, 1" : "=v"(one_)); (void)v;
    return __hip_atomic_fetch_add(p, one_, __ATOMIC_RELAXED, __HIP_MEMORY_SCOPE_AGENT); }
__device__ __forceinline__ unsigned ticket_take(gu32* ctr) { unsigned one_, z_; asm volatile("v_mov_b32 %0, 1\n\tv_mov_b32 %1, 0" : "=v"(one_), "=v"(z_));
    return __hip_atomic_fetch_add((gu32*)((GAS char*)ctr + z_), one_, RLX_AGENT); }
__device__ __forceinline__ unsigned xb_xcc_id() { return (unsigned)__builtin_amdgcn_s_getreg((3 << 11) | 20) & 0xFu; }
#define XB_SPIN(cond, bar) do { unsigned _sp = 0; while (cond) { __builtin_amdgcn_s_sleep(1); \
    if ((++_sp & 255u) == 0u) { if (xb_ld(&(bar)[XB_TMO])) break; if (_sp > XB_SPIN_CAP) { atomicAdd(&(bar)[XB_TMO], 1u); break; } } } } while (0)
struct XcdBarrier { unsigned* bar; unsigned x; volatile LAS unsigned* st; };
__device__ __forceinline__ XcdBarrier xcd_barrier_post(unsigned* bar, volatile LAS unsigned* st, const int tid) {
    XcdBarrier b; b.bar = bar; b.x = xb_xcc_id(); b.st = st;
    if (tid == 0) (void)xb_add(&bar[XB_XCNT(b.x)], 1u);
    return b;
}
__device__ __forceinline__ void xcd_barrier_complete(unsigned* bar, unsigned x, unsigned& nloc, unsigned& nx) {
    const unsigned G = gridDim.x * gridDim.y * gridDim.z;
    unsigned sum, cnt, mine, sp = 0u;
    for (;;) {
        sum = 0u; cnt = 0u; mine = 0u;
#pragma unroll
        for (unsigned j = 0; j < 16; ++j) { const unsigned c = xb_ld(&bar[XB_XCNT(j)]); sum += c; cnt += (c > 0u) ? 1u : 0u; }
        mine = xb_ld(&bar[XB_XCNT(x)]);
        if (sum == G) break;
        __builtin_amdgcn_s_sleep(1);
        if ((++sp & 255u) == 0u) { if (xb_ld(&bar[XB_TMO])) break; if (sp > XB_SPIN_CAP) { atomicAdd(&bar[XB_TMO], 1u); break; } }
    }
    nloc = mine > 0u ? mine : 1u; nx = cnt > 0u ? cnt : 1u;
}
__device__ __forceinline__ void xcd_barrier(const XcdBarrier& b, const int tid  ) {
    asm volatile("s_waitcnt vmcnt(0)" ::: "memory");
    __syncthreads();
    if (tid == 0) {
        unsigned* bar = b.bar;
        __builtin_amdgcn_s_waitcnt(0);
        unsigned nloc = b.st[0], nx = b.st[1];
        if (nloc == 0u) { xcd_barrier_complete(bar, b.x, nloc, nx); b.st[0] = nloc; b.st[1] = nx; }
        const unsigned old = xb_add(&bar[XB_XSUB(b.x)], 1u);
        const unsigned gen = old / nloc;
        if (old + 1u == (gen + 1u) * nloc) {
            __builtin_amdgcn_fence(__ATOMIC_RELEASE, "agent");
            asm volatile("s_waitcnt vmcnt(0)" ::: "memory");
            const unsigned og = xb_add(&bar[XB_TOP], 1u);
            const unsigned tg = og / nx;
            if (og + 1u == (tg + 1u) * nx) xb_add(&bar[XB_TOPGEN], 1u);
            else XB_SPIN(xb_ld(&bar[XB_TOPGEN]) == tg, bar);
            __builtin_amdgcn_fence(__ATOMIC_ACQUIRE, "agent");
            xb_add(&bar[XB_XGEN(b.x)], 1u);
            asm volatile("s_waitcnt vmcnt(0)" ::: "memory");
        } else {
            XB_SPIN(xb_ld(&bar[XB_XGEN(b.x)]) == gen, bar);
            __builtin_amdgcn_fence(__ATOMIC_ACQUIRE, "agent");
            asm volatile("s_waitcnt vmcnt(0)" ::: "memory");
        }
    }
    __syncthreads();
}

struct Args { const float* in[27]; float* out; unsigned char* ws; int ph_lo, ph_hi; unsigned mask; int pad; };
struct Frame {
    LAS unsigned char* lds;
    volatile LAS unsigned* MISC;
    gu32* ctl;
    int tid, lane, wave, vcu, G;
    unsigned char* ws;
    const __attribute__((address_space(4))) struct Args* A;
    float* out;
};
__device__ __forceinline__ float lane_xor_f(float v, int m, int lane) { return __builtin_bit_cast(float, __builtin_amdgcn_ds_bpermute((lane ^ m) << 2, __builtin_bit_cast(int, v))); }
__device__ __forceinline__ int lane_up_i(int v, int o, int lane) { return __builtin_amdgcn_ds_bpermute((lane >= o ? lane - o : lane) << 2, v); }
__device__ __forceinline__ double lane_up_d(double v, int o, int lane) { const unsigned long long u = __builtin_bit_cast(unsigned long long, v); const int a = (lane >= o ? lane - o : lane) << 2;
    const unsigned lo = (unsigned)__builtin_amdgcn_ds_bpermute(a, (int)(unsigned)u), hi = (unsigned)__builtin_amdgcn_ds_bpermute(a, (int)(unsigned)(u >> 32)); return __builtin_bit_cast(double, ((unsigned long long)hi << 32) | lo); }
__device__ __forceinline__ double lane_get_d(double v, int src) { const unsigned long long u = __builtin_bit_cast(unsigned long long, v);
    const unsigned lo = (unsigned)__builtin_amdgcn_readlane((int)(unsigned)u, src), hi = (unsigned)__builtin_amdgcn_readlane((int)(unsigned)(u >> 32), src); return __builtin_bit_cast(double, ((unsigned long long)hi << 32) | lo); }
#define DPP_ADD(v, ctrl) ((v) + __builtin_bit_cast(float, __builtin_amdgcn_update_dpp(__builtin_bit_cast(int, (v)), __builtin_bit_cast(int, (v)), (ctrl), 0xf, 0xf, false)))
__device__ __forceinline__ float wave_sum_l(float v, int  ) {
    v = DPP_ADD(v, 0xB1);
    v = DPP_ADD(v, 0x4E);
    v = DPP_ADD(v, 0x141);
    v = DPP_ADD(v, 0x140);
    const float r0 = __builtin_bit_cast(float, __builtin_amdgcn_readlane(__builtin_bit_cast(int, v), 0)), r1 = __builtin_bit_cast(float, __builtin_amdgcn_readlane(__builtin_bit_cast(int, v), 16));
    const float r2 = __builtin_bit_cast(float, __builtin_amdgcn_readlane(__builtin_bit_cast(int, v), 32)), r3 = __builtin_bit_cast(float, __builtin_amdgcn_readlane(__builtin_bit_cast(int, v), 48));
    return (r0 + r1) + (r2 + r3);
}
#define DPP_GET(v, ctrl) __builtin_bit_cast(float, __builtin_amdgcn_update_dpp(__builtin_bit_cast(int, (v)), __builtin_bit_cast(int, (v)), (ctrl), 0xf, 0xf, false))
__device__ __forceinline__ float wave_reduce32(const float (&v)[32], int lane) {
    float u[16], w[8], x[4], y[2];
#pragma unroll
    for (int i = 0; i < 16; ++i) { const auto rr = __builtin_amdgcn_permlane32_swap(__builtin_bit_cast(unsigned, v[i]), __builtin_bit_cast(unsigned, v[i + 16]), false, false);
        u[i] = __builtin_bit_cast(float, (unsigned)rr[0]) + __builtin_bit_cast(float, (unsigned)rr[1]); }
#pragma unroll
    for (int i = 0; i < 8; ++i) { const auto rr = __builtin_amdgcn_permlane16_swap(__builtin_bit_cast(unsigned, u[i]), __builtin_bit_cast(unsigned, u[i + 8]), false, false);
        w[i] = __builtin_bit_cast(float, (unsigned)rr[0]) + __builtin_bit_cast(float, (unsigned)rr[1]); }
    const bool b3 = (lane & 8) != 0, b2 = (lane & 4) != 0, b1 = (lane & 2) != 0;
#pragma unroll
    for (int i = 0; i < 4; ++i) { const float keep = b3 ? w[i + 4] : w[i], give = b3 ? w[i] : w[i + 4]; x[i] = keep + DPP_GET(give, 0x140); }
#pragma unroll
    for (int i = 0; i < 2; ++i) { const float keep = b2 ? x[i + 2] : x[i], give = b2 ? x[i] : x[i + 2]; y[i] = keep + DPP_GET(give, 0x141); }
    float z; { const float keep = b1 ? y[1] : y[0], give = b1 ? y[0] : y[1]; z = keep + DPP_GET(give, 0x4E); }
    z = z + DPP_GET(z, 0xB1);
    return z;
}
#define SWAP32_ADD(a, b) ([&]() { const auto rr_ = __builtin_amdgcn_permlane32_swap(__builtin_bit_cast(unsigned, (a)), __builtin_bit_cast(unsigned, (b)), false, false); return __builtin_bit_cast(float, (unsigned)rr_[0]) + __builtin_bit_cast(float, (unsigned)rr_[1]); }())
#define SWAP16_ADD(a, b) ([&]() { const auto rr_ = __builtin_amdgcn_permlane16_swap(__builtin_bit_cast(unsigned, (a)), __builtin_bit_cast(unsigned, (b)), false, false); return __builtin_bit_cast(float, (unsigned)rr_[0]) + __builtin_bit_cast(float, (unsigned)rr_[1]); }())
__device__ __forceinline__ float wave_reduce16(const float (&v)[16], int lane) {
    float u[8], w[4], x[2];
#pragma unroll
    for (int i = 0; i < 8; ++i) u[i] = SWAP32_ADD(v[i], v[i + 8]);
#pragma unroll
    for (int i = 0; i < 4; ++i) w[i] = SWAP16_ADD(u[i], u[i + 4]);
    const bool b3 = (lane & 8) != 0, b2 = (lane & 4) != 0;
#pragma unroll
    for (int i = 0; i < 2; ++i) { const float keep = b3 ? w[i + 2] : w[i], give = b3 ? w[i] : w[i + 2]; x[i] = keep + DPP_GET(give, 0x140); }
    float z; { const float keep = b2 ? x[1] : x[0], give = b2 ? x[0] : x[1]; z = keep + DPP_GET(give, 0x141); }
    z = z + DPP_GET(z, 0x4E); z = z + DPP_GET(z, 0xB1);
    return z;
}
__device__ __forceinline__ float wave_reduce8(const float (&v)[8], int lane) {
    float u[4], w[2];
#pragma unroll
    for (int i = 0; i < 4; ++i) u[i] = SWAP32_ADD(v[i], v[i + 4]);
#pragma unroll
    for (int i = 0; i < 2; ++i) w[i] = SWAP16_ADD(u[i], u[i + 2]);
    const bool b3 = (lane & 8) != 0;
    float z; { const float keep = b3 ? w[1] : w[0], give = b3 ? w[0] : w[1]; z = keep + DPP_GET(give, 0x140); }
    z = z + DPP_GET(z, 0x141); z = z + DPP_GET(z, 0x4E); z = z + DPP_GET(z, 0xB1);
    return z;
}
#if BRINGUP
__device__ __forceinline__ float wave_sum(float v) {
#pragma unroll
    for (int o = 1; o < 64; o <<= 1) v += __shfl_xor(v, o);
    return v;
}
#endif

__device__ __forceinline__ void cvt_finish16(const f32x4 (&t)[8], bf16* dst, int K, LAS float* scr, int lane, const float* gk  ) {
    { const int kr = lane >> 3, c4 = (lane & 7) * 4;
#pragma unroll
      for (int i = 0; i < 8; ++i) { const int kk = 8 * i + kr; const float gg = gk ? gk[kk] : 1.0f; LAS float* d = scr + kk * 33 + c4; d[0] = t[i].x * gg; d[1] = t[i].y * gg; d[2] = t[i].z * gg; d[3] = t[i].w * gg; } }
    LDS_WAIT(); asm volatile("" ::: "memory");
    const int c = lane & 7;
#pragma unroll
    for (int j = 0; j < 4; ++j) { const int n = (lane >> 3) + 8 * j; const LAS float* s = scr + (8 * c) * 33 + n;
        v4u o; o.x = pk2(s[0 * 33], s[1 * 33]); o.y = pk2(s[2 * 33], s[3 * 33]); o.z = pk2(s[4 * 33], s[5 * 33]); o.w = pk2(s[6 * 33], s[7 * 33]);
        *(GAS v4u*)(dst + (size_t)n * K + 8 * c) = o; }
    LDS_WAIT(); asm volatile("" ::: "memory");
}
__device__ __forceinline__ void cvt8_finish_g(const f32x4 (&t)[8], unsigned char* dst, int Kb, LAS float* scr, int lane, float qs, const float* gk) {
    { const int kr = lane >> 3, c4 = (lane & 7) * 4;
#pragma unroll
      for (int i = 0; i < 8; ++i) { const float gg = gk ? gk[8 * i + kr] : 1.0f; LAS float* d = scr + (8 * i + kr) * 33 + c4; d[0] = t[i].x * gg; d[1] = t[i].y * gg; d[2] = t[i].z * gg; d[3] = t[i].w * gg; } }
    LDS_WAIT(); asm volatile("" ::: "memory");
    const int n = lane >> 1, h = lane & 1; const LAS float* s = scr + (32 * h) * 33 + n;
    v4u o0, o1;
    o0.x = pk4f8(s[0 * 33] * qs, s[1 * 33] * qs, s[2 * 33] * qs, s[3 * 33] * qs);     o0.y = pk4f8(s[4 * 33] * qs, s[5 * 33] * qs, s[6 * 33] * qs, s[7 * 33] * qs);
    o0.z = pk4f8(s[8 * 33] * qs, s[9 * 33] * qs, s[10 * 33] * qs, s[11 * 33] * qs);   o0.w = pk4f8(s[12 * 33] * qs, s[13 * 33] * qs, s[14 * 33] * qs, s[15 * 33] * qs);
    o1.x = pk4f8(s[16 * 33] * qs, s[17 * 33] * qs, s[18 * 33] * qs, s[19 * 33] * qs); o1.y = pk4f8(s[20 * 33] * qs, s[21 * 33] * qs, s[22 * 33] * qs, s[23 * 33] * qs);
    o1.z = pk4f8(s[24 * 33] * qs, s[25 * 33] * qs, s[26 * 33] * qs, s[27 * 33] * qs); o1.w = pk4f8(s[28 * 33] * qs, s[29 * 33] * qs, s[30 * 33] * qs, s[31 * 33] * qs);
    GAS v4u* d = (GAS v4u*)(dst + (size_t)n * Kb + 32 * h); d[0] = o0; d[1] = o1;
    LDS_WAIT(); asm volatile("" ::: "memory");
}
__device__ __forceinline__ void cvt_block(const float* src, int ldw, bf16* dst, int K, LAS float* scr, int lane, const float* gk  ) {
    { const int kr = lane >> 3, c4 = (lane & 7) * 4; f32x4 t[8];
#pragma unroll
      for (int i = 0; i < 8; ++i) t[i] = *(const GAS f32x4*)(src + (size_t)(8 * i + kr) * ldw + c4);
#pragma unroll
      for (int i = 0; i < 8; ++i) { const int kk = 8 * i + kr; const float gg = gk ? gk[kk] : 1.0f; LAS float* d = scr + kk * 33 + c4; d[0] = t[i].x * gg; d[1] = t[i].y * gg; d[2] = t[i].z * gg; d[3] = t[i].w * gg; } }
    LDS_WAIT(); asm volatile("" ::: "memory");
    const int c = lane & 7;
#pragma unroll
    for (int j = 0; j < 4; ++j) { const int n = (lane >> 3) + 8 * j; const LAS float* s = scr + (8 * c) * 33 + n;
        v4u o; o.x = pk2(s[0 * 33], s[1 * 33]); o.y = pk2(s[2 * 33], s[3 * 33]); o.z = pk2(s[4 * 33], s[5 * 33]); o.w = pk2(s[6 * 33], s[7 * 33]);
        *(GAS v4u*)(dst + (size_t)n * K + 8 * c) = o; }
    LDS_WAIT(); asm volatile("" ::: "memory");
}
__device__ __forceinline__ void cvt_block8(const float* src, int ldw, unsigned char* dst, int Kb, LAS float* scr, int lane, float qs, const float* gk) {
    { const int kr = lane >> 3, c4 = (lane & 7) * 4; f32x4 t[8];
#pragma unroll
      for (int i = 0; i < 8; ++i) t[i] = *(const GAS f32x4*)(src + (size_t)(8 * i + kr) * ldw + c4);
#pragma unroll
      for (int i = 0; i < 8; ++i) { const float gg = gk ? gk[8 * i + kr] : 1.0f; LAS float* d = scr + (8 * i + kr) * 33 + c4; d[0] = t[i].x * gg; d[1] = t[i].y * gg; d[2] = t[i].z * gg; d[3] = t[i].w * gg; } }
    LDS_WAIT(); asm volatile("" ::: "memory");
    const int n = lane >> 1, h = lane & 1; const LAS float* s = scr + (32 * h) * 33 + n;
    v4u o0, o1;
    o0.x = pk4f8(s[0 * 33] * qs, s[1 * 33] * qs, s[2 * 33] * qs, s[3 * 33] * qs);     o0.y = pk4f8(s[4 * 33] * qs, s[5 * 33] * qs, s[6 * 33] * qs, s[7 * 33] * qs);
    o0.z = pk4f8(s[8 * 33] * qs, s[9 * 33] * qs, s[10 * 33] * qs, s[11 * 33] * qs);   o0.w = pk4f8(s[12 * 33] * qs, s[13 * 33] * qs, s[14 * 33] * qs, s[15 * 33] * qs);
    o1.x = pk4f8(s[16 * 33] * qs, s[17 * 33] * qs, s[18 * 33] * qs, s[19 * 33] * qs); o1.y = pk4f8(s[20 * 33] * qs, s[21 * 33] * qs, s[22 * 33] * qs, s[23 * 33] * qs);
    o1.z = pk4f8(s[24 * 33] * qs, s[25 * 33] * qs, s[26 * 33] * qs, s[27 * 33] * qs); o1.w = pk4f8(s[28 * 33] * qs, s[29 * 33] * qs, s[30 * 33] * qs, s[31 * 33] * qs);
    GAS v4u* d = (GAS v4u*)(dst + (size_t)n * Kb + 32 * h); d[0] = o0; d[1] = o1;
    LDS_WAIT(); asm volatile("" ::: "memory");
}
__device__ __forceinline__ void cvt8_load(f32x4 (&t)[8], const float* src, int ldw, int lane) {
    const int kr = lane >> 3, c4 = (lane & 7) * 4;
    const unsigned voff = (unsigned)(kr * ldw + c4) * 4u;
#pragma unroll
    for (int i = 0; i < 8; ++i) t[i] = *(const GAS f32x4*)((const GAS char*)(src + (size_t)(8 * i) * ldw) + voff);
}
__device__ __forceinline__ void cvt8_finish(const f32x4 (&t)[8], unsigned char* dst, int Kb, LAS float* scr, int lane, float qs) {
    { const int kr = lane >> 3, c4 = (lane & 7) * 4;
#pragma unroll
      for (int i = 0; i < 8; ++i) { LAS float* d = scr + (8 * i + kr) * 33 + c4; d[0] = t[i].x; d[1] = t[i].y; d[2] = t[i].z; d[3] = t[i].w; } }
    LDS_WAIT(); asm volatile("" ::: "memory");
    const int n = lane >> 1, h = lane & 1; const LAS float* s = scr + (32 * h) * 33 + n;
    v4u o0, o1;
    o0.x = pk4f8(s[0 * 33] * qs, s[1 * 33] * qs, s[2 * 33] * qs, s[3 * 33] * qs);     o0.y = pk4f8(s[4 * 33] * qs, s[5 * 33] * qs, s[6 * 33] * qs, s[7 * 33] * qs);
    o0.z = pk4f8(s[8 * 33] * qs, s[9 * 33] * qs, s[10 * 33] * qs, s[11 * 33] * qs);   o0.w = pk4f8(s[12 * 33] * qs, s[13 * 33] * qs, s[14 * 33] * qs, s[15 * 33] * qs);
    o1.x = pk4f8(s[16 * 33] * qs, s[17 * 33] * qs, s[18 * 33] * qs, s[19 * 33] * qs); o1.y = pk4f8(s[20 * 33] * qs, s[21 * 33] * qs, s[22 * 33] * qs, s[23 * 33] * qs);
    o1.z = pk4f8(s[24 * 33] * qs, s[25 * 33] * qs, s[26 * 33] * qs, s[27 * 33] * qs); o1.w = pk4f8(s[28 * 33] * qs, s[29 * 33] * qs, s[30 * 33] * qs, s[31 * 33] * qs);
    GAS v4u* d = (GAS v4u*)(dst + (size_t)n * Kb + 32 * h); d[0] = o0; d[1] = o1;
    LDS_WAIT(); asm volatile("" ::: "memory");
}
__device__ __forceinline__ void cvt_matrix(Frame& F, const float* src, const float* src2, int ldw, bf16* dst, int K, int N, int kind, int nrep, size_t sstride, size_t dstride, float qs = 0.f  , const float* gain = nullptr  ) {
    LAS float* scr = (LAS float*)(F.lds + RING_OFF + F.wave * 16384);
    const int gw = F.vcu * NWAVES + F.wave, NGW = F.G * NWAVES;
    const int nb_n = N / 32, per = nb_n * (K / 64), total = per * nrep;
    auto locate = [&](int it, const float*& sp, size_t& doff, int& kbo) {
        const int rep = it / per, loc = it - rep * per, kb = loc / nb_n, nb = loc - kb * nb_n;
        const int n0 = 32 * nb, pn = n0 >> 8, rho = n0 & 255, bj = rho >> 7, wc = (rho & 127) >> 5;
        const float* s = src; int col;
        if (kind == 0) col = n0;
        else if (kind == 1) { const int L = 256 * pn + 64 * wc + 32 * bj; col = L < 3 * FOXD ? L : L + NH; }
        else if (kind == 2) col = 256 * pn + 64 * wc + 32 * bj;
        else if (kind == 3) { col = 128 * pn + (rho & 127); if (bj) s = src2; }
        else { col = pn < 6 ? 128 * pn + (rho & 127) + (bj ? CONVD : 0) : 2 * CONVD + 64 * wc + 32 * bj; }
        sp = s + (size_t)rep * sstride + (size_t)(64 * kb) * ldw + col; doff = (size_t)rep * dstride + (size_t)n0 * K + 64 * kb; kbo = kb; };
    auto finish = [&](const f32x4 (&t)[8], size_t doff, int kb) {
        if (qs != 0.f) cvt8_finish_g(t, (unsigned char*)dst + doff, K, scr, F.lane, qs, gain ? gain + 64 * kb : nullptr);
        else cvt_finish16(t, dst + doff, K, scr, F.lane, gain ? gain + 64 * kb : nullptr); };
    for (int it = gw; it < total; it += 2 * NGW) {
        const int it2 = it + NGW; const bool two = it2 < total;
        const float* sA; size_t dA; int kA; locate(it, sA, dA, kA);
        const float* sB = sA; size_t dB = dA; int kB = kA; if (two) locate(it2, sB, dB, kB);
        f32x4 tA[8], tB[8]; cvt8_load(tA, sA, ldw, F.lane); cvt8_load(tB, sB, ldw, F.lane);
        finish(tA, dA, kA); if (two) finish(tB, dB, kB);
    }
}
__device__ __forceinline__ void convert_moe(Frame& F, int j) {
    cvt_matrix(F, F.A->in[24] + (size_t)j * NE * DM * EFF, F.A->in[25] + (size_t)j * NE * DM * EFF, EFF, (bf16*)(F.ws + WS_WMGU + (size_t)j * WS_WM_LAYER), DM, 2 * EFF, 3, NE, (size_t)DM * EFF, (size_t)2 * EFF * DM, WSC_GU);
    cvt_matrix(F, F.A->in[26] + (size_t)j * NE * EFF * DM, nullptr, DM, (bf16*)(F.ws + WS_WMD + (size_t)j * WS_WM_LAYER), EFF, DM, 0, NE, (size_t)EFF * DM, (size_t)DM * EFF, WSC_D);
}
constexpr int MOE_GU_ITEMS = NE * (2 * EFF / 32) * (DM / 64), MOE_D_ITEMS = NE * (DM / 32) * (EFF / 64), MOE_BATCH = 4;
__device__ __forceinline__ void convert_moe_queue(Frame& F, int j, gu32* ctr, int maxr = 1 << 30  ) {
    LAS float* scr = (LAS float*)(F.lds + RING_OFF + F.wave * 16384);
    const float* wg = F.A->in[24] + (size_t)j * NE * DM * EFF; const float* wu = F.A->in[25] + (size_t)j * NE * DM * EFF; const float* wd = F.A->in[26] + (size_t)j * NE * EFF * DM;
    unsigned char* dgu = F.ws + WS_WMGU + (size_t)j * WS_WM_LAYER; unsigned char* dd = F.ws + WS_WMD + (size_t)j * WS_WM_LAYER;
    LAS unsigned* tk = (LAS unsigned*)(F.lds + RING_OFF + 12288);
    constexpr unsigned NBATCH = (MOE_GU_ITEMS + MOE_D_ITEMS) / MOE_BATCH; static_assert(NBATCH % NWAVES == 0, "ticket shape");
    if (F.tid == 0) tk[0] = ticket_take(ctr);
    __syncthreads();
    for (int r = 0; r < maxr; ++r) {
        const unsigned t8 = (unsigned)__builtin_amdgcn_readfirstlane((int)tk[r & 1]);
        if (t8 * NWAVES >= NBATCH) break;
        unsigned nxt_ = 0; if (F.tid == 0 && r + 1 < maxr) nxt_ = ticket_take(ctr);
        const unsigned bt = t8 * NWAVES + (unsigned)F.wave;
        f32x4 tb[MOE_BATCH][8]; unsigned char* dp[MOE_BATCH]; int kbt[MOE_BATCH]; float qsb[MOE_BATCH];
        static_assert(MOE_BATCH == 4 && MOE_GU_ITEMS % 4 == 0 && MOE_D_ITEMS % 4 == 0, "batch shape");
#pragma unroll
        for (int k = 0; k < MOE_BATCH; ++k) { int b = (int)bt;
            if (b < MOE_GU_ITEMS / 4) {
                constexpr int nb_n = 2 * EFF / 32, perb = (nb_n / 2) * (DM / 128);
                const int rep = b / perb, loc = b - rep * perb, kb2 = loc / (nb_n / 2), nb2 = loc - kb2 * (nb_n / 2), kb = 2 * kb2 + (k >> 1), nb = 2 * nb2 + (k & 1), n0 = 32 * nb, pn = n0 >> 8, rho = n0 & 255, bj = rho >> 7;
                cvt8_load(tb[k], (bj ? wu : wg) + (size_t)rep * DM * EFF + (size_t)(64 * kb) * EFF + 128 * pn + (rho & 127), EFF, F.lane);
                dp[k] = dgu + (size_t)rep * (2 * EFF * DM) + (size_t)n0 * DM + 64 * kb; kbt[k] = DM; qsb[k] = WSC_GU;
            } else { b -= MOE_GU_ITEMS / 4;
                constexpr int nb_n = DM / 32, perb = (nb_n / 2) * (EFF / 128);
                const int rep = b / perb, loc = b - rep * perb, kb2 = loc / (nb_n / 2), nb2 = loc - kb2 * (nb_n / 2), kb = 2 * kb2 + (k >> 1), nb = 2 * nb2 + (k & 1), n0 = 32 * nb;
                cvt8_load(tb[k], wd + (size_t)rep * EFF * DM + (size_t)(64 * kb) * DM + n0, DM, F.lane);
                dp[k] = dd + (size_t)rep * (DM * EFF) + (size_t)n0 * EFF + 64 * kb; kbt[k] = EFF; qsb[k] = WSC_D; }
        }
        if (F.tid == 0) tk[(r + 1) & 1] = nxt_;
#pragma unroll
        for (int k = 0; k < MOE_BATCH; ++k) cvt8_finish(tb[k], dp[k], kbt[k], scr, F.lane, qsb[k]);
        __syncthreads();
    }
}
__device__ __forceinline__ void phase_prologue(Frame& F) {
#pragma unroll 1
    for (int jq = 0; jq < 2; ++jq) { int j = jq; asm volatile("" : "+s"(j));
        if ((IN8L2 && j == 1) || (IN8L0 && j == 0)) cvt_matrix(F, F.A->in[8] + (size_t)j * DM * FOXIN, nullptr, FOXIN, (bf16*)(F.ws + WS_WINE + (size_t)j * 2560 * DM * 2), DM, 2560, 1, 1, 0, 0, WSC_GU);
        else cvt_matrix(F, F.A->in[8] + (size_t)j * DM * FOXIN, nullptr, FOXIN, (bf16*)(F.ws + WS_WINE) + (size_t)j * 2560 * DM, DM, 2560, 1, 1, 0, 0);
        cvt_matrix(F, F.A->in[12] + (size_t)j * DM * DM, nullptr, DM, (bf16*)(F.ws + WS_WOUTE) + (size_t)j * DM * DM, DM, DM, 0, 1, 0, 0);
        if ((IN8ODD >> j) & 1) cvt_matrix(F, F.A->in[13] + (size_t)j * DM * CONVIN, nullptr, CONVIN, (bf16*)(F.ws + WS_WINO + (size_t)j * CONVIN * DM * 2), DM, CONVIN, 4, 1, 0, 0, WSC_GU, F.A->in[2] + (size_t)(2 * j + 1) * DM);
        else cvt_matrix(F, F.A->in[13] + (size_t)j * DM * CONVIN, nullptr, CONVIN, (bf16*)(F.ws + WS_WINO) + (size_t)j * CONVIN * DM, DM, CONVIN, 4, 1, 0, 0, 0.f, (FUSENORM && !BRINGUP) ? F.A->in[2] + (size_t)(2 * j + 1) * DM : nullptr);
        cvt_matrix(F, F.A->in[19] + (size_t)j * DM * DM, nullptr, DM, (bf16*)(F.ws + WS_WOUTO) + (size_t)j * DM * DM, DM, DM, 0, 1, 0, 0);
        const bool d8_ = DENSE8 == 1 || (DENSE8 == 2 && j == 1), u8_ = d8_ || (UP8L0 && j == 0);
        if (u8_) cvt_matrix(F, F.A->in[20] + (size_t)j * DM * FF, F.A->in[21] + (size_t)j * DM * FF, FF, (bf16*)(F.ws + WS_WGU + (size_t)j * 2 * FF * DM * 2), DM, 2 * FF, 3, 1, 0, 0, WSC_GU, (FUSENORM && !BRINGUP) ? F.A->in[4] + (size_t)(2 * j) * DM : nullptr);
        else cvt_matrix(F, F.A->in[20] + (size_t)j * DM * FF, F.A->in[21] + (size_t)j * DM * FF, FF, (bf16*)(F.ws + WS_WGU) + (size_t)j * 2 * FF * DM, DM, 2 * FF, 3, 1, 0, 0, 0.f, (FUSENORM && !BRINGUP) ? F.A->in[4] + (size_t)(2 * j) * DM : nullptr);
        if (d8_) cvt_matrix(F, F.A->in[22] + (size_t)j * FF * DM, nullptr, DM, (bf16*)(F.ws + WS_WD + (size_t)j * DM * FF * 2), FF, DM, 0, 1, 0, 0, WSC_D);
        else cvt_matrix(F, F.A->in[22] + (size_t)j * FF * DM, nullptr, DM, (bf16*)(F.ws + WS_WD) + (size_t)j * DM * FF, FF, DM, 0, 1, 0, 0);
    }
    cvt_matrix(F, F.A->in[5], nullptr, 2 * MEMD, (bf16*)(F.ws + WS_WKV), DM, 2 * MEMD, 2, 4, (size_t)DM * 2 * MEMD, (size_t)2 * MEMD * DM);
#if !MOEQ
    convert_moe(F, 0); convert_moe(F, 1);
#endif
    if (F.vcu == 0) { float* gt = (float*)(F.ws + WS_GT);
        for (int idx = F.tid; idx < 4 * 3 * 64; idx += NWAVES * 64) { const int L = idx / 192, r = (idx / 64) % 3, c = idx & 63, jj = L >> 1;
            gt[idx] = r == 0 ? F.A->in[10][jj * HD + c] * C2 : (r == 1 ? F.A->in[11][jj * HD + c] : F.A->in[6][L * HD + c] * C2); }
        if (F.wave == 0) for (int jj = 0; jj < 2; ++jj) { float mq = fabsf(F.A->in[10][jj * HD + F.lane]), mk = fabsf(F.A->in[11][jj * HD + F.lane]);
#pragma unroll
            for (int o = 1; o < 64; o <<= 1) { mq = fmaxf(mq, lane_xor_f(mq, o, F.lane)); mk = fmaxf(mk, lane_xor_f(mk, o, F.lane)); }
            if (F.lane == 0) gt[1024 + jj] = 2.0f * (64.0f * C2 * mq * mk) + 40.0f; } }
    const int gw = F.vcu * NWAVES + F.wave, NGW = F.G * NWAVES;
    for (int r = gw; r < BATCH * ML; r += NGW) {
        const GAS f32x4* xr = (const GAS f32x4*)(F.A->in[1] + (size_t)r * DM) + F.lane;
        f32x4 v[4]; float ss = 0.f;
#pragma unroll
        for (int j = 0; j < 4; ++j) { v[j] = xr[64 * j]; ss += (v[j].x * v[j].x + v[j].y * v[j].y) + (v[j].z * v[j].z + v[j].w * v[j].w); }
        const float rs = __builtin_amdgcn_rsqf(wave_sum_l(ss, F.lane) * (1.0f / DM) + lconst(RMS_EPS));
        for (int i = 0; i < 4; ++i) {
            const f32x4* gp = (const f32x4*)(F.A->in[3] + (size_t)i * DM) + F.lane;
            GAS v2u* o8 = (GAS v2u*)((bf16*)(F.ws + WS_MEMN) + ((size_t)i * BATCH * ML + r) * DM) + F.lane;
#pragma unroll
            for (int j = 0; j < 4; ++j) { const f32x4 g = gp[64 * j]; v2u w; w.x = pk2(v[j].x * rs * g.x, v[j].y * rs * g.y); w.y = pk2(v[j].z * rs * g.z, v[j].w * rs * g.w); o8[64 * j] = w; }
        }
    }
}

__device__ __forceinline__ void phase_norm(Frame& F, const float* src32  , bf16* h16, const float* gain, int kind, bool combine, const float* wx  , const float* bf  , bool f8out = false) {
    LAS float* wl = (LAS float*)(F.lds + RING_OFF);
    LAS int* wcnt = (LAS int*)(F.lds + RING_OFF + 65536);
    __syncthreads();
    static_assert(DM == 2 * NWAVES * 64 && NH == 12 && NE == 8 && (FOXIN * 4) % 16 == 0 && (3 * FOXD * 4) % 16 == 0, "weight staging shape");
    if (kind == 1) { f32x4 r[2][3];
#pragma unroll
        for (int q = 0; q < 2; ++q) { const GAS f32x4* src = (const GAS f32x4*)(wx + (size_t)(F.tid + 512 * q) * FOXIN + 3 * FOXD);
#pragma unroll
            for (int c = 0; c < 3; ++c) r[q][c] = src[c]; }
#pragma unroll
        for (int q = 0; q < 2; ++q)
#pragma unroll
            for (int c = 0; c < 3; ++c)
#pragma unroll
                for (int e = 0; e < 4; ++e) wl[(4 * c + e) * DM + F.tid + 512 * q] = r[q][c][e]; }
    if (kind == 2) { f32x4 r[2][2];
#pragma unroll
        for (int q = 0; q < 2; ++q) { const GAS f32x4* src = (const GAS f32x4*)(wx + (size_t)(F.tid + 512 * q) * NE); r[q][0] = src[0]; r[q][1] = src[1]; }
#pragma unroll
        for (int q = 0; q < 2; ++q)
#pragma unroll
            for (int c = 0; c < 2; ++c)
#pragma unroll
                for (int e = 0; e < 4; ++e) wl[(4 * c + e) * DM + F.tid + 512 * q] = r[q][c][e]; }
    __syncthreads();
    f32x4 g[4];
#pragma unroll
    for (int j = 0; j < 4; ++j) g[j] = ((const f32x4*)gain)[64 * j + F.lane];
    bf16* UB = (bf16*)(F.ws + WS_UB);
    const bf16* Y = (const bf16*)(F.ws + WS_XS);
    const int* SLOT = (const int*)(F.ws + WS_SLOT);
    for (int chunk = F.vcu; chunk < T / 128; chunk += F.G) {
        int cnt[NE];
#pragma unroll
        for (int e = 0; e < NE; ++e) cnt[e] = 0;
        const int mb = chunk * 128 + F.wave * 16;
        f32x4 n32[4]; v2u n16[4], na[4], nb[4];
        auto issue = [&](int m, int s0, int s1) {
            if (src32) { const GAS f32x4* xr = (const GAS f32x4*)(src32 + (size_t)m * DM) + F.lane;
#pragma unroll
                for (int j = 0; j < 4; ++j) n32[j] = xr[64 * j]; }
            else { const GAS v2u* hr = (const GAS v2u*)(h16 + (size_t)m * DM) + F.lane;
#pragma unroll
                for (int j = 0; j < 4; ++j) n16[j] = hr[64 * j]; }
            if (combine) { const GAS v2u* y0 = (const GAS v2u*)(Y + (size_t)s0 * DM) + F.lane; const GAS v2u* y1 = (const GAS v2u*)(Y + (size_t)s1 * DM) + F.lane;
#pragma unroll
                for (int j = 0; j < 4; ++j) { na[j] = y0[64 * j]; nb[j] = y1[64 * j]; } } };
        const int l1 = F.lane & 1; int fv = 0;
        { int v0 = 0; if (combine) { v0 = ((const GAS int*)SLOT)[2 * mb + l1]; fv = ((const GAS int*)SLOT)[2 * mb + 2 + l1]; }
          issue(mb, __builtin_amdgcn_readlane(v0, 0), __builtin_amdgcn_readlane(v0, 1)); }
#pragma unroll 1
        for (int i = 0; i < 16; ++i) {
            const int m = mb + i;
            f32x4 v[4];
            if (src32) {
#pragma unroll
                for (int j = 0; j < 4; ++j) v[j] = n32[j]; }
            else {
#pragma unroll
                for (int j = 0; j < 4; ++j) v[j] = (f32x4){bflo(n16[j].x), bfhi(n16[j].x), bflo(n16[j].y), bfhi(n16[j].y)}; }
            v2u ca[4], cb_[4];
            if (combine) {
#pragma unroll
                for (int j = 0; j < 4; ++j) { ca[j] = na[j]; cb_[j] = nb[j]; } }
            if (i + 1 < 16) { const int vc = fv;
                if (combine && i + 2 < 16) fv = ((const GAS int*)SLOT)[2 * m + 4 + l1];
                issue(m + 1, __builtin_amdgcn_readlane(vc, 0), __builtin_amdgcn_readlane(vc, 1)); }
            if (combine) {
                GAS v2u* ho = (GAS v2u*)(h16 + (size_t)m * DM) + F.lane;
#pragma unroll
                for (int j = 0; j < 4; ++j) { const v2u a = ca[j], b = cb_[j];
                    v[j].x += bflo(a.x) + bflo(b.x); v[j].y += bfhi(a.x) + bfhi(b.x); v[j].z += bflo(a.y) + bflo(b.y); v[j].w += bfhi(a.y) + bfhi(b.y);
                    v2u w; w.x = pk2(v[j].x, v[j].y); w.y = pk2(v[j].z, v[j].w); ho[64 * j] = w;
                    v[j] = (f32x4){bflo(w.x), bfhi(w.x), bflo(w.y), bfhi(w.y)}; }
            }
            float ss = 0.f;
#pragma unroll
            for (int j = 0; j < 4; ++j) ss += (v[j].x * v[j].x + v[j].y * v[j].y) + (v[j].z * v[j].z + v[j].w * v[j].w);
            const float rs = __builtin_amdgcn_rsqf(wave_sum_l(ss, F.lane) * (1.0f / DM) + lconst(RMS_EPS));
            GAS v2u* o8 = (GAS v2u*)(UB + (size_t)m * DM) + F.lane; GAS unsigned* o4 = (GAS unsigned*)((unsigned char*)UB + (size_t)m * DM) + F.lane;
#pragma unroll
            for (int j = 0; j < 4; ++j) { v[j] = v[j] * rs * g[j];
                if (kind == 2 || f8out) o4[64 * j] = pk4f8(clampf8(v[j].x * ASC_Z), clampf8(v[j].y * ASC_Z), clampf8(v[j].z * ASC_Z), clampf8(v[j].w * ASC_Z));
                else { v2u w; w.x = pk2(v[j].x, v[j].y); w.y = pk2(v[j].z, v[j].w); o8[64 * j] = w; } }
            if (kind == 1) {
                float pv[16];
#pragma unroll
                for (int h = 0; h < NH; ++h) { float p = 0.f;
#pragma unroll
                    for (int j = 0; j < 4; ++j) { const f32x4 w = ((const LAS f32x4*)(wl + h * DM))[64 * j + F.lane]; p += (v[j].x * w.x + v[j].y * w.y) + (v[j].z * w.z + v[j].w * w.w); }
                    pv[h] = p; }
#pragma unroll
                for (int h = NH; h < 16; ++h) pv[h] = pv[h - NH];
                const float z = wave_reduce16(pv, F.lane); const int hh = F.lane >> 2;
                if ((F.lane & 3) == 0 && hh < NH) { const float x = z + bf[hh]; const float lf = fminf(x, 0.f) - 0.6931471805599453f * __builtin_amdgcn_logf(1.0f + __builtin_amdgcn_exp2f(-1.4426950408889634f * fabsf(x))); ((float*)(F.ws + WS_LOGF))[(size_t)m * NH + hh] = lf; }
            }
            if (kind == 2) {
                float lg[NE];
                { float pv[NE];
#pragma unroll
                  for (int e = 0; e < NE; ++e) { float p = 0.f;
#pragma unroll
                    for (int j = 0; j < 4; ++j) { const f32x4 w = ((const LAS f32x4*)(wl + e * DM))[64 * j + F.lane]; p += (v[j].x * w.x + v[j].y * w.y) + (v[j].z * w.z + v[j].w * w.w); }
                    pv[e] = p; }
                  const float z = wave_reduce8(pv, F.lane);
#pragma unroll
                  for (int e = 0; e < NE; ++e) lg[e] = __builtin_bit_cast(float, __builtin_amdgcn_readlane(__builtin_bit_cast(int, z), 8 * e)); }
                int e1 = 0; float l1 = lg[0];
#pragma unroll
                for (int e = 1; e < NE; ++e) if (lg[e] > l1) { l1 = lg[e]; e1 = e; }
                int e2 = -1; float l2 = -INFINITY;
#pragma unroll
                for (int e = 0; e < NE; ++e) if (e != e1 && lg[e] > l2) { l2 = lg[e]; e2 = e; }
                const float ex = __builtin_amdgcn_exp2f(1.4426950408889634f * (l2 - l1)), g1 = __builtin_amdgcn_rcpf(1.0f + ex), g2 = ex * g1;
                if (F.lane == 0) { int* te = (int*)(F.ws + WS_TOPE) + 2 * m; float* tg = (float*)(F.ws + WS_TOPG) + 2 * m; te[0] = e1; te[1] = e2; tg[0] = g1; tg[1] = g2; }
#pragma unroll
                for (int e = 0; e < NE; ++e) cnt[e] += (e == e1) + (e == e2);
            }
        }
        if (kind == 2) {
            __syncthreads();
            if (F.lane == 0) {
#pragma unroll
                for (int e = 0; e < NE; ++e) wcnt[F.wave * NE + e] = cnt[e];
            }
            __syncthreads();
            if (F.tid < NE) { int s = 0; for (int w = 0; w < NWAVES; ++w) s += wcnt[w * NE + F.tid]; ((int*)(F.ws + WS_CNT))[chunk * NE + F.tid] = s; }
        }
    }
}

__device__ __forceinline__ void phase_cumsum(Frame& F) {
    const float* LOGF = (const float*)(F.ws + WS_LOGF); float* CB = (float*)(F.ws + WS_CB);
    LAS double* wtot = (LAS double*)(F.lds + RING_OFF);
    for (int sq = F.vcu; sq < BATCH * NH; sq += F.G) {
        const int b = sq / NH, h = sq - b * NH; const int t0 = F.wave * 512;
        float x[8];
#pragma unroll
        for (int k = 0; k < 8; ++k) x[k] = LOGF[((size_t)b * SEQ + t0 + k * 64 + F.lane) * NH + h];
        double sc[8]; double carry = 0.0;
#pragma unroll
        for (int k = 0; k < 8; ++k) {
            double v = (double)x[k];
#pragma unroll
            for (int o = 1; o < 64; o <<= 1) { const double n = lane_up_d(v, o, F.lane); if (F.lane >= o) v += n; }
            v += carry; sc[k] = v; carry = lane_get_d(v, 63);
        }
        __syncthreads();
        if (F.lane == 0) wtot[F.wave] = carry;
        __syncthreads();
        double base = 0.0; for (int w = 0; w < F.wave; ++w) base += wtot[w];
#pragma unroll
        for (int k = 0; k < 8; ++k) CB[(size_t)sq * SEQ + t0 + k * 64 + F.lane] = (float)((sc[k] + base) * 1.4426950408889634);
    }
    __syncthreads();
}

__device__ __forceinline__ void glds16_s(unsigned voff32, const void* sbase, unsigned ldsdst) { unsigned keep_;
    asm volatile("s_mov_b32 %0, m0\n\ts_mov_b32 m0, %3\n\ts_nop 0\n\tglobal_load_lds_dwordx4 %1, %2\n\ts_mov_b32 m0, %0" : "=&s"(keep_) : "v"(voff32), "s"(sbase), "s"(ldsdst) : "memory"); }
__device__ __forceinline__ void gstore32_s(unsigned voff32, unsigned data, const void* sbase) { asm volatile("global_store_dword %0, %1, %2" :: "v"(voff32), "v"(data), "s"(sbase) : "memory"); }
typedef float f32x2p __attribute__((ext_vector_type(2)));
template <int R> __device__ __forceinline__ void conv_row(f32x2p (&o)[16], const f32x2p (&w)[CW], const unsigned (&xr)[46]) {
    const unsigned x = xr[R]; const f32x2p xv = {bflo(x), bfhi(x)};
#pragma unroll
    for (int j = 0; j < CW; ++j) { const int tt = R - j; if (tt >= 0 && tt < 16) o[tt] = __builtin_elementwise_fma(w[j], xv, o[tt]); }
    __builtin_amdgcn_sched_barrier(0);
}
template <int... Rs> __device__ __forceinline__ void conv_rows(std::integer_sequence<int, Rs...>, f32x2p (&o)[16], const f32x2p (&w)[CW], const LAS unsigned* p0, const LAS unsigned* p1, const LAS unsigned* p2) {
    unsigned xr[46];
    ((xr[Rs] = (((Rs + 2) >> 4) == 0 ? p0 : ((Rs + 2) >> 4) == 1 ? p1 : p2)[((Rs + 2) & 15) * 384]), ...);
    __builtin_amdgcn_sched_barrier(0);
    (conv_row<Rs>(o, w, xr), ...);
}
#ifndef CONV_LN_OLD
#define CONV_LN_OLD 0
#endif
__device__ __forceinline__ void phase_conv(Frame& F, const float* dw, const float* dwb, const float* lng, const float* lnb) {
    const bf16* GLU = (const bf16*)(F.ws + WS_GLU); bf16* MIX = (bf16*)(F.ws + WS_MIX);
    LAS unsigned* tile = (LAS unsigned*)(F.lds + RING_OFF);
    LAS float* red = (LAS float*)(F.lds + RING_OFF + 4 * 24576);
    const int tid = F.tid; const bool act = tid < 384; const int ct = act ? tid : tid - 128; const int c0 = 2 * ct;
    f32x2p w[CW]; float b0, b1, g0, g1, lb0, lb1; const unsigned co4 = (unsigned)c0 * 4u;
#pragma unroll
    for (int j = 0; j < CW; ++j) w[j] = *(const GAS f32x2p*)((const GAS char*)(dw + j * CONVD) + co4);
    { const f32x2p bb = *(const GAS f32x2p*)((const GAS char*)dwb + co4), gg = *(const GAS f32x2p*)((const GAS char*)lng + co4), ll = *(const GAS f32x2p*)((const GAS char*)lnb + co4); b0 = bb.x; b1 = bb.y; g0 = gg.x; g1 = gg.y; lb0 = ll.x; lb1 = ll.y; }
    const unsigned tile0 = (unsigned)(uintptr_t)tile;
    auto dma_block = [&](int b, int B) { const char* gb = (const char*)(GLU + ((size_t)b * SEQ + (size_t)B * 16) * CONVD); const unsigned dst = tile0 + (unsigned)(B & 3) * 24576u;
#pragma unroll
        for (int i = 0; i < 3; ++i) { const int c = F.wave + 8 * i; glds16_s((unsigned)(c * 1024 + F.lane * 16), gb, (unsigned)__builtin_amdgcn_readfirstlane((int)(dst + (unsigned)c * 1024u))); } };
    for (int run = F.vcu; run < T / 128; run += F.G) {
        const int b = run >> 5, B0 = (run & 31) * 8;
        __syncthreads();
        if (B0 == 0) {
            unsigned zz; asm volatile("v_mov_b32 %0, 0" : "=v"(zz));
#pragma unroll
            for (int i = 0; i < 6; ++i) { const int c = F.wave + 8 * i; *(LAS v4u*)((LAS unsigned char*)tile + 2 * 24576 + c * 1024 + F.lane * 16) = (v4u){zz, zz, zz, zz}; }
        } else { dma_block(b, B0 - 2); dma_block(b, B0 - 1); }
        dma_block(b, B0);
#pragma unroll 1
        for (int it = 0; it < 8; ++it) {
            const int B = B0 + it, t0 = B * 16;
            asm volatile("s_waitcnt vmcnt(0)" ::: "memory");
            __syncthreads();
            if (it < 7) dma_block(b, B + 1);
            f32x2p o[16];
#pragma unroll
            for (int tt = 0; tt < 16; ++tt) o[tt] = (f32x2p){b0, b1};
            conv_rows(std::make_integer_sequence<int, 46>{}, o, w, tile + ((B - 2) & 3) * 6144 + ct, tile + ((B - 1) & 3) * 6144 + ct, tile + (B & 3) * 6144 + ct);
            { float pv[32];
#pragma unroll
              for (int tt = 0; tt < 16; ++tt) { pv[2 * tt] = o[tt].x + o[tt].y; pv[2 * tt + 1] = o[tt].x * o[tt].x + o[tt].y * o[tt].y; }
              const float z = wave_reduce32(pv, F.lane);
              if ((F.lane & 1) == 0 && F.wave < 6) red[F.wave * 32 + (F.lane >> 1)] = z; }
            __syncthreads();
#if !CONV_LN_OLD
#ifndef CONV_VAR
#define CONV_VAR 0
#endif
            { const int tk = F.lane & 15; float s1, s2;
              { const f32x2p r2 = *(const LAS f32x2p*)(red + tk * 2); s1 = r2.x; s2 = r2.y; }
#pragma unroll
              for (int w6 = 1; w6 < 6; ++w6) { const f32x2p r2 = *(const LAS f32x2p*)(red + (w6 * 16 + tk) * 2); s1 += r2.x; s2 += r2.y; }
              const float mean = s1 * (1.0f / CONVD), var = fmaxf(s2 * (1.0f / CONVD) - mean * mean, 0.f), rstd = __builtin_amdgcn_rsqf(var + lconst(RMS_EPS));
              LAS f32x2p* st = (LAS f32x2p*)(red + 192) + F.wave * 16;
#if CONV_VAR == 3
              st[tk] = (f32x2p){rstd, -mean * rstd};
#else
              if (F.lane < 16) st[tk] = (f32x2p){rstd, -mean * rstd};
#endif
              asm volatile("s_waitcnt lgkmcnt(0)" ::: "memory");
#if CONV_VAR == 1
#pragma unroll 4
#elif CONV_VAR == 2
#pragma unroll 1
#else
#pragma unroll
#endif
              for (int tt = 0; tt < 16; ++tt) {
#if CONV_VAR == 4
                float a_ = ((const LAS float*)st)[2 * tt], b_ = ((const LAS float*)st)[2 * tt + 1]; asm volatile("" : "+v"(a_), "+v"(b_)); const f32x2p ab = {a_, b_};
#else
                const f32x2p ab = st[tt];
#endif
                const float y0 = (o[tt].x * ab.x + ab.y) * g0 + lb0, y1 = (o[tt].y * ab.x + ab.y) * g1 + lb1;
                const float z0 = y0 * __builtin_amdgcn_rcpf(1.0f + __builtin_amdgcn_exp2f(-1.4426950408889634f * y0)), z1 = y1 * __builtin_amdgcn_rcpf(1.0f + __builtin_amdgcn_exp2f(-1.4426950408889634f * y1));
                if (act) *(GAS unsigned*)((GAS char*)(MIX + ((size_t)b * SEQ + t0 + tt) * DM) + (co4 >> 1)) = pk2(z0, z1);
#if CONV_VAR == 5
                __builtin_amdgcn_sched_barrier(0);
#endif
              } }
#else
#pragma unroll
            for (int tt = 0; tt < 16; ++tt) { float s1 = 0.f, s2 = 0.f;
#pragma unroll
                for (int w6 = 0; w6 < 6; ++w6) { s1 += red[(w6 * 16 + tt) * 2]; s2 += red[(w6 * 16 + tt) * 2 + 1]; }
                const float mean = s1 * (1.0f / CONVD), var = fmaxf(s2 * (1.0f / CONVD) - mean * mean, 0.f), rstd = __builtin_amdgcn_rsqf(var + lconst(RMS_EPS));
                const float y0 = (o[tt].x - mean) * rstd * g0 + lb0, y1 = (o[tt].y - mean) * rstd * g1 + lb1;
                const float z0 = y0 * __builtin_amdgcn_rcpf(1.0f + __builtin_amdgcn_exp2f(-1.4426950408889634f * y0)), z1 = y1 * __builtin_amdgcn_rcpf(1.0f + __builtin_amdgcn_exp2f(-1.4426950408889634f * y1));
                if (act) *(GAS unsigned*)((GAS char*)(MIX + ((size_t)b * SEQ + t0 + tt) * DM) + (co4 >> 1)) = pk2(z0, z1); }
#endif
        }
    }
    __syncthreads();
}

__device__ __forceinline__ void phase_scatter(Frame& F) {
    LAS int* pre = (LAS int*)(F.lds + RING_OFF);
    LAS int* wtot = pre + 2048;
    LAS int* tot = wtot + 32;
    LAS int* wc2 = tot + 16;
    LAS int* rowl = wc2 + 32;
    const int* CNT = (const int*)(F.ws + WS_CNT); const int* TOPE = (const int*)(F.ws + WS_TOPE); const float* TOPG = (const float*)(F.ws + WS_TOPG);
    int* SLOT = (int*)(F.ws + WS_SLOT); float* ROWG = (float*)(F.ws + WS_ROWG); int* TAB = (int*)(F.ws + WS_TAB);
    const unsigned char* UB = (const unsigned char*)(F.ws + WS_UB); unsigned char* XS = (unsigned char*)(F.ws + WS_XS);
    const int tid = F.tid, lane = F.lane, wave = F.wave;
    int v[NE];
    if (tid < 256) {
#pragma unroll
        for (int e = 0; e < NE; ++e) v[e] = CNT[tid * NE + e];
        int inc[NE];
#pragma unroll
        for (int e = 0; e < NE; ++e) { int x = v[e];
#pragma unroll
            for (int o = 1; o < 64; o <<= 1) { const int n = lane_up_i(x, o, lane); if (lane >= o) x += n; }
            inc[e] = x; }
        if (lane == 63) {
#pragma unroll
            for (int e = 0; e < NE; ++e) wtot[wave * NE + e] = inc[e];
        }
#pragma unroll
        for (int e = 0; e < NE; ++e) v[e] = inc[e] - v[e];
    }
    __syncthreads();
    if (tid < 256) {
#pragma unroll
        for (int e = 0; e < NE; ++e) { int add = 0; for (int w = 0; w < wave; ++w) add += wtot[w * NE + e]; pre[tid * NE + e] = v[e] + add; }
    }
    if (tid < NE) { int s = 0; for (int w = 0; w < 4; ++w) s += wtot[w * NE + tid]; tot[tid] = s; }
    __syncthreads();
    if (tid == 0) { int ps; asm volatile("v_mov_b32 %0, 0" : "=v"(ps)); for (int e = 0; e < NE; ++e) { tot[8 + e] = ps; ps += (tot[e] + 255) & ~255; } }
    __syncthreads();
    for (int chunk = F.vcu; chunk < T / 128; chunk += F.G) {
        int e = 0, rank = 0; const int f = chunk * 256 + tid;
        if (tid < 256) {
            e = TOPE[f];
#pragma unroll
            for (int x = 0; x < NE; ++x) { const unsigned long long mask = __ballot(e == x); if (e == x) rank = __popcll(mask & ((1ull << lane) - 1ull)); if (lane == 0) wc2[wave * NE + x] = __popcll(mask); }
        }
        __syncthreads();
        if (tid < 256) {
            int base = tot[8 + e] + pre[chunk * NE + e]; for (int w = 0; w < wave; ++w) base += wc2[w * NE + e];
            const int row = base + rank; SLOT[f] = row; ROWG[row] = TOPG[f]; rowl[tid] = row;
        }
        __syncthreads();
#pragma unroll 1
        for (int i0 = 0; i0 < 32; i0 += 8) {
            v4u rw[4];
#pragma unroll
            for (int q = 0; q < 4; ++q) { const int tok = chunk * 128 + ((wave * 32 + i0) >> 1) + q; rw[q] = ((const GAS v4u*)(UB + (size_t)tok * DM) + lane)[0]; }
#pragma unroll
            for (int q = 0; q < 8; ++q) { const int row = rowl[wave * 32 + i0 + q]; ((GAS v4u*)(XS + (size_t)row * DM) + lane)[0] = rw[q >> 1]; } }
        __syncthreads();
    }
    for (int e = F.vcu; e < NE; e += F.G) { const int lo = tot[8 + e] + tot[e], hi = tot[8 + e] + ((tot[e] + 255) & ~255);
        unsigned zz; asm volatile("v_mov_b32 %0, 0" : "=v"(zz));
        for (int r = lo + wave; r < hi; r += NWAVES) { GAS v4u* d = (GAS v4u*)(XS + (size_t)r * DM) + lane; d[0] = (v4u){zz, zz, zz, zz}; if (lane == 0) ROWG[r] = 0.f; } }
    if (F.vcu == 0) {
        if (tid == 0) { int nrt = 0; for (int e = 0; e < NE; ++e) nrt += (tot[e] + 255) >> 8; TAB[0] = nrt; }
        if (tid < MAXRT) { int ex = NE - 1; for (int e = NE - 1; e >= 0; --e) if (tid * 256 < tot[8 + e] + ((tot[e] + 255) & ~255)) ex = e; TAB[16 + tid] = ex; }
    }
}

__device__ __forceinline__ void phase_final(Frame& F) {
    const bf16* Y = (const bf16*)(F.ws + WS_XS); const GAS int* SLOT = (const GAS int*)(F.ws + WS_SLOT); const bf16* H16 = (const bf16*)(F.ws + WS_H16);
    const int gw = F.vcu * NWAVES + F.wave, NGW = F.G * NWAVES;
    v2u nh[4], na[4], nb[4];
    auto issue = [&](int m, int s0, int s1) {
        const GAS v2u* hr = (const GAS v2u*)(H16 + (size_t)m * DM) + F.lane; const GAS v2u* y0 = (const GAS v2u*)(Y + (size_t)s0 * DM) + F.lane; const GAS v2u* y1 = (const GAS v2u*)(Y + (size_t)s1 * DM) + F.lane;
#pragma unroll
        for (int j = 0; j < 4; ++j) { nh[j] = hr[64 * j]; na[j] = y0[64 * j]; nb[j] = y1[64 * j]; } };
    const int l1 = F.lane & 1; int fv = 0;
#define SLOT2(v) __builtin_amdgcn_readlane((v), 0), __builtin_amdgcn_readlane((v), 1)
    if (gw < T) { const int v0 = SLOT[2 * gw + l1]; if (gw + NGW < T) fv = SLOT[2 * (gw + NGW) + l1]; issue(gw, SLOT2(v0)); }
#pragma unroll 1
    for (int m = gw; m < T; m += NGW) {
        GAS f32x4* xr = (GAS f32x4*)(F.out + (size_t)m * DM) + F.lane;
        v2u ch[4], ca[4], cb_[4];
#pragma unroll
        for (int j = 0; j < 4; ++j) { ch[j] = nh[j]; ca[j] = na[j]; cb_[j] = nb[j]; }
        if (m + NGW < T) { const int vc = fv; if (m + 2 * NGW < T) fv = SLOT[2 * (m + 2 * NGW) + l1]; issue(m + NGW, SLOT2(vc)); }
#pragma unroll
        for (int j = 0; j < 4; ++j) { const v2u h = ch[j], a = ca[j], b = cb_[j]; f32x4 v;
            v.x = bflo(h.x) + (bflo(a.x) + bflo(b.x)); v.y = bfhi(h.x) + (bfhi(a.x) + bfhi(b.x)); v.z = bflo(h.y) + (bflo(a.y) + bflo(b.y)); v.w = bfhi(h.y) + (bfhi(a.y) + bfhi(b.y)); xr[64 * j] = v; }
    }
}
#ifndef DIS_PRO
#define DIS_PRO 0
#endif
#ifndef DIS_NORM
#define DIS_NORM 0
#endif
#ifndef DIS_PMK
#define DIS_PMK 0
#endif
#ifndef DIS_CUM
#define DIS_CUM 0
#endif
#ifndef DIS_INE
#define DIS_INE 0
#endif
#ifndef DIS_INO
#define DIS_INO 0
#endif
#ifndef DIS_FOX
#define DIS_FOX 0
#endif
#ifndef DIS_CONV
#define DIS_CONV 0
#endif
#ifndef DIS_MEM
#define DIS_MEM 0
#endif
#ifndef DIS_OUT
#define DIS_OUT 0
#endif
#ifndef DIS_SCAT
#define DIS_SCAT 0
#endif
#ifndef DIS_UP
#define DIS_UP 0
#endif
#ifndef DIS_DOWN
#define DIS_DOWN 0
#endif
#ifndef DIS_FIN
#define DIS_FIN 0
#endif
#ifndef DIS_UPD
#define DIS_UPD 0
#endif
#ifndef DIS_UPM
#define DIS_UPM 0
#endif
#ifndef REP_GIN
#define REP_GIN 1
#endif
#ifndef REP_GOUT
#define REP_GOUT 1
#endif
#ifndef REP_GDENSE
#define REP_GDENSE 1
#endif
#ifndef REP_GMOE
#define REP_GMOE 1
#endif
#ifndef REP_N0C
#define REP_N0C 1
#endif
#ifndef REP_CONV
#define REP_CONV 1
#endif
#ifndef REP_PRO
#define REP_PRO 1
#endif
#ifndef REP_ATT
#define REP_ATT 1
#endif
#ifndef REP_THIN
#define REP_THIN 1
#endif
#ifndef REP_MEM
#define REP_MEM 1
#endif
struct AttnUnitId { int bh, qb; };
struct FoxOrder { int vcu, G;
    __device__ __forceinline__ bool next(int i, AttnUnitId& u) const { const int p = vcu + G * (i >> 1); if (p >= BATCH * NH * 8) return false; const int s = p & 7; u.bh = p >> 3; u.qb = (i & 1) ? 15 - s : s; return true; } };
struct MemOrder { int vcu, G;
    __device__ __forceinline__ bool next(int i, AttnUnitId& u) const { const int p = vcu + G * i; if (p >= BATCH * MEMH * 16) return false; u.bh = p >> 4; u.qb = p & 15; return true; } };

__global__ void __launch_bounds__(NWAVES * 64, 2) mega_fwd(Args args) {
    extern __shared__ __attribute__((aligned(16))) unsigned char lds[];
    Frame F;
    F.lds = (LAS unsigned char*)lds;
    F.MISC = (volatile LAS unsigned*)(F.lds + MISC_OFF);
    const int wave0 = __builtin_amdgcn_readfirstlane((int)threadIdx.x >> 6);
    F.tid = threadIdx.x; F.lane = F.tid & 63; F.wave = wave0;
    F.G = gridDim.x; { const int bx = blockIdx.x; F.vcu = (F.G % 8 == 0) ? (bx % 8) * (F.G / 8) + bx / 8 : bx; }
    const int vcu0 = F.vcu;
    F.ws = args.ws; F.out = args.out; F.ctl = (gu32*)(args.ws + WS_CTL);
    F.A = (const __attribute__((address_space(4))) Args*)__builtin_amdgcn_kernarg_segment_ptr();
    { unsigned z0_; asm volatile("v_mov_b32 %0, 0" : "=v"(z0_)); for (int u = F.tid; u < (LDS_BYTES - LDSCTL_OFF) / 4; u += NWAVES * 64) ((LAS unsigned*)(F.lds + LDSCTL_OFF))[u] = z0_; }
    __syncthreads();
#if BRINGUP
    const int lo = args.ph_lo, hi = args.ph_hi; const unsigned mask = args.mask;
#else
    constexpr int lo = 0, hi = NPH; constexpr unsigned mask = C_ALL;
#endif
    XcdBarrier bar; bar.bar = (unsigned*)(F.ctl + CW_BAR); bar.x = 0; bar.st = nullptr;
    if (hi - lo > 1) bar = xcd_barrier_post((unsigned*)(F.ctl + CW_BAR), F.MISC + 8, F.tid);
#define IN(k) (lo <= (k) && (k) < hi)
#define SLOT_VARS int Lq = L; asm volatile("" : "+s"(Lq)); const int pb = 1 + 9 * Lq, j = Lq >> 1; const bool odd = (Lq & 1) != 0; const float* hsrc = (Lq == 0) ? F.A->in[0] : nullptr; bf16* H16 = (bf16*)(F.ws + WS_H16); (void)j; (void)hsrc; (void)odd; (void)H16
#ifndef REP_BAR
#define REP_BAR 1
#endif
#define SEAM(k) do { if ((k) + 1 < hi) for (int rb_ = 0; rb_ < REP_BAR; ++rb_) { XcdBarrier bz_ = bar; { unsigned pl_ = (unsigned)(unsigned long long)bz_.bar, ph_ = (unsigned)((unsigned long long)bz_.bar >> 32); asm volatile("" : "+v"(pl_), "+v"(ph_)); bz_.bar = (unsigned*)(((unsigned long long)(unsigned)__builtin_amdgcn_readfirstlane((int)ph_) << 32) | (unsigned)__builtin_amdgcn_readfirstlane((int)pl_)); } int tb_; asm volatile("v_mbcnt_lo_u32_b32 %0, -1, 0\n\tv_mbcnt_hi_u32_b32 %0, -1, %0" : "=v"(tb_)); xcd_barrier(bz_, wave0 * 64 + tb_); } } while (0)
    unsigned char* ws = args.ws; bf16 *UB, *MIX, *MQ, *QKV;
#define RS_FINISH() do { const int gt_ = F.vcu * (NWAVES * 64) + F.tid; if (gt_ < T) ((float*)(ws + WS_RS))[gt_] = pg8::row_rs((const float*)(ws + WS_SSQ), gt_); \
        XcdBarrier bz_ = bar; { unsigned long long pz_ = (unsigned long long)bz_.bar; asm volatile("" : "+s"(pz_)); bz_.bar = (unsigned*)pz_; } xcd_barrier(bz_, F.tid); } while (0)
#define PHASE_BEGIN() do { int tz_; asm volatile("v_mbcnt_lo_u32_b32 %0, -1, 0\n\tv_mbcnt_hi_u32_b32 %0, -1, %0" : "=v"(tz_)); { int w_ = wave0, c_ = vcu0, g_ = (int)gridDim.x; asm volatile("" : "+s"(w_), "+s"(c_), "+s"(g_)); F.lane = tz_; F.wave = w_; F.tid = w_ * 64 + tz_; F.vcu = c_; F.G = g_; }   \
        { unsigned wl_ = (unsigned)(unsigned long long)args.ws, wh_ = (unsigned)((unsigned long long)args.ws >> 32); asm volatile("" : "+v"(wl_), "+v"(wh_)); \
          ws = (unsigned char*)(((unsigned long long)(unsigned)__builtin_amdgcn_readfirstlane((int)wh_) << 32) | (unsigned)__builtin_amdgcn_readfirstlane((int)wl_)); F.ws = ws; } \
        { unsigned la_ = (unsigned)(uintptr_t)(LAS unsigned char*)lds; asm volatile("" : "+s"(la_)); LAS unsigned char* lp_ = (LAS unsigned char*)(uintptr_t)la_; F.lds = lp_; F.MISC = (volatile LAS unsigned*)(lp_ + MISC_OFF); } \
        { unsigned long long ka_ = (unsigned long long)__builtin_amdgcn_kernarg_segment_ptr(); asm volatile("" : "+s"(ka_)); F.A = (const __attribute__((address_space(4))) Args*)ka_; } \
        UB = (bf16*)(ws + WS_UB); MIX = (bf16*)(ws + WS_MIX); MQ = (bf16*)(ws + WS_MQ); QKV = (bf16*)(ws + WS_QKV); } while (0)

    if (IN(0)) { PHASE_BEGIN(); if ((mask & C_THIN) && !DIS_PRO) for (int rep_ = 0; rep_ < REP_PRO; ++rep_) { phase_prologue(F); __syncthreads(); } }

    for (int L = 0; L < 4; ++L) {
        { SLOT_VARS;
        if (IN(pb + 0) && !(FUSENORM && !BRINGUP && odd)) {
            PHASE_BEGIN();
            if (mask & C_THIN) {
                if (!DIS_NORM) for (int rn_ = 0; rn_ < ((Lq == 2) ? 1 : REP_N0C); ++rn_) phase_norm(F, hsrc, H16, F.A->in[2] + (size_t)Lq * DM, odd ? 0 : 1, (Lq == 2), odd ? nullptr : F.A->in[8] + (size_t)j * DM * FOXIN, odd ? nullptr : F.A->in[9] + (size_t)j * NH, (IN8L2 && Lq == 2) || (IN8L0 && Lq == 0));
            }
            SEAM(pb + 0);
        } }
        { SLOT_VARS;
        if (IN(pb + 1)) {
            PHASE_BEGIN();
            if (!odd) {
                if (Lq == 0 && (mask & C_PMK) && !DIS_PMK) {
                    pg8::Gemm g{ws + WS_MEMN, ws + WS_WKV, DM * 2, (size_t)2 * MEMD * DM * 2};
                    pg8::Order S; S.init(4 * BATCH * ML / 256, 2, F.G, (int)blockIdx.x, nullptr, BATCH * ML / 256); const pg8::OrderT ST = pg8::order_table(S, F.lds + ORDTAB_OFF, F.tid);
                    pg8::EpiMemKV E{(pg8::bf16_t*)(ws + WS_MKV), F.A->in[7]};
                    pg8::gemm_phase<pg8::EpiMemKV, pg8::OrderT, true, true>(F.lds + RING_OFF, g, ST, E, F.wave);
                }
                if ((mask & C_THIN) && !DIS_CUM) phase_cumsum(F);
                if ((mask & C_INPROJ) && !DIS_INE && ((IN8L2 && Lq == 2) || (IN8L0 && Lq == 0))) {
                    pg8::Gemm g{UB, ws + WS_WINE + (size_t)j * 2560 * DM * 2, DM, 0};
                    pg8::Order S; S.init(T / 256, 10, F.G, (int)blockIdx.x, nullptr, 0); const pg8::OrderT ST = pg8::order_table(S, F.lds + ORDTAB_OFF, F.tid);
                    pg8::EpiInEven E{QKV, MQ, (const float*)(ws + WS_GT) + Lq * 192, 1.0f / (ASC_Z * WSC_GU)};
                    for (int rg_ = 0; rg_ < REP_GIN; ++rg_) pg8::gemm_phase<pg8::EpiInEven, pg8::OrderT, true, true, true>(F.lds + RING_OFF, g, ST, E, F.wave);
                } else if ((mask & C_INPROJ) && !DIS_INE) {
                    pg8::Gemm g{UB, (const pg8::bf16_t*)(ws + WS_WINE) + (size_t)j * 2560 * DM, DM * 2, 0};
                    pg8::Order S; S.init(T / 256, 10, F.G, (int)blockIdx.x, nullptr, 0); const pg8::OrderT ST = pg8::order_table(S, F.lds + ORDTAB_OFF, F.tid);
                    pg8::EpiInEven E{QKV, MQ, (const float*)(ws + WS_GT) + Lq * 192};
                    for (int rg_ = 0; rg_ < REP_GIN; ++rg_) pg8::gemm_phase<pg8::EpiInEven, pg8::OrderT, true, true>(F.lds + RING_OFF, g, ST, E, F.wave);
#if MOEQ
                    if (Lq == 0 && (mask & C_THIN)) { pg8::Order Sp; Sp.init(4 * BATCH * ML / 256, 2, F.G, (int)blockIdx.x, nullptr, BATCH * ML / 256); pg8::Unit up_; if (!Sp.next(0, up_)) { __syncthreads(); convert_moe_queue(F, 0, (gu32*)(ws + WS_CTL) + CW_QUEUE, 2); } }
#endif
                }
            } else if ((mask & C_INPROJ) && !DIS_INO && ((IN8ODD >> j) & 1)) {
                pg8::Gemm g{UB, ws + WS_WINO + (size_t)j * CONVIN * DM * 2, DM, 0};
                pg8::Order S; S.init(T / 256, 7, F.G, (int)blockIdx.x, nullptr, 0); const pg8::OrderT ST = pg8::order_table(S, F.lds + ORDTAB_OFF, F.tid);
                pg8::EpiInOdd E{(pg8::bf16_t*)(ws + WS_GLU), MQ, F.A->in[14] + (size_t)j * 2 * CONVD, (const float*)(ws + WS_GT) + Lq * 192 + 128, (const float*)(ws + WS_SSQ), 1.0f / (ASC_Z * WSC_GU)};
                for (int rg_ = 0; rg_ < REP_GIN; ++rg_) pg8::gemm_phase<pg8::EpiInOdd, pg8::OrderT, true, true, true>(F.lds + RING_OFF, g, ST, E, F.wave);
            } else if ((mask & C_INPROJ) && !DIS_INO) {
                pg8::Gemm g{(FUSENORM && !BRINGUP) ? (const void*)(ws + WS_H16) : (const void*)UB, (const pg8::bf16_t*)(ws + WS_WINO) + (size_t)j * CONVIN * DM, DM * 2, 0};
                pg8::Order S; S.init(T / 256, 7, F.G, (int)blockIdx.x, nullptr, 0); const pg8::OrderT ST = pg8::order_table(S, F.lds + ORDTAB_OFF, F.tid);
                pg8::EpiInOdd E{(pg8::bf16_t*)(ws + WS_GLU), MQ, F.A->in[14] + (size_t)j * 2 * CONVD, (const float*)(ws + WS_GT) + Lq * 192 + 128, (FUSENORM && !BRINGUP) ? (const float*)(ws + WS_SSQ) : nullptr};
                for (int rg_ = 0; rg_ < REP_GIN; ++rg_) pg8::gemm_phase<pg8::EpiInOdd, pg8::OrderT, true, true>(F.lds + RING_OFF, g, ST, E, F.wave);
            }
            SEAM(pb + 1);
        } }
        { SLOT_VARS;
        if (IN(pb + 2)) {
            PHASE_BEGIN();
            if (!odd) {
                if ((mask & C_FOX) && !DIS_FOX) for (int rep_ = 0; rep_ < REP_ATT; ++rep_) {
                    const FoxOrder S{F.vcu, F.G}; AttnUnitId u;
                    int tfx_; asm volatile("v_mbcnt_lo_u32_b32 %0, -1, 0\n\tv_mbcnt_hi_u32_b32 %0, -1, %0" : "=v"(tfx_)); const int tidf = F.wave * 64 + tfx_;
                    const float xskip = ((const float*)(ws + WS_GT))[1024 + j];
                    float cqn = 0.f, ckn = 0.f; AttnUnitId un; bool hn = S.next(0, un);
                    auto bias_req = [&](const AttnUnitId& q) { const float* cbq = (const float*)(ws + WS_CB) + (size_t)q.bh * SEQ; const int NT = 4 * (q.qb + 1); const int jt = tfx_; cqn = ((const GAS float*)cbq)[q.qb * 256]; ckn = ((const GAS float*)cbq)[(jt < NT ? jt : NT - 1) * 64 + 63]; };
                    if (hn) bias_req(un);
                    for (int i = 0; hn; ++i) {
                        u = un; const float cq = cqn, ck = ckn;
                        hn = S.next(i + 1, un); if (hn) bias_req(un);
                        const int b = u.bh / NH, h = u.bh - b * NH; const size_t r0 = (size_t)b * SEQ;
                        const float* cbq = (const float*)(ws + WS_CB) + (size_t)u.bh * SEQ; const int NT = 4 * (u.qb + 1);
                        int j0; { const int jt = tfx_;
                            const unsigned long long live = __builtin_amdgcn_ballot_w64(jt < NT && (cq - ck >= -xskip));
                            j0 = live ? (int)__builtin_ctzll(live) : NT - 4; j0 = __builtin_amdgcn_readfirstlane(j0); if (j0 > NT - 4) j0 = NT - 4; j0 &= ~1; }
                        attn_body::attn_unit<24, true, true, 3 * FOXD, 3 * FOXD, DM, true>((const attn_body::bf16*)QKV + (r0 + (size_t)u.qb * 256) * (3 * FOXD) + h * HD,
                            (const attn_body::bf16*)QKV + (r0 + (size_t)j0 * 64) * (3 * FOXD) + FOXD + h * HD, (const attn_body::bf16*)QKV + (r0 + (size_t)j0 * 64) * (3 * FOXD) + 2 * FOXD + h * HD,
                            (attn_body::bf16*)MIX + (r0 + (size_t)u.qb * 256) * DM + h * HD, cbq + j0 * 64, NT - j0, (char*)lds + RING_OFF, tidf, fminf((xskip - 40.0f) * 0.505f + 0.25f, 60.0f));
                    }
                }
            } else if ((mask & C_THIN) && !DIS_CONV) for (int rn_ = 0; rn_ < REP_CONV; ++rn_) {
                phase_conv(F, F.A->in[15] + (size_t)j * CW * CONVD, F.A->in[16] + (size_t)j * CONVD, F.A->in[17] + (size_t)j * CONVD, F.A->in[18] + (size_t)j * CONVD);
            }
            if ((mask & C_MEMATT) && !DIS_MEM) for (int rep_ = 0; rep_ < REP_MEM; ++rep_) {
                int tmx_; asm volatile("v_mbcnt_lo_u32_b32 %0, -1, 0\n\tv_mbcnt_hi_u32_b32 %0, -1, %0" : "=v"(tmx_)); const int tidm = F.wave * 64 + tmx_;
                const MemOrder S{F.vcu, F.G}; AttnUnitId u; const attn_body::bf16* MKVL = (const attn_body::bf16*)(ws + WS_MKV) + (size_t)Lq * BATCH * ML * 2 * MEMD;
                for (int i = 0; S.next(i, u); ++i) {
                    const int b = u.bh / MEMH, h = u.bh - b * MEMH; const size_t r0 = (size_t)b * SEQ + (size_t)u.qb * 256;
                    attn_body::attn_unit<8, false, false, MEMD, 2 * MEMD, DM>((const attn_body::bf16*)MQ + r0 * MEMD + h * HD, MKVL + (size_t)b * ML * (2 * MEMD) + h * HD, MKVL + (size_t)b * ML * (2 * MEMD) + MEMD + h * HD,
                        (attn_body::bf16*)MIX + r0 * DM + FOXD + h * HD, nullptr, ML / 64, (char*)lds + RING_OFF, tidm);
                }
            }
#if MOEQ
#ifndef REP_MOEQ
#define REP_MOEQ 1
#endif
            if (!odd && (mask & C_THIN)) { for (int rq_ = 0; rq_ < REP_MOEQ; ++rq_) { __syncthreads(); convert_moe_queue(F, j, (gu32*)(ws + WS_CTL) + CW_QUEUE + 64 * j + 256 * rq_); } }
#endif
            SEAM(pb + 2);
        } }
        { SLOT_VARS;
        if (IN(pb + 3)) {
            PHASE_BEGIN();
            if ((mask & C_OUTPROJ) && !DIS_OUT) {
                pg8::Gemm g{MIX, (const pg8::bf16_t*)(ws + (odd ? WS_WOUTO : WS_WOUTE)) + (size_t)j * DM * DM, DM * 2, 0};
                pg8::Order S; S.init(T / 256, 4, F.G, (int)blockIdx.x, nullptr, 0); const pg8::OrderT ST = pg8::order_table(S, F.lds + ORDTAB_OFF, F.tid);
                pg8::EpiResid E{hsrc, (pg8::bf16_t*)(ws + WS_H16), 1.0f, (FUSENORM && !BRINGUP && !odd) ? (float*)(ws + WS_SSQ) : nullptr, (FUSENORM && !BRINGUP && !odd && (DENSE8 == 1 || (DENSE8 == 2 && Lq == 2) || (UP8L0 && Lq == 0))) ? (unsigned char*)UB : nullptr};
                for (int rg_ = 0; rg_ < REP_GOUT; ++rg_) { if (rg_) { E.isc = 0.f; E.base32 = nullptr; } pg8::gemm_phase<pg8::EpiResid, pg8::OrderT, true, true>(F.lds + RING_OFF, g, ST, E, F.wave); }
            }
            SEAM(pb + 3);
        } }
        { SLOT_VARS;
        if (IN(pb + 4) && !(FUSENORM && !BRINGUP && !odd)) {
            PHASE_BEGIN();
            if ((mask & C_THIN) && !DIS_NORM) for (int rep_ = 0; rep_ < REP_THIN; ++rep_) phase_norm(F, nullptr, H16, F.A->in[4] + (size_t)Lq * DM, odd ? 2 : 0, false, odd ? F.A->in[23] + (size_t)j * DM * NE : nullptr, nullptr, DENSE8 == 1 || (DENSE8 == 2 && Lq == 2));
            SEAM(pb + 4);
        } }
        { SLOT_VARS;
        if (odd && IN(pb + 5)) {
            PHASE_BEGIN();
            if ((mask & C_THIN) && !DIS_SCAT) for (int rep_ = 0; rep_ < REP_THIN; ++rep_) { phase_scatter(F); __syncthreads(); }
            SEAM(pb + 5);
        } }
        { SLOT_VARS;
        if (IN(pb + 6)) {
            PHASE_BEGIN();
            if ((mask & C_FFNUP) && !DIS_UP) {
                const bool d8 = DENSE8 == 1 || (DENSE8 == 2 && Lq == 2), u8 = d8 || (UP8L0 && Lq == 0);
                if (!odd && !u8 && !DIS_UPD) {
                    pg8::Gemm g{(FUSENORM && !BRINGUP) ? (const void*)(ws + WS_H16) : (const void*)UB, (const pg8::bf16_t*)(ws + WS_WGU) + (size_t)j * 2 * FF * DM, DM * 2, 0};
                    pg8::Order S; S.init(T / 256, 2 * FF / 256, F.G, (int)blockIdx.x, nullptr, 0); const pg8::OrderT ST = pg8::order_table(S, F.lds + ORDTAB_OFF, F.tid);
                    pg8::EpiSwiGLU E{(pg8::bf16_t*)(ws + WS_HIDD), FF, (FUSENORM && !BRINGUP) ? (const float*)(ws + WS_SSQ) : nullptr};
                    for (int rg_ = 0; rg_ < REP_GDENSE; ++rg_) pg8::gemm_phase<pg8::EpiSwiGLU, pg8::OrderT, true, true, false>(F.lds + RING_OFF, g, ST, E, F.wave);
                } else if (!odd && u8 && !d8) {
                    pg8::Gemm g{UB, ws + WS_WGU + (size_t)j * 2 * FF * DM * 2, DM, 0};
                    pg8::Order S; S.init(T / 256, 2 * FF / 256, F.G, (int)blockIdx.x, nullptr, 0); const pg8::OrderT ST = pg8::order_table(S, F.lds + ORDTAB_OFF, F.tid);
                    pg8::EpiSwiGLU8B E{ws + WS_HIDD, FF, 1.0f / (ASC_Z * WSC_GU), 1.0f, (FUSENORM && !BRINGUP) ? (const float*)(ws + WS_SSQ) : nullptr};
                    for (int rg_ = 0; rg_ < REP_GDENSE; ++rg_) pg8::gemm_phase<pg8::EpiSwiGLU8B, pg8::OrderT, true, true, true>(F.lds + RING_OFF, g, ST, E, F.wave);
                } else if (!odd && d8) {
                    pg8::Gemm g{UB, ws + WS_WGU + (size_t)j * 2 * FF * DM * 2, DM, 0};
                    pg8::Order S; S.init(T / 256, 2 * FF / 256, F.G, (int)blockIdx.x, nullptr, 0); const pg8::OrderT ST = pg8::order_table(S, F.lds + ORDTAB_OFF, F.tid);
                    pg8::EpiSwiGLU8 E{ws + WS_HIDD, FF, 1.0f / (ASC_Z * WSC_GU), ASC_H, (FUSENORM && !BRINGUP) ? (const float*)(ws + WS_SSQ) : nullptr};
                    for (int rg_ = 0; rg_ < REP_GDENSE; ++rg_) pg8::gemm_phase<pg8::EpiSwiGLU8, pg8::OrderT, true, true, true>(F.lds + RING_OFF, g, ST, E, F.wave);
                } else if (odd && !DIS_UPM) {
                    const int* TAB = (const int*)(ws + WS_TAB);
                    pg8::Gemm g{ws + WS_XS, ws + WS_WMGU + (size_t)j * WS_WM_LAYER, DM, (size_t)2 * EFF * DM};
                    pg8::Order S; S.init(__builtin_amdgcn_readfirstlane(TAB[0]), 2 * EFF / 256, F.G, (int)blockIdx.x, TAB + 16, 0); const pg8::OrderT ST = pg8::order_table(S, F.lds + ORDTAB_OFF, F.tid);
                    pg8::EpiSwiGLU8 E{ws + WS_HIDM, EFF, 1.0f / (ASC_Z * WSC_GU), ASC_H, nullptr};
                    for (int rg_ = 0; rg_ < REP_GMOE; ++rg_) pg8::gemm_phase<pg8::EpiSwiGLU8, pg8::OrderT, true, true, true>(F.lds + RING_OFF, g, ST, E, F.wave);
#if MOEQ
                    if (Lq == 1 && (mask & C_THIN)) { const int nu_ = __builtin_amdgcn_readfirstlane(TAB[0]) * (2 * EFF / 256); pg8::Unit ux_; if (!S.next(nu_ / F.G, ux_)) { __syncthreads(); convert_moe_queue(F, 1, (gu32*)(ws + WS_CTL) + CW_QUEUE + 64, 1); } }
#endif
                }
            }
            SEAM(pb + 6);
        } }
        { SLOT_VARS;
        if (IN(pb + 7)) {
            PHASE_BEGIN();
            if ((mask & C_FFNDOWN) && !DIS_DOWN) {
                if (!odd) {
                    const bool d8 = DENSE8 == 1 || (DENSE8 == 2 && Lq == 2);
                    if (d8) {
                    pg8::Gemm g{ws + WS_HIDD, ws + WS_WD + (size_t)j * DM * FF * 2, FF, 0};
                    pg8::Order S; S.init(T / 256, 4, F.G, (int)blockIdx.x, nullptr, 0); const pg8::OrderT ST = pg8::order_table(S, F.lds + ORDTAB_OFF, F.tid);
                    pg8::EpiResid E{nullptr, (pg8::bf16_t*)(ws + WS_H16), 1.0f / (ASC_H * WSC_D), (FUSENORM && !BRINGUP) ? (float*)(ws + WS_SSQ) : nullptr, ((IN8ODD >> j) & 1) ? (unsigned char*)UB : nullptr};
                    for (int rg_ = 0; rg_ < REP_GDENSE; ++rg_) { if (rg_) { E.isc = 0.f; E.base32 = nullptr; } pg8::gemm_phase<pg8::EpiResid, pg8::OrderT, true, true, true>(F.lds + RING_OFF, g, ST, E, F.wave); }
                    } else {
                    pg8::Gemm g{ws + WS_HIDD, (const pg8::bf16_t*)(ws + WS_WD) + (size_t)j * DM * FF, FF * 2, 0};
                    pg8::Order S; S.init(T / 256, 4, F.G, (int)blockIdx.x, nullptr, 0); const pg8::OrderT ST = pg8::order_table(S, F.lds + ORDTAB_OFF, F.tid);
                    pg8::EpiResid E{nullptr, (pg8::bf16_t*)(ws + WS_H16), 1.0f, (FUSENORM && !BRINGUP) ? (float*)(ws + WS_SSQ) : nullptr, ((IN8ODD >> j) & 1) ? (unsigned char*)UB : nullptr};
                    for (int rg_ = 0; rg_ < REP_GDENSE; ++rg_) { if (rg_) { E.isc = 0.f; E.base32 = nullptr; } pg8::gemm_phase<pg8::EpiResid, pg8::OrderT, true, true>(F.lds + RING_OFF, g, ST, E, F.wave); }
                    }
                } else {
                    const int* TAB = (const int*)(ws + WS_TAB);
                    pg8::Gemm g{ws + WS_HIDM, ws + WS_WMD + (size_t)j * WS_WM_LAYER, EFF, (size_t)DM * EFF};
                    pg8::Order S; S.init(__builtin_amdgcn_readfirstlane(TAB[0]), 4, F.G, (int)blockIdx.x, TAB + 16, 0); const pg8::OrderT ST = pg8::order_table(S, F.lds + ORDTAB_OFF, F.tid);
                    pg8::EpiRowGate E{(pg8::bf16_t*)(ws + WS_XS), (const float*)(ws + WS_ROWG), DM, 1.0f / (ASC_H * WSC_D)};
                    for (int rg_ = 0; rg_ < REP_GMOE; ++rg_) pg8::gemm_phase<pg8::EpiRowGate, pg8::OrderT, true, true, true>(F.lds + RING_OFF, g, ST, E, F.wave);
#if MOEQ
                    if (Lq == 1 && (mask & C_THIN)) { pg8::Unit u5_; if (!S.next(4, u5_)) { __syncthreads(); convert_moe_queue(F, 1, (gu32*)(ws + WS_CTL) + CW_QUEUE + 64, 3); } }
#endif
                }
            }
            SEAM(pb + 7);
        } }
        { SLOT_VARS;
        if (Lq == 3 && IN(pb + 8)) { PHASE_BEGIN(); if ((mask & C_THIN) && !DIS_FIN) phase_final(F); } }
    }
#undef IN
#undef SEAM
}
#if BRINGUP
namespace naive {
typedef short bf16x8 __attribute__((ext_vector_type(8)));
typedef float f32x4 __attribute__((ext_vector_type(4)));
struct NG { const bf16* A; int lda; const float* W; const float* W2; int ldw; int wcol0, w2col0; int N, K; int mode;
            float* Cf; bf16* Cb; int ldc; int ccol0; const float* base; const float* bias1; const float* bias2; const float* rowg; const int* tab; size_t wstride; };
__global__ __launch_bounds__(256) void gemm(NG g) {
    __shared__ __attribute__((aligned(16))) bf16 sA[64][40];
    __shared__ __attribute__((aligned(16))) bf16 sB[64][40];
    __shared__ __attribute__((aligned(16))) bf16 sB2[64][40];
    const int ntn = g.N / 64, tn = blockIdx.x % ntn, tm = blockIdx.x / ntn;
    const float* W = g.W; const float* W2 = g.W2;
    if (g.tab) { const int rt = tm / 4; if (rt >= g.tab[0]) return; const int e = g.tab[16 + rt]; W += (size_t)e * g.wstride; if (W2) W2 += (size_t)e * g.wstride; }
    const int tid = threadIdx.x, wave = tid >> 6, lane = tid & 63, wr = wave >> 1, wc = wave & 1, fr = lane & 15, fq = lane >> 4;
    const bool dual = (g.mode == 2 || g.mode == 3);
    f32x4 acc[2][2], acc2[2][2];
    for (int a = 0; a < 2; ++a) for (int b = 0; b < 2; ++b) { acc[a][b] = (f32x4){0.f, 0.f, 0.f, 0.f}; acc2[a][b] = (f32x4){0.f, 0.f, 0.f, 0.f}; }
    for (int k0 = 0; k0 < g.K; k0 += 32) {
        { const int r = tid >> 2, kc = (tid & 3) * 8; *(v4u*)&sA[r][kc] = *(const v4u*)(g.A + (size_t)(tm * 64 + r) * g.lda + k0 + kc); }
        { const int k = tid >> 3, nc = (tid & 7) * 8; const float* p = W + (size_t)(k0 + k) * g.ldw + g.wcol0 + tn * 64 + nc;
          for (int i = 0; i < 8; ++i) sB[nc + i][k] = (bf16)f2bf(p[i]);
          if (dual) { const float* p2 = W2 + (size_t)(k0 + k) * g.ldw + g.w2col0 + tn * 64 + nc; for (int i = 0; i < 8; ++i) sB2[nc + i][k] = (bf16)f2bf(p2[i]); } }
        __syncthreads();
        bf16x8 a[2], b[2], b2[2];
        for (int i = 0; i < 2; ++i) { a[i] = *(const bf16x8*)&sA[wr * 32 + i * 16 + fr][fq * 8]; b[i] = *(const bf16x8*)&sB[wc * 32 + i * 16 + fr][fq * 8]; if (dual) b2[i] = *(const bf16x8*)&sB2[wc * 32 + i * 16 + fr][fq * 8]; }
        for (int mi = 0; mi < 2; ++mi) for (int ni = 0; ni < 2; ++ni) { acc[mi][ni] = __builtin_amdgcn_mfma_f32_16x16x32_bf16(a[mi], b[ni], acc[mi][ni], 0, 0, 0);
            if (dual) acc2[mi][ni] = __builtin_amdgcn_mfma_f32_16x16x32_bf16(a[mi], b2[ni], acc2[mi][ni], 0, 0, 0); }
        __syncthreads();
    }
    for (int mi = 0; mi < 2; ++mi) for (int ni = 0; ni < 2; ++ni) for (int jj = 0; jj < 4; ++jj) {
        const int row = tm * 64 + wr * 32 + mi * 16 + fq * 4 + jj, col = tn * 64 + wc * 32 + ni * 16 + fr; const float v = acc[mi][ni][jj], v2 = acc2[mi][ni][jj];
        const size_t o = (size_t)row * g.ldc + g.ccol0 + col;
        if (g.mode == 0) g.Cf[o] = v;
        else if (g.mode == 1) g.Cf[o] = g.base[o] + v;
        else if (g.mode == 2) g.Cb[o] = (bf16)f2bf(v / (1.0f + expf(-v)) * v2);
        else if (g.mode == 3) g.Cb[o] = (bf16)f2bf((v + g.bias1[col]) / (1.0f + expf(-(v2 + g.bias2[col]))));
        else g.Cb[o] = (bf16)f2bf(v * g.rowg[row]);
    }
}
__global__ void headnorm(const float* P, int ldp, int pcol0, int nheads, const float* gain, float sc, int norm, bf16* dst, int ldd, int dcol0, int rows) {
    const int idx = blockIdx.x * blockDim.x + threadIdx.x; if (idx >= rows * nheads) return;
    const int row = idx / nheads, h = idx - row * nheads; const float* p = P + (size_t)row * ldp + pcol0 + h * 64; bf16* d = dst + (size_t)row * ldd + dcol0 + h * 64;
    float r = 1.f;
    if (norm) { float ss = 0.f; for (int i = 0; i < 64; ++i) ss += p[i] * p[i]; r = sc / sqrtf(ss * (1.0f / 64.0f) + 1e-6f); }
    for (int i = 0; i < 64; ++i) d[i] = (bf16)f2bf(norm ? p[i] * r * gain[i] : p[i]);
}
__global__ __launch_bounds__(256) void attn(const bf16* Q, int qp, const bf16* K, const bf16* V, int kp, bf16* O, int op, const float* CB, int nheads, int sq, int skv, int causal) {
    const int lane = threadIdx.x & 63; const long gw = (long)blockIdx.x * 4 + (threadIdx.x >> 6);
    const int t = (int)(gw % sq); const int bh = (int)(gw / sq), h = bh % nheads, b = bh / nheads;
    float qf[64]; { const bf16* qrow = Q + ((size_t)b * sq + t) * qp + h * 64;
#pragma unroll
        for (int d = 0; d < 64; ++d) qf[d] = bflo((unsigned)qrow[d]); }
    const int nk = causal ? t + 1 : skv; float m = -INFINITY, l = 0.f, o = 0.f;
    for (int s0 = 0; s0 < nk; s0 += 64) {
        const int s = s0 + lane; float sc = -INFINITY;
        if (s < nk) { const bf16* krow = K + ((size_t)b * skv + s) * kp + h * 64; float dot = 0.f;
#pragma unroll
            for (int d = 0; d < 64; d += 2) { const unsigned w = *(const unsigned*)(krow + d); dot += qf[d] * bflo(w) + qf[d + 1] * bfhi(w); }
            sc = dot - (CB ? CB[(size_t)bh * skv + s] : 0.f); }
        float tm = sc; for (int x = 1; x < 64; x <<= 1) tm = fmaxf(tm, __shfl_xor(tm, x));
        const float mn = fmaxf(m, tm), alpha = exp2f(m - mn), p = (s < nk) ? exp2f(sc - mn) : 0.f;
        l = l * alpha + wave_sum(p); o *= alpha;
        const int lim = (nk - s0) < 64 ? (nk - s0) : 64;
        for (int jj = 0; jj < lim; ++jj) { const float pj = __shfl(p, jj); o += pj * bflo((unsigned)V[((size_t)b * skv + s0 + jj) * kp + h * 64 + lane]); }
        m = mn;
    }
    O[((size_t)b * sq + t) * op + h * 64 + lane] = (bf16)f2bf(o / l);
}
}
#endif

static void launch_mega(int grid, hipStream_t stream, Args a, int lo, int hi, unsigned mask) {
    a.ph_lo = lo; a.ph_hi = hi; a.mask = mask;
    hipLaunchKernelGGL(mega_fwd, dim3(grid), dim3(NWAVES * 64), LDS_BYTES, stream, a);
}
extern "C" void kernel_launch(void* const* d_in, const int* in_sizes, int n_in, void* d_out, int out_size, void* d_ws, size_t ws_size, hipStream_t stream) {
    static int grid = 0;
    if (grid == 0) {
        if (n_in != 27 || in_sizes[0] != T * DM || out_size != T * DM || ws_size < WS_END) { fprintf(stderr, "kernel_launch: unexpected shapes or workspace (n_in %d, ws %zu < %zu); nothing launched\n", n_in, ws_size, (size_t)WS_END); grid = -1; return; }
        int dev = 0, cus = 0, per_cu = 0;
        if (hipGetDevice(&dev) != hipSuccess || hipDeviceGetAttribute(&cus, hipDeviceAttributeMultiprocessorCount, dev) != hipSuccess) { grid = -1; return; }
        if (hipFuncSetAttribute((const void*)mega_fwd, hipFuncAttributeMaxDynamicSharedMemorySize, LDS_BYTES) != hipSuccess) { fprintf(stderr, "kernel_launch: hipFuncSetAttribute failed\n"); grid = -1; return; }
        if (hipOccupancyMaxActiveBlocksPerMultiprocessor(&per_cu, (const void*)mega_fwd, NWAVES * 64, LDS_BYTES) != hipSuccess || per_cu < 1) { fprintf(stderr, "kernel_launch: occupancy query reports %d\n", per_cu); }
        (void)hipGetLastError();
        grid = cus;
    }
    if (grid < 0) return;
#ifdef DIAG_ZERO_WS
    if (hipMemsetAsync((char*)d_ws, 0, WS_END, stream) != hipSuccess) return;
#endif
    if (hipMemsetAsync((char*)d_ws + WS_CTL, 0, CTL_ZERO_BYTES, stream) != hipSuccess) return;
    Args a{};
    for (int i = 0; i < 27; ++i) a.in[i] = (const float*)d_in[i];
    a.out = (float*)d_out; a.ws = (unsigned char*)d_ws;
#if !BRINGUP
    launch_mega(grid, stream, a, 0, NPH, C_ALL);
#else
    unsigned char* ws = (unsigned char*)d_ws; const float* const* in = a.in;
    const unsigned fast = FASTMASK;
    bf16* UB = (bf16*)(ws + WS_UB); bf16* MIX = (bf16*)(ws + WS_MIX); bf16* MQ = (bf16*)(ws + WS_MQ); bf16* QKV = (bf16*)(ws + WS_QKV); float* NT_ = (float*)(ws + WS_NTMP);
    auto ngemm = [&](naive::NG g, int rows) { hipLaunchKernelGGL(naive::gemm, dim3((rows / 64) * (g.N / 64)), dim3(256), 0, stream, g); };
    auto nhead = [&](const float* P, int ldp, int pcol0, int nheads, const float* gain, float sc, int norm, bf16* dst, int ldd, int dcol0, int rows) {
        hipLaunchKernelGGL(naive::headnorm, dim3((rows * nheads + 255) / 256), dim3(256), 0, stream, P, ldp, pcol0, nheads, gain, sc, norm, dst, ldd, dcol0, rows); };
    launch_mega(grid, stream, a, 0, 1, C_THIN);
#ifndef NLAYERS
#define NLAYERS 4
#endif
    for (int L = 0; L < NLAYERS; ++L) {
        const int pb = 1 + 9 * L, j = L >> 1; const bool odd = L & 1; const float* hsrc = L == 0 ? in[0] : (const float*)d_out;
        launch_mega(grid, stream, a, pb, pb + 1, C_THIN);
        if (!odd) {
            if (L == 0) {
                if (fast & C_PMK) launch_mega(grid, stream, a, pb + 1, pb + 2, C_PMK);
                else for (int i = 0; i < 4; ++i) {
                    naive::NG g{}; g.A = (const bf16*)(ws + WS_MEMN) + (size_t)i * 2048 * DM; g.lda = DM; g.W = in[5] + (size_t)i * DM * 512; g.ldw = 512; g.N = 512; g.K = DM; g.mode = 0; g.Cf = NT_; g.ldc = 512; ngemm(g, 2048);
                    nhead(NT_, 512, 0, 4, in[7] + i * 64, 1.0f, 1, (bf16*)(ws + WS_MKV) + (size_t)i * 2048 * 512, 512, 0, 2048);
                    nhead(NT_, 512, 256, 4, in[7], 1.0f, 0, (bf16*)(ws + WS_MKV) + (size_t)i * 2048 * 512, 512, 256, 2048);
                }
            }
            launch_mega(grid, stream, a, pb + 1, pb + 2, C_THIN);
            if (fast & C_INPROJ) launch_mega(grid, stream, a, pb + 1, pb + 2, C_INPROJ);
            else {
                naive::NG g{}; g.A = UB; g.lda = DM; g.W = in[8] + (size_t)j * DM * FOXIN; g.ldw = FOXIN; g.K = DM; g.mode = 0; g.Cf = NT_; g.ldc = 2560;
                g.wcol0 = 0; g.N = 2304; g.ccol0 = 0; ngemm(g, T);
                g.wcol0 = 2316; g.N = 256; g.ccol0 = 2304; ngemm(g, T);
                nhead(NT_, 2560, 0, 12, in[10] + j * 64, C2, 1, QKV, 2304, 0, T);
                nhead(NT_, 2560, 768, 12, in[11] + j * 64, 1.0f, 1, QKV, 2304, 768, T);
                nhead(NT_, 2560, 1536, 12, in[11], 1.0f, 0, QKV, 2304, 1536, T);
                nhead(NT_, 2560, 2304, 4, in[6] + L * 64, C2, 1, MQ, 256, 0, T);
            }
        } else {
            if (fast & C_INPROJ) launch_mega(grid, stream, a, pb + 1, pb + 2, C_INPROJ);
            else {
                naive::NG g{}; g.A = UB; g.lda = DM; g.W = in[13] + (size_t)j * DM * CONVIN; g.W2 = g.W; g.ldw = CONVIN; g.K = DM;
                g.mode = 3; g.wcol0 = 0; g.w2col0 = 768; g.N = 768; g.Cb = (bf16*)(ws + WS_GLU); g.ldc = 768; g.bias1 = in[14] + (size_t)j * 1536; g.bias2 = g.bias1 + 768; ngemm(g, T);
                naive::NG h{}; h.A = UB; h.lda = DM; h.W = g.W; h.ldw = CONVIN; h.K = DM; h.mode = 0; h.wcol0 = 1536; h.N = 256; h.Cf = NT_; h.ldc = 256; ngemm(h, T);
                nhead(NT_, 256, 0, 4, in[6] + L * 64, C2, 1, MQ, 256, 0, T);
            }
        }
        if (!odd) {
            if (fast & C_FOX) launch_mega(grid, stream, a, pb + 2, pb + 3, C_FOX);
            else hipLaunchKernelGGL(naive::attn, dim3(BATCH * NH * SEQ / 4), dim3(256), 0, stream, (const bf16*)QKV, 2304, (const bf16*)QKV + 768, (const bf16*)QKV + 1536, 2304, MIX, DM, (const float*)(ws + WS_CB), NH, SEQ, SEQ, 1);
        } else launch_mega(grid, stream, a, pb + 2, pb + 3, C_THIN);
        if (fast & C_MEMATT) launch_mega(grid, stream, a, pb + 2, pb + 3, C_MEMATT);
        else { const bf16* mkv = (const bf16*)(ws + WS_MKV) + (size_t)L * 2048 * 512;
            hipLaunchKernelGGL(naive::attn, dim3(BATCH * MEMH * SEQ / 4), dim3(256), 0, stream, (const bf16*)MQ, 256, mkv, mkv + 256, 512, MIX + 768, DM, (const float*)nullptr, MEMH, SEQ, ML, 0); }
        if (fast & C_OUTPROJ) launch_mega(grid, stream, a, pb + 3, pb + 4, C_OUTPROJ);
        else { naive::NG g{}; g.A = MIX; g.lda = DM; g.W = in[odd ? 19 : 12] + (size_t)j * DM * DM; g.ldw = DM; g.N = DM; g.K = DM; g.mode = 1; g.Cf = (float*)d_out; g.ldc = DM; g.base = hsrc; ngemm(g, T); }
        launch_mega(grid, stream, a, pb + 4, pb + 5, C_THIN);
        if (odd) launch_mega(grid, stream, a, pb + 5, pb + 6, C_THIN);
        if (fast & C_FFNUP) launch_mega(grid, stream, a, pb + 6, pb + 7, C_FFNUP);
        else if (!odd) { naive::NG g{}; g.A = UB; g.lda = DM; g.W = in[20] + (size_t)j * DM * FF; g.W2 = in[21] + (size_t)j * DM * FF; g.ldw = FF; g.N = FF; g.K = DM; g.mode = 2; g.Cb = (bf16*)(ws + WS_HIDD); g.ldc = FF; ngemm(g, T); }
        else { naive::NG g{}; g.A = (const bf16*)(ws + WS_XS); g.lda = DM; g.W = in[24] + (size_t)j * NE * DM * EFF; g.W2 = in[25] + (size_t)j * NE * DM * EFF; g.ldw = EFF; g.N = EFF; g.K = DM; g.mode = 2; g.Cb = (bf16*)(ws + WS_HIDM); g.ldc = EFF;
               g.tab = (const int*)(ws + WS_TAB); g.wstride = (size_t)DM * EFF; ngemm(g, MAXROWS); }
        if (fast & C_FFNDOWN) launch_mega(grid, stream, a, pb + 7, pb + 8, C_FFNDOWN);
        else if (!odd) { naive::NG g{}; g.A = (const bf16*)(ws + WS_HIDD); g.lda = FF; g.W = in[22] + (size_t)j * FF * DM; g.ldw = DM; g.N = DM; g.K = FF; g.mode = 1; g.Cf = (float*)d_out; g.ldc = DM; g.base = (const float*)d_out; ngemm(g, T); }
        else { naive::NG g{}; g.A = (const bf16*)(ws + WS_HIDM); g.lda = EFF; g.W = in[26] + (size_t)j * NE * EFF * DM; g.ldw = DM; g.N = DM; g.K = EFF; g.mode = 4; g.Cb = (bf16*)(ws + WS_XS); g.ldc = DM; g.rowg = (const float*)(ws + WS_ROWG);
               g.tab = (const int*)(ws + WS_TAB); g.wstride = (size_t)EFF * DM; ngemm(g, MAXROWS); }
        if (L == 3 || (odd && L == NLAYERS - 1)) launch_mega(grid, stream, a, 1 + 27 + 8, 1 + 27 + 9, C_THIN);
    }
#endif
}
```

```cpp
#define BRINGUP 0
#define FASTMASK 0
#include <hip/hip_runtime.h>
#include <hip/hip_bf16.h>
#include <cstdio>
#include <cstdint>
#include <cmath>
#include <utility>

#ifndef BRINGUP
#define BRINGUP 0
#endif
#ifndef DENSE8
#define DENSE8 2
#endif
#ifndef UP8L0
#define UP8L0 0
#endif
#ifndef IN8L2
#define IN8L2 1
#endif
#ifndef IN8L0
#define IN8L0 1
#endif
#ifndef IN8ODD
#define IN8ODD 0
#endif
#ifndef FUSENORM
#define FUSENORM 1
#endif
#ifndef MOEQ
#define MOEQ 1
#endif
#ifndef FASTMASK
#define FASTMASK 0
#endif

__device__ __forceinline__ float lconst(float c) { asm volatile("" : "+s"(c)); return c; }
__device__ __forceinline__ int lconsti(int c) { asm volatile("" : "+s"(c)); return c; }

constexpr int BATCH = 8, SEQ = 4096, DM = 1024, T = BATCH * SEQ, NH = 12, HD = 64, FOXD = 768, MEMD = 256, MEMH = 4, ML = 256;
constexpr int FF = 2816, EFF = 3584, NE = 8, CW = 31, CONVD = 768, FOXIN = 2572, CONVIN = 1792;
constexpr int MAXRT = 264, MAXROWS = MAXRT * 256;
constexpr float RMS_EPS = 1e-6f;
constexpr float LOG2E = 1.4426950408889634f;
constexpr float C2 = 0.125f * 1.4426950408889634f;

constexpr size_t MiB = 1u << 20, KiB = 1u << 10;
constexpr size_t WS_CTL = 0, CTL_ZERO_BYTES = 1 * MiB;
constexpr size_t WS_LOGF = 1 * MiB;
constexpr size_t WS_CB = 3 * MiB;
constexpr size_t WS_RS = 4 * MiB + 512 * KiB;
constexpr size_t WS_TOPE = 5 * MiB;
constexpr size_t WS_TOPG = 5 * MiB + 512 * KiB;
constexpr size_t WS_SLOT = 6 * MiB;
constexpr size_t WS_ROWG = 6 * MiB + 512 * KiB;
constexpr size_t WS_CNT = 7 * MiB;
constexpr size_t WS_TAB = 7 * MiB + 64 * KiB;
constexpr size_t WS_GT = 7 * MiB + 128 * KiB;
constexpr size_t WS_MKV = 8 * MiB;
constexpr size_t WS_MEMN = 16 * MiB;
constexpr size_t WS_WINE = 32 * MiB;
constexpr size_t WS_WOUTE = 42 * MiB;
constexpr size_t WS_WINO = 46 * MiB;
constexpr size_t WS_WOUTO = 53 * MiB;
constexpr size_t WS_WGU = 57 * MiB;
constexpr size_t WS_WD = 79 * MiB;
constexpr size_t WS_WKV = 90 * MiB;
constexpr size_t WS_SSQ = 94 * MiB;
constexpr size_t WS_WMGU = 96 * MiB;
constexpr size_t WS_WMD = 152 * MiB;
constexpr size_t WS_WM_LAYER = 84 * MiB;
constexpr float WSC_GU = 256.f, WSC_D = 1024.f, ASC_Z = 8.f, ASC_H = 8.f;
constexpr size_t WS_R = 264 * MiB;
constexpr size_t WS_QKV = WS_R;
constexpr size_t WS_GLU = WS_R;
constexpr size_t WS_XS = WS_R;
constexpr size_t WS_MQ = WS_R + 144 * MiB;
constexpr size_t WS_MIX = WS_R + 160 * MiB;
constexpr size_t WS_UB = WS_R + 224 * MiB;
constexpr size_t WS_HIDD = WS_R + 288 * MiB;
constexpr size_t WS_HIDM = WS_R + 132 * MiB;
constexpr size_t WS_NTMP = WS_R + 288 * MiB;
constexpr size_t WS_H16 = WS_R + 594 * MiB;
#if BRINGUP
constexpr size_t WS_END = WS_R + 672 * MiB;
#else
constexpr size_t WS_END = WS_R + 658 * MiB;
#endif
static_assert(WS_HIDM + (size_t)MAXROWS * EFF * 2 <= WS_R + 594 * MiB, "ws map");
static_assert(WS_XS + (size_t)MAXROWS * DM * 2 <= WS_HIDM, "ws map");
static_assert(WS_HIDD + (size_t)T * FF * 2 <= WS_R + 594 * MiB, "ws map");
constexpr int CW_TMO = 0, CW_CODE = 1;
constexpr int CW_BAR = 4096;
constexpr int CW_QUEUE = 8192;

constexpr int NPH = 37;
constexpr unsigned C_THIN = 1u, C_PMK = 2u, C_INPROJ = 4u, C_FOX = 8u, C_MEMATT = 16u, C_OUTPROJ = 32u, C_FFNUP = 64u, C_FFNDOWN = 128u, C_ALL = 0xffu;
namespace pg8 {
#define PG8_LAS __attribute__((address_space(3)))
#define PG8_GAS __attribute__((address_space(1)))
typedef unsigned short bf16_t;
typedef short bf16x8 __attribute__((ext_vector_type(8)));
typedef float f32x4 __attribute__((ext_vector_type(4)));
typedef unsigned u32x4 __attribute__((ext_vector_type(4)));
constexpr int BM = 256, BK = 64, HALF = 128, HTB = HALF * BK * 2  , STAGE_BYTES = 8 * HTB, NXCD = 8, WGM = 8;

__host__ __device__ __forceinline__ int lds_byte(int r, int c) { const int st = (r >> 4) * 2 + (c >> 5), rr = r & 15, cc = c & 31, ob = rr * 64 + cc * 2; return st * 1024 + (ob ^ (((ob >> 9) & 1) << 5)); }
__host__ __device__ __forceinline__ void stage_rc(int b, int& R, int& C) { const int st = b / 1024, sb = b % 1024, swz = sb ^ (((sb >> 9) & 1) << 5); R = (st >> 1) * 16 + swz / 64; C = (st & 1) * 32 + (swz % 64) / 2; }
__host__ __device__ __forceinline__ int perm32(int rho) { const int n = rho >> 4, i = rho & 15; return 8 * (i >> 2) + 4 * n + (i & 3); }

typedef int v8i __attribute__((ext_vector_type(8)));
typedef int v4i __attribute__((ext_vector_type(4)));
struct Unit { int pm, pn, g; };
struct Gemm { const void* A; const void* Bt; int Kb; size_t gstride; };

struct Order {
    int nM, nN, nwg, G, c, gdiv; const int* tile_g;
    __device__ __forceinline__ void init(int nM_, int nN_, int G_, int c_, const int* tg, int gd) { nM = nM_; nN = nN_; nwg = nM * nN; G = G_; c = c_; tile_g = tg; gdiv = gd; }
    __device__ __forceinline__ bool next(int i, Unit& u) const {
        const long L = (long)i * G + c; if (L >= nwg) return false;
        int wgid = (int)L; { const int q = nwg / NXCD, r = nwg % NXCD, xcd = wgid % NXCD, off = wgid / NXCD; wgid = (xcd < r ? xcd * (q + 1) : r * (q + 1) + (xcd - r) * q) + off; }
        const int nig = WGM * nN, gid = wgid / nig, fm = gid * WGM, gsz = (nM - fm) < WGM ? (nM - fm) : WGM;
        u.pm = fm + ((wgid % nig) % gsz); u.pn = (wgid % nig) / gsz;
        if (tile_g) { const int* tg = tile_g; asm volatile("" : "+s"(tg)); u.g = __builtin_amdgcn_readfirstlane(tg[u.pm]); }
        else u.g = gdiv ? u.pm / gdiv : 0;
        return true;
    }
    __device__ __forceinline__ bool next_lane(int i, Unit& u) const {
        const long L = (long)i * G + c; if (L >= nwg) return false;
        int wgid = (int)L; { const int q = nwg / NXCD, r = nwg % NXCD, xcd = wgid % NXCD, off = wgid / NXCD; wgid = (xcd < r ? xcd * (q + 1) : r * (q + 1) + (xcd - r) * q) + off; }
        const int nig = WGM * nN, gid = wgid / nig, fm = gid * WGM, gsz = (nM - fm) < WGM ? (nM - fm) : WGM;
        u.pm = fm + ((wgid % nig) % gsz); u.pn = (wgid % nig) / gsz;
        if (tile_g) u.g = ((const PG8_GAS int*)tile_g)[u.pm]; else u.g = gdiv ? u.pm / gdiv : 0;
        return true;
    }
};
constexpr int ORD_ENT = 48;
struct OrderT {
    const PG8_LAS v4i* tab;
    __device__ __forceinline__ bool next(int i, Unit& u) const {
        const v4i e = tab[i < ORD_ENT - 1 ? i : ORD_ENT - 1];
        u.pm = __builtin_amdgcn_readfirstlane(e.x); u.pn = __builtin_amdgcn_readfirstlane(e.y); u.g = __builtin_amdgcn_readfirstlane(e.z);
        return __builtin_amdgcn_readfirstlane(e.w) != 0;
    }
};
__device__ __forceinline__ OrderT order_table(const Order& S, PG8_LAS unsigned char* lds_tab, int tid) {
    PG8_LAS v4i* t = (PG8_LAS v4i*)lds_tab;
    if (tid < ORD_ENT) { Unit u; u.pm = 0; u.pn = 0; u.g = 0; const bool ok = (tid < ORD_ENT - 1) && S.next_lane(tid, u); v4i e; e.x = u.pm; e.y = u.pn; e.z = u.g; e.w = ok ? 1 : 0; t[tid] = e; }
    __syncthreads();
    OrderT r; r.tab = t; return r;
}

__device__ __forceinline__ unsigned cvt_pk_bf16(float lo, float hi) { unsigned r; asm volatile("v_cvt_pk_bf16_f32 %0, %1, %2" : "=v"(r) : "v"(lo), "v"(hi)); return r; }
__device__ __forceinline__ u32x4 pack8(const f32x4 a, const f32x4 b) { u32x4 w; w.x = cvt_pk_bf16(a[0], a[1]); w.y = cvt_pk_bf16(a[2], a[3]); w.z = cvt_pk_bf16(b[0], b[1]); w.w = cvt_pk_bf16(b[2], b[3]); return w; }
__device__ __forceinline__ float sigmoidf_fast(float x) { return __builtin_amdgcn_rcpf(1.0f + __builtin_amdgcn_exp2f(-1.4426950408889634f * x)); }
__device__ __forceinline__ f32x4 sig4(const f32x4 x) { f32x4 r; r[0] = sigmoidf_fast(x[0]); r[1] = sigmoidf_fast(x[1]); r[2] = sigmoidf_fast(x[2]); r[3] = sigmoidf_fast(x[3]); return r; }

__device__ __forceinline__ f32x4 swiglu4(const f32x4 a, const f32x4 b, const float rt, const float irq  ) {
    const f32x4 t = a * rt; f32x4 r;
#pragma unroll
    for (int i = 0; i < 4; ++i) { const float e = __builtin_amdgcn_exp2f(t[i]); r[i] = __builtin_amdgcn_rcpf(__builtin_fmaf(e, irq, irq)); }
    return (a * b) * r;
}

__device__ __forceinline__ float fq_sum(float ss) {
    { const auto r = __builtin_amdgcn_permlane16_swap(__builtin_bit_cast(unsigned, ss), __builtin_bit_cast(unsigned, ss), false, false); ss = __builtin_bit_cast(float, (unsigned)r[0]) + __builtin_bit_cast(float, (unsigned)r[1]); }
    { const auto r = __builtin_amdgcn_permlane32_swap(__builtin_bit_cast(unsigned, ss), __builtin_bit_cast(unsigned, ss), false, false); ss = __builtin_bit_cast(float, (unsigned)r[0]) + __builtin_bit_cast(float, (unsigned)r[1]); }
    return ss;
}
struct Gain16 { f32x4 a, b, c, d; };
__device__ __forceinline__ Gain16 load_gain16(const float* gl  ) { Gain16 g; g.a = *(const PG8_GAS f32x4*)(gl); g.b = *(const PG8_GAS f32x4*)(gl + 4); g.c = *(const PG8_GAS f32x4*)(gl + 32); g.d = *(const PG8_GAS f32x4*)(gl + 36); return g; }
__device__ __forceinline__ void headnorm_store(const f32x4 (&acc)[2][2][4][2], int ai, int m, bool norm, const Gain16& gn, float sc, bf16_t* rowp  , int lane, float pre = 1.0f  ) {
    f32x4 v00 = acc[ai][0][m][0] * pre, v01 = acc[ai][0][m][1] * pre, v10 = acc[ai][1][m][0] * pre, v11 = acc[ai][1][m][1] * pre;
    if (norm) {
        const f32x4 q = v00 * v00 + v01 * v01 + v10 * v10 + v11 * v11;
        float ss = (q[0] + q[1]) + (q[2] + q[3]);
        ss += __builtin_bit_cast(float, __builtin_amdgcn_ds_bpermute((lane ^ 16) << 2, __builtin_bit_cast(int, ss))); ss += __builtin_bit_cast(float, __builtin_amdgcn_ds_bpermute((lane ^ 32) << 2, __builtin_bit_cast(int, ss)));
        const float r = __builtin_amdgcn_rsqf(ss * (1.0f / 64.0f) + lconst(1e-6f)) * sc;
        v00 = v00 * r * gn.a; v01 = v01 * r * gn.b; v10 = v10 * r * gn.c; v11 = v11 * r * gn.d;
    }
    *(PG8_GAS u32x4*)(rowp) = pack8(v00, v01);
    *(PG8_GAS u32x4*)(rowp + 32) = pack8(v10, v11);
}
__device__ __forceinline__ float row_rs(const float* ssq, int row) {
    const f32x4 a = *(const PG8_GAS f32x4*)(ssq + (size_t)row * 16), b = *(const PG8_GAS f32x4*)(ssq + (size_t)row * 16 + 4), c = *(const PG8_GAS f32x4*)(ssq + (size_t)row * 16 + 8), d = *(const PG8_GAS f32x4*)(ssq + (size_t)row * 16 + 12);
    const f32x4 t = (a + b) + (c + d); return __builtin_amdgcn_rsqf(((t[0] + t[1]) + (t[2] + t[3])) * (1.0f / 1024.0f) + 1e-6f);
}
__device__ __forceinline__ void row_scales(float (&rsv)[2][4], const float* ssq, int row0, int fr, int fq) {
    f32x4 t[2][4]; const int lane = fq * 16 + fr; const float eps_ = lconst(1e-6f);
#pragma unroll
    for (int ai = 0; ai < 2; ++ai)
#pragma unroll
        for (int m = 0; m < 4; ++m) t[ai][m] = *(const PG8_GAS f32x4*)(ssq + (size_t)(row0 + ai * HALF + m * 16) * 16 + 4 * fq);
#pragma unroll
    for (int ai = 0; ai < 2; ++ai)
#pragma unroll
        for (int m = 0; m < 4; ++m) { float ss = (t[ai][m][0] + t[ai][m][1]) + (t[ai][m][2] + t[ai][m][3]);
            ss += __builtin_bit_cast(float, __builtin_amdgcn_ds_bpermute((lane ^ 16) << 2, __builtin_bit_cast(int, ss))); ss += __builtin_bit_cast(float, __builtin_amdgcn_ds_bpermute((lane ^ 32) << 2, __builtin_bit_cast(int, ss)));
            rsv[ai][m] = __builtin_amdgcn_rsqf(ss * (1.0f / 1024.0f) + eps_); }
}
struct EpiInEven {
    static constexpr bool PERM = true, AFTER_DRAIN = false;
    bf16_t* QKV; bf16_t* MQ; const float* gt; float isc = 1.0f;
    __device__ __forceinline__ void operator()(const f32x4 (&acc)[2][2][4][2], const Unit& u, int wr, int wc, int fr, int fq) const {
        const int row0 = u.pm * BM + wr * 64 + fr; const int pn = u.pn;
        float isc_ = isc; asm volatile("" : "+v"(isc_));
        const bool norm = (pn < 6) || (pn == 9);
        const int sel = pn < 3 ? 0 : (pn < 6 ? 1 : 2);
        const Gain16 gn = load_gain16(gt + 64 * sel + 8 * fq);
        const int ld = (pn == 9) ? MEMD : 3 * FOXD;
        const size_t dofs = (pn == 9) ? (size_t)((const char*)MQ - (const char*)QKV) / 2 : (size_t)256 * pn;
        bf16_t* dst = QKV + dofs + 64 * wc + 8 * fq;
#pragma unroll
        for (int ai = 0; ai < 2; ++ai)
#pragma unroll
            for (int m = 0; m < 4; ++m) headnorm_store(acc, ai, m, norm, gn, 1.0f, dst + (size_t)(row0 + ai * HALF + m * 16) * ld, fq * 16 + fr, isc_);
    }
};
struct EpiMemKV {
    static constexpr bool PERM = true, AFTER_DRAIN = false;
    bf16_t* MKV; const float* gmk;
    __device__ __forceinline__ void operator()(const f32x4 (&acc)[2][2][4][2], const Unit& u, int wr, int wc, int fr, int fq) const {
        const int row0 = u.pm * BM + wr * 64 + fr;
        const Gain16 gn = load_gain16(gmk + 64 * u.g + 8 * fq);
        bf16_t* dst = MKV + 256 * u.pn + 64 * wc + 8 * fq;
#pragma unroll
        for (int ai = 0; ai < 2; ++ai)
#pragma unroll
            for (int m = 0; m < 4; ++m) headnorm_store(acc, ai, m, u.pn == 0, gn, 1.0f, dst + (size_t)(row0 + ai * HALF + m * 16) * 512, fq * 16 + fr);
    }
};
struct EpiInOdd {
    static constexpr bool PERM = true, AFTER_DRAIN = false;
    bf16_t* GLU; bf16_t* MQ; const float* bias; const float* gmq; const float* ssq; float isc = 1.0f;
    __device__ __forceinline__ void operator()(f32x4 (&acc)[2][2][4][2], const Unit& u, int wr, int wc, int fr, int fq) const {
        const int row0 = u.pm * BM + wr * 64 + fr;
        if (ssq) { float rsv[2][4]; row_scales(rsv, ssq, row0, fr, fq); float isc_ = isc; asm volatile("" : "+v"(isc_));
#pragma unroll
            for (int ai = 0; ai < 2; ++ai)
#pragma unroll
                for (int m = 0; m < 4; ++m) { const float rs = rsv[ai][m] * isc_;
#pragma unroll
                    for (int bj = 0; bj < 2; ++bj)
#pragma unroll
                        for (int n = 0; n < 2; ++n) acc[ai][bj][m][n] = acc[ai][bj][m][n] * rs; }
        }
        if (u.pn == 6) {
            const Gain16 gn = load_gain16(gmq + 8 * fq);
            bf16_t* dst = MQ + 64 * wc + 8 * fq;
#pragma unroll
            for (int ai = 0; ai < 2; ++ai)
#pragma unroll
                for (int m = 0; m < 4; ++m) headnorm_store(acc, ai, m, true, gn, 1.0f, dst + (size_t)(row0 + ai * HALF + m * 16) * MEMD, fq * 16 + fr);
        } else {
            const int col0 = u.pn * 128 + wc * 32 + 8 * fq;
            const f32x4 ba0 = *(const PG8_GAS f32x4*)(bias + col0), ba1 = *(const PG8_GAS f32x4*)(bias + col0 + 4), bg0 = *(const PG8_GAS f32x4*)(bias + CONVD + col0), bg1 = *(const PG8_GAS f32x4*)(bias + CONVD + col0 + 4);
#pragma unroll
            for (int ai = 0; ai < 2; ++ai)
#pragma unroll
                for (int m = 0; m < 4; ++m) {
                    const f32x4 o0 = (acc[ai][0][m][0] + ba0) * sig4(acc[ai][1][m][0] + bg0), o1 = (acc[ai][0][m][1] + ba1) * sig4(acc[ai][1][m][1] + bg1);
                    *(PG8_GAS u32x4*)(GLU + (size_t)(row0 + ai * HALF + m * 16) * CONVD + col0) = pack8(o0, o1);
                }
        }
    }
};
struct EpiSwiGLU {
    static constexpr bool PERM = true, AFTER_DRAIN = false;
    bf16_t* O; int ldc; const float* ssq;
    __device__ __forceinline__ void operator()(const f32x4 (&acc)[2][2][4][2], const Unit& u, int wr, int wc, int fr, int fq) const {
        const int row0 = u.pm * BM + wr * 64 + fr; const int col0 = u.pn * 128 + wc * 32 + 8 * fq;
        float rsv[2][4]; float nl2 = -1.4426950408889634f; asm volatile("" : "+v"(nl2));
        if (ssq) row_scales(rsv, ssq, row0, fr, fq);
        else {
#pragma unroll
            for (int ai = 0; ai < 2; ++ai)
#pragma unroll
                for (int m = 0; m < 4; ++m) rsv[ai][m] = 1.0f; }
#pragma unroll
        for (int ai = 0; ai < 2; ++ai)
#pragma unroll
            for (int m = 0; m < 4; ++m) {
                const float rs = rsv[ai][m], rt = rs * nl2, rq = __builtin_amdgcn_rcpf(rs * rs);
                const f32x4 o0 = swiglu4(acc[ai][0][m][0], acc[ai][1][m][0], rt, rq), o1 = swiglu4(acc[ai][0][m][1], acc[ai][1][m][1], rt, rq);
                *(PG8_GAS u32x4*)(O + (size_t)(row0 + ai * HALF + m * 16) * ldc + col0) = pack8(o0, o1);
            }
    }
};
__device__ __forceinline__ unsigned pk4_fp8(const f32x4 v) { int p = __builtin_amdgcn_cvt_pk_fp8_f32(v[0], v[1], __builtin_bit_cast(int, v[0])  , false); p = __builtin_amdgcn_cvt_pk_fp8_f32(v[2], v[3], p, true); return (unsigned)p; }
__device__ __forceinline__ f32x4 clamp8(const f32x4 v, const float c) { f32x4 r; r[0] = __builtin_amdgcn_fmed3f(v[0], -c, c); r[1] = __builtin_amdgcn_fmed3f(v[1], -c, c); r[2] = __builtin_amdgcn_fmed3f(v[2], -c, c); r[3] = __builtin_amdgcn_fmed3f(v[3], -c, c); return r; }
template <bool OUT16> struct EpiSwiGLU8T {
    static constexpr bool PERM = true, AFTER_DRAIN = false;
    unsigned char* O; int ldc; float isc, osc; const float* ssq;
    __device__ __forceinline__ void operator()(const f32x4 (&acc)[2][2][4][2], const Unit& u, int wr, int wc, int fr, int fq) const {
#ifdef PROBE_EPI2
        for (int rp_ = 0; rp_ < 2; ++rp_) { asm volatile("" ::: "memory");
#endif
        const int row0 = u.pm * BM + wr * 64 + fr; const int col0 = u.pn * 128 + wc * 32 + 8 * fq;
        float isc_ = isc, uo = OUT16 ? isc : isc * osc, c448 = 448.f, nl2 = -1.4426950408889634f; asm volatile("" : "+v"(isc_), "+v"(uo), "+v"(c448), "+v"(nl2));
        float rsv[2][4];
        if (ssq) row_scales(rsv, ssq, row0, fr, fq);
        else {
#pragma unroll
            for (int ai = 0; ai < 2; ++ai)
#pragma unroll
                for (int m = 0; m < 4; ++m) rsv[ai][m] = 1.0f; }
#pragma unroll
        for (int ai = 0; ai < 2; ++ai)
#pragma unroll
            for (int m = 0; m < 4; ++m) {
                const float ri = rsv[ai][m] * isc_, rt = ri * nl2, rq = __builtin_amdgcn_rcpf(ri * (rsv[ai][m] * uo));
                const f32x4 o0 = swiglu4(acc[ai][0][m][0], acc[ai][1][m][0], rt, rq), o1 = swiglu4(acc[ai][0][m][1], acc[ai][1][m][1], rt, rq);
                if constexpr (OUT16) *(PG8_GAS u32x4*)((bf16_t*)O + (size_t)(row0 + ai * HALF + m * 16) * ldc + col0) = pack8(o0, o1);
                else { typedef unsigned u32x2 __attribute__((ext_vector_type(2)));
                u32x2 w; w.x = pk4_fp8(clamp8(o0, c448)); w.y = pk4_fp8(clamp8(o1, c448));
                *(PG8_GAS u32x2*)(O + (size_t)(row0 + ai * HALF + m * 16) * ldc + col0) = w; }
                __builtin_amdgcn_sched_barrier(0);
            }
#ifdef PROBE_EPI2
        }
#endif
    }
};
typedef EpiSwiGLU8T<false> EpiSwiGLU8;
typedef EpiSwiGLU8T<true> EpiSwiGLU8B;
struct EpiResid {
    static constexpr bool PERM = true, AFTER_DRAIN = false;
    const float* base32; bf16_t* h16; float isc; float* ssq; unsigned char* h8;
    __device__ __forceinline__ void operator()(const f32x4 (&acc)[2][2][4][2], const Unit& u, int wr, int wc, int fr, int fq) const {
        const int row0 = u.pm * BM + wr * 64 + fr; const int col0 = u.pn * BM + wc * 32 + 8 * fq;
        float isc_ = isc, c448 = 448.f; asm volatile("" : "+v"(isc_), "+v"(c448)); const int lane = fq * 16 + fr;
        auto rowof = [&](int gi) { return row0 + (gi >> 2) * HALF + (gi & 3) * 16; };
        auto finish = [&](int gi, const f32x4 (&cu)[2][2]) { const int ai = gi >> 2, m = gi & 3; const int row = rowof(gi);
            float ss = 0.f;
#pragma unroll
            for (int bj = 0; bj < 2; ++bj) { const f32x4 o0 = cu[bj][0] + acc[ai][bj][m][0] * isc_, o1 = cu[bj][1] + acc[ai][bj][m][1] * isc_;
                *(PG8_GAS u32x4*)(h16 + (size_t)row * DM + col0 + bj * HALF) = pack8(o0, o1);
                if (ssq) { const f32x4 q = o0 * o0 + o1 * o1; ss += (q[0] + q[1]) + (q[2] + q[3]); }
                if (h8) { typedef unsigned u32x2 __attribute__((ext_vector_type(2))); u32x2 w; w.x = pk4_fp8(clamp8(o0 * ASC_Z, c448)); w.y = pk4_fp8(clamp8(o1 * ASC_Z, c448)); *(PG8_GAS u32x2*)(h8 + (size_t)row * DM + col0 + bj * HALF) = w; } }
            if (ssq) { ss += __builtin_bit_cast(float, __builtin_amdgcn_ds_bpermute((lane ^ 16) << 2, __builtin_bit_cast(int, ss))); ss += __builtin_bit_cast(float, __builtin_amdgcn_ds_bpermute((lane ^ 32) << 2, __builtin_bit_cast(int, ss)));
                if (fq == 0) *(PG8_GAS float*)(ssq + (size_t)row * 16 + u.pn * 4 + wc) = ss; }
            __builtin_amdgcn_sched_barrier(0); };
        if (base32) {
#pragma unroll
            for (int hb = 0; hb < 2; ++hb) { f32x4 rf[4][2][2];
#pragma unroll
                for (int g = 0; g < 4; ++g)
#pragma unroll
                    for (int bj = 0; bj < 2; ++bj) { const size_t p = (size_t)rowof(4 * hb + g) * DM + col0 + bj * HALF; rf[g][bj][0] = *(const PG8_GAS f32x4*)(base32 + p); rf[g][bj][1] = *(const PG8_GAS f32x4*)(base32 + p + 4); }
                __builtin_amdgcn_sched_barrier(0);
#pragma unroll
                for (int g = 0; g < 4; ++g) finish(4 * hb + g, rf[g]); }
        } else {
            u32x4 rw[8][2];
#pragma unroll
            for (int gi = 0; gi < 8; ++gi)
#pragma unroll
                for (int bj = 0; bj < 2; ++bj) rw[gi][bj] = *(const PG8_GAS u32x4*)(h16 + (size_t)rowof(gi) * DM + col0 + bj * HALF);
            __builtin_amdgcn_sched_barrier(0);
#pragma unroll
            for (int gi = 0; gi < 8; ++gi) { f32x4 cu[2][2];
#pragma unroll
                for (int bj = 0; bj < 2; ++bj) { const u32x4 w = rw[gi][bj];
                    cu[bj][0] = (f32x4){__builtin_bit_cast(float, w.x << 16), __builtin_bit_cast(float, w.x & 0xffff0000u), __builtin_bit_cast(float, w.y << 16), __builtin_bit_cast(float, w.y & 0xffff0000u)};
                    cu[bj][1] = (f32x4){__builtin_bit_cast(float, w.z << 16), __builtin_bit_cast(float, w.z & 0xffff0000u), __builtin_bit_cast(float, w.w << 16), __builtin_bit_cast(float, w.w & 0xffff0000u)}; }
                finish(gi, cu); }
        }
    }
};
struct EpiRowGate {
    static constexpr bool PERM = true, AFTER_DRAIN = false;
    bf16_t* Y; const float* rowg; int ldc; float isc;
    __device__ __forceinline__ void operator()(const f32x4 (&acc)[2][2][4][2], const Unit& u, int wr, int wc, int fr, int fq) const {
        const int row0 = u.pm * BM + wr * 64 + fr; const int col0 = u.pn * BM + wc * 32 + 8 * fq;
        float isc_ = isc; asm volatile("" : "+v"(isc_));
        float rgv[2][4];
#pragma unroll
        for (int ai = 0; ai < 2; ++ai)
#pragma unroll
            for (int m = 0; m < 4; ++m) rgv[ai][m] = *(const PG8_GAS float*)(rowg + row0 + ai * HALF + m * 16);
#pragma unroll
        for (int ai = 0; ai < 2; ++ai)
#pragma unroll
            for (int m = 0; m < 4; ++m) { const int row = row0 + ai * HALF + m * 16; const float rg = rgv[ai][m] * isc_;
#pragma unroll
                for (int bj = 0; bj < 2; ++bj) *(PG8_GAS u32x4*)(Y + (size_t)row * ldc + col0 + bj * HALF) = pack8(acc[ai][bj][m][0] * rg, acc[ai][bj][m][1] * rg);
                __builtin_amdgcn_sched_barrier(0); }
    }
};

template <class Epi, class Sched, bool ALIGN_EPI = false, bool SP2 = false, bool F8 = false>
__device__ __forceinline__ void gemm_phase(PG8_LAS unsigned char* lds, const Gemm g, const Sched& S, const Epi& E, const int wave_in  ) {
    int lane; asm volatile("v_mbcnt_lo_u32_b32 %0, -1, 0\n\tv_mbcnt_hi_u32_b32 %0, -1, %0" : "=v"(lane));
    const int wid = wave_in, tid = wave_in * 64 + lane, wr = wid >> 2, wc = wid & 3, fr = lane & 15, fq = lane >> 4;
    const int Kb = g.Kb, nt = Kb / (BK * 2);
    unsigned voffA, voffB;
    { int R, C; stage_rc(tid * 16, R, C); const int Rb = Epi::PERM ? ((R & ~31) + perm32(R & 31)) : R; voffA = (unsigned)(R * Kb + C * 2); voffB = (unsigned)(Rb * Kb + C * 2); }
    const size_t pstep = (size_t)64 * Kb;
    const size_t kstep = (size_t)(BK * 2);
    const size_t hstep = (size_t)HALF * Kb;
    const size_t tstep = 2 * hstep;
    const unsigned ldsw = (unsigned)wid * 1024u;
    const unsigned lds0 = (unsigned)(uintptr_t)lds;
    const int aoff = lds_byte(wr * 64 + fr, fq * 8), boff = lds_byte(wc * 32 + fr, fq * 8);
    PG8_LAS unsigned char* pa = lds + aoff; PG8_LAS unsigned char* pb = lds + 4 * HTB + boff; asm volatile("" : "+v"(pa), "+v"(pb));
#define PG8_SA(b, h) (((b) * 2 + (h)) * HTB)
#define PG8_SB(b, h) ((4 + (b) * 2 + (h)) * HTB)
#define PG8_GLDS(voff32, gbase, ldsdst) do { unsigned keep_; asm volatile("s_mov_b32 %0, m0\n\ts_mov_b32 m0, %3\n\ts_nop 0\n\tglobal_load_lds_dwordx4 %1, %2\n\ts_mov_b32 m0, %0" \
        : "=&s"(keep_) : "v"(voff32), "s"(gbase), "s"(ldsdst) : "memory"); } while (0)
#define PG8_STAGE(bufoff, gbase, voff) do { _Pragma("unroll") for (int _i = 0; _i < 2; ++_i) \
        PG8_GLDS((voff), (const char*)(gbase) + _i * pstep, (unsigned)__builtin_amdgcn_readfirstlane((int)(lds0 + (unsigned)(bufoff) + ldsw + (unsigned)(_i * 8192)))); } while (0)
#define PG8_RDA(off) (*(const PG8_LAS v4i*)(pa + (off)))
#define PG8_RDB(off) (*(const PG8_LAS v4i*)(pb + (off)))
#define PG8_LDA(dst, b, h) do { _Pragma("unroll") for (int m = 0; m < 4; ++m) { \
        if constexpr (F8) dst##8[m] = __builtin_shufflevector(PG8_RDA(PG8_SA(b, h) + m * 2048), PG8_RDA(PG8_SA(b, h) + m * 2048 + 1024), 0, 1, 2, 3, 4, 5, 6, 7); \
        else { _Pragma("unroll") for (int k = 0; k < 2; ++k) dst[m][k] = *(const PG8_LAS bf16x8*)(pa + PG8_SA(b, h) + m * 2048 + k * 1024); } } } while (0)
#define PG8_LDB(dst, b, h) do { _Pragma("unroll") for (int n = 0; n < 2; ++n) { \
        if constexpr (F8) dst##8[n] = __builtin_shufflevector(PG8_RDB(PG8_SB(b, h) - 4 * HTB + n * 2048), PG8_RDB(PG8_SB(b, h) - 4 * HTB + n * 2048 + 1024), 0, 1, 2, 3, 4, 5, 6, 7); \
        else { _Pragma("unroll") for (int k = 0; k < 2; ++k) dst[n][k] = *(const PG8_LAS bf16x8*)(pb + PG8_SB(b, h) - 4 * HTB + n * 2048 + k * 1024); } } } while (0)
#define PG8_MMA(ai, bj, Af, Bf) do { __builtin_amdgcn_s_setprio(1); _Pragma("unroll") for (int m = 0; m < 4; ++m) _Pragma("unroll") for (int n = 0; n < 2; ++n) { \
        if constexpr (F8) acc[ai][bj][m][n] = __builtin_amdgcn_mfma_scale_f32_16x16x128_f8f6f4(Bf##8[n], Af##8[m], acc[ai][bj][m][n], 0, 0, 0, sc1_, 0, sc1_); \
        else { _Pragma("unroll") for (int k = 0; k < 2; ++k) acc[ai][bj][m][n] = __builtin_amdgcn_mfma_f32_16x16x32_bf16(Bf[n][k], Af[m][k], acc[ai][bj][m][n], 0, 0, 0); } } \
        __builtin_amdgcn_s_setprio(0); } while (0)
#define PG8_WAIT_V(n) asm volatile("s_waitcnt vmcnt(" #n ")" ::: "memory")
#define PG8_WAIT_L(n) asm volatile("s_waitcnt lgkmcnt(" #n ")" ::: "memory")
#define PG8_BAR __builtin_amdgcn_s_barrier()
#define PG8_SCHED __builtin_amdgcn_sched_barrier(0)
    int sc1_ = 0x7f7f7f7f; asm volatile("" : "+v"(sc1_));
    Unit cur, nxt; int ui = 0;
    if (!S.next(0, cur)) return;
    f32x4 acc[2][2][4][2];
#pragma unroll
    for (int a = 0; a < 2; ++a)
#pragma unroll
        for (int b = 0; b < 2; ++b)
#pragma unroll
            for (int m = 0; m < 4; ++m)
#pragma unroll
                for (int n = 0; n < 2; ++n) acc[a][b][m][n] = (f32x4){0.f, 0.f, 0.f, 0.f};
    bf16x8 At[4][2], B0[2][2], B1[2][2]; v8i At8[4], B08[2], B18[2];
    const char* cA = (const char*)g.A + (size_t)cur.pm * tstep; const char* cB = (const char*)g.Bt + (size_t)cur.g * g.gstride + (size_t)cur.pn * tstep;
    if constexpr (SP2) {
        PG8_STAGE(PG8_SB(0, 0), cB, voffB); PG8_STAGE(PG8_SB(0, 1), cB + hstep, voffB); PG8_STAGE(PG8_SA(0, 0), cA, voffA); PG8_STAGE(PG8_SA(0, 1), cA + hstep, voffA);
        if (wr == 1) PG8_BAR;
        PG8_WAIT_V(2); PG8_BAR;
        PG8_STAGE(PG8_SB(1, 0), cB + kstep, voffB); PG8_STAGE(PG8_SA(1, 0), cA + kstep, voffA); PG8_STAGE(PG8_SB(1, 1), cB + hstep + kstep, voffB);
        PG8_WAIT_V(6); PG8_BAR;
    } else {
        PG8_STAGE(PG8_SB(0, 0), cB, voffB); PG8_STAGE(PG8_SA(0, 0), cA, voffA); PG8_STAGE(PG8_SB(0, 1), cB + hstep, voffB); PG8_STAGE(PG8_SA(0, 1), cA + hstep, voffA);
        if (wr == 1) PG8_BAR;
        PG8_WAIT_V(4); PG8_BAR;
        PG8_STAGE(PG8_SB(1, 0), cB + kstep, voffB); PG8_STAGE(PG8_SA(1, 0), cA + kstep, voffA); PG8_STAGE(PG8_SB(1, 1), cB + hstep + kstep, voffB);
        PG8_WAIT_V(6); PG8_BAR;
    }
    for (;;) {
        const bool has_next = S.next(ui + 1, nxt);
        const char* nA = has_next ? (const char*)g.A + (size_t)nxt.pm * tstep : cA; const char* nB = has_next ? (const char*)g.Bt + (size_t)nxt.g * g.gstride + (size_t)nxt.pn * tstep : cB;
#pragma unroll 1
        for (int t = 0; t < nt; t += 2) {
            const bool last = (t == nt - 2);
            const char* a1 = cA + (size_t)(t + 1) * kstep;
            const char* a2 = last ? nA : cA + (size_t)(t + 2) * kstep; const char* b2 = last ? nB : cB + (size_t)(t + 2) * kstep;
            const char* a3 = a2 + kstep; const char* b3 = b2 + kstep;
            if constexpr (SP2) {
            PG8_LDB(B0, 0, 0); PG8_LDB(B1, 0, 1); PG8_SCHED; PG8_LDA(At, 0, 0); PG8_STAGE(PG8_SA(1, 1), a1 + hstep, voffA);
            PG8_WAIT_V(8); PG8_WAIT_L(0); PG8_BAR; PG8_MMA(0, 0, At, B0); PG8_MMA(0, 1, At, B1); PG8_BAR; PG8_SCHED;
            PG8_LDA(At, 0, 1); PG8_STAGE(PG8_SB(0, 0), b2, voffB); PG8_STAGE(PG8_SB(0, 1), b2 + hstep, voffB); PG8_STAGE(PG8_SA(0, 0), a2, voffA);
            PG8_WAIT_V(8); PG8_WAIT_L(0); PG8_BAR; PG8_MMA(1, 0, At, B0); PG8_MMA(1, 1, At, B1); PG8_BAR; PG8_SCHED;
            PG8_LDB(B0, 1, 0); PG8_LDB(B1, 1, 1); PG8_SCHED; PG8_LDA(At, 1, 0); PG8_STAGE(PG8_SA(0, 1), a2 + hstep, voffA);
            PG8_WAIT_V(8); PG8_WAIT_L(0); PG8_BAR; PG8_MMA(0, 0, At, B0); PG8_MMA(0, 1, At, B1); PG8_BAR; PG8_SCHED;
            PG8_LDA(At, 1, 1); PG8_STAGE(PG8_SB(1, 0), b3, voffB); PG8_STAGE(PG8_SB(1, 1), b3 + hstep, voffB); PG8_STAGE(PG8_SA(1, 0), a3, voffA);
            PG8_WAIT_V(8); PG8_WAIT_L(0); PG8_BAR; PG8_MMA(1, 0, At, B0); PG8_MMA(1, 1, At, B1); PG8_BAR; PG8_SCHED;
            } else {
            PG8_LDB(B0, 0, 0); PG8_SCHED; PG8_LDA(At, 0, 0); PG8_STAGE(PG8_SA(1, 1), a1 + hstep, voffA);
            PG8_WAIT_L(8); PG8_BAR; PG8_WAIT_L(0); PG8_MMA(0, 0, At, B0); PG8_BAR; PG8_SCHED;
            PG8_LDB(B1, 0, 1); PG8_STAGE(PG8_SB(0, 0), b2, voffB);
            PG8_BAR; PG8_WAIT_L(0); PG8_MMA(0, 1, At, B1); PG8_BAR;
            PG8_LDA(At, 0, 1); PG8_STAGE(PG8_SA(0, 0), a2, voffA);
            PG8_BAR; PG8_WAIT_L(0); PG8_MMA(1, 0, At, B0); PG8_BAR; PG8_SCHED;
            PG8_STAGE(PG8_SB(0, 1), b2 + hstep, voffB);
            PG8_WAIT_V(6); PG8_BAR; PG8_MMA(1, 1, At, B1); PG8_BAR;
            PG8_LDB(B0, 1, 0); PG8_SCHED; PG8_LDA(At, 1, 0); PG8_STAGE(PG8_SA(0, 1), a2 + hstep, voffA);
            PG8_WAIT_L(8); PG8_BAR; PG8_WAIT_L(0); PG8_MMA(0, 0, At, B0); PG8_BAR; PG8_SCHED;
            PG8_LDB(B1, 1, 1); PG8_STAGE(PG8_SB(1, 0), b3, voffB);
            PG8_BAR; PG8_WAIT_L(0); PG8_MMA(0, 1, At, B1); PG8_BAR;
            PG8_LDA(At, 1, 1); PG8_STAGE(PG8_SA(1, 0), a3, voffA);
            PG8_BAR; PG8_WAIT_L(0); PG8_MMA(1, 0, At, B0); PG8_BAR; PG8_SCHED;
            PG8_STAGE(PG8_SB(1, 1), b3 + hstep, voffB);
            PG8_WAIT_V(6); PG8_BAR; PG8_MMA(1, 1, At, B1); PG8_BAR;
            }
        }
        if constexpr (ALIGN_EPI) { if (wr == 0) PG8_BAR; }
        { int lz; asm volatile("v_mbcnt_lo_u32_b32 %0, -1, 0\n\tv_mbcnt_hi_u32_b32 %0, -1, %0" : "=v"(lz));
          E(acc, cur, wr, wc, lz & 15, lz >> 4); }
        if (!has_next) break;
#pragma unroll
        for (int a = 0; a < 2; ++a)
#pragma unroll
            for (int b = 0; b < 2; ++b)
#pragma unroll
                for (int m = 0; m < 4; ++m)
#pragma unroll
                    for (int n = 0; n < 2; ++n) { typedef double d2_t __attribute__((ext_vector_type(2))); d2_t z_;
                        asm volatile("v_mov_b64 %0, 0" : "=v"(z_.x)); asm volatile("v_mov_b64 %0, 0" : "=v"(z_.y)); acc[a][b][m][n] = __builtin_bit_cast(f32x4, z_); }
        cur = nxt; cA = nA; cB = nB; ++ui;
        if constexpr (ALIGN_EPI) { if (wr == 1) PG8_BAR; }
    }
    PG8_WAIT_V(0);
    if constexpr (!ALIGN_EPI) { if (wr == 0) PG8_BAR; }
    PG8_BAR;
#undef PG8_SA
#undef PG8_SB
#undef PG8_STAGE
#undef PG8_GLDS
#undef PG8_LDA
#undef PG8_LDB
#undef PG8_MMA
#undef PG8_RDA
#undef PG8_RDB
#undef PG8_WAIT_V
#undef PG8_WAIT_L
#undef PG8_BAR
#undef PG8_SCHED
}
}
namespace attn_body {
using bf16=__hip_bfloat16;
using bf16x8=__attribute__((ext_vector_type(8)))short;
using s16x4=__attribute__((ext_vector_type(4)))short;
using f32x16=__attribute__((ext_vector_type(16)))float;
using f32x4=__attribute__((ext_vector_type(4)))float;
using u32x4=__attribute__((ext_vector_type(4)))unsigned;
constexpr int D=64;
constexpr int NW=8,QBLK=32,QB=QBLK*NW,KVBLK=64;
__device__ __forceinline__ int crow(int r,int hi){return (r&3)+8*(r>>2)+4*hi;}
#define SBAR() __builtin_amdgcn_sched_barrier(0)
__device__ __forceinline__ void cmask(f32x16&p0,f32x16&p1,int jb,int qrel,int hi){
  const float NEG=lconst(-INFINITY); int kb=64*jb+4*hi;
  #pragma unroll
  for(int r=0;r<16;++r){int kv=kb+(r&3)+8*(r>>2); if(kv>qrel)p0[r]=NEG; if(kv+32>qrel)p1[r]=NEG;}
}
constexpr int NSLOT=3, SLOTB=8192;
constexpr int LDS_K=0, LDS_V=NSLOT*SLOTB, LDS_WS=2*NSLOT*SLOTB, LDS_OST=LDS_WS+NW*64*4, LDS_CB=LDS_OST+NW*4096, LDS_BYTES=LDS_CB+16384;
__device__ __forceinline__ void glds16(const void*gsrc,unsigned lds_dst){unsigned keep;
  asm volatile("s_mov_b32 %0, m0\n\ts_mov_b32 m0, %2\n\ts_nop 0\n\tglobal_load_lds_dwordx4 %1, off\n\ts_mov_b32 m0, %0":"=&s"(keep):"v"(gsrc),"s"(lds_dst):"memory");}
__device__ __forceinline__ float max3f(float a,float b,float c){float r;asm("v_max3_f32 %0, %1, %2, %3":"=v"(r):"v"(a),"v"(b),"v"(c));return r;}
__device__ __forceinline__ float max2f(float a,float b){float r;asm("v_max_f32_e32 %0, %1, %2":"=v"(r):"v"(a),"v"(b));return r;}
__device__ __forceinline__ float fadd_s(float a,float b){float r;asm("v_add_f32_e32 %0, %1, %2":"=v"(r):"v"(a),"v"(b));return r;}
__device__ __forceinline__ float fsub_s(float a,float b){float r;asm("v_sub_f32_e32 %0, %1, %2":"=v"(r):"v"(a),"v"(b));return r;}
typedef float f32x2_t __attribute__((ext_vector_type(2))); typedef __bf16 bf16x2_t __attribute__((ext_vector_type(2)));
__device__ __forceinline__ unsigned cvtpk_s(float lo,float hi){f32x2_t v={lo,hi};bf16x2_t b=__builtin_convertvector(v,bf16x2_t);return __builtin_bit_cast(unsigned,b);}
#define WAIT_BAR(N) asm volatile("s_waitcnt vmcnt(" #N ") lgkmcnt(0)\n\ts_barrier":::"memory")

__device__ __forceinline__ void qkt(f32x16&p0,f32x16&p1,const char*Kslot,const bf16x8*qr,int r32,int hi){
  const char*kb=Kslot+hi*1024+r32*16;
  #pragma unroll
  for(int d0=0;d0<4;++d0){
    const bf16x8 b0=*reinterpret_cast<const bf16x8*>(kb+d0*2048);
    const bf16x8 b1=*reinterpret_cast<const bf16x8*>(kb+d0*2048+512);
    p0=__builtin_amdgcn_mfma_f32_32x32x16_bf16(b0,qr[d0],p0,0,0,0);p1=__builtin_amdgcn_mfma_f32_32x32x16_bf16(b1,qr[d0],p1,0,0,0);}
}
typedef __attribute__((address_space(3))) const char* lds_cptr;
typedef short v4i16_t __attribute__((ext_vector_type(4)));
__device__ __forceinline__ void kload8(bf16x8*kf,lds_cptr kp){
  kf[0]=*(const __attribute__((address_space(3))) bf16x8*)(kp);      kf[1]=*(const __attribute__((address_space(3))) bf16x8*)(kp+512);
  kf[2]=*(const __attribute__((address_space(3))) bf16x8*)(kp+2048); kf[3]=*(const __attribute__((address_space(3))) bf16x8*)(kp+2560);
  kf[4]=*(const __attribute__((address_space(3))) bf16x8*)(kp+4096); kf[5]=*(const __attribute__((address_space(3))) bf16x8*)(kp+4608);
  kf[6]=*(const __attribute__((address_space(3))) bf16x8*)(kp+6144); kf[7]=*(const __attribute__((address_space(3))) bf16x8*)(kp+6656);
}
__device__ __forceinline__ void kload2(bf16x8*kf,lds_cptr kp,int j){ kf[2*j]=*(const __attribute__((address_space(3))) bf16x8*)(kp+j*2048); kf[2*j+1]=*(const __attribute__((address_space(3))) bf16x8*)(kp+j*2048+512); }
__device__ __forceinline__ s16x4 vtr(lds_cptr p){ return __builtin_bit_cast(s16x4,__builtin_amdgcn_ds_read_tr16_b64_v4i16((__attribute__((address_space(3))) v4i16_t*)p)); }
__device__ __forceinline__ float rowmax(const f32x16&p0,const f32x16&p1){
  float a=max3f(p0[0],p0[1],p1[0]),b=max3f(p0[2],p0[3],p1[1]);a=max3f(a,p1[2],p1[3]);
  #pragma unroll
  for(int r=4;r<16;r+=4){a=max3f(a,p0[r],p0[r+1]);b=max3f(b,p0[r+2],p0[r+3]);a=max3f(a,p1[r],p1[r+1]);b=max3f(b,p1[r+2],p1[r+3]);}
  const float m=max2f(a,b);
  auto rr=__builtin_amdgcn_permlane32_swap(__float_as_uint(m),__float_as_uint(m),false,false);
  return max2f(__uint_as_float(rr[0]),__uint_as_float(rr[1]));
}
__device__ __forceinline__ void pv(f32x16*o,int vb,bf16x8 pa0,bf16x8 pa1,bf16x8 pa2,bf16x8 pa3){
  #pragma unroll
  for(int d0=0;d0<2;++d0){s16x4 lo[4],hi[4];
    #pragma unroll
    for(int ks=0;ks<4;++ks){
      asm volatile("ds_read_b64_tr_b16 %0,%1 offset:%c2":"=&v"(lo[ks]):"v"(vb),"i"(d0*4096+ks*1024):"memory");
      asm volatile("ds_read_b64_tr_b16 %0,%1 offset:%c2":"=&v"(hi[ks]):"v"(vb),"i"(d0*4096+ks*1024+512):"memory");}
    asm volatile("s_waitcnt lgkmcnt(0)":::"memory");SBAR();
    #define PK(k) (bf16x8){lo[k][0],lo[k][1],lo[k][2],lo[k][3],hi[k][0],hi[k][1],hi[k][2],hi[k][3]}
    o[d0]=__builtin_amdgcn_mfma_f32_32x32x16_bf16(pa0,PK(0),o[d0],0,0,0);
    o[d0]=__builtin_amdgcn_mfma_f32_32x32x16_bf16(pa1,PK(1),o[d0],0,0,0);
    o[d0]=__builtin_amdgcn_mfma_f32_32x32x16_bf16(pa2,PK(2),o[d0],0,0,0);
    o[d0]=__builtin_amdgcn_mfma_f32_32x32x16_bf16(pa3,PK(3),o[d0],0,0,0);
    #undef PK
  }
}
template<bool BIAS> __device__ __forceinline__ void cinit(f32x16&c0,f32x16&c1,lds_cptr shm3,int t,int hi,float nmh){
  if constexpr(BIAS){
    const __attribute__((address_space(3))) f32x4* cb4=(const __attribute__((address_space(3))) f32x4*)(shm3+LDS_CB)+t*16+hi;
    #pragma unroll
    for(int g=0;g<4;++g){ const f32x4 b0=cb4[2*g], b1=cb4[8+2*g]; SBAR();
      c0[4*g]=nmh-b0[0]; c0[4*g+1]=nmh-b0[1]; c0[4*g+2]=nmh-b0[2]; c0[4*g+3]=nmh-b0[3];
      c1[4*g]=nmh-b1[0]; c1[4*g+1]=nmh-b1[1]; c1[4*g+2]=nmh-b1[2]; c1[4*g+3]=nmh-b1[3]; SBAR(); }
  } else {
    #pragma unroll
    for(int r=0;r<16;++r){c0[r]=nmh;c1[r]=nmh;}
  }
}
template<int THRL,bool CAUSAL,bool BIAS,int QP,int KP,int OP,bool FIXM=false> __device__ __forceinline__ void attn_unit(const bf16*Qu,const bf16*__restrict__ Ku,const bf16*__restrict__ Vu,bf16*Ou,const float*cbu,const int NT,char*shm,const int tid,const float mfix=0.f){
  const int lane=tid&63,r32=lane&31,hi=lane>>5; const int wid=__builtin_amdgcn_readfirstlane(tid>>6);
  const bf16*Qw=Qu+(long)(wid*QBLK)*QP;
  const unsigned lds0=(unsigned)(uintptr_t)shm;
  float*wsf=(float*)(shm+LDS_WS)+wid*64;
  const bf16*ksrc=Ku+(long)lane*KP+wid*8;
  const bf16*vsrc=Vu+(long)(16*(wid&3)+(lane>>2))*KP+(wid>>2)*32+(lane&3)*8;
  const unsigned kdst=lds0+LDS_K+wid*1024, vdst=lds0+LDS_V+wid*1024;
  #define DMA_K(t,slot) glds16(ksrc+(long)(t)*KVBLK*KP,(unsigned)__builtin_amdgcn_readfirstlane(kdst+(slot)))
  #define DMA_V(t,slot) glds16(vsrc+(long)(t)*KVBLK*KP,(unsigned)__builtin_amdgcn_readfirstlane(vdst+(slot)))
  const int vb0=(int)(lds0+LDS_V)+((lane>>4)&1)*32+(lane&3)*8+(4*hi+((lane&15)>>2))*64;
  const char*Kbase=shm+LDS_K; bf16x8 kf[8];
  const lds_cptr shm3=(lds_cptr)shm; const lds_cptr kp0=shm3+LDS_K+hi*1024+r32*16; const lds_cptr vp0=shm3+LDS_V+((lane>>4)&1)*32+(lane&3)*8+(4*hi+((lane&15)>>2))*64;
  f32x4 cbv0=(f32x4){0.f,0.f,0.f,0.f},cbv1=cbv0;
  if constexpr(BIAS){ const int ncb=NT*16; if(tid<ncb)cbv0=((const f32x4*)cbu)[tid]; if(tid+512<ncb)cbv1=((const f32x4*)cbu)[tid+512]; }
  float cbi_=0.f; if constexpr(BIAS&&FIXM) cbi_=cbu[NT*64-256+wid*QBLK+r32];
  DMA_K(0,0);DMA_V(0,0);DMA_K(1,SLOTB);
  bf16x8 qr[4];
  #pragma unroll
  for(int d0=0;d0<4;++d0)qr[d0]=*reinterpret_cast<const bf16x8*>(&Qw[(long)r32*QP+d0*16+hi*8]);
  { __attribute__((address_space(3))) bf16x8* qw_=(__attribute__((address_space(3))) bf16x8*)((__attribute__((address_space(3))) char*)shm+LDS_OST+wid*4096)+lane;
    qw_[0]=qr[0]; qw_[64]=qr[1]; qw_[128]=qr[2]; qw_[192]=qr[3]; }
  const __attribute__((address_space(3))) bf16x8* qst=(const __attribute__((address_space(3))) bf16x8*)(shm3+LDS_OST+wid*4096)+lane;
  #define QLD(d) qst[(d)*64]
  if constexpr(BIAS){ __attribute__((address_space(3))) f32x4* cbl=(__attribute__((address_space(3))) f32x4*)((__attribute__((address_space(3))) char*)shm+LDS_CB); const int ncb=NT*16; if(tid<ncb)cbl[tid]=cbv0; if(tid+512<ncb)cbl[tid+512]=cbv1; }
  float mhat,nmh,l_reg; asm volatile("v_mov_b32 %0, 0\n\tv_mov_b32 %1, 0\n\tv_mov_b32 %2, 0":"=v"(mhat),"=v"(nmh),"=v"(l_reg));
  if constexpr(FIXM){ mhat=mfix-cbi_; nmh=-mhat; }
  f32x16 o[2];o[0]=f32x16{};o[1]=f32x16{};
  const int qrel=wid*QBLK+r32;
  #define CMASK(P0,P1,t) do{ if(CAUSAL){int jb_=(t)-(NT-4); if(jb_>=0)cmask(P0,P1,jb_,qrel,hi);} }while(0)
  bool resc=false;
  #define START(P0,P1) do{ resc=false; if constexpr(!FIXM){ const float rm=rowmax(P0,P1); \
    { const float dl=rm; mhat=fadd_s(mhat,dl); \
      _Pragma("unroll") for(int r=0;r<16;++r){P0[r]=fsub_s(P0[r],dl);P1[r]=fsub_s(P1[r],dl);} \
      nmh=-mhat; } } \
    _Pragma("unroll") for(int r=0;r<16;++r)P0[r]=__builtin_amdgcn_exp2f(P0[r]); }while(0)
  #define RESC() do{ if(resc){ asm volatile("s_waitcnt lgkmcnt(0)":::"memory"); \
      _Pragma("unroll") for(int d_=0;d_<2;++d_) _Pragma("unroll") for(int r=0;r<16;++r)o[d_][r]*=wsf[crow(r,hi)]; } }while(0)
  f32x16 pA0,pA1,pB0,pB1;
  int sl_prev=0,sl_cur=0,sl_next=SLOTB;
  #define ROT() do{sl_prev=sl_cur;sl_cur=sl_next;sl_next=(sl_next==(NSLOT-1)*SLOTB)?0:sl_next+SLOTB;}while(0)
  DMA_K(2,2*SLOTB);
  WAIT_BAR(3);
  cinit<BIAS>(pA0,pA1,shm3,0,hi,nmh);qkt(pA0,pA1,Kbase,qr,r32,hi);asm volatile("s_nop 15\n\ts_nop 7":"+v"(pA0),"+v"(pA1));CMASK(pA0,pA1,0);
  START(pA0,pA1);
  _Pragma("unroll") for(int r=0;r<16;++r)pA1[r]=__builtin_amdgcn_exp2f(pA1[r]);
  WAIT_BAR(0);
  DMA_K(3,0);DMA_V(1,SLOTB);
  ROT();
  kload8(kf,kp0+sl_cur);
  WAIT_BAR(2);
  s16x4 vlo[8],vhi[8]; u32x4 pw0,pw1,pw2,pw3;
  #define PKW(P,B) cvtpk_s(P[B],P[B+1])
  #define PAF(k) __builtin_bit_cast(bf16x8,pw##k)
  #define VFR(i) (bf16x8){vlo[i][0],vlo[i][1],vlo[i][2],vlo[i][3],vhi[i][0],vhi[i][1],vhi[i][2],vhi[i][3]}
  #define PIN(x) asm volatile("":"+v"(x))
  #define MX3(a,b,c) __builtin_fmaxf(__builtin_fmaxf((a),(b)),(c))
  #define GAPA(MF,A0,A1,A2,A3,W0,W1,PW) do{ MF; sacc+=A0; sacc+=A1; sacc+=A2; sacc+=A3; PIN(sacc); W0; W1; PIN(PW); SBAR(); }while(0)
  #define EX(v) __builtin_amdgcn_exp2f(v)
  #define GAPB(MF,X,B) do{ MF; X[B]=EX(X[B]); X[B+1]=EX(X[B+1]); X[B+2]=EX(X[B+2]); X[B+3]=EX(X[B+3]); PIN(X); SBAR(); }while(0)
  #define VRD(i) do{ vlo[i]=vtr(vp_+(((i)>>2)*4096+((i)&3)*1024)); vhi[i]=vtr(vp_+(((i)>>2)*4096+((i)&3)*1024+512)); }while(0)
  #define KRD(G,j) do{ if(G){ kload2(kf,kp0+sl_next,j); SBAR(); } }while(0)
  #define STEP(C0,C1,P0,P1,t,GK,GV,GL) do{ SBAR(); \
    cinit<BIAS>(C0,C1,shm3,(t),hi,nmh); SBAR(); \
    const lds_cptr vp_=vp0+sl_prev; \
    bf16x8 qa_=QLD(0), qb_=QLD(1); \
    VRD(0); SBAR(); float sacc=(P0[0]+P0[1]); \
    GAPA(C0=__builtin_amdgcn_mfma_f32_32x32x16_bf16(kf[0],qa_,C0,0,0,0), P0[2],P0[3],P0[4],P0[5],     pw0[0]=PKW(P0,0), pw0[1]=PKW(P0,2), pw0); \
    VRD(4); SBAR(); GAPA(C1=__builtin_amdgcn_mfma_f32_32x32x16_bf16(kf[1],qa_,C1,0,0,0), P0[6],P0[7],P0[8],P0[9],     pw0[2]=PKW(P0,4), pw0[3]=PKW(P0,6), pw0); \
    qa_=QLD(2); VRD(1); SBAR(); GAPA(C0=__builtin_amdgcn_mfma_f32_32x32x16_bf16(kf[2],qb_,C0,0,0,0),   P0[10],P0[11],P0[12],P0[13], pw1[0]=PKW(P0,8), pw1[1]=PKW(P0,10), pw1); \
    VRD(5); SBAR(); GAPA(C1=__builtin_amdgcn_mfma_f32_32x32x16_bf16(kf[3],qb_,C1,0,0,0),   P0[14],P0[15],P1[0],P1[1],   pw1[2]=PKW(P0,12),pw1[3]=PKW(P0,14), pw1); \
    qb_=QLD(3); VRD(2); SBAR(); GAPA(C0=__builtin_amdgcn_mfma_f32_32x32x16_bf16(kf[4],qa_,C0,0,0,0),   P1[2],P1[3],P1[4],P1[5],     pw2[0]=PKW(P1,0), pw2[1]=PKW(P1,2), pw2); \
    VRD(6); SBAR(); GAPA(C1=__builtin_amdgcn_mfma_f32_32x32x16_bf16(kf[5],qa_,C1,0,0,0),   P1[6],P1[7],P1[8],P1[9],     pw2[2]=PKW(P1,4), pw2[3]=PKW(P1,6), pw2); \
    VRD(3); SBAR(); GAPA(C0=__builtin_amdgcn_mfma_f32_32x32x16_bf16(kf[6],qb_,C0,0,0,0),   P1[10],P1[11],P1[12],P1[13], pw3[0]=PKW(P1,8), pw3[1]=PKW(P1,10), pw3); \
    VRD(7); SBAR(); GAPA(C1=__builtin_amdgcn_mfma_f32_32x32x16_bf16(kf[7],qb_,C1,0,0,0),   P1[14],P1[15],0.f,0.f,       pw3[2]=PKW(P1,12),pw3[3]=PKW(P1,14), pw3); \
    l_reg+=sacc; \
    if(GK){DMA_K((t)+3,sl_cur);} if(GV){DMA_V((t)+1,sl_next);} \
    CMASK(C0,C1,t); \
    if constexpr(!FIXM) { float a=MX3(C0[0],C0[1],C1[0]),b=MX3(C0[2],C0[3],C1[1]); a=MX3(a,C1[2],C1[3]); \
      _Pragma("unroll") for(int r=4;r<16;r+=4){a=MX3(a,C0[r],C0[r+1]);b=MX3(b,C0[r+2],C0[r+3]);a=MX3(a,C1[r],C1[r+1]);b=MX3(b,C1[r+2],C1[r+3]);} \
      float rm=__builtin_fmaxf(a,b); { auto rr=__builtin_amdgcn_permlane32_swap(__float_as_uint(rm),__float_as_uint(rm),false,false); rm=__builtin_fmaxf(__uint_as_float(rr[0]),__uint_as_float(rr[1])); } \
      resc=false; \
      if(__builtin_expect(__any(rm>(float)THRL),0)){ const float dl=__builtin_fmaxf(rm,0.f); mhat+=dl; \
        _Pragma("unroll") for(int r=0;r<16;++r){C0[r]-=dl;C1[r]-=dl;} \
        nmh=-mhat; \
        const float f=__builtin_amdgcn_exp2f(-dl); l_reg*=f; if(hi==0)wsf[r32]=f; resc=true; } } \
    SBAR(); \
    GAPB(o[0]=__builtin_amdgcn_mfma_f32_32x32x16_bf16(PAF(0),VFR(0),o[0],0,0,0), C0,0); \
    GAPB(o[1]=__builtin_amdgcn_mfma_f32_32x32x16_bf16(PAF(0),VFR(4),o[1],0,0,0), C0,4); \
    KRD(GL,0); GAPB(o[0]=__builtin_amdgcn_mfma_f32_32x32x16_bf16(PAF(1),VFR(1),o[0],0,0,0), C0,8); \
    KRD(GL,1); GAPB(o[1]=__builtin_amdgcn_mfma_f32_32x32x16_bf16(PAF(1),VFR(5),o[1],0,0,0), C0,12); \
    KRD(GL,2); GAPB(o[0]=__builtin_amdgcn_mfma_f32_32x32x16_bf16(PAF(2),VFR(2),o[0],0,0,0), C1,0); \
    KRD(GL,3); GAPB(o[1]=__builtin_amdgcn_mfma_f32_32x32x16_bf16(PAF(2),VFR(6),o[1],0,0,0), C1,4); \
    GAPB(o[0]=__builtin_amdgcn_mfma_f32_32x32x16_bf16(PAF(3),VFR(3),o[0],0,0,0), C1,8); \
    GAPB(o[1]=__builtin_amdgcn_mfma_f32_32x32x16_bf16(PAF(3),VFR(7),o[1],0,0,0), C1,12); \
    }while(0)
  int t=1;
  #undef CMASK
  #define CMASK(P0,P1,t) do{}while(0)
  for(;t+5<NT;t+=2){
    STEP(pB0,pB1,pA0,pA1,t,true,true,true);     WAIT_BAR(2); RESC(); ROT();
    STEP(pA0,pA1,pB0,pB1,t+1,true,true,true);   WAIT_BAR(2); RESC(); ROT();
  }
  #undef CMASK
  #define CMASK(P0,P1,t) do{ if(CAUSAL){int jb_=(t)-(NT-4); if(jb_>=0)cmask(P0,P1,jb_,qrel,hi);} }while(0)
  #define ENDW(tt) do{ if((tt)+3<NT){WAIT_BAR(2);} else if((tt)+2<NT){WAIT_BAR(1);} else {WAIT_BAR(0);} }while(0)
  for(;t+1<NT;t+=2){
    STEP(pB0,pB1,pA0,pA1,t,(t+3<NT),(t+1<NT),(t+1<NT));       ENDW(t);   RESC(); ROT();
    STEP(pA0,pA1,pB0,pB1,t+1,(t+4<NT),(t+2<NT),(t+2<NT));     ENDW(t+1); RESC(); ROT();
  }
  STEP(pB0,pB1,pA0,pA1,NT-1,false,false,false); RESC();
  { float sacc=pB0[0]+pB0[1]; _Pragma("unroll") for(int r=2;r<16;++r)sacc+=pB0[r]; _Pragma("unroll") for(int r=0;r<16;++r)sacc+=pB1[r]; l_reg+=sacc;
    pw0=(u32x4){PKW(pB0,0),PKW(pB0,2),PKW(pB0,4),PKW(pB0,6)};pw1=(u32x4){PKW(pB0,8),PKW(pB0,10),PKW(pB0,12),PKW(pB0,14)};pw2=(u32x4){PKW(pB1,0),PKW(pB1,2),PKW(pB1,4),PKW(pB1,6)};pw3=(u32x4){PKW(pB1,8),PKW(pB1,10),PKW(pB1,12),PKW(pB1,14)};
    SBAR(); pv(o,vb0+sl_cur,PAF(0),PAF(1),PAF(2),PAF(3)); }
  #undef PKW
  #undef PAF
  #undef VFR
  #undef PIN
  #undef MX3
  #undef GAPA
  #undef GAPB
  #undef EX
  #undef VRD
  #undef KRD
  #undef STEP
  #undef ENDW
  {auto rr=__builtin_amdgcn_permlane32_swap(__float_as_uint(l_reg),__float_as_uint(l_reg),false,false);l_reg=__uint_as_float(rr[0])+__uint_as_float(rr[1]);}
  if(hi==0)wsf[32+r32]=l_reg;asm volatile("s_waitcnt lgkmcnt(0)":::"memory");
  float rli[16];
  #pragma unroll
  for(int r=0;r<16;++r)rli[r]=__builtin_amdgcn_rcpf(wsf[32+crow(r,hi)]);
  bf16*Ow=Ou+(long)(wid*QBLK)*OP;
  { bf16*stg=(bf16*)(shm+LDS_OST)+wid*2048;
    #pragma unroll
    for(int r=0;r<16;++r){const int orow=crow(r,hi);
      #pragma unroll
      for(int d0=0;d0<2;++d0)stg[orow*64+d0*32+r32]=__float2bfloat16(o[d0][r]*rli[r]);}
    asm volatile("s_waitcnt lgkmcnt(0)":::"memory");
    #pragma unroll
    for(int i=0;i<4;++i){const int row=i*8+(lane>>3),ch=lane&7; const u32x4 v=*(const u32x4*)(stg+row*64+ch*8); *(u32x4*)(Ow+(long)row*OP+ch*8)=v;} }
  asm volatile("s_waitcnt lgkmcnt(0)\n\ts_barrier":::"memory");
  #undef QLD
  #undef DMA_K
  #undef DMA_V
  #undef CMASK
  #undef START
  #undef RESC
  #undef ROT
}
#undef SBAR
#undef WAIT_BAR
}
constexpr int NWAVES = 8;
constexpr int RING_OFF = 0, RING_BYTES = 131072;
constexpr int LDSCTL_OFF = RING_BYTES, MISC_OFF = LDSCTL_OFF + 320;
constexpr int LDS_BYTES = 147456;
constexpr int ORDTAB_OFF = LDSCTL_OFF + 1024;
static_assert(MISC_OFF + 128 <= LDS_BYTES, "LDS map");
static_assert(attn_body::LDS_BYTES <= RING_BYTES && pg8::STAGE_BYTES <= RING_BYTES, "LDS map");

#define GAS __attribute__((address_space(1)))
#define LAS __attribute__((address_space(3)))
typedef unsigned short bf16;
typedef unsigned v4u __attribute__((ext_vector_type(4)));
typedef unsigned v2u __attribute__((ext_vector_type(2)));
typedef float f32x4 __attribute__((ext_vector_type(4)));
typedef GAS unsigned gu32;
#define RLX_AGENT __ATOMIC_RELAXED, __HIP_MEMORY_SCOPE_AGENT
#define LDS_WAIT() asm volatile("s_waitcnt lgkmcnt(0)" ::: "memory")
#define VM_WAIT() asm volatile("s_waitcnt vmcnt(0)" ::: "memory")
__device__ __forceinline__ unsigned f2bf(float f) { unsigned u = __builtin_bit_cast(unsigned, f); return (u + 0x7fffu + ((u >> 16) & 1u)) >> 16; }
__device__ __forceinline__ unsigned pk2(float lo, float hi) { unsigned r; asm volatile("v_cvt_pk_bf16_f32 %0, %1, %2" : "=v"(r) : "v"(lo), "v"(hi)); return r; }
__device__ __forceinline__ float bflo(unsigned w) { return __builtin_bit_cast(float, w << 16); }
__device__ __forceinline__ float bfhi(unsigned w) { return __builtin_bit_cast(float, w & 0xffff0000u); }

__device__ __forceinline__ unsigned pk4f8(float a, float b, float c, float d) { int p = __builtin_amdgcn_cvt_pk_fp8_f32(a, b, __builtin_bit_cast(int, a), false); p = __builtin_amdgcn_cvt_pk_fp8_f32(c, d, p, true); return (unsigned)p; }
__device__ __forceinline__ float clampf8(float x) { const float c = lconst(448.f); return __builtin_amdgcn_fmed3f(x, -c, c); }

#define XB_TMO      128
#define XB_XCNT(j)  (256  + 64 * (j))
#define XB_XSUB(j)  (1280 + 64 * (j))
#define XB_XGEN(j)  (2304 + 64 * (j))
#define XB_TOP      3328
#define XB_TOPGEN   3392
#define XCD_BAR_WORDS 3456
#define XB_SPIN_CAP (1u << 18)
__device__ __forceinline__ unsigned xb_ld(unsigned* p)              { return __hip_atomic_load(p, __ATOMIC_RELAXED, __HIP_MEMORY_SCOPE_AGENT); }
__device__ __forceinline__ unsigned xb_add(unsigned* p, unsigned v) { unsigned one_; asm volatile("v_mov_b32 %0, 1" : "=v"(one_)); (void)v;
    return __hip_atomic_fetch_add(p, one_, __ATOMIC_RELAXED, __HIP_MEMORY_SCOPE_AGENT); }
__device__ __forceinline__ unsigned ticket_take(gu32* ctr) { unsigned one_, z_; asm volatile("v_mov_b32 %0, 1\n\tv_mov_b32 %1, 0" : "=v"(one_), "=v"(z_));
    return __hip_atomic_fetch_add((gu32*)((GAS char*)ctr + z_), one_, RLX_AGENT); }
__device__ __forceinline__ unsigned xb_xcc_id() { return (unsigned)__builtin_amdgcn_s_getreg((3 << 11) | 20) & 0xFu; }
#define XB_SPIN(cond, bar) do { unsigned _sp = 0; while (cond) { __builtin_amdgcn_s_sleep(1); \
    if ((++_sp & 255u) == 0u) { if (xb_ld(&(bar)[XB_TMO])) break; if (_sp > XB_SPIN_CAP) { atomicAdd(&(bar)[XB_TMO], 1u); break; } } } } while (0)
struct XcdBarrier { unsigned* bar; unsigned x; volatile LAS unsigned* st; };
__device__ __forceinline__ XcdBarrier xcd_barrier_post(unsigned* bar, volatile LAS unsigned* st, const int tid) {
    XcdBarrier b; b.bar = bar; b.x = xb_xcc_id(); b.st = st;
    if (tid == 0) (void)xb_add(&bar[XB_XCNT(b.x)], 1u);
    return b;
}
__device__ __forceinline__ void xcd_barrier_complete(unsigned* bar, unsigned x, unsigned& nloc, unsigned& nx) {
    const unsigned G = gridDim.x * gridDim.y * gridDim.z;
    unsigned sum, cnt, mine, sp = 0u;
    for (;;) {
        sum = 0u; cnt = 0u; mine = 0u;
#pragma unroll
        for (unsigned j = 0; j < 16; ++j) { const unsigned c = xb_ld(&bar[XB_XCNT(j)]); sum += c; cnt += (c > 0u) ? 1u : 0u; }
        mine = xb_ld(&bar[XB_XCNT(x)]);
        if (sum == G) break;
        __builtin_amdgcn_s_sleep(1);
        if ((++sp & 255u) == 0u) { if (xb_ld(&bar[XB_TMO])) break; if (sp > XB_SPIN_CAP) { atomicAdd(&bar[XB_TMO], 1u); break; } }
    }
    nloc = mine > 0u ? mine : 1u; nx = cnt > 0u ? cnt : 1u;
}
__device__ __forceinline__ void xcd_barrier(const XcdBarrier& b, const int tid  ) {
    asm volatile("s_waitcnt vmcnt(0)" ::: "memory");
    __syncthreads();
    if (tid == 0) {
        unsigned* bar = b.bar;
        __builtin_amdgcn_s_waitcnt(0);
        unsigned nloc = b.st[0], nx = b.st[1];
        if (nloc == 0u) { xcd_barrier_complete(bar, b.x, nloc, nx); b.st[0] = nloc; b.st[1] = nx; }
        const unsigned old = xb_add(&bar[XB_XSUB(b.x)], 1u);
        const unsigned gen = old / nloc;
        if (old + 1u == (gen + 1u) * nloc) {
            __builtin_amdgcn_fence(__ATOMIC_RELEASE, "agent");
            asm volatile("s_waitcnt vmcnt(0)" ::: "memory");
            const unsigned og = xb_add(&bar[XB_TOP], 1u);
            const unsigned tg = og / nx;
            if (og + 1u == (tg + 1u) * nx) xb_add(&bar[XB_TOPGEN], 1u);
            else XB_SPIN(xb_ld(&bar[XB_TOPGEN]) == tg, bar);
            __builtin_amdgcn_fence(__ATOMIC_ACQUIRE, "agent");
            xb_add(&bar[XB_XGEN(b.x)], 1u);
            asm volatile("s_waitcnt vmcnt(0)" ::: "memory");
        } else {
            XB_SPIN(xb_ld(&bar[XB_XGEN(b.x)]) == gen, bar);
            __builtin_amdgcn_fence(__ATOMIC_ACQUIRE, "agent");
            asm volatile("s_waitcnt vmcnt(0)" ::: "memory");
        }
    }
    __syncthreads();
}

struct Args { const float* in[27]; float* out; unsigned char* ws; int ph_lo, ph_hi; unsigned mask; int pad; };
struct Frame {
    LAS unsigned char* lds;
    volatile LAS unsigned* MISC;
    gu32* ctl;
    int tid, lane, wave, vcu, G;
    unsigned char* ws;
    const __attribute__((address_space(4))) struct Args* A;
    float* out;
};
__device__ __forceinline__ float lane_xor_f(float v, int m, int lane) { return __builtin_bit_cast(float, __builtin_amdgcn_ds_bpermute((lane ^ m) << 2, __builtin_bit_cast(int, v))); }
__device__ __forceinline__ int lane_up_i(int v, int o, int lane) { return __builtin_amdgcn_ds_bpermute((lane >= o ? lane - o : lane) << 2, v); }
__device__ __forceinline__ double lane_up_d(double v, int o, int lane) { const unsigned long long u = __builtin_bit_cast(unsigned long long, v); const int a = (lane >= o ? lane - o : lane) << 2;
    const unsigned lo = (unsigned)__builtin_amdgcn_ds_bpermute(a, (int)(unsigned)u), hi = (unsigned)__builtin_amdgcn_ds_bpermute(a, (int)(unsigned)(u >> 32)); return __builtin_bit_cast(double, ((unsigned long long)hi << 32) | lo); }
__device__ __forceinline__ double lane_get_d(double v, int src) { const unsigned long long u = __builtin_bit_cast(unsigned long long, v);
    const unsigned lo = (unsigned)__builtin_amdgcn_readlane((int)(unsigned)u, src), hi = (unsigned)__builtin_amdgcn_readlane((int)(unsigned)(u >> 32), src); return __builtin_bit_cast(double, ((unsigned long long)hi << 32) | lo); }
#define DPP_ADD(v, ctrl) ((v) + __builtin_bit_cast(float, __builtin_amdgcn_update_dpp(__builtin_bit_cast(int, (v)), __builtin_bit_cast(int, (v)), (ctrl), 0xf, 0xf, false)))
__device__ __forceinline__ float wave_sum_l(float v, int  ) {
    v = DPP_ADD(v, 0xB1);
    v = DPP_ADD(v, 0x4E);
    v = DPP_ADD(v, 0x141);
    v = DPP_ADD(v, 0x140);
    const float r0 = __builtin_bit_cast(float, __builtin_amdgcn_readlane(__builtin_bit_cast(int, v), 0)), r1 = __builtin_bit_cast(float, __builtin_amdgcn_readlane(__builtin_bit_cast(int, v), 16));
    const float r2 = __builtin_bit_cast(float, __builtin_amdgcn_readlane(__builtin_bit_cast(int, v), 32)), r3 = __builtin_bit_cast(float, __builtin_amdgcn_readlane(__builtin_bit_cast(int, v), 48));
    return (r0 + r1) + (r2 + r3);
}
#define DPP_GET(v, ctrl) __builtin_bit_cast(float, __builtin_amdgcn_update_dpp(__builtin_bit_cast(int, (v)), __builtin_bit_cast(int, (v)), (ctrl), 0xf, 0xf, false))
__device__ __forceinline__ float wave_reduce32(const float (&v)[32], int lane) {
    float u[16], w[8], x[4], y[2];
#pragma unroll
    for (int i = 0; i < 16; ++i) { const auto rr = __builtin_amdgcn_permlane32_swap(__builtin_bit_cast(unsigned, v[i]), __builtin_bit_cast(unsigned, v[i + 16]), false, false);
        u[i] = __builtin_bit_cast(float, (unsigned)rr[0]) + __builtin_bit_cast(float, (unsigned)rr[1]); }
#pragma unroll
    for (int i = 0; i < 8; ++i) { const auto rr = __builtin_amdgcn_permlane16_swap(__builtin_bit_cast(unsigned, u[i]), __builtin_bit_cast(unsigned, u[i + 8]), false, false);
        w[i] = __builtin_bit_cast(float, (unsigned)rr[0]) + __builtin_bit_cast(float, (unsigned)rr[1]); }
    const bool b3 = (lane & 8) != 0, b2 = (lane & 4) != 0, b1 = (lane & 2) != 0;
#pragma unroll
    for (int i = 0; i < 4; ++i) { const float keep = b3 ? w[i + 4] : w[i], give = b3 ? w[i] : w[i + 4]; x[i] = keep + DPP_GET(give, 0x140); }
#pragma unroll
    for (int i = 0; i < 2; ++i) { const float keep = b2 ? x[i + 2] : x[i], give = b2 ? x[i] : x[i + 2]; y[i] = keep + DPP_GET(give, 0x141); }
    float z; { const float keep = b1 ? y[1] : y[0], give = b1 ? y[0] : y[1]; z = keep + DPP_GET(give, 0x4E); }
    z = z + DPP_GET(z, 0xB1);
    return z;
}
#define SWAP32_ADD(a, b) ([&]() { const auto rr_ = __builtin_amdgcn_permlane32_swap(__builtin_bit_cast(unsigned, (a)), __builtin_bit_cast(unsigned, (b)), false, false); return __builtin_bit_cast(float, (unsigned)rr_[0]) + __builtin_bit_cast(float, (unsigned)rr_[1]); }())
#define SWAP16_ADD(a, b) ([&]() { const auto rr_ = __builtin_amdgcn_permlane16_swap(__builtin_bit_cast(unsigned, (a)), __builtin_bit_cast(unsigned, (b)), false, false); return __builtin_bit_cast(float, (unsigned)rr_[0]) + __builtin_bit_cast(float, (unsigned)rr_[1]); }())
__device__ __forceinline__ float wave_reduce16(const float (&v)[16], int lane) {
    float u[8], w[4], x[2];
#pragma unroll
    for (int i = 0; i < 8; ++i) u[i] = SWAP32_ADD(v[i], v[i + 8]);
#pragma unroll
    for (int i = 0; i < 4; ++i) w[i] = SWAP16_ADD(u[i], u[i + 4]);
    const bool b3 = (lane & 8) != 0, b2 = (lane & 4) != 0;
#pragma unroll
    for (int i = 0; i < 2; ++i) { const float keep = b3 ? w[i + 2] : w[i], give = b3 ? w[i] : w[i + 2]; x[i] = keep + DPP_GET(give, 0x140); }
    float z; { const float keep = b2 ? x[1] : x[0], give = b2 ? x[0] : x[1]; z = keep + DPP_GET(give, 0x141); }
    z = z + DPP_GET(z, 0x4E); z = z + DPP_GET(z, 0xB1);
    return z;
}
__device__ __forceinline__ float wave_reduce8(const float (&v)[8], int lane) {
    float u[4], w[2];
#pragma unroll
    for (int i = 0; i < 4; ++i) u[i] = SWAP32_ADD(v[i], v[i + 4]);
#pragma unroll
    for (int i = 0; i < 2; ++i) w[i] = SWAP16_ADD(u[i], u[i + 2]);
    const bool b3 = (lane & 8) != 0;
    float z; { const float keep = b3 ? w[1] : w[0], give = b3 ? w[0] : w[1]; z = keep + DPP_GET(give, 0x140); }
    z = z + DPP_GET(z, 0x141); z = z + DPP_GET(z, 0x4E); z = z + DPP_GET(z, 0xB1);
    return z;
}
#if BRINGUP
__device__ __forceinline__ float wave_sum(float v) {
#pragma unroll
    for (int o = 1; o < 64; o <<= 1) v += __shfl_xor(v, o);
    return v;
}
#endif

__device__ __forceinline__ void cvt_finish16(const f32x4 (&t)[8], bf16* dst, int K, LAS float* scr, int lane, const float* gk  ) {
    { const int kr = lane >> 3, c4 = (lane & 7) * 4;
#pragma unroll
      for (int i = 0; i < 8; ++i) { const int kk = 8 * i + kr; const float gg = gk ? gk[kk] : 1.0f; LAS float* d = scr + kk * 33 + c4; d[0] = t[i].x * gg; d[1] = t[i].y * gg; d[2] = t[i].z * gg; d[3] = t[i].w * gg; } }
    LDS_WAIT(); asm volatile("" ::: "memory");
    const int c = lane & 7;
#pragma unroll
    for (int j = 0; j < 4; ++j) { const int n = (lane >> 3) + 8 * j; const LAS float* s = scr + (8 * c) * 33 + n;
        v4u o; o.x = pk2(s[0 * 33], s[1 * 33]); o.y = pk2(s[2 * 33], s[3 * 33]); o.z = pk2(s[4 * 33], s[5 * 33]); o.w = pk2(s[6 * 33], s[7 * 33]);
        *(GAS v4u*)(dst + (size_t)n * K + 8 * c) = o; }
    LDS_WAIT(); asm volatile("" ::: "memory");
}
__device__ __forceinline__ void cvt8_finish_g(const f32x4 (&t)[8], unsigned char* dst, int Kb, LAS float* scr, int lane, float qs, const float* gk) {
    { const int kr = lane >> 3, c4 = (lane & 7) * 4;
#pragma unroll
      for (int i = 0; i < 8; ++i) { const float gg = gk ? gk[8 * i + kr] : 1.0f; LAS float* d = scr + (8 * i + kr) * 33 + c4; d[0] = t[i].x * gg; d[1] = t[i].y * gg; d[2] = t[i].z * gg; d[3] = t[i].w * gg; } }
    LDS_WAIT(); asm volatile("" ::: "memory");
    const int n = lane >> 1, h = lane & 1; const LAS float* s = scr + (32 * h) * 33 + n;
    v4u o0, o1;
    o0.x = pk4f8(s[0 * 33] * qs, s[1 * 33] * qs, s[2 * 33] * qs, s[3 * 33] * qs);     o0.y = pk4f8(s[4 * 33] * qs, s[5 * 33] * qs, s[6 * 33] * qs, s[7 * 33] * qs);
    o0.z = pk4f8(s[8 * 33] * qs, s[9 * 33] * qs, s[10 * 33] * qs, s[11 * 33] * qs);   o0.w = pk4f8(s[12 * 33] * qs, s[13 * 33] * qs, s[14 * 33] * qs, s[15 * 33] * qs);
    o1.x = pk4f8(s[16 * 33] * qs, s[17 * 33] * qs, s[18 * 33] * qs, s[19 * 33] * qs); o1.y = pk4f8(s[20 * 33] * qs, s[21 * 33] * qs, s[22 * 33] * qs, s[23 * 33] * qs);
    o1.z = pk4f8(s[24 * 33] * qs, s[25 * 33] * qs, s[26 * 33] * qs, s[27 * 33] * qs); o1.w = pk4f8(s[28 * 33] * qs, s[29 * 33] * qs, s[30 * 33] * qs, s[31 * 33] * qs);
    GAS v4u* d = (GAS v4u*)(dst + (size_t)n * Kb + 32 * h); d[0] = o0; d[1] = o1;
    LDS_WAIT(); asm volatile("" ::: "memory");
}
__device__ __forceinline__ void cvt_block(const float* src, int ldw, bf16* dst, int K, LAS float* scr, int lane, const float* gk  ) {
    { const int kr = lane >> 3, c4 = (lane & 7) * 4; f32x4 t[8];
#pragma unroll
      for (int i = 0; i < 8; ++i) t[i] = *(const GAS f32x4*)(src + (size_t)(8 * i + kr) * ldw + c4);
#pragma unroll
      for (int i = 0; i < 8; ++i) { const int kk = 8 * i + kr; const float gg = gk ? gk[kk] : 1.0f; LAS float* d = scr + kk * 33 + c4; d[0] = t[i].x * gg; d[1] = t[i].y * gg; d[2] = t[i].z * gg; d[3] = t[i].w * gg; } }
    LDS_WAIT(); asm volatile("" ::: "memory");
    const int c = lane & 7;
#pragma unroll
    for (int j = 0; j < 4; ++j) { const int n = (lane >> 3) + 8 * j; const LAS float* s = scr + (8 * c) * 33 + n;
        v4u o; o.x = pk2(s[0 * 33], s[1 * 33]); o.y = pk2(s[2 * 33], s[3 * 33]); o.z = pk2(s[4 * 33], s[5 * 33]); o.w = pk2(s[6 * 33], s[7 * 33]);
        *(GAS v4u*)(dst + (size_t)n * K + 8 * c) = o; }
    LDS_WAIT(); asm volatile("" ::: "memory");
}
__device__ __forceinline__ void cvt_block8(const float* src, int ldw, unsigned char* dst, int Kb, LAS float* scr, int lane, float qs, const float* gk) {
    { const int kr = lane >> 3, c4 = (lane & 7) * 4; f32x4 t[8];
#pragma unroll
      for (int i = 0; i < 8; ++i) t[i] = *(const GAS f32x4*)(src + (size_t)(8 * i + kr) * ldw + c4);
#pragma unroll
      for (int i = 0; i < 8; ++i) { const float gg = gk ? gk[8 * i + kr] : 1.0f; LAS float* d = scr + (8 * i + kr) * 33 + c4; d[0] = t[i].x * gg; d[1] = t[i].y * gg; d[2] = t[i].z * gg; d[3] = t[i].w * gg; } }
    LDS_WAIT(); asm volatile("" ::: "memory");
    const int n = lane >> 1, h = lane & 1; const LAS float* s = scr + (32 * h) * 33 + n;
    v4u o0, o1;
    o0.x = pk4f8(s[0 * 33] * qs, s[1 * 33] * qs, s[2 * 33] * qs, s[3 * 33] * qs);     o0.y = pk4f8(s[4 * 33] * qs, s[5 * 33] * qs, s[6 * 33] * qs, s[7 * 33] * qs);
    o0.z = pk4f8(s[8 * 33] * qs, s[9 * 33] * qs, s[10 * 33] * qs, s[11 * 33] * qs);   o0.w = pk4f8(s[12 * 33] * qs, s[13 * 33] * qs, s[14 * 33] * qs, s[15 * 33] * qs);
    o1.x = pk4f8(s[16 * 33] * qs, s[17 * 33] * qs, s[18 * 33] * qs, s[19 * 33] * qs); o1.y = pk4f8(s[20 * 33] * qs, s[21 * 33] * qs, s[22 * 33] * qs, s[23 * 33] * qs);
    o1.z = pk4f8(s[24 * 33] * qs, s[25 * 33] * qs, s[26 * 33] * qs, s[27 * 33] * qs); o1.w = pk4f8(s[28 * 33] * qs, s[29 * 33] * qs, s[30 * 33] * qs, s[31 * 33] * qs);
    GAS v4u* d = (GAS v4u*)(dst + (size_t)n * Kb + 32 * h); d[0] = o0; d[1] = o1;
    LDS_WAIT(); asm volatile("" ::: "memory");
}
__device__ __forceinline__ void cvt8_load(f32x4 (&t)[8], const float* src, int ldw, int lane) {
    const int kr = lane >> 3, c4 = (lane & 7) * 4;
    const unsigned voff = (unsigned)(kr * ldw + c4) * 4u;
#pragma unroll
    for (int i = 0; i < 8; ++i) t[i] = *(const GAS f32x4*)((const GAS char*)(src + (size_t)(8 * i) * ldw) + voff);
}
__device__ __forceinline__ void cvt8_finish(const f32x4 (&t)[8], unsigned char* dst, int Kb, LAS float* scr, int lane, float qs) {
    { const int kr = lane >> 3, c4 = (lane & 7) * 4;
#pragma unroll
      for (int i = 0; i < 8; ++i) { LAS float* d = scr + (8 * i + kr) * 33 + c4; d[0] = t[i].x; d[1] = t[i].y; d[2] = t[i].z; d[3] = t[i].w; } }
    LDS_WAIT(); asm volatile("" ::: "memory");
    const int n = lane >> 1, h = lane & 1; const LAS float* s = scr + (32 * h) * 33 + n;
    v4u o0, o1;
    o0.x = pk4f8(s[0 * 33] * qs, s[1 * 33] * qs, s[2 * 33] * qs, s[3 * 33] * qs);     o0.y = pk4f8(s[4 * 33] * qs, s[5 * 33] * qs, s[6 * 33] * qs, s[7 * 33] * qs);
    o0.z = pk4f8(s[8 * 33] * qs, s[9 * 33] * qs, s[10 * 33] * qs, s[11 * 33] * qs);   o0.w = pk4f8(s[12 * 33] * qs, s[13 * 33] * qs, s[14 * 33] * qs, s[15 * 33] * qs);
    o1.x = pk4f8(s[16 * 33] * qs, s[17 * 33] * qs, s[18 * 33] * qs, s[19 * 33] * qs); o1.y = pk4f8(s[20 * 33] * qs, s[21 * 33] * qs, s[22 * 33] * qs, s[23 * 33] * qs);
    o1.z = pk4f8(s[24 * 33] * qs, s[25 * 33] * qs, s[26 * 33] * qs, s[27 * 33] * qs); o1.w = pk4f8(s[28 * 33] * qs, s[29 * 33] * qs, s[30 * 33] * qs, s[31 * 33] * qs);
    GAS v4u* d = (GAS v4u*)(dst + (size_t)n * Kb + 32 * h); d[0] = o0; d[1] = o1;
    LDS_WAIT(); asm volatile("" ::: "memory");
}
__device__ __forceinline__ void cvt_matrix(Frame& F, const float* src, const float* src2, int ldw, bf16* dst, int K, int N, int kind, int nrep, size_t sstride, size_t dstride, float qs = 0.f  , const float* gain = nullptr  , int* rot = nullptr  ) {
    LAS float* scr = (LAS float*)(F.lds + RING_OFF + F.wave * 16384);
    const int NGW = F.G * NWAVES;
    const int nb_n = N / 32, per = nb_n * (K / 64), total = per * nrep;
    int gw = F.vcu * NWAVES + F.wave; if (rot) { gw -= *rot % NGW; if (gw < 0) gw += NGW; *rot += total; }
    auto locate = [&](int it, const float*& sp, size_t& doff, int& kbo) {
        const int rep = it / per, loc = it - rep * per, kb = loc / nb_n, nb = loc - kb * nb_n;
        const int n0 = 32 * nb, pn = n0 >> 8, rho = n0 & 255, bj = rho >> 7, wc = (rho & 127) >> 5;
        const float* s = src; int col;
        if (kind == 0) col = n0;
        else if (kind == 1) { const int L = 256 * pn + 64 * wc + 32 * bj; col = L < 3 * FOXD ? L : L + NH; }
        else if (kind == 2) col = 256 * pn + 64 * wc + 32 * bj;
        else if (kind == 3) { col = 128 * pn + (rho & 127); if (bj) s = src2; }
        else { col = pn < 6 ? 128 * pn + (rho & 127) + (bj ? CONVD : 0) : 2 * CONVD + 64 * wc + 32 * bj; }
        sp = s + (size_t)rep * sstride + (size_t)(64 * kb) * ldw + col; doff = (size_t)rep * dstride + (size_t)n0 * K + 64 * kb; kbo = kb; };
    auto finish = [&](const f32x4 (&t)[8], size_t doff, int kb) {
        if (qs != 0.f) cvt8_finish_g(t, (unsigned char*)dst + doff, K, scr, F.lane, qs, gain ? gain + 64 * kb : nullptr);
        else cvt_finish16(t, dst + doff, K, scr, F.lane, gain ? gain + 64 * kb : nullptr); };
    for (int it = gw; it < total; it += 2 * NGW) {
        const int it2 = it + NGW; const bool two = it2 < total;
        const float* sA; size_t dA; int kA; locate(it, sA, dA, kA);
        const float* sB = sA; size_t dB = dA; int kB = kA; if (two) locate(it2, sB, dB, kB);
        f32x4 tA[8], tB[8]; cvt8_load(tA, sA, ldw, F.lane); cvt8_load(tB, sB, ldw, F.lane);
        finish(tA, dA, kA); if (two) finish(tB, dB, kB);
    }
}
__device__ __forceinline__ void convert_moe(Frame& F, int j) {
    cvt_matrix(F, F.A->in[24] + (size_t)j * NE * DM * EFF, F.A->in[25] + (size_t)j * NE * DM * EFF, EFF, (bf16*)(F.ws + WS_WMGU + (size_t)j * WS_WM_LAYER), DM, 2 * EFF, 3, NE, (size_t)DM * EFF, (size_t)2 * EFF * DM, WSC_GU);
    cvt_matrix(F, F.A->in[26] + (size_t)j * NE * EFF * DM, nullptr, DM, (bf16*)(F.ws + WS_WMD + (size_t)j * WS_WM_LAYER), EFF, DM, 0, NE, (size_t)EFF * DM, (size_t)DM * EFF, WSC_D);
}
constexpr int MOE_GU_ITEMS = NE * (2 * EFF / 32) * (DM / 64), MOE_D_ITEMS = NE * (DM / 32) * (EFF / 64), MOE_BATCH = 4;
__device__ __forceinline__ void convert_moe_queue(Frame& F, int j, gu32* ctr, int maxr = 1 << 30  ) {
    LAS float* scr = (LAS float*)(F.lds + RING_OFF + F.wave * 16384);
    const float* wg = F.A->in[24] + (size_t)j * NE * DM * EFF; const float* wu = F.A->in[25] + (size_t)j * NE * DM * EFF; const float* wd = F.A->in[26] + (size_t)j * NE * EFF * DM;
    unsigned char* dgu = F.ws + WS_WMGU + (size_t)j * WS_WM_LAYER; unsigned char* dd = F.ws + WS_WMD + (size_t)j * WS_WM_LAYER;
    LAS unsigned* tk = (LAS unsigned*)(F.lds + RING_OFF + 12288);
    constexpr unsigned NBATCH = (MOE_GU_ITEMS + MOE_D_ITEMS) / MOE_BATCH; static_assert(NBATCH % NWAVES == 0, "ticket shape");
    if (F.tid == 0) tk[0] = ticket_take(ctr);
    __syncthreads();
    for (int r = 0; r < maxr; ++r) {
        const unsigned t8 = (unsigned)__builtin_amdgcn_readfirstlane((int)tk[r & 1]);
        if (t8 * NWAVES >= NBATCH) break;
        unsigned nxt_ = 0; if (F.tid == 0 && r + 1 < maxr) nxt_ = ticket_take(ctr);
        const unsigned bt = t8 * NWAVES + (unsigned)F.wave;
        f32x4 tb[MOE_BATCH][8]; unsigned char* dp[MOE_BATCH]; int kbt[MOE_BATCH]; float qsb[MOE_BATCH];
        static_assert(MOE_BATCH == 4 && MOE_GU_ITEMS % 4 == 0 && MOE_D_ITEMS % 4 == 0, "batch shape");
#pragma unroll
        for (int k = 0; k < MOE_BATCH; ++k) { int b = (int)bt;
            if (b < MOE_GU_ITEMS / 4) {
                constexpr int nb_n = 2 * EFF / 32, perb = (nb_n / 2) * (DM / 128);
                const int rep = b / perb, loc = b - rep * perb, kb2 = loc / (nb_n / 2), nb2 = loc - kb2 * (nb_n / 2), kb = 2 * kb2 + (k >> 1), nb = 2 * nb2 + (k & 1), n0 = 32 * nb, pn = n0 >> 8, rho = n0 & 255, bj = rho >> 7;
                cvt8_load(tb[k], (bj ? wu : wg) + (size_t)rep * DM * EFF + (size_t)(64 * kb) * EFF + 128 * pn + (rho & 127), EFF, F.lane);
                dp[k] = dgu + (size_t)rep * (2 * EFF * DM) + (size_t)n0 * DM + 64 * kb; kbt[k] = DM; qsb[k] = WSC_GU;
            } else { b -= MOE_GU_ITEMS / 4;
                constexpr int nb_n = DM / 32, perb = (nb_n / 2) * (EFF / 128);
                const int rep = b / perb, loc = b - rep * perb, kb2 = loc / (nb_n / 2), nb2 = loc - kb2 * (nb_n / 2), kb = 2 * kb2 + (k >> 1), nb = 2 * nb2 + (k & 1), n0 = 32 * nb;
                cvt8_load(tb[k], wd + (size_t)rep * EFF * DM + (size_t)(64 * kb) * DM + n0, DM, F.lane);
                dp[k] = dd + (size_t)rep * (DM * EFF) + (size_t)n0 * EFF + 64 * kb; kbt[k] = EFF; qsb[k] = WSC_D; }
        }
        if (F.tid == 0) tk[(r + 1) & 1] = nxt_;
#pragma unroll
        for (int k = 0; k < MOE_BATCH; ++k) cvt8_finish(tb[k], dp[k], kbt[k], scr, F.lane, qsb[k]);
        __syncthreads();
    }
}
__device__ __forceinline__ void phase_prologue(Frame& F) {
    int rot = 0;
#pragma unroll 1
    for (int jq = 0; jq < 2; ++jq) { int j = jq; asm volatile("" : "+s"(j));
        if ((IN8L2 && j == 1) || (IN8L0 && j == 0)) cvt_matrix(F, F.A->in[8] + (size_t)j * DM * FOXIN, nullptr, FOXIN, (bf16*)(F.ws + WS_WINE + (size_t)j * 2560 * DM * 2), DM, 2560, 1, 1, 0, 0, WSC_GU, nullptr, &rot);
        else cvt_matrix(F, F.A->in[8] + (size_t)j * DM * FOXIN, nullptr, FOXIN, (bf16*)(F.ws + WS_WINE) + (size_t)j * 2560 * DM, DM, 2560, 1, 1, 0, 0, 0.f, nullptr, &rot);
        cvt_matrix(F, F.A->in[12] + (size_t)j * DM * DM, nullptr, DM, (bf16*)(F.ws + WS_WOUTE) + (size_t)j * DM * DM, DM, DM, 0, 1, 0, 0, 0.f, nullptr, &rot);
        if ((IN8ODD >> j) & 1) cvt_matrix(F, F.A->in[13] + (size_t)j * DM * CONVIN, nullptr, CONVIN, (bf16*)(F.ws + WS_WINO + (size_t)j * CONVIN * DM * 2), DM, CONVIN, 4, 1, 0, 0, WSC_GU, F.A->in[2] + (size_t)(2 * j + 1) * DM, &rot);
        else cvt_matrix(F, F.A->in[13] + (size_t)j * DM * CONVIN, nullptr, CONVIN, (bf16*)(F.ws + WS_WINO) + (size_t)j * CONVIN * DM, DM, CONVIN, 4, 1, 0, 0, 0.f, (FUSENORM && !BRINGUP) ? F.A->in[2] + (size_t)(2 * j + 1) * DM : nullptr, &rot);
        cvt_matrix(F, F.A->in[19] + (size_t)j * DM * DM, nullptr, DM, (bf16*)(F.ws + WS_WOUTO) + (size_t)j * DM * DM, DM, DM, 0, 1, 0, 0, 0.f, nullptr, &rot);
        const bool d8_ = DENSE8 == 1 || (DENSE8 == 2 && j == 1), u8_ = d8_ || (UP8L0 && j == 0);
        if (u8_) cvt_matrix(F, F.A->in[20] + (size_t)j * DM * FF, F.A->in[21] + (size_t)j * DM * FF, FF, (bf16*)(F.ws + WS_WGU + (size_t)j * 2 * FF * DM * 2), DM, 2 * FF, 3, 1, 0, 0, WSC_GU, (FUSENORM && !BRINGUP) ? F.A->in[4] + (size_t)(2 * j) * DM : nullptr, &rot);
        else cvt_matrix(F, F.A->in[20] + (size_t)j * DM * FF, F.A->in[21] + (size_t)j * DM * FF, FF, (bf16*)(F.ws + WS_WGU) + (size_t)j * 2 * FF * DM, DM, 2 * FF, 3, 1, 0, 0, 0.f, (FUSENORM && !BRINGUP) ? F.A->in[4] + (size_t)(2 * j) * DM : nullptr, &rot);
        if (d8_) cvt_matrix(F, F.A->in[22] + (size_t)j * FF * DM, nullptr, DM, (bf16*)(F.ws + WS_WD + (size_t)j * DM * FF * 2), FF, DM, 0, 1, 0, 0, WSC_D, nullptr, &rot);
        else cvt_matrix(F, F.A->in[22] + (size_t)j * FF * DM, nullptr, DM, (bf16*)(F.ws + WS_WD) + (size_t)j * DM * FF, FF, DM, 0, 1, 0, 0, 0.f, nullptr, &rot);
    }
    cvt_matrix(F, F.A->in[5], nullptr, 2 * MEMD, (bf16*)(F.ws + WS_WKV), DM, 2 * MEMD, 2, 4, (size_t)DM * 2 * MEMD, (size_t)2 * MEMD * DM, 0.f, nullptr, &rot);
#if !MOEQ
    convert_moe(F, 0); convert_moe(F, 1);
#endif
    if (F.vcu == 0) { float* gt = (float*)(F.ws + WS_GT);
        for (int idx = F.tid; idx < 4 * 3 * 64; idx += NWAVES * 64) { const int L = idx / 192, r = (idx / 64) % 3, c = idx & 63, jj = L >> 1;
            gt[idx] = r == 0 ? F.A->in[10][jj * HD + c] * C2 : (r == 1 ? F.A->in[11][jj * HD + c] : F.A->in[6][L * HD + c] * C2); }
        if (F.wave == 0) for (int jj = 0; jj < 2; ++jj) { float mq = fabsf(F.A->in[10][jj * HD + F.lane]), mk = fabsf(F.A->in[11][jj * HD + F.lane]);
#pragma unroll
            for (int o = 1; o < 64; o <<= 1) { mq = fmaxf(mq, lane_xor_f(mq, o, F.lane)); mk = fmaxf(mk, lane_xor_f(mk, o, F.lane)); }
            if (F.lane == 0) gt[1024 + jj] = 2.0f * (64.0f * C2 * mq * mk) + 40.0f; } }
    const int gw = F.vcu * NWAVES + F.wave, NGW = F.G * NWAVES;
    for (int r = gw; r < BATCH * ML; r += NGW) {
        const GAS f32x4* xr = (const GAS f32x4*)(F.A->in[1] + (size_t)r * DM) + F.lane;
        f32x4 v[4]; float ss = 0.f;
#pragma unroll
        for (int j = 0; j < 4; ++j) { v[j] = xr[64 * j]; ss += (v[j].x * v[j].x + v[j].y * v[j].y) + (v[j].z * v[j].z + v[j].w * v[j].w); }
        const float rs = __builtin_amdgcn_rsqf(wave_sum_l(ss, F.lane) * (1.0f / DM) + lconst(RMS_EPS));
        for (int i = 0; i < 4; ++i) {
            const f32x4* gp = (const f32x4*)(F.A->in[3] + (size_t)i * DM) + F.lane;
            GAS v2u* o8 = (GAS v2u*)((bf16*)(F.ws + WS_MEMN) + ((size_t)i * BATCH * ML + r) * DM) + F.lane;
#pragma unroll
            for (int j = 0; j < 4; ++j) { const f32x4 g = gp[64 * j]; v2u w; w.x = pk2(v[j].x * rs * g.x, v[j].y * rs * g.y); w.y = pk2(v[j].z * rs * g.z, v[j].w * rs * g.w); o8[64 * j] = w; }
        }
    }
}

__device__ __forceinline__ void phase_norm(Frame& F, const float* src32  , bf16* h16, const float* gain, int kind, bool combine, const float* wx  , const float* bf  , bool f8out = false) {
    LAS float* wl = (LAS float*)(F.lds + RING_OFF);
    LAS int* wcnt = (LAS int*)(F.lds + RING_OFF + 65536);
    __syncthreads();
    static_assert(DM == 2 * NWAVES * 64 && NH == 12 && NE == 8 && (FOXIN * 4) % 16 == 0 && (3 * FOXD * 4) % 16 == 0, "weight staging shape");
    if (kind == 1) { f32x4 r[2][3];
#pragma unroll
        for (int q = 0; q < 2; ++q) { const GAS f32x4* src = (const GAS f32x4*)(wx + (size_t)(F.tid + 512 * q) * FOXIN + 3 * FOXD);
#pragma unroll
            for (int c = 0; c < 3; ++c) r[q][c] = src[c]; }
#pragma unroll
        for (int q = 0; q < 2; ++q)
#pragma unroll
            for (int c = 0; c < 3; ++c)
#pragma unroll
                for (int e = 0; e < 4; ++e) wl[(4 * c + e) * DM + F.tid + 512 * q] = r[q][c][e]; }
    if (kind == 2) { f32x4 r[2][2];
#pragma unroll
        for (int q = 0; q < 2; ++q) { const GAS f32x4* src = (const GAS f32x4*)(wx + (size_t)(F.tid + 512 * q) * NE); r[q][0] = src[0]; r[q][1] = src[1]; }
#pragma unroll
        for (int q = 0; q < 2; ++q)
#pragma unroll
            for (int c = 0; c < 2; ++c)
#pragma unroll
                for (int e = 0; e < 4; ++e) wl[(4 * c + e) * DM + F.tid + 512 * q] = r[q][c][e]; }
    __syncthreads();
    f32x4 g[4];
#pragma unroll
    for (int j = 0; j < 4; ++j) g[j] = ((const f32x4*)gain)[64 * j + F.lane];
    bf16* UB = (bf16*)(F.ws + WS_UB);
    const bf16* Y = (const bf16*)(F.ws + WS_XS);
    const int* SLOT = (const int*)(F.ws + WS_SLOT);
    for (int chunk = F.vcu; chunk < T / 128; chunk += F.G) {
        int cnt[NE];
#pragma unroll
        for (int e = 0; e < NE; ++e) cnt[e] = 0;
        const int mb = chunk * 128 + F.wave * 16;
        f32x4 n32[4]; v2u n16[4], na[4], nb[4];
        auto issue = [&](int m, int s0, int s1) {
            if (src32) { const GAS f32x4* xr = (const GAS f32x4*)(src32 + (size_t)m * DM) + F.lane;
#pragma unroll
                for (int j = 0; j < 4; ++j) n32[j] = xr[64 * j]; }
            else { const GAS v2u* hr = (const GAS v2u*)(h16 + (size_t)m * DM) + F.lane;
#pragma unroll
                for (int j = 0; j < 4; ++j) n16[j] = hr[64 * j]; }
            if (combine) { const GAS v2u* y0 = (const GAS v2u*)(Y + (size_t)s0 * DM) + F.lane; const GAS v2u* y1 = (const GAS v2u*)(Y + (size_t)s1 * DM) + F.lane;
#pragma unroll
                for (int j = 0; j < 4; ++j) { na[j] = y0[64 * j]; nb[j] = y1[64 * j]; } } };
        const int l1 = F.lane & 1; int fv = 0;
        { int v0 = 0; if (combine) { v0 = ((const GAS int*)SLOT)[2 * mb + l1]; fv = ((const GAS int*)SLOT)[2 * mb + 2 + l1]; }
          issue(mb, __builtin_amdgcn_readlane(v0, 0), __builtin_amdgcn_readlane(v0, 1)); }
#pragma unroll 1
        for (int i = 0; i < 16; ++i) {
            const int m = mb + i;
            f32x4 v[4];
            if (src32) {
#pragma unroll
                for (int j = 0; j < 4; ++j) v[j] = n32[j]; }
            else {
#pragma unroll
                for (int j = 0; j < 4; ++j) v[j] = (f32x4){bflo(n16[j].x), bfhi(n16[j].x), bflo(n16[j].y), bfhi(n16[j].y)}; }
            v2u ca[4], cb_[4];
            if (combine) {
#pragma unroll
                for (int j = 0; j < 4; ++j) { ca[j] = na[j]; cb_[j] = nb[j]; } }
            if (i + 1 < 16) { const int vc = fv;
                if (combine && i + 2 < 16) fv = ((const GAS int*)SLOT)[2 * m + 4 + l1];
                issue(m + 1, __builtin_amdgcn_readlane(vc, 0), __builtin_amdgcn_readlane(vc, 1)); }
            if (combine) {
                GAS v2u* ho = (GAS v2u*)(h16 + (size_t)m * DM) + F.lane;
#pragma unroll
                for (int j = 0; j < 4; ++j) { const v2u a = ca[j], b = cb_[j];
                    v[j].x += bflo(a.x) + bflo(b.x); v[j].y += bfhi(a.x) + bfhi(b.x); v[j].z += bflo(a.y) + bflo(b.y); v[j].w += bfhi(a.y) + bfhi(b.y);
                    v2u w; w.x = pk2(v[j].x, v[j].y); w.y = pk2(v[j].z, v[j].w); ho[64 * j] = w;
                    v[j] = (f32x4){bflo(w.x), bfhi(w.x), bflo(w.y), bfhi(w.y)}; }
            }
            float ss = 0.f;
#pragma unroll
            for (int j = 0; j < 4; ++j) ss += (v[j].x * v[j].x + v[j].y * v[j].y) + (v[j].z * v[j].z + v[j].w * v[j].w);
            const float rs = __builtin_amdgcn_rsqf(wave_sum_l(ss, F.lane) * (1.0f / DM) + lconst(RMS_EPS));
            GAS v2u* o8 = (GAS v2u*)(UB + (size_t)m * DM) + F.lane; GAS unsigned* o4 = (GAS unsigned*)((unsigned char*)UB + (size_t)m * DM) + F.lane;
#pragma unroll
            for (int j = 0; j < 4; ++j) { v[j] = v[j] * rs * g[j];
                if (kind == 2 || f8out) o4[64 * j] = pk4f8(clampf8(v[j].x * ASC_Z), clampf8(v[j].y * ASC_Z), clampf8(v[j].z * ASC_Z), clampf8(v[j].w * ASC_Z));
                else { v2u w; w.x = pk2(v[j].x, v[j].y); w.y = pk2(v[j].z, v[j].w); o8[64 * j] = w; } }
            if (kind == 1) {
                float pv[16];
#pragma unroll
                for (int h = 0; h < NH; ++h) { float p = 0.f;
#pragma unroll
                    for (int j = 0; j < 4; ++j) { const f32x4 w = ((const LAS f32x4*)(wl + h * DM))[64 * j + F.lane]; p += (v[j].x * w.x + v[j].y * w.y) + (v[j].z * w.z + v[j].w * w.w); }
                    pv[h] = p; }
#pragma unroll
                for (int h = NH; h < 16; ++h) pv[h] = pv[h - NH];
                const float z = wave_reduce16(pv, F.lane); const int hh = F.lane >> 2;
                if ((F.lane & 3) == 0 && hh < NH) { const float x = z + bf[hh]; const float lf = fminf(x, 0.f) - 0.6931471805599453f * __builtin_amdgcn_logf(1.0f + __builtin_amdgcn_exp2f(-1.4426950408889634f * fabsf(x))); ((float*)(F.ws + WS_LOGF))[(size_t)m * NH + hh] = lf; }
            }
            if (kind == 2) {
                float lg[NE];
                { float pv[NE];
#pragma unroll
                  for (int e = 0; e < NE; ++e) { float p = 0.f;
#pragma unroll
                    for (int j = 0; j < 4; ++j) { const f32x4 w = ((const LAS f32x4*)(wl + e * DM))[64 * j + F.lane]; p += (v[j].x * w.x + v[j].y * w.y) + (v[j].z * w.z + v[j].w * w.w); }
                    pv[e] = p; }
                  const float z = wave_reduce8(pv, F.lane);
#pragma unroll
                  for (int e = 0; e < NE; ++e) lg[e] = __builtin_bit_cast(float, __builtin_amdgcn_readlane(__builtin_bit_cast(int, z), 8 * e)); }
                int e1 = 0; float l1 = lg[0];
#pragma unroll
                for (int e = 1; e < NE; ++e) if (lg[e] > l1) { l1 = lg[e]; e1 = e; }
                int e2 = -1; float l2 = -INFINITY;
#pragma unroll
                for (int e = 0; e < NE; ++e) if (e != e1 && lg[e] > l2) { l2 = lg[e]; e2 = e; }
                const float ex = __builtin_amdgcn_exp2f(1.4426950408889634f * (l2 - l1)), g1 = __builtin_amdgcn_rcpf(1.0f + ex), g2 = ex * g1;
                if (F.lane == 0) { int* te = (int*)(F.ws + WS_TOPE) + 2 * m; float* tg = (float*)(F.ws + WS_TOPG) + 2 * m; te[0] = e1; te[1] = e2; tg[0] = g1; tg[1] = g2; }
#pragma unroll
                for (int e = 0; e < NE; ++e) cnt[e] += (e == e1) + (e == e2);
            }
        }
        if (kind == 2) {
            __syncthreads();
            if (F.lane == 0) {
#pragma unroll
                for (int e = 0; e < NE; ++e) wcnt[F.wave * NE + e] = cnt[e];
            }
            __syncthreads();
            if (F.tid < NE) { int s = 0; for (int w = 0; w < NWAVES; ++w) s += wcnt[w * NE + F.tid]; ((int*)(F.ws + WS_CNT))[chunk * NE + F.tid] = s; }
        }
    }
}

__device__ __forceinline__ void phase_cumsum(Frame& F) {
    const float* LOGF = (const float*)(F.ws + WS_LOGF); float* CB = (float*)(F.ws + WS_CB);
    LAS double* wtot = (LAS double*)(F.lds + RING_OFF);
    for (int sq = F.vcu; sq < BATCH * NH; sq += F.G) {
        const int b = sq / NH, h = sq - b * NH; const int t0 = F.wave * 512;
        float x[8];
#pragma unroll
        for (int k = 0; k < 8; ++k) x[k] = LOGF[((size_t)b * SEQ + t0 + k * 64 + F.lane) * NH + h];
        double sc[8]; double carry = 0.0;
#pragma unroll
        for (int k = 0; k < 8; ++k) {
            double v = (double)x[k];
#pragma unroll
            for (int o = 1; o < 64; o <<= 1) { const double n = lane_up_d(v, o, F.lane); if (F.lane >= o) v += n; }
            v += carry; sc[k] = v; carry = lane_get_d(v, 63);
        }
        __syncthreads();
        if (F.lane == 0) wtot[F.wave] = carry;
        __syncthreads();
        double base = 0.0; for (int w = 0; w < F.wave; ++w) base += wtot[w];
#pragma unroll
        for (int k = 0; k < 8; ++k) CB[(size_t)sq * SEQ + t0 + k * 64 + F.lane] = (float)((sc[k] + base) * 1.4426950408889634);
    }
    __syncthreads();
}

__device__ __forceinline__ void glds16_s(unsigned voff32, const void* sbase, unsigned ldsdst) { unsigned keep_;
    asm volatile("s_mov_b32 %0, m0\n\ts_mov_b32 m0, %3\n\ts_nop 0\n\tglobal_load_lds_dwordx4 %1, %2\n\ts_mov_b32 m0, %0" : "=&s"(keep_) : "v"(voff32), "s"(sbase), "s"(ldsdst) : "memory"); }
__device__ __forceinline__ void gstore32_s(unsigned voff32, unsigned data, const void* sbase) { asm volatile("global_store_dword %0, %1, %2" :: "v"(voff32), "v"(data), "s"(sbase) : "memory"); }
typedef float f32x2p __attribute__((ext_vector_type(2)));
template <int R> __device__ __forceinline__ void conv_row(f32x2p (&o)[16], const f32x2p (&w)[CW], const unsigned (&xr)[46]) {
    const unsigned x = xr[R]; const f32x2p xv = {bflo(x), bfhi(x)};
#pragma unroll
    for (int j = 0; j < CW; ++j) { const int tt = R - j; if (tt >= 0 && tt < 16) o[tt] = __builtin_elementwise_fma(w[j], xv, o[tt]); }
    __builtin_amdgcn_sched_barrier(0);
}
template <int... Rs> __device__ __forceinline__ void conv_rows(std::integer_sequence<int, Rs...>, f32x2p (&o)[16], const f32x2p (&w)[CW], const LAS unsigned* p0, const LAS unsigned* p1, const LAS unsigned* p2) {
    unsigned xr[46];
    ((xr[Rs] = (((Rs + 2) >> 4) == 0 ? p0 : ((Rs + 2) >> 4) == 1 ? p1 : p2)[((Rs + 2) & 15) * 384]), ...);
    __builtin_amdgcn_sched_barrier(0);
    (conv_row<Rs>(o, w, xr), ...);
}
#ifndef CONV_LN_OLD
#define CONV_LN_OLD 0
#endif
__device__ __forceinline__ void phase_conv(Frame& F, const float* dw, const float* dwb, const float* lng, const float* lnb) {
    const bf16* GLU = (const bf16*)(F.ws + WS_GLU); bf16* MIX = (bf16*)(F.ws + WS_MIX);
    LAS unsigned* tile = (LAS unsigned*)(F.lds + RING_OFF);
    LAS float* red = (LAS float*)(F.lds + RING_OFF + 4 * 24576);
    const int tid = F.tid; const bool act = tid < 384; const int ct = act ? tid : tid - 128; const int c0 = 2 * ct;
    f32x2p w[CW]; float b0, b1, g0, g1, lb0, lb1; const unsigned co4 = (unsigned)c0 * 4u;
#pragma unroll
    for (int j = 0; j < CW; ++j) w[j] = *(const GAS f32x2p*)((const GAS char*)(dw + j * CONVD) + co4);
    { const f32x2p bb = *(const GAS f32x2p*)((const GAS char*)dwb + co4), gg = *(const GAS f32x2p*)((const GAS char*)lng + co4), ll = *(const GAS f32x2p*)((const GAS char*)lnb + co4); b0 = bb.x; b1 = bb.y; g0 = gg.x; g1 = gg.y; lb0 = ll.x; lb1 = ll.y; }
    const unsigned tile0 = (unsigned)(uintptr_t)tile;
    auto dma_block = [&](int b, int B) { const char* gb = (const char*)(GLU + ((size_t)b * SEQ + (size_t)B * 16) * CONVD); const unsigned dst = tile0 + (unsigned)(B & 3) * 24576u;
#pragma unroll
        for (int i = 0; i < 3; ++i) { const int c = F.wave + 8 * i; glds16_s((unsigned)(c * 1024 + F.lane * 16), gb, (unsigned)__builtin_amdgcn_readfirstlane((int)(dst + (unsigned)c * 1024u))); } };
    for (int run = F.vcu; run < T / 128; run += F.G) {
        const int b = run >> 5, B0 = (run & 31) * 8;
        __syncthreads();
        if (B0 == 0) {
            unsigned zz; asm volatile("v_mov_b32 %0, 0" : "=v"(zz));
#pragma unroll
            for (int i = 0; i < 6; ++i) { const int c = F.wave + 8 * i; *(LAS v4u*)((LAS unsigned char*)tile + 2 * 24576 + c * 1024 + F.lane * 16) = (v4u){zz, zz, zz, zz}; }
        } else { dma_block(b, B0 - 2); dma_block(b, B0 - 1); }
        dma_block(b, B0);
#pragma unroll 1
        for (int it = 0; it < 8; ++it) {
            const int B = B0 + it, t0 = B * 16;
            asm volatile("s_waitcnt vmcnt(0)" ::: "memory");
            __syncthreads();
            if (it < 7) dma_block(b, B + 1);
            f32x2p o[16];
#pragma unroll
            for (int tt = 0; tt < 16; ++tt) o[tt] = (f32x2p){b0, b1};
            conv_rows(std::make_integer_sequence<int, 46>{}, o, w, tile + ((B - 2) & 3) * 6144 + ct, tile + ((B - 1) & 3) * 6144 + ct, tile + (B & 3) * 6144 + ct);
            { float pv[32];
#pragma unroll
              for (int tt = 0; tt < 16; ++tt) { pv[2 * tt] = o[tt].x + o[tt].y; pv[2 * tt + 1] = o[tt].x * o[tt].x + o[tt].y * o[tt].y; }
              const float z = wave_reduce32(pv, F.lane);
              if ((F.lane & 1) == 0 && F.wave < 6) red[F.wave * 32 + (F.lane >> 1)] = z; }
            __syncthreads();
#if !CONV_LN_OLD
#ifndef CONV_VAR
#define CONV_VAR 0
#endif
            { const int tk = F.lane & 15; float s1, s2;
              { const f32x2p r2 = *(const LAS f32x2p*)(red + tk * 2); s1 = r2.x; s2 = r2.y; }
#pragma unroll
              for (int w6 = 1; w6 < 6; ++w6) { const f32x2p r2 = *(const LAS f32x2p*)(red + (w6 * 16 + tk) * 2); s1 += r2.x; s2 += r2.y; }
              const float mean = s1 * (1.0f / CONVD), var = fmaxf(s2 * (1.0f / CONVD) - mean * mean, 0.f), rstd = __builtin_amdgcn_rsqf(var + lconst(RMS_EPS));
              LAS f32x2p* st = (LAS f32x2p*)(red + 192) + F.wave * 16;
#if CONV_VAR == 3
              st[tk] = (f32x2p){rstd, -mean * rstd};
#else
              if (F.lane < 16) st[tk] = (f32x2p){rstd, -mean * rstd};
#endif
              asm volatile("s_waitcnt lgkmcnt(0)" ::: "memory");
#if CONV_VAR == 1
#pragma unroll 4
#elif CONV_VAR == 2
#pragma unroll 1
#else
#pragma unroll
#endif
              for (int tt = 0; tt < 16; ++tt) {
#if CONV_VAR == 4
                float a_ = ((const LAS float*)st)[2 * tt], b_ = ((const LAS float*)st)[2 * tt + 1]; asm volatile("" : "+v"(a_), "+v"(b_)); const f32x2p ab = {a_, b_};
#else
                const f32x2p ab = st[tt];
#endif
                const float y0 = (o[tt].x * ab.x + ab.y) * g0 + lb0, y1 = (o[tt].y * ab.x + ab.y) * g1 + lb1;
                const float z0 = y0 * __builtin_amdgcn_rcpf(1.0f + __builtin_amdgcn_exp2f(-1.4426950408889634f * y0)), z1 = y1 * __builtin_amdgcn_rcpf(1.0f + __builtin_amdgcn_exp2f(-1.4426950408889634f * y1));
                if (act) *(GAS unsigned*)((GAS char*)(MIX + ((size_t)b * SEQ + t0 + tt) * DM) + (co4 >> 1)) = pk2(z0, z1);
#if CONV_VAR == 5
                __builtin_amdgcn_sched_barrier(0);
#endif
              } }
#else
#pragma unroll
            for (int tt = 0; tt < 16; ++tt) { float s1 = 0.f, s2 = 0.f;
#pragma unroll
                for (int w6 = 0; w6 < 6; ++w6) { s1 += red[(w6 * 16 + tt) * 2]; s2 += red[(w6 * 16 + tt) * 2 + 1]; }
                const float mean = s1 * (1.0f / CONVD), var = fmaxf(s2 * (1.0f / CONVD) - mean * mean, 0.f), rstd = __builtin_amdgcn_rsqf(var + lconst(RMS_EPS));
                const float y0 = (o[tt].x - mean) * rstd * g0 + lb0, y1 = (o[tt].y - mean) * rstd * g1 + lb1;
                const float z0 = y0 * __builtin_amdgcn_rcpf(1.0f + __builtin_amdgcn_exp2f(-1.4426950408889634f * y0)), z1 = y1 * __builtin_amdgcn_rcpf(1.0f + __builtin_amdgcn_exp2f(-1.4426950408889634f * y1));
                if (act) *(GAS unsigned*)((GAS char*)(MIX + ((size_t)b * SEQ + t0 + tt) * DM) + (co4 >> 1)) = pk2(z0, z1); }
#endif
        }
    }
    __syncthreads();
}

__device__ __forceinline__ void phase_scatter(Frame& F) {
    LAS int* pre = (LAS int*)(F.lds + RING_OFF);
    LAS int* wtot = pre + 2048;
    LAS int* tot = wtot + 32;
    LAS int* wc2 = tot + 16;
    LAS int* rowl = wc2 + 32;
    const int* CNT = (const int*)(F.ws + WS_CNT); const int* TOPE = (const int*)(F.ws + WS_TOPE); const float* TOPG = (const float*)(F.ws + WS_TOPG);
    int* SLOT = (int*)(F.ws + WS_SLOT); float* ROWG = (float*)(F.ws + WS_ROWG); int* TAB = (int*)(F.ws + WS_TAB);
    const unsigned char* UB = (const unsigned char*)(F.ws + WS_UB); unsigned char* XS = (unsigned char*)(F.ws + WS_XS);
    const int tid = F.tid, lane = F.lane, wave = F.wave;
    int v[NE];
    if (tid < 256) {
#pragma unroll
        for (int e = 0; e < NE; ++e) v[e] = CNT[tid * NE + e];
        int inc[NE];
#pragma unroll
        for (int e = 0; e < NE; ++e) { int x = v[e];
#pragma unroll
            for (int o = 1; o < 64; o <<= 1) { const int n = lane_up_i(x, o, lane); if (lane >= o) x += n; }
            inc[e] = x; }
        if (lane == 63) {
#pragma unroll
            for (int e = 0; e < NE; ++e) wtot[wave * NE + e] = inc[e];
        }
#pragma unroll
        for (int e = 0; e < NE; ++e) v[e] = inc[e] - v[e];
    }
    __syncthreads();
    if (tid < 256) {
#pragma unroll
        for (int e = 0; e < NE; ++e) { int add = 0; for (int w = 0; w < wave; ++w) add += wtot[w * NE + e]; pre[tid * NE + e] = v[e] + add; }
    }
    if (tid < NE) { int s = 0; for (int w = 0; w < 4; ++w) s += wtot[w * NE + tid]; tot[tid] = s; }
    __syncthreads();
    if (tid == 0) { int ps; asm volatile("v_mov_b32 %0, 0" : "=v"(ps)); for (int e = 0; e < NE; ++e) { tot[8 + e] = ps; ps += (tot[e] + 255) & ~255; } }
    __syncthreads();
    for (int chunk = F.vcu; chunk < T / 128; chunk += F.G) {
        int e = 0, rank = 0; const int f = chunk * 256 + tid;
        if (tid < 256) {
            e = TOPE[f];
#pragma unroll
            for (int x = 0; x < NE; ++x) { const unsigned long long mask = __ballot(e == x); if (e == x) rank = __popcll(mask & ((1ull << lane) - 1ull)); if (lane == 0) wc2[wave * NE + x] = __popcll(mask); }
        }
        __syncthreads();
        if (tid < 256) {
            int base = tot[8 + e] + pre[chunk * NE + e]; for (int w = 0; w < wave; ++w) base += wc2[w * NE + e];
            const int row = base + rank; SLOT[f] = row; ROWG[row] = TOPG[f]; rowl[tid] = row;
        }
        __syncthreads();
#pragma unroll 1
        for (int i0 = 0; i0 < 32; i0 += 8) {
            v4u rw[4];
#pragma unroll
            for (int q = 0; q < 4; ++q) { const int tok = chunk * 128 + ((wave * 32 + i0) >> 1) + q; rw[q] = ((const GAS v4u*)(UB + (size_t)tok * DM) + lane)[0]; }
#pragma unroll
            for (int q = 0; q < 8; ++q) { const int row = rowl[wave * 32 + i0 + q]; ((GAS v4u*)(XS + (size_t)row * DM) + lane)[0] = rw[q >> 1]; } }
        __syncthreads();
    }
    for (int e = F.vcu; e < NE; e += F.G) { const int lo = tot[8 + e] + tot[e], hi = tot[8 + e] + ((tot[e] + 255) & ~255);
        unsigned zz; asm volatile("v_mov_b32 %0, 0" : "=v"(zz));
        for (int r = lo + wave; r < hi; r += NWAVES) { GAS v4u* d = (GAS v4u*)(XS + (size_t)r * DM) + lane; d[0] = (v4u){zz, zz, zz, zz}; if (lane == 0) ROWG[r] = 0.f; } }
    if (F.vcu == 0) {
        if (tid == 0) { int nrt = 0; for (int e = 0; e < NE; ++e) nrt += (tot[e] + 255) >> 8; TAB[0] = nrt; }
        if (tid < MAXRT) { int ex = NE - 1; for (int e = NE - 1; e >= 0; --e) if (tid * 256 < tot[8 + e] + ((tot[e] + 255) & ~255)) ex = e; TAB[16 + tid] = ex; }
    }
}

__device__ __forceinline__ void phase_final(Frame& F) {
    const bf16* Y = (const bf16*)(F.ws + WS_XS); const GAS int* SLOT = (const GAS int*)(F.ws + WS_SLOT); const bf16* H16 = (const bf16*)(F.ws + WS_H16);
    const int gw = F.vcu * NWAVES + F.wave, NGW = F.G * NWAVES;
    v2u nh[4], na[4], nb[4];
    auto issue = [&](int m, int s0, int s1) {
        const GAS v2u* hr = (const GAS v2u*)(H16 + (size_t)m * DM) + F.lane; const GAS v2u* y0 = (const GAS v2u*)(Y + (size_t)s0 * DM) + F.lane; const GAS v2u* y1 = (const GAS v2u*)(Y + (size_t)s1 * DM) + F.lane;
#pragma unroll
        for (int j = 0; j < 4; ++j) { nh[j] = hr[64 * j]; na[j] = y0[64 * j]; nb[j] = y1[64 * j]; } };
    const int l1 = F.lane & 1; int fv = 0;
#define SLOT2(v) __builtin_amdgcn_readlane((v), 0), __builtin_amdgcn_readlane((v), 1)
    if (gw < T) { const int v0 = SLOT[2 * gw + l1]; if (gw + NGW < T) fv = SLOT[2 * (gw + NGW) + l1]; issue(gw, SLOT2(v0)); }
#pragma unroll 1
    for (int m = gw; m < T; m += NGW) {
        GAS f32x4* xr = (GAS f32x4*)(F.out + (size_t)m * DM) + F.lane;
        v2u ch[4], ca[4], cb_[4];
#pragma unroll
        for (int j = 0; j < 4; ++j) { ch[j] = nh[j]; ca[j] = na[j]; cb_[j] = nb[j]; }
        if (m + NGW < T) { const int vc = fv; if (m + 2 * NGW < T) fv = SLOT[2 * (m + 2 * NGW) + l1]; issue(m + NGW, SLOT2(vc)); }
#pragma unroll
        for (int j = 0; j < 4; ++j) { const v2u h = ch[j], a = ca[j], b = cb_[j]; f32x4 v;
            v.x = bflo(h.x) + (bflo(a.x) + bflo(b.x)); v.y = bfhi(h.x) + (bfhi(a.x) + bfhi(b.x)); v.z = bflo(h.y) + (bflo(a.y) + bflo(b.y)); v.w = bfhi(h.y) + (bfhi(a.y) + bfhi(b.y)); xr[64 * j] = v; }
    }
}
#ifndef DIS_PRO
#define DIS_PRO 0
#endif
#ifndef DIS_NORM
#define DIS_NORM 0
#endif
#ifndef DIS_PMK
#define DIS_PMK 0
#endif
#ifndef DIS_CUM
#define DIS_CUM 0
#endif
#ifndef DIS_INE
#define DIS_INE 0
#endif
#ifndef DIS_INO
#define DIS_INO 0
#endif
#ifndef DIS_FOX
#define DIS_FOX 0
#endif
#ifndef DIS_CONV
#define DIS_CONV 0
#endif
#ifndef DIS_MEM
#define DIS_MEM 0
#endif
#ifndef DIS_OUT
#define DIS_OUT 0
#endif
#ifndef DIS_SCAT
#define DIS_SCAT 0
#endif
#ifndef DIS_UP
#define DIS_UP 0
#endif
#ifndef DIS_DOWN
#define DIS_DOWN 0
#endif
#ifndef DIS_FIN
#define DIS_FIN 0
#endif
#ifndef DIS_UPD
#define DIS_UPD 0
#endif
#ifndef DIS_UPM
#define DIS_UPM 0
#endif
#ifndef REP_GIN
#define REP_GIN 1
#endif
#ifndef REP_GOUT
#define REP_GOUT 1
#endif
#ifndef REP_GDENSE
#define REP_GDENSE 1
#endif
#ifndef REP_GMOE
#define REP_GMOE 1
#endif
#ifndef REP_N0C
#define REP_N0C 1
#endif
#ifndef REP_CONV
#define REP_CONV 1
#endif
#ifndef REP_PRO
#define REP_PRO 1
#endif
#ifndef REP_ATT
#define REP_ATT 1
#endif
#ifndef REP_THIN
#define REP_THIN 1
#endif
#ifndef REP_MEM
#define REP_MEM 1
#endif
struct AttnUnitId { int bh, qb; };
struct FoxOrder { int vcu, G;
    __device__ __forceinline__ bool next(int i, AttnUnitId& u) const { const int p = vcu + G * (i >> 1); if (p >= BATCH * NH * 8) return false; const int s = p & 7; u.bh = p >> 3; u.qb = (i & 1) ? 15 - s : s; return true; } };
struct MemOrder { int vcu, G;
    __device__ __forceinline__ bool next(int i, AttnUnitId& u) const { const int p = vcu + G * i; if (p >= BATCH * MEMH * 16) return false; u.bh = p >> 4; u.qb = p & 15; return true; } };

__global__ void __launch_bounds__(NWAVES * 64, 2) mega_fwd(Args args) {
    extern __shared__ __attribute__((aligned(16))) unsigned char lds[];
    Frame F;
    F.lds = (LAS unsigned char*)lds;
    F.MISC = (volatile LAS unsigned*)(F.lds + MISC_OFF);
    const int wave0 = __builtin_amdgcn_readfirstlane((int)threadIdx.x >> 6);
    F.tid = threadIdx.x; F.lane = F.tid & 63; F.wave = wave0;
    F.G = gridDim.x; { const int bx = blockIdx.x; F.vcu = (F.G % 8 == 0) ? (bx % 8) * (F.G / 8) + bx / 8 : bx; }
    const int vcu0 = F.vcu;
    F.ws = args.ws; F.out = args.out; F.ctl = (gu32*)(args.ws + WS_CTL);
    F.A = (const __attribute__((address_space(4))) Args*)__builtin_amdgcn_kernarg_segment_ptr();
    { unsigned z0_; asm volatile("v_mov_b32 %0, 0" : "=v"(z0_)); for (int u = F.tid; u < (LDS_BYTES - LDSCTL_OFF) / 4; u += NWAVES * 64) ((LAS unsigned*)(F.lds + LDSCTL_OFF))[u] = z0_; }
    __syncthreads();
#if BRINGUP
    const int lo = args.ph_lo, hi = args.ph_hi; const unsigned mask = args.mask;
#else
    constexpr int lo = 0, hi = NPH; constexpr unsigned mask = C_ALL;
#endif
    XcdBarrier bar; bar.bar = (unsigned*)(F.ctl + CW_BAR); bar.x = 0; bar.st = nullptr;
    if (hi - lo > 1) bar = xcd_barrier_post((unsigned*)(F.ctl + CW_BAR), F.MISC + 8, F.tid);
#define IN(k) (lo <= (k) && (k) < hi)
#define SLOT_VARS int Lq = L; asm volatile("" : "+s"(Lq)); const int pb = 1 + 9 * Lq, j = Lq >> 1; const bool odd = (Lq & 1) != 0; const float* hsrc = (Lq == 0) ? F.A->in[0] : nullptr; bf16* H16 = (bf16*)(F.ws + WS_H16); (void)j; (void)hsrc; (void)odd; (void)H16
#ifndef REP_BAR
#define REP_BAR 1
#endif
#ifdef PROBE_WAIT_SLOT
#define PW_T0(k) unsigned long long pw0_ = __builtin_amdgcn_s_memrealtime()
#define PW_AMP(k) do { if ((((k) - 1) % 9) == PROBE_WAIT_SLOT && (k) >= 1) { const unsigned long long pw1_ = __builtin_amdgcn_s_memrealtime(); const unsigned long long pwe_ = pw1_ + 4ull * (pw1_ - pw0_); while (__builtin_amdgcn_s_memrealtime() < pwe_) __builtin_amdgcn_s_sleep(8); __syncthreads(); } } while (0)
#else
#define PW_T0(k) do {} while (0)
#define PW_AMP(k) do {} while (0)
#endif
#define SEAM(k) do { if ((k) + 1 < hi) for (int rb_ = 0; rb_ < REP_BAR; ++rb_) { XcdBarrier bz_ = bar; { unsigned pl_ = (unsigned)(unsigned long long)bz_.bar, ph_ = (unsigned)((unsigned long long)bz_.bar >> 32); asm volatile("" : "+v"(pl_), "+v"(ph_)); bz_.bar = (unsigned*)(((unsigned long long)(unsigned)__builtin_amdgcn_readfirstlane((int)ph_) << 32) | (unsigned)__builtin_amdgcn_readfirstlane((int)pl_)); } int tb_; asm volatile("v_mbcnt_lo_u32_b32 %0, -1, 0\n\tv_mbcnt_hi_u32_b32 %0, -1, %0" : "=v"(tb_)); PW_T0(k); xcd_barrier(bz_, wave0 * 64 + tb_); PW_AMP(k); } } while (0)
    unsigned char* ws = args.ws; bf16 *UB, *MIX, *MQ, *QKV;
#define RS_FINISH() do { const int gt_ = F.vcu * (NWAVES * 64) + F.tid; if (gt_ < T) ((float*)(ws + WS_RS))[gt_] = pg8::row_rs((const float*)(ws + WS_SSQ), gt_); \
        XcdBarrier bz_ = bar; { unsigned long long pz_ = (unsigned long long)bz_.bar; asm volatile("" : "+s"(pz_)); bz_.bar = (unsigned*)pz_; } xcd_barrier(bz_, F.tid); } while (0)
#define PHASE_BEGIN() do { int tz_; asm volatile("v_mbcnt_lo_u32_b32 %0, -1, 0\n\tv_mbcnt_hi_u32_b32 %0, -1, %0" : "=v"(tz_)); { int w_ = wave0, c_ = vcu0, g_ = (int)gridDim.x; asm volatile("" : "+s"(w_), "+s"(c_), "+s"(g_)); F.lane = tz_; F.wave = w_; F.tid = w_ * 64 + tz_; F.vcu = c_; F.G = g_; }   \
        { unsigned wl_ = (unsigned)(unsigned long long)args.ws, wh_ = (unsigned)((unsigned long long)args.ws >> 32); asm volatile("" : "+v"(wl_), "+v"(wh_)); \
          ws = (unsigned char*)(((unsigned long long)(unsigned)__builtin_amdgcn_readfirstlane((int)wh_) << 32) | (unsigned)__builtin_amdgcn_readfirstlane((int)wl_)); F.ws = ws; } \
        { unsigned la_ = (unsigned)(uintptr_t)(LAS unsigned char*)lds; asm volatile("" : "+s"(la_)); LAS unsigned char* lp_ = (LAS unsigned char*)(uintptr_t)la_; F.lds = lp_; F.MISC = (volatile LAS unsigned*)(lp_ + MISC_OFF); } \
        { unsigned long long ka_ = (unsigned long long)__builtin_amdgcn_kernarg_segment_ptr(); asm volatile("" : "+s"(ka_)); F.A = (const __attribute__((address_space(4))) Args*)ka_; } \
        UB = (bf16*)(ws + WS_UB); MIX = (bf16*)(ws + WS_MIX); MQ = (bf16*)(ws + WS_MQ); QKV = (bf16*)(ws + WS_QKV); } while (0)

    if (IN(0)) { PHASE_BEGIN(); if ((mask & C_THIN) && !DIS_PRO) for (int rep_ = 0; rep_ < REP_PRO; ++rep_) { phase_prologue(F); __syncthreads(); } }

    for (int L = 0; L < 4; ++L) {
        { SLOT_VARS;
        if (IN(pb + 0) && !(FUSENORM && !BRINGUP && odd)) {
            PHASE_BEGIN();
            if (mask & C_THIN) {
                if (!DIS_NORM) for (int rn_ = 0; rn_ < ((Lq == 2) ? 1 : REP_N0C); ++rn_) phase_norm(F, hsrc, H16, F.A->in[2] + (size_t)Lq * DM, odd ? 0 : 1, (Lq == 2), odd ? nullptr : F.A->in[8] + (size_t)j * DM * FOXIN, odd ? nullptr : F.A->in[9] + (size_t)j * NH, (IN8L2 && Lq == 2) || (IN8L0 && Lq == 0));
            }
            SEAM(pb + 0);
        } }
        { SLOT_VARS;
        if (IN(pb + 1)) {
            PHASE_BEGIN();
            if (!odd) {
                if (Lq == 0 && (mask & C_PMK) && !DIS_PMK) {
                    pg8::Gemm g{ws + WS_MEMN, ws + WS_WKV, DM * 2, (size_t)2 * MEMD * DM * 2};
                    pg8::Order S; S.init(4 * BATCH * ML / 256, 2, F.G, (int)blockIdx.x, nullptr, BATCH * ML / 256); const pg8::OrderT ST = pg8::order_table(S, F.lds + ORDTAB_OFF, F.tid);
                    pg8::EpiMemKV E{(pg8::bf16_t*)(ws + WS_MKV), F.A->in[7]};
                    pg8::gemm_phase<pg8::EpiMemKV, pg8::OrderT, true, true>(F.lds + RING_OFF, g, ST, E, F.wave);
                }
                if ((mask & C_THIN) && !DIS_CUM) phase_cumsum(F);
                if ((mask & C_INPROJ) && !DIS_INE && ((IN8L2 && Lq == 2) || (IN8L0 && Lq == 0))) {
                    pg8::Gemm g{UB, ws + WS_WINE + (size_t)j * 2560 * DM * 2, DM, 0};
                    pg8::Order S; S.init(T / 256, 10, F.G, (int)blockIdx.x, nullptr, 0); const pg8::OrderT ST = pg8::order_table(S, F.lds + ORDTAB_OFF, F.tid);
                    pg8::EpiInEven E{QKV, MQ, (const float*)(ws + WS_GT) + Lq * 192, 1.0f / (ASC_Z * WSC_GU)};
                    for (int rg_ = 0; rg_ < REP_GIN; ++rg_) pg8::gemm_phase<pg8::EpiInEven, pg8::OrderT, true, true, true>(F.lds + RING_OFF, g, ST, E, F.wave);
                } else if ((mask & C_INPROJ) && !DIS_INE) {
                    pg8::Gemm g{UB, (const pg8::bf16_t*)(ws + WS_WINE) + (size_t)j * 2560 * DM, DM * 2, 0};
                    pg8::Order S; S.init(T / 256, 10, F.G, (int)blockIdx.x, nullptr, 0); const pg8::OrderT ST = pg8::order_table(S, F.lds + ORDTAB_OFF, F.tid);
                    pg8::EpiInEven E{QKV, MQ, (const float*)(ws + WS_GT) + Lq * 192};
                    for (int rg_ = 0; rg_ < REP_GIN; ++rg_) pg8::gemm_phase<pg8::EpiInEven, pg8::OrderT, true, true>(F.lds + RING_OFF, g, ST, E, F.wave);
#if MOEQ
                    if (Lq == 0 && (mask & C_THIN)) { pg8::Order Sp; Sp.init(4 * BATCH * ML / 256, 2, F.G, (int)blockIdx.x, nullptr, BATCH * ML / 256); pg8::Unit up_; if (!Sp.next(0, up_)) { __syncthreads(); convert_moe_queue(F, 0, (gu32*)(ws + WS_CTL) + CW_QUEUE, 2); } }
#endif
                }
            } else if ((mask & C_INPROJ) && !DIS_INO && ((IN8ODD >> j) & 1)) {
                pg8::Gemm g{UB, ws + WS_WINO + (size_t)j * CONVIN * DM * 2, DM, 0};
                pg8::Order S; S.init(T / 256, 7, F.G, (int)blockIdx.x, nullptr, 0); const pg8::OrderT ST = pg8::order_table(S, F.lds + ORDTAB_OFF, F.tid);
                pg8::EpiInOdd E{(pg8::bf16_t*)(ws + WS_GLU), MQ, F.A->in[14] + (size_t)j * 2 * CONVD, (const float*)(ws + WS_GT) + Lq * 192 + 128, (const float*)(ws + WS_SSQ), 1.0f / (ASC_Z * WSC_GU)};
                for (int rg_ = 0; rg_ < REP_GIN; ++rg_) pg8::gemm_phase<pg8::EpiInOdd, pg8::OrderT, true, true, true>(F.lds + RING_OFF, g, ST, E, F.wave);
            } else if ((mask & C_INPROJ) && !DIS_INO) {
                pg8::Gemm g{(FUSENORM && !BRINGUP) ? (const void*)(ws + WS_H16) : (const void*)UB, (const pg8::bf16_t*)(ws + WS_WINO) + (size_t)j * CONVIN * DM, DM * 2, 0};
                pg8::Order S; S.init(T / 256, 7, F.G, (int)blockIdx.x, nullptr, 0); const pg8::OrderT ST = pg8::order_table(S, F.lds + ORDTAB_OFF, F.tid);
                pg8::EpiInOdd E{(pg8::bf16_t*)(ws + WS_GLU), MQ, F.A->in[14] + (size_t)j * 2 * CONVD, (const float*)(ws + WS_GT) + Lq * 192 + 128, (FUSENORM && !BRINGUP) ? (const float*)(ws + WS_SSQ) : nullptr};
                for (int rg_ = 0; rg_ < REP_GIN; ++rg_) pg8::gemm_phase<pg8::EpiInOdd, pg8::OrderT, true, true>(F.lds + RING_OFF, g, ST, E, F.wave);
            }
            SEAM(pb + 1);
        } }
        { SLOT_VARS;
        if (IN(pb + 2)) {
            PHASE_BEGIN();
            if (!odd) {
                if ((mask & C_FOX) && !DIS_FOX) for (int rep_ = 0; rep_ < REP_ATT; ++rep_) {
                    const FoxOrder S{F.vcu, F.G}; AttnUnitId u;
                    int tfx_; asm volatile("v_mbcnt_lo_u32_b32 %0, -1, 0\n\tv_mbcnt_hi_u32_b32 %0, -1, %0" : "=v"(tfx_)); const int tidf = F.wave * 64 + tfx_;
                    const float xskip = ((const float*)(ws + WS_GT))[1024 + j];
                    float cqn = 0.f, ckn = 0.f; AttnUnitId un; bool hn = S.next(0, un);
                    auto bias_req = [&](const AttnUnitId& q) { const float* cbq = (const float*)(ws + WS_CB) + (size_t)q.bh * SEQ; const int NT = 4 * (q.qb + 1); const int jt = tfx_; cqn = ((const GAS float*)cbq)[q.qb * 256]; ckn = ((const GAS float*)cbq)[(jt < NT ? jt : NT - 1) * 64 + 63]; };
                    if (hn) bias_req(un);
                    for (int i = 0; hn; ++i) {
                        u = un; const float cq = cqn, ck = ckn;
                        hn = S.next(i + 1, un); if (hn) bias_req(un);
                        const int b = u.bh / NH, h = u.bh - b * NH; const size_t r0 = (size_t)b * SEQ;
                        const float* cbq = (const float*)(ws + WS_CB) + (size_t)u.bh * SEQ; const int NT = 4 * (u.qb + 1);
                        int j0; { const int jt = tfx_;
                            const unsigned long long live = __builtin_amdgcn_ballot_w64(jt < NT && (cq - ck >= -xskip));
                            j0 = live ? (int)__builtin_ctzll(live) : NT - 4; j0 = __builtin_amdgcn_readfirstlane(j0); if (j0 > NT - 4) j0 = NT - 4; j0 &= ~1; }
                        attn_body::attn_unit<24, true, true, 3 * FOXD, 3 * FOXD, DM, true>((const attn_body::bf16*)QKV + (r0 + (size_t)u.qb * 256) * (3 * FOXD) + h * HD,
                            (const attn_body::bf16*)QKV + (r0 + (size_t)j0 * 64) * (3 * FOXD) + FOXD + h * HD, (const attn_body::bf16*)QKV + (r0 + (size_t)j0 * 64) * (3 * FOXD) + 2 * FOXD + h * HD,
                            (attn_body::bf16*)MIX + (r0 + (size_t)u.qb * 256) * DM + h * HD, cbq + j0 * 64, NT - j0, (char*)lds + RING_OFF, tidf, fminf((xskip - 40.0f) * 0.505f + 0.25f, 60.0f));
                    }
                }
            } else if ((mask & C_THIN) && !DIS_CONV) for (int rn_ = 0; rn_ < REP_CONV; ++rn_) {
                phase_conv(F, F.A->in[15] + (size_t)j * CW * CONVD, F.A->in[16] + (size_t)j * CONVD, F.A->in[17] + (size_t)j * CONVD, F.A->in[18] + (size_t)j * CONVD);
            }
            if ((mask & C_MEMATT) && !DIS_MEM) for (int rep_ = 0; rep_ < REP_MEM; ++rep_) {
                int tmx_; asm volatile("v_mbcnt_lo_u32_b32 %0, -1, 0\n\tv_mbcnt_hi_u32_b32 %0, -1, %0" : "=v"(tmx_)); const int tidm = F.wave * 64 + tmx_;
                const MemOrder S{F.vcu, F.G}; AttnUnitId u; const attn_body::bf16* MKVL = (const attn_body::bf16*)(ws + WS_MKV) + (size_t)Lq * BATCH * ML * 2 * MEMD;
                for (int i = 0; S.next(i, u); ++i) {
                    const int b = u.bh / MEMH, h = u.bh - b * MEMH; const size_t r0 = (size_t)b * SEQ + (size_t)u.qb * 256;
                    attn_body::attn_unit<8, false, false, MEMD, 2 * MEMD, DM>((const attn_body::bf16*)MQ + r0 * MEMD + h * HD, MKVL + (size_t)b * ML * (2 * MEMD) + h * HD, MKVL + (size_t)b * ML * (2 * MEMD) + MEMD + h * HD,
                        (attn_body::bf16*)MIX + r0 * DM + FOXD + h * HD, nullptr, ML / 64, (char*)lds + RING_OFF, tidm);
                }
            }
#if MOEQ
#ifndef REP_MOEQ
#define REP_MOEQ 1
#endif
            if (!odd && (mask & C_THIN)) { for (int rq_ = 0; rq_ < REP_MOEQ; ++rq_) { __syncthreads(); convert_moe_queue(F, j, (gu32*)(ws + WS_CTL) + CW_QUEUE + 64 * j + 256 * rq_); } }
#endif
            SEAM(pb + 2);
        } }
        { SLOT_VARS;
        if (IN(pb + 3)) {
            PHASE_BEGIN();
            if ((mask & C_OUTPROJ) && !DIS_OUT) {
                pg8::Gemm g{MIX, (const pg8::bf16_t*)(ws + (odd ? WS_WOUTO : WS_WOUTE)) + (size_t)j * DM * DM, DM * 2, 0};
                pg8::Order S; S.init(T / 256, 4, F.G, (int)blockIdx.x, nullptr, 0); const pg8::OrderT ST = pg8::order_table(S, F.lds + ORDTAB_OFF, F.tid);
                pg8::EpiResid E{hsrc, (pg8::bf16_t*)(ws + WS_H16), 1.0f, (FUSENORM && !BRINGUP && !odd) ? (float*)(ws + WS_SSQ) : nullptr, (FUSENORM && !BRINGUP && !odd && (DENSE8 == 1 || (DENSE8 == 2 && Lq == 2) || (UP8L0 && Lq == 0))) ? (unsigned char*)UB : nullptr};
                for (int rg_ = 0; rg_ < REP_GOUT; ++rg_) { if (rg_) { E.isc = 0.f; E.base32 = nullptr; } pg8::gemm_phase<pg8::EpiResid, pg8::OrderT, true, true>(F.lds + RING_OFF, g, ST, E, F.wave); }
            }
            SEAM(pb + 3);
        } }
        { SLOT_VARS;
        if (IN(pb + 4) && !(FUSENORM && !BRINGUP && !odd)) {
            PHASE_BEGIN();
            if ((mask & C_THIN) && !DIS_NORM) for (int rep_ = 0; rep_ < REP_THIN; ++rep_) phase_norm(F, nullptr, H16, F.A->in[4] + (size_t)Lq * DM, odd ? 2 : 0, false, odd ? F.A->in[23] + (size_t)j * DM * NE : nullptr, nullptr, DENSE8 == 1 || (DENSE8 == 2 && Lq == 2));
            SEAM(pb + 4);
        } }
        { SLOT_VARS;
        if (odd && IN(pb + 5)) {
            PHASE_BEGIN();
            if ((mask & C_THIN) && !DIS_SCAT) for (int rep_ = 0; rep_ < REP_THIN; ++rep_) { phase_scatter(F); __syncthreads(); }
            SEAM(pb + 5);
        } }
        { SLOT_VARS;
        if (IN(pb + 6)) {
            PHASE_BEGIN();
            if ((mask & C_FFNUP) && !DIS_UP) {
                const bool d8 = DENSE8 == 1 || (DENSE8 == 2 && Lq == 2), u8 = d8 || (UP8L0 && Lq == 0);
                if (!odd && !u8 && !DIS_UPD) {
                    pg8::Gemm g{(FUSENORM && !BRINGUP) ? (const void*)(ws + WS_H16) : (const void*)UB, (const pg8::bf16_t*)(ws + WS_WGU) + (size_t)j * 2 * FF * DM, DM * 2, 0};
                    pg8::Order S; S.init(T / 256, 2 * FF / 256, F.G, (int)blockIdx.x, nullptr, 0); const pg8::OrderT ST = pg8::order_table(S, F.lds + ORDTAB_OFF, F.tid);
                    pg8::EpiSwiGLU E{(pg8::bf16_t*)(ws + WS_HIDD), FF, (FUSENORM && !BRINGUP) ? (const float*)(ws + WS_SSQ) : nullptr};
                    for (int rg_ = 0; rg_ < REP_GDENSE; ++rg_) pg8::gemm_phase<pg8::EpiSwiGLU, pg8::OrderT, true, true, false>(F.lds + RING_OFF, g, ST, E, F.wave);
                } else if (!odd && u8 && !d8) {
                    pg8::Gemm g{UB, ws + WS_WGU + (size_t)j * 2 * FF * DM * 2, DM, 0};
                    pg8::Order S; S.init(T / 256, 2 * FF / 256, F.G, (int)blockIdx.x, nullptr, 0); const pg8::OrderT ST = pg8::order_table(S, F.lds + ORDTAB_OFF, F.tid);
                    pg8::EpiSwiGLU8B E{ws + WS_HIDD, FF, 1.0f / (ASC_Z * WSC_GU), 1.0f, (FUSENORM && !BRINGUP) ? (const float*)(ws + WS_SSQ) : nullptr};
                    for (int rg_ = 0; rg_ < REP_GDENSE; ++rg_) pg8::gemm_phase<pg8::EpiSwiGLU8B, pg8::OrderT, true, true, true>(F.lds + RING_OFF, g, ST, E, F.wave);
                } else if (!odd && d8) {
                    pg8::Gemm g{UB, ws + WS_WGU + (size_t)j * 2 * FF * DM * 2, DM, 0};
                    pg8::Order S; S.init(T / 256, 2 * FF / 256, F.G, (int)blockIdx.x, nullptr, 0); const pg8::OrderT ST = pg8::order_table(S, F.lds + ORDTAB_OFF, F.tid);
                    pg8::EpiSwiGLU8 E{ws + WS_HIDD, FF, 1.0f / (ASC_Z * WSC_GU), ASC_H, (FUSENORM && !BRINGUP) ? (const float*)(ws + WS_SSQ) : nullptr};
                    for (int rg_ = 0; rg_ < REP_GDENSE; ++rg_) pg8::gemm_phase<pg8::EpiSwiGLU8, pg8::OrderT, true, true, true>(F.lds + RING_OFF, g, ST, E, F.wave);
                } else if (odd && !DIS_UPM) {
                    const int* TAB = (const int*)(ws + WS_TAB);
                    pg8::Gemm g{ws + WS_XS, ws + WS_WMGU + (size_t)j * WS_WM_LAYER, DM, (size_t)2 * EFF * DM};
                    pg8::Order S; S.init(__builtin_amdgcn_readfirstlane(TAB[0]), 2 * EFF / 256, F.G, (int)blockIdx.x, TAB + 16, 0); const pg8::OrderT ST = pg8::order_table(S, F.lds + ORDTAB_OFF, F.tid);
                    pg8::EpiSwiGLU8 E{ws + WS_HIDM, EFF, 1.0f / (ASC_Z * WSC_GU), ASC_H, nullptr};
                    for (int rg_ = 0; rg_ < REP_GMOE; ++rg_) pg8::gemm_phase<pg8::EpiSwiGLU8, pg8::OrderT, true, true, true>(F.lds + RING_OFF, g, ST, E, F.wave);
#if MOEQ
                    if (Lq == 1 && (mask & C_THIN)) { const int nu_ = __builtin_amdgcn_readfirstlane(TAB[0]) * (2 * EFF / 256); pg8::Unit ux_; if (!S.next(nu_ / F.G, ux_)) { __syncthreads(); convert_moe_queue(F, 1, (gu32*)(ws + WS_CTL) + CW_QUEUE + 64, 1); } }
#endif
                }
            }
            SEAM(pb + 6);
        } }
        { SLOT_VARS;
        if (IN(pb + 7)) {
            PHASE_BEGIN();
            if ((mask & C_FFNDOWN) && !DIS_DOWN) {
                if (!odd) {
                    const bool d8 = DENSE8 == 1 || (DENSE8 == 2 && Lq == 2);
                    if (d8) {
                    pg8::Gemm g{ws + WS_HIDD, ws + WS_WD + (size_t)j * DM * FF * 2, FF, 0};
                    pg8::Order S; S.init(T / 256, 4, F.G, (int)blockIdx.x, nullptr, 0); const pg8::OrderT ST = pg8::order_table(S, F.lds + ORDTAB_OFF, F.tid);
                    pg8::EpiResid E{nullptr, (pg8::bf16_t*)(ws + WS_H16), 1.0f / (ASC_H * WSC_D), (FUSENORM && !BRINGUP) ? (float*)(ws + WS_SSQ) : nullptr, ((IN8ODD >> j) & 1) ? (unsigned char*)UB : nullptr};
                    for (int rg_ = 0; rg_ < REP_GDENSE; ++rg_) { if (rg_) { E.isc = 0.f; E.base32 = nullptr; } pg8::gemm_phase<pg8::EpiResid, pg8::OrderT, true, true, true>(F.lds + RING_OFF, g, ST, E, F.wave); }
                    } else {
                    pg8::Gemm g{ws + WS_HIDD, (const pg8::bf16_t*)(ws + WS_WD) + (size_t)j * DM * FF, FF * 2, 0};
                    pg8::Order S; S.init(T / 256, 4, F.G, (int)blockIdx.x, nullptr, 0); const pg8::OrderT ST = pg8::order_table(S, F.lds + ORDTAB_OFF, F.tid);
                    pg8::EpiResid E{nullptr, (pg8::bf16_t*)(ws + WS_H16), 1.0f, (FUSENORM && !BRINGUP) ? (float*)(ws + WS_SSQ) : nullptr, ((IN8ODD >> j) & 1) ? (unsigned char*)UB : nullptr};
                    for (int rg_ = 0; rg_ < REP_GDENSE; ++rg_) { if (rg_) { E.isc = 0.f; E.base32 = nullptr; } pg8::gemm_phase<pg8::EpiResid, pg8::OrderT, true, true>(F.lds + RING_OFF, g, ST, E, F.wave); }
                    }
                } else {
                    const int* TAB = (const int*)(ws + WS_TAB);
                    pg8::Gemm g{ws + WS_HIDM, ws + WS_WMD + (size_t)j * WS_WM_LAYER, EFF, (size_t)DM * EFF};
                    pg8::Order S; S.init(__builtin_amdgcn_readfirstlane(TAB[0]), 4, F.G, (int)blockIdx.x, TAB + 16, 0); const pg8::OrderT ST = pg8::order_table(S, F.lds + ORDTAB_OFF, F.tid);
                    pg8::EpiRowGate E{(pg8::bf16_t*)(ws + WS_XS), (const float*)(ws + WS_ROWG), DM, 1.0f / (ASC_H * WSC_D)};
                    for (int rg_ = 0; rg_ < REP_GMOE; ++rg_) pg8::gemm_phase<pg8::EpiRowGate, pg8::OrderT, true, true, true>(F.lds + RING_OFF, g, ST, E, F.wave);
#if MOEQ
                    if (Lq == 1 && (mask & C_THIN)) { pg8::Unit u5_; if (!S.next(4, u5_)) { __syncthreads(); convert_moe_queue(F, 1, (gu32*)(ws + WS_CTL) + CW_QUEUE + 64, 3); } }
#endif
                }
            }
            SEAM(pb + 7);
        } }
        { SLOT_VARS;
        if (Lq == 3 && IN(pb + 8)) { PHASE_BEGIN(); if ((mask & C_THIN) && !DIS_FIN) phase_final(F); } }
    }
#undef IN
#undef SEAM
}
#if BRINGUP
namespace naive {
typedef short bf16x8 __attribute__((ext_vector_type(8)));
typedef float f32x4 __attribute__((ext_vector_type(4)));
struct NG { const bf16* A; int lda; const float* W; const float* W2; int ldw; int wcol0, w2col0; int N, K; int mode;
            float* Cf; bf16* Cb; int ldc; int ccol0; const float* base; const float* bias1; const float* bias2; const float* rowg; const int* tab; size_t wstride; };
__global__ __launch_bounds__(256) void gemm(NG g) {
    __shared__ __attribute__((aligned(16))) bf16 sA[64][40];
    __shared__ __attribute__((aligned(16))) bf16 sB[64][40];
    __shared__ __attribute__((aligned(16))) bf16 sB2[64][40];
    const int ntn = g.N / 64, tn = blockIdx.x % ntn, tm = blockIdx.x / ntn;
    const float* W = g.W; const float* W2 = g.W2;
    if (g.tab) { const int rt = tm / 4; if (rt >= g.tab[0]) return; const int e = g.tab[16 + rt]; W += (size_t)e * g.wstride; if (W2) W2 += (size_t)e * g.wstride; }
    const int tid = threadIdx.x, wave = tid >> 6, lane = tid & 63, wr = wave >> 1, wc = wave & 1, fr = lane & 15, fq = lane >> 4;
    const bool dual = (g.mode == 2 || g.mode == 3);
    f32x4 acc[2][2], acc2[2][2];
    for (int a = 0; a < 2; ++a) for (int b = 0; b < 2; ++b) { acc[a][b] = (f32x4){0.f, 0.f, 0.f, 0.f}; acc2[a][b] = (f32x4){0.f, 0.f, 0.f, 0.f}; }
    for (int k0 = 0; k0 < g.K; k0 += 32) {
        { const int r = tid >> 2, kc = (tid & 3) * 8; *(v4u*)&sA[r][kc] = *(const v4u*)(g.A + (size_t)(tm * 64 + r) * g.lda + k0 + kc); }
        { const int k = tid >> 3, nc = (tid & 7) * 8; const float* p = W + (size_t)(k0 + k) * g.ldw + g.wcol0 + tn * 64 + nc;
          for (int i = 0; i < 8; ++i) sB[nc + i][k] = (bf16)f2bf(p[i]);
          if (dual) { const float* p2 = W2 + (size_t)(k0 + k) * g.ldw + g.w2col0 + tn * 64 + nc; for (int i = 0; i < 8; ++i) sB2[nc + i][k] = (bf16)f2bf(p2[i]); } }
        __syncthreads();
        bf16x8 a[2], b[2], b2[2];
        for (int i = 0; i < 2; ++i) { a[i] = *(const bf16x8*)&sA[wr * 32 + i * 16 + fr][fq * 8]; b[i] = *(const bf16x8*)&sB[wc * 32 + i * 16 + fr][fq * 8]; if (dual) b2[i] = *(const bf16x8*)&sB2[wc * 32 + i * 16 + fr][fq * 8]; }
        for (int mi = 0; mi < 2; ++mi) for (int ni = 0; ni < 2; ++ni) { acc[mi][ni] = __builtin_amdgcn_mfma_f32_16x16x32_bf16(a[mi], b[ni], acc[mi][ni], 0, 0, 0);
            if (dual) acc2[mi][ni] = __builtin_amdgcn_mfma_f32_16x16x32_bf16(a[mi], b2[ni], acc2[mi][ni], 0, 0, 0); }
        __syncthreads();
    }
    for (int mi = 0; mi < 2; ++mi) for (int ni = 0; ni < 2; ++ni) for (int jj = 0; jj < 4; ++jj) {
        const int row = tm * 64 + wr * 32 + mi * 16 + fq * 4 + jj, col = tn * 64 + wc * 32 + ni * 16 + fr; const float v = acc[mi][ni][jj], v2 = acc2[mi][ni][jj];
        const size_t o = (size_t)row * g.ldc + g.ccol0 + col;
        if (g.mode == 0) g.Cf[o] = v;
        else if (g.mode == 1) g.Cf[o] = g.base[o] + v;
        else if (g.mode == 2) g.Cb[o] = (bf16)f2bf(v / (1.0f + expf(-v)) * v2);
        else if (g.mode == 3) g.Cb[o] = (bf16)f2bf((v + g.bias1[col]) / (1.0f + expf(-(v2 + g.bias2[col]))));
        else g.Cb[o] = (bf16)f2bf(v * g.rowg[row]);
    }
}
__global__ void headnorm(const float* P, int ldp, int pcol0, int nheads, const float* gain, float sc, int norm, bf16* dst, int ldd, int dcol0, int rows) {
    const int idx = blockIdx.x * blockDim.x + threadIdx.x; if (idx >= rows * nheads) return;
    const int row = idx / nheads, h = idx - row * nheads; const float* p = P + (size_t)row * ldp + pcol0 + h * 64; bf16* d = dst + (size_t)row * ldd + dcol0 + h * 64;
    float r = 1.f;
    if (norm) { float ss = 0.f; for (int i = 0; i < 64; ++i) ss += p[i] * p[i]; r = sc / sqrtf(ss * (1.0f / 64.0f) + 1e-6f); }
    for (int i = 0; i < 64; ++i) d[i] = (bf16)f2bf(norm ? p[i] * r * gain[i] : p[i]);
}
__global__ __launch_bounds__(256) void attn(const bf16* Q, int qp, const bf16* K, const bf16* V, int kp, bf16* O, int op, const float* CB, int nheads, int sq, int skv, int causal) {
    const int lane = threadIdx.x & 63; const long gw = (long)blockIdx.x * 4 + (threadIdx.x >> 6);
    const int t = (int)(gw % sq); const int bh = (int)(gw / sq), h = bh % nheads, b = bh / nheads;
    float qf[64]; { const bf16* qrow = Q + ((size_t)b * sq + t) * qp + h * 64;
#pragma unroll
        for (int d = 0; d < 64; ++d) qf[d] = bflo((unsigned)qrow[d]); }
    const int nk = causal ? t + 1 : skv; float m = -INFINITY, l = 0.f, o = 0.f;
    for (int s0 = 0; s0 < nk; s0 += 64) {
        const int s = s0 + lane; float sc = -INFINITY;
        if (s < nk) { const bf16* krow = K + ((size_t)b * skv + s) * kp + h * 64; float dot = 0.f;
#pragma unroll
            for (int d = 0; d < 64; d += 2) { const unsigned w = *(const unsigned*)(krow + d); dot += qf[d] * bflo(w) + qf[d + 1] * bfhi(w); }
            sc = dot - (CB ? CB[(size_t)bh * skv + s] : 0.f); }
        float tm = sc; for (int x = 1; x < 64; x <<= 1) tm = fmaxf(tm, __shfl_xor(tm, x));
        const float mn = fmaxf(m, tm), alpha = exp2f(m - mn), p = (s < nk) ? exp2f(sc - mn) : 0.f;
        l = l * alpha + wave_sum(p); o *= alpha;
        const int lim = (nk - s0) < 64 ? (nk - s0) : 64;
        for (int jj = 0; jj < lim; ++jj) { const float pj = __shfl(p, jj); o += pj * bflo((unsigned)V[((size_t)b * skv + s0 + jj) * kp + h * 64 + lane]); }
        m = mn;
    }
    O[((size_t)b * sq + t) * op + h * 64 + lane] = (bf16)f2bf(o / l);
}
}
#endif

static void launch_mega(int grid, hipStream_t stream, Args a, int lo, int hi, unsigned mask) {
    a.ph_lo = lo; a.ph_hi = hi; a.mask = mask;
    hipLaunchKernelGGL(mega_fwd, dim3(grid), dim3(NWAVES * 64), LDS_BYTES, stream, a);
}
extern "C" void kernel_launch(void* const* d_in, const int* in_sizes, int n_in, void* d_out, int out_size, void* d_ws, size_t ws_size, hipStream_t stream) {
    static int grid = 0;
    if (grid == 0) {
        if (n_in != 27 || in_sizes[0] != T * DM || out_size != T * DM || ws_size < WS_END) { fprintf(stderr, "kernel_launch: unexpected shapes or workspace (n_in %d, ws %zu < %zu); nothing launched\n", n_in, ws_size, (size_t)WS_END); grid = -1; return; }
        int dev = 0, cus = 0, per_cu = 0;
        if (hipGetDevice(&dev) != hipSuccess || hipDeviceGetAttribute(&cus, hipDeviceAttributeMultiprocessorCount, dev) != hipSuccess) { grid = -1; return; }
        if (hipFuncSetAttribute((const void*)mega_fwd, hipFuncAttributeMaxDynamicSharedMemorySize, LDS_BYTES) != hipSuccess) { fprintf(stderr, "kernel_launch: hipFuncSetAttribute failed\n"); grid = -1; return; }
        if (hipOccupancyMaxActiveBlocksPerMultiprocessor(&per_cu, (const void*)mega_fwd, NWAVES * 64, LDS_BYTES) != hipSuccess || per_cu < 1) { fprintf(stderr, "kernel_launch: occupancy query reports %d\n", per_cu); }
        (void)hipGetLastError();
        grid = cus;
    }
    if (grid < 0) return;
#ifdef DIAG_ZERO_WS
    if (hipMemsetAsync((char*)d_ws, 0, WS_END, stream) != hipSuccess) return;
#endif
    if (hipMemsetAsync((char*)d_ws + WS_CTL, 0, CTL_ZERO_BYTES, stream) != hipSuccess) return;
    Args a{};
    for (int i = 0; i < 27; ++i) a.in[i] = (const float*)d_in[i];
    a.out = (float*)d_out; a.ws = (unsigned char*)d_ws;
#if !BRINGUP
    launch_mega(grid, stream, a, 0, NPH, C_ALL);
#else
    unsigned char* ws = (unsigned char*)d_ws; const float* const* in = a.in;
    const unsigned fast = FASTMASK;
    bf16* UB = (bf16*)(ws + WS_UB); bf16* MIX = (bf16*)(ws + WS_MIX); bf16* MQ = (bf16*)(ws + WS_MQ); bf16* QKV = (bf16*)(ws + WS_QKV); float* NT_ = (float*)(ws + WS_NTMP);
    auto ngemm = [&](naive::NG g, int rows) { hipLaunchKernelGGL(naive::gemm, dim3((rows / 64) * (g.N / 64)), dim3(256), 0, stream, g); };
    auto nhead = [&](const float* P, int ldp, int pcol0, int nheads, const float* gain, float sc, int norm, bf16* dst, int ldd, int dcol0, int rows) {
        hipLaunchKernelGGL(naive::headnorm, dim3((rows * nheads + 255) / 256), dim3(256), 0, stream, P, ldp, pcol0, nheads, gain, sc, norm, dst, ldd, dcol0, rows); };
    launch_mega(grid, stream, a, 0, 1, C_THIN);
#ifndef NLAYERS
#define NLAYERS 4
#endif
    for (int L = 0; L < NLAYERS; ++L) {
        const int pb = 1 + 9 * L, j = L >> 1; const bool odd = L & 1; const float* hsrc = L == 0 ? in[0] : (const float*)d_out;
        launch_mega(grid, stream, a, pb, pb + 1, C_THIN);
        if (!odd) {
            if (L == 0) {
                if (fast & C_PMK) launch_mega(grid, stream, a, pb + 1, pb + 2, C_PMK);
                else for (int i = 0; i < 4; ++i) {
                    naive::NG g{}; g.A = (const bf16*)(ws + WS_MEMN) + (size_t)i * 2048 * DM; g.lda = DM; g.W = in[5] + (size_t)i * DM * 512; g.ldw = 512; g.N = 512; g.K = DM; g.mode = 0; g.Cf = NT_; g.ldc = 512; ngemm(g, 2048);
                    nhead(NT_, 512, 0, 4, in[7] + i * 64, 1.0f, 1, (bf16*)(ws + WS_MKV) + (size_t)i * 2048 * 512, 512, 0, 2048);
                    nhead(NT_, 512, 256, 4, in[7], 1.0f, 0, (bf16*)(ws + WS_MKV) + (size_t)i * 2048 * 512, 512, 256, 2048);
                }
            }
            launch_mega(grid, stream, a, pb + 1, pb + 2, C_THIN);
            if (fast & C_INPROJ) launch_mega(grid, stream, a, pb + 1, pb + 2, C_INPROJ);
            else {
                naive::NG g{}; g.A = UB; g.lda = DM; g.W = in[8] + (size_t)j * DM * FOXIN; g.ldw = FOXIN; g.K = DM; g.mode = 0; g.Cf = NT_; g.ldc = 2560;
                g.wcol0 = 0; g.N = 2304; g.ccol0 = 0; ngemm(g, T);
                g.wcol0 = 2316; g.N = 256; g.ccol0 = 2304; ngemm(g, T);
                nhead(NT_, 2560, 0, 12, in[10] + j * 64, C2, 1, QKV, 2304, 0, T);
                nhead(NT_, 2560, 768, 12, in[11] + j * 64, 1.0f, 1, QKV, 2304, 768, T);
                nhead(NT_, 2560, 1536, 12, in[11], 1.0f, 0, QKV, 2304, 1536, T);
                nhead(NT_, 2560, 2304, 4, in[6] + L * 64, C2, 1, MQ, 256, 0, T);
            }
        } else {
            if (fast & C_INPROJ) launch_mega(grid, stream, a, pb + 1, pb + 2, C_INPROJ);
            else {
                naive::NG g{}; g.A = UB; g.lda = DM; g.W = in[13] + (size_t)j * DM * CONVIN; g.W2 = g.W; g.ldw = CONVIN; g.K = DM;
                g.mode = 3; g.wcol0 = 0; g.w2col0 = 768; g.N = 768; g.Cb = (bf16*)(ws + WS_GLU); g.ldc = 768; g.bias1 = in[14] + (size_t)j * 1536; g.bias2 = g.bias1 + 768; ngemm(g, T);
                naive::NG h{}; h.A = UB; h.lda = DM; h.W = g.W; h.ldw = CONVIN; h.K = DM; h.mode = 0; h.wcol0 = 1536; h.N = 256; h.Cf = NT_; h.ldc = 256; ngemm(h, T);
                nhead(NT_, 256, 0, 4, in[6] + L * 64, C2, 1, MQ, 256, 0, T);
            }
        }
        if (!odd) {
            if (fast & C_FOX) launch_mega(grid, stream, a, pb + 2, pb + 3, C_FOX);
            else hipLaunchKernelGGL(naive::attn, dim3(BATCH * NH * SEQ / 4), dim3(256), 0, stream, (const bf16*)QKV, 2304, (const bf16*)QKV + 768, (const bf16*)QKV + 1536, 2304, MIX, DM, (const float*)(ws + WS_CB), NH, SEQ, SEQ, 1);
        } else launch_mega(grid, stream, a, pb + 2, pb + 3, C_THIN);
        if (fast & C_MEMATT) launch_mega(grid, stream, a, pb + 2, pb + 3, C_MEMATT);
        else { const bf16* mkv = (const bf16*)(ws + WS_MKV) + (size_t)L * 2048 * 512;
            hipLaunchKernelGGL(naive::attn, dim3(BATCH * MEMH * SEQ / 4), dim3(256), 0, stream, (const bf16*)MQ, 256, mkv, mkv + 256, 512, MIX + 768, DM, (const float*)nullptr, MEMH, SEQ, ML, 0); }
        if (fast & C_OUTPROJ) launch_mega(grid, stream, a, pb + 3, pb + 4, C_OUTPROJ);
        else { naive::NG g{}; g.A = MIX; g.lda = DM; g.W = in[odd ? 19 : 12] + (size_t)j * DM * DM; g.ldw = DM; g.N = DM; g.K = DM; g.mode = 1; g.Cf = (float*)d_out; g.ldc = DM; g.base = hsrc; ngemm(g, T); }
        launch_mega(grid, stream, a, pb + 4, pb + 5, C_THIN);
        if (odd) launch_mega(grid, stream, a, pb + 5, pb + 6, C_THIN);
        if (fast & C_FFNUP) launch_mega(grid, stream, a, pb + 6, pb + 7, C_FFNUP);
        else if (!odd) { naive::NG g{}; g.A = UB; g.lda = DM; g.W = in[20] + (size_t)j * DM * FF; g.W2 = in[21] + (size_t)j * DM * FF; g.ldw = FF; g.N = FF; g.K = DM; g.mode = 2; g.Cb = (bf16*)(ws + WS_HIDD); g.ldc = FF; ngemm(g, T); }
        else { naive::NG g{}; g.A = (const bf16*)(ws + WS_XS); g.lda = DM; g.W = in[24] + (size_t)j * NE * DM * EFF; g.W2 = in[25] + (size_t)j * NE * DM * EFF; g.ldw = EFF; g.N = EFF; g.K = DM; g.mode = 2; g.Cb = (bf16*)(ws + WS_HIDM); g.ldc = EFF;
               g.tab = (const int*)(ws + WS_TAB); g.wstride = (size_t)DM * EFF; ngemm(g, MAXROWS); }
        if (fast & C_FFNDOWN) launch_mega(grid, stream, a, pb + 7, pb + 8, C_FFNDOWN);
        else if (!odd) { naive::NG g{}; g.A = (const bf16*)(ws + WS_HIDD); g.lda = FF; g.W = in[22] + (size_t)j * FF * DM; g.ldw = DM; g.N = DM; g.K = FF; g.mode = 1; g.Cf = (float*)d_out; g.ldc = DM; g.base = (const float*)d_out; ngemm(g, T); }
        else { naive::NG g{}; g.A = (const bf16*)(ws + WS_HIDM); g.lda = EFF; g.W = in[26] + (size_t)j * NE * EFF * DM; g.ldw = DM; g.N = DM; g.K = EFF; g.mode = 4; g.Cb = (bf16*)(ws + WS_XS); g.ldc = DM; g.rowg = (const float*)(ws + WS_ROWG);
               g.tab = (const int*)(ws + WS_TAB); g.wstride = (size_t)EFF * DM; ngemm(g, MAXROWS); }
        if (L == 3 || (odd && L == NLAYERS - 1)) launch_mega(grid, stream, a, 1 + 27 + 8, 1 + 27 + 9, C_THIN);
    }
#endif
}
```

```cpp
#define BRINGUP 0
#define FASTMASK 0
#include <hip/hip_runtime.h>
#include <hip/hip_bf16.h>
#include <cstdio>
#include <cstdint>
#include <cmath>
#include <utility>

#ifndef BRINGUP
#define BRINGUP 0
#endif
#ifndef DENSE8
#define DENSE8 2
#endif
#ifndef UP8L0
#define UP8L0 0
#endif
#ifndef IN8L2
#define IN8L2 1
#endif
#ifndef IN8L0
#define IN8L0 1
#endif
#ifndef IN8ODD
#define IN8ODD 0
#endif
#ifndef FUSENORM
#define FUSENORM 1
#endif
#ifndef MOEQ
#define MOEQ 1
#endif
#ifndef FASTMASK
#define FASTMASK 0
#endif

__device__ __forceinline__ float lconst(float c) { asm volatile("" : "+s"(c)); return c; }
__device__ __forceinline__ int lconsti(int c) { asm volatile("" : "+s"(c)); return c; }

constexpr int BATCH = 8, SEQ = 4096, DM = 1024, T = BATCH * SEQ, NH = 12, HD = 64, FOXD = 768, MEMD = 256, MEMH = 4, ML = 256;
constexpr int FF = 2816, EFF = 3584, NE = 8, CW = 31, CONVD = 768, FOXIN = 2572, CONVIN = 1792;
constexpr int MAXRT = 264, MAXROWS = MAXRT * 256;
constexpr float RMS_EPS = 1e-6f;
constexpr float LOG2E = 1.4426950408889634f;
constexpr float C2 = 0.125f * 1.4426950408889634f;

constexpr size_t MiB = 1u << 20, KiB = 1u << 10;
constexpr size_t WS_CTL = 0, CTL_ZERO_BYTES = 1 * MiB;
constexpr size_t WS_LOGF = 1 * MiB;
constexpr size_t WS_CB = 3 * MiB;
constexpr size_t WS_RS = 4 * MiB + 512 * KiB;
constexpr size_t WS_TOPE = 5 * MiB;
constexpr size_t WS_TOPG = 5 * MiB + 512 * KiB;
constexpr size_t WS_SLOT = 6 * MiB;
constexpr size_t WS_ROWG = 6 * MiB + 512 * KiB;
constexpr size_t WS_CNT = 7 * MiB;
constexpr size_t WS_TAB = 7 * MiB + 64 * KiB;
constexpr size_t WS_GT = 7 * MiB + 128 * KiB;
constexpr size_t WS_MKV = 8 * MiB;
constexpr size_t WS_MEMN = 16 * MiB;
constexpr size_t WS_WINE = 32 * MiB;
constexpr size_t WS_WOUTE = 42 * MiB;
constexpr size_t WS_WINO = 46 * MiB;
constexpr size_t WS_WOUTO = 53 * MiB;
constexpr size_t WS_WGU = 57 * MiB;
constexpr size_t WS_WD = 79 * MiB;
constexpr size_t WS_WKV = 90 * MiB;
constexpr size_t WS_SSQ = 94 * MiB;
constexpr size_t WS_WMGU = 96 * MiB;
constexpr size_t WS_WMD = 152 * MiB;
constexpr size_t WS_WM_LAYER = 84 * MiB;
constexpr float WSC_GU = 256.f, WSC_D = 1024.f, ASC_Z = 8.f, ASC_H = 8.f;
constexpr size_t WS_R = 264 * MiB;
constexpr size_t WS_QKV = WS_R;
constexpr size_t WS_GLU = WS_R;
constexpr size_t WS_XS = WS_R;
constexpr size_t WS_MQ = WS_R + 144 * MiB;
constexpr size_t WS_MIX = WS_R + 160 * MiB;
constexpr size_t WS_UB = WS_R + 224 * MiB;
constexpr size_t WS_HIDD = WS_R + 288 * MiB;
constexpr size_t WS_HIDM = WS_R + 132 * MiB;
constexpr size_t WS_NTMP = WS_R + 288 * MiB;
constexpr size_t WS_H16 = WS_R + 594 * MiB;
#if BRINGUP
constexpr size_t WS_END = WS_R + 672 * MiB;
#else
constexpr size_t WS_END = WS_R + 658 * MiB;
#endif
static_assert(WS_HIDM + (size_t)MAXROWS * EFF * 2 <= WS_R + 594 * MiB, "ws map");
static_assert(WS_XS + (size_t)MAXROWS * DM * 2 <= WS_HIDM, "ws map");
static_assert(WS_HIDD + (size_t)T * FF * 2 <= WS_R + 594 * MiB, "ws map");
constexpr int CW_TMO = 0, CW_CODE = 1;
constexpr int CW_BAR = 4096;
constexpr int CW_QUEUE = 8192;

constexpr int NPH = 37;
constexpr unsigned C_THIN = 1u, C_PMK = 2u, C_INPROJ = 4u, C_FOX = 8u, C_MEMATT = 16u, C_OUTPROJ = 32u, C_FFNUP = 64u, C_FFNDOWN = 128u, C_ALL = 0xffu;
namespace pg8 {
#define PG8_LAS __attribute__((address_space(3)))
#define PG8_GAS __attribute__((address_space(1)))
typedef unsigned short bf16_t;
typedef short bf16x8 __attribute__((ext_vector_type(8)));
typedef float f32x4 __attribute__((ext_vector_type(4)));
typedef unsigned u32x4 __attribute__((ext_vector_type(4)));
constexpr int BM = 256, BK = 64, HALF = 128, HTB = HALF * BK * 2  , STAGE_BYTES = 8 * HTB, NXCD = 8, WGM = 8;

__host__ __device__ __forceinline__ int lds_byte(int r, int c) { const int st = (r >> 4) * 2 + (c >> 5), rr = r & 15, cc = c & 31, ob = rr * 64 + cc * 2; return st * 1024 + (ob ^ (((ob >> 9) & 1) << 5)); }
__host__ __device__ __forceinline__ void stage_rc(int b, int& R, int& C) { const int st = b / 1024, sb = b % 1024, swz = sb ^ (((sb >> 9) & 1) << 5); R = (st >> 1) * 16 + swz / 64; C = (st & 1) * 32 + (swz % 64) / 2; }
__host__ __device__ __forceinline__ int perm32(int rho) { const int n = rho >> 4, i = rho & 15; return 8 * (i >> 2) + 4 * n + (i & 3); }

typedef int v8i __attribute__((ext_vector_type(8)));
typedef int v4i __attribute__((ext_vector_type(4)));
struct Unit { int pm, pn, g; };
struct Gemm { const void* A; const void* Bt; int Kb; size_t gstride; };

struct Order {
    int nM, nN, nwg, G, c, gdiv; const int* tile_g;
    __device__ __forceinline__ void init(int nM_, int nN_, int G_, int c_, const int* tg, int gd) { nM = nM_; nN = nN_; nwg = nM * nN; G = G_; c = c_; tile_g = tg; gdiv = gd; }
    __device__ __forceinline__ bool next(int i, Unit& u) const {
        const long L = (long)i * G + c; if (L >= nwg) return false;
        int wgid = (int)L; { const int q = nwg / NXCD, r = nwg % NXCD, xcd = wgid % NXCD, off = wgid / NXCD; wgid = (xcd < r ? xcd * (q + 1) : r * (q + 1) + (xcd - r) * q) + off; }
        const int nig = WGM * nN, gid = wgid / nig, fm = gid * WGM, gsz = (nM - fm) < WGM ? (nM - fm) : WGM;
        u.pm = fm + ((wgid % nig) % gsz); u.pn = (wgid % nig) / gsz;
        if (tile_g) { const int* tg = tile_g; asm volatile("" : "+s"(tg)); u.g = __builtin_amdgcn_readfirstlane(tg[u.pm]); }
        else u.g = gdiv ? u.pm / gdiv : 0;
        return true;
    }
    __device__ __forceinline__ bool next_lane(int i, Unit& u) const {
        const long L = (long)i * G + c; if (L >= nwg) return false;
        int wgid = (int)L; { const int q = nwg / NXCD, r = nwg % NXCD, xcd = wgid % NXCD, off = wgid / NXCD; wgid = (xcd < r ? xcd * (q + 1) : r * (q + 1) + (xcd - r) * q) + off; }
        const int nig = WGM * nN, gid = wgid / nig, fm = gid * WGM, gsz = (nM - fm) < WGM ? (nM - fm) : WGM;
        u.pm = fm + ((wgid % nig) % gsz); u.pn = (wgid % nig) / gsz;
        if (tile_g) u.g = ((const PG8_GAS int*)tile_g)[u.pm]; else u.g = gdiv ? u.pm / gdiv : 0;
        return true;
    }
};
constexpr int ORD_ENT = 48;
struct OrderT {
    const PG8_LAS v4i* tab;
    __device__ __forceinline__ bool next(int i, Unit& u) const {
        const v4i e = tab[i < ORD_ENT - 1 ? i : ORD_ENT - 1];
        u.pm = __builtin_amdgcn_readfirstlane(e.x); u.pn = __builtin_amdgcn_readfirstlane(e.y); u.g = __builtin_amdgcn_readfirstlane(e.z);
        return __builtin_amdgcn_readfirstlane(e.w) != 0;
    }
};
__device__ __forceinline__ OrderT order_table(const Order& S, PG8_LAS unsigned char* lds_tab, int tid) {
    PG8_LAS v4i* t = (PG8_LAS v4i*)lds_tab;
    if (tid < ORD_ENT) { Unit u; u.pm = 0; u.pn = 0; u.g = 0; const bool ok = (tid < ORD_ENT - 1) && S.next_lane(tid, u); v4i e; e.x = u.pm; e.y = u.pn; e.z = u.g; e.w = ok ? 1 : 0; t[tid] = e; }
    __syncthreads();
    OrderT r; r.tab = t; return r;
}

__device__ __forceinline__ unsigned cvt_pk_bf16(float lo, float hi) { unsigned r; asm volatile("v_cvt_pk_bf16_f32 %0, %1, %2" : "=v"(r) : "v"(lo), "v"(hi)); return r; }
__device__ __forceinline__ u32x4 pack8(const f32x4 a, const f32x4 b) { u32x4 w; w.x = cvt_pk_bf16(a[0], a[1]); w.y = cvt_pk_bf16(a[2], a[3]); w.z = cvt_pk_bf16(b[0], b[1]); w.w = cvt_pk_bf16(b[2], b[3]); return w; }
__device__ __forceinline__ float sigmoidf_fast(float x) { return __builtin_amdgcn_rcpf(1.0f + __builtin_amdgcn_exp2f(-1.4426950408889634f * x)); }
__device__ __forceinline__ f32x4 sig4(const f32x4 x) { f32x4 r; r[0] = sigmoidf_fast(x[0]); r[1] = sigmoidf_fast(x[1]); r[2] = sigmoidf_fast(x[2]); r[3] = sigmoidf_fast(x[3]); return r; }

__device__ __forceinline__ f32x4 swiglu4(const f32x4 a, const f32x4 b, const float rt, const float irq  ) {
    const f32x4 t = a * rt; f32x4 r;
#pragma unroll
    for (int i = 0; i < 4; ++i) { const float e = __builtin_amdgcn_exp2f(t[i]); r[i] = __builtin_amdgcn_rcpf(__builtin_fmaf(e, irq, irq)); }
    return (a * b) * r;
}

__device__ __forceinline__ float fq_sum(float ss) {
    { const auto r = __builtin_amdgcn_permlane16_swap(__builtin_bit_cast(unsigned, ss), __builtin_bit_cast(unsigned, ss), false, false); ss = __builtin_bit_cast(float, (unsigned)r[0]) + __builtin_bit_cast(float, (unsigned)r[1]); }
    { const auto r = __builtin_amdgcn_permlane32_swap(__builtin_bit_cast(unsigned, ss), __builtin_bit_cast(unsigned, ss), false, false); ss = __builtin_bit_cast(float, (unsigned)r[0]) + __builtin_bit_cast(float, (unsigned)r[1]); }
    return ss;
}
struct Gain16 { f32x4 a, b, c, d; };
__device__ __forceinline__ Gain16 load_gain16(const float* gl  ) { Gain16 g; g.a = *(const PG8_GAS f32x4*)(gl); g.b = *(const PG8_GAS f32x4*)(gl + 4); g.c = *(const PG8_GAS f32x4*)(gl + 32); g.d = *(const PG8_GAS f32x4*)(gl + 36); return g; }
__device__ __forceinline__ void headnorm_store(const f32x4 (&acc)[2][2][4][2], int ai, int m, bool norm, const Gain16& gn, float sc, bf16_t* rowp  , int lane, float pre = 1.0f  ) {
    f32x4 v00 = acc[ai][0][m][0] * pre, v01 = acc[ai][0][m][1] * pre, v10 = acc[ai][1][m][0] * pre, v11 = acc[ai][1][m][1] * pre;
    if (norm) {
        const f32x4 q = v00 * v00 + v01 * v01 + v10 * v10 + v11 * v11;
        float ss = (q[0] + q[1]) + (q[2] + q[3]);
        ss += __builtin_bit_cast(float, __builtin_amdgcn_ds_bpermute((lane ^ 16) << 2, __builtin_bit_cast(int, ss))); ss += __builtin_bit_cast(float, __builtin_amdgcn_ds_bpermute((lane ^ 32) << 2, __builtin_bit_cast(int, ss)));
        const float r = __builtin_amdgcn_rsqf(ss * (1.0f / 64.0f) + lconst(1e-6f)) * sc;
        v00 = v00 * r * gn.a; v01 = v01 * r * gn.b; v10 = v10 * r * gn.c; v11 = v11 * r * gn.d;
    }
    *(PG8_GAS u32x4*)(rowp) = pack8(v00, v01);
    *(PG8_GAS u32x4*)(rowp + 32) = pack8(v10, v11);
}
__device__ __forceinline__ float row_rs(const float* ssq, int row) {
    const f32x4 a = *(const PG8_GAS f32x4*)(ssq + (size_t)row * 16), b = *(const PG8_GAS f32x4*)(ssq + (size_t)row * 16 + 4), c = *(const PG8_GAS f32x4*)(ssq + (size_t)row * 16 + 8), d = *(const PG8_GAS f32x4*)(ssq + (size_t)row * 16 + 12);
    const f32x4 t = (a + b) + (c + d); return __builtin_amdgcn_rsqf(((t[0] + t[1]) + (t[2] + t[3])) * (1.0f / 1024.0f) + 1e-6f);
}
__device__ __forceinline__ void row_scales(float (&rsv)[2][4], const float* ssq, int row0, int fr, int fq) {
    f32x4 t[2][4]; const int lane = fq * 16 + fr; const float eps_ = lconst(1e-6f);
#pragma unroll
    for (int ai = 0; ai < 2; ++ai)
#pragma unroll
        for (int m = 0; m < 4; ++m) t[ai][m] = *(const PG8_GAS f32x4*)(ssq + (size_t)(row0 + ai * HALF + m * 16) * 16 + 4 * fq);
#pragma unroll
    for (int ai = 0; ai < 2; ++ai)
#pragma unroll
        for (int m = 0; m < 4; ++m) { float ss = (t[ai][m][0] + t[ai][m][1]) + (t[ai][m][2] + t[ai][m][3]);
            ss += __builtin_bit_cast(float, __builtin_amdgcn_ds_bpermute((lane ^ 16) << 2, __builtin_bit_cast(int, ss))); ss += __builtin_bit_cast(float, __builtin_amdgcn_ds_bpermute((lane ^ 32) << 2, __builtin_bit_cast(int, ss)));
            rsv[ai][m] = __builtin_amdgcn_rsqf(ss * (1.0f / 1024.0f) + eps_); }
}
struct EpiInEven {
    static constexpr bool PERM = true, AFTER_DRAIN = false;
    bf16_t* QKV; bf16_t* MQ; const float* gt; float isc = 1.0f;
    __device__ __forceinline__ void operator()(const f32x4 (&acc)[2][2][4][2], const Unit& u, int wr, int wc, int fr, int fq) const {
        const int row0 = u.pm * BM + wr * 64 + fr; const int pn = u.pn;
        float isc_ = isc; asm volatile("" : "+v"(isc_));
        const bool norm = (pn < 6) || (pn == 9);
        const int sel = pn < 3 ? 0 : (pn < 6 ? 1 : 2);
        const Gain16 gn = load_gain16(gt + 64 * sel + 8 * fq);
        const int ld = (pn == 9) ? MEMD : 3 * FOXD;
        const size_t dofs = (pn == 9) ? (size_t)((const char*)MQ - (const char*)QKV) / 2 : (size_t)256 * pn;
        bf16_t* dst = QKV + dofs + 64 * wc + 8 * fq;
#pragma unroll
        for (int ai = 0; ai < 2; ++ai)
#pragma unroll
            for (int m = 0; m < 4; ++m) headnorm_store(acc, ai, m, norm, gn, 1.0f, dst + (size_t)(row0 + ai * HALF + m * 16) * ld, fq * 16 + fr, isc_);
    }
};
struct EpiMemKV {
    static constexpr bool PERM = true, AFTER_DRAIN = false;
    bf16_t* MKV; const float* gmk;
    __device__ __forceinline__ void operator()(const f32x4 (&acc)[2][2][4][2], const Unit& u, int wr, int wc, int fr, int fq) const {
        const int row0 = u.pm * BM + wr * 64 + fr;
        const Gain16 gn = load_gain16(gmk + 64 * u.g + 8 * fq);
        bf16_t* dst = MKV + 256 * u.pn + 64 * wc + 8 * fq;
#pragma unroll
        for (int ai = 0; ai < 2; ++ai)
#pragma unroll
            for (int m = 0; m < 4; ++m) headnorm_store(acc, ai, m, u.pn == 0, gn, 1.0f, dst + (size_t)(row0 + ai * HALF + m * 16) * 512, fq * 16 + fr);
    }
};
struct EpiInOdd {
    static constexpr bool PERM = true, AFTER_DRAIN = false;
    bf16_t* GLU; bf16_t* MQ; const float* bias; const float* gmq; const float* ssq; float isc = 1.0f;
    __device__ __forceinline__ void operator()(f32x4 (&acc)[2][2][4][2], const Unit& u, int wr, int wc, int fr, int fq) const {
        const int row0 = u.pm * BM + wr * 64 + fr;
        if (ssq) { float rsv[2][4]; row_scales(rsv, ssq, row0, fr, fq); float isc_ = isc; asm volatile("" : "+v"(isc_));
#pragma unroll
            for (int ai = 0; ai < 2; ++ai)
#pragma unroll
                for (int m = 0; m < 4; ++m) { const float rs = rsv[ai][m] * isc_;
#pragma unroll
                    for (int bj = 0; bj < 2; ++bj)
#pragma unroll
                        for (int n = 0; n < 2; ++n) acc[ai][bj][m][n] = acc[ai][bj][m][n] * rs; }
        }
        if (u.pn == 6) {
            const Gain16 gn = load_gain16(gmq + 8 * fq);
            bf16_t* dst = MQ + 64 * wc + 8 * fq;
#pragma unroll
            for (int ai = 0; ai < 2; ++ai)
#pragma unroll
                for (int m = 0; m < 4; ++m) headnorm_store(acc, ai, m, true, gn, 1.0f, dst + (size_t)(row0 + ai * HALF + m * 16) * MEMD, fq * 16 + fr);
        } else {
            const int col0 = u.pn * 128 + wc * 32 + 8 * fq;
            const f32x4 ba0 = *(const PG8_GAS f32x4*)(bias + col0), ba1 = *(const PG8_GAS f32x4*)(bias + col0 + 4), bg0 = *(const PG8_GAS f32x4*)(bias + CONVD + col0), bg1 = *(const PG8_GAS f32x4*)(bias + CONVD + col0 + 4);
#pragma unroll
            for (int ai = 0; ai < 2; ++ai)
#pragma unroll
                for (int m = 0; m < 4; ++m) {
                    const f32x4 o0 = (acc[ai][0][m][0] + ba0) * sig4(acc[ai][1][m][0] + bg0), o1 = (acc[ai][0][m][1] + ba1) * sig4(acc[ai][1][m][1] + bg1);
                    *(PG8_GAS u32x4*)(GLU + (size_t)(row0 + ai * HALF + m * 16) * CONVD + col0) = pack8(o0, o1);
                }
        }
    }
};
struct EpiSwiGLU {
    static constexpr bool PERM = true, AFTER_DRAIN = false;
    bf16_t* O; int ldc; const float* ssq;
    __device__ __forceinline__ void operator()(const f32x4 (&acc)[2][2][4][2], const Unit& u, int wr, int wc, int fr, int fq) const {
        const int row0 = u.pm * BM + wr * 64 + fr; const int col0 = u.pn * 128 + wc * 32 + 8 * fq;
        float rsv[2][4]; float nl2 = -1.4426950408889634f; asm volatile("" : "+v"(nl2));
        if (ssq) row_scales(rsv, ssq, row0, fr, fq);
        else {
#pragma unroll
            for (int ai = 0; ai < 2; ++ai)
#pragma unroll
                for (int m = 0; m < 4; ++m) rsv[ai][m] = 1.0f; }
#pragma unroll
        for (int ai = 0; ai < 2; ++ai)
#pragma unroll
            for (int m = 0; m < 4; ++m) {
                const float rs = rsv[ai][m], rt = rs * nl2, rq = __builtin_amdgcn_rcpf(rs * rs);
                const f32x4 o0 = swiglu4(acc[ai][0][m][0], acc[ai][1][m][0], rt, rq), o1 = swiglu4(acc[ai][0][m][1], acc[ai][1][m][1], rt, rq);
                *(PG8_GAS u32x4*)(O + (size_t)(row0 + ai * HALF + m * 16) * ldc + col0) = pack8(o0, o1);
            }
    }
};
__device__ __forceinline__ unsigned pk4_fp8(const f32x4 v) { int p = __builtin_amdgcn_cvt_pk_fp8_f32(v[0], v[1], __builtin_bit_cast(int, v[0])  , false); p = __builtin_amdgcn_cvt_pk_fp8_f32(v[2], v[3], p, true); return (unsigned)p; }
__device__ __forceinline__ f32x4 clamp8(const f32x4 v, const float c) { f32x4 r; r[0] = __builtin_amdgcn_fmed3f(v[0], -c, c); r[1] = __builtin_amdgcn_fmed3f(v[1], -c, c); r[2] = __builtin_amdgcn_fmed3f(v[2], -c, c); r[3] = __builtin_amdgcn_fmed3f(v[3], -c, c); return r; }
template <bool OUT16> struct EpiSwiGLU8T {
    static constexpr bool PERM = true, AFTER_DRAIN = false;
    unsigned char* O; int ldc; float isc, osc; const float* ssq;
    __device__ __forceinline__ void operator()(const f32x4 (&acc)[2][2][4][2], const Unit& u, int wr, int wc, int fr, int fq) const {
#ifdef PROBE_EPI2
        for (int rp_ = 0; rp_ < 2; ++rp_) { asm volatile("" ::: "memory");
#endif
        const int row0 = u.pm * BM + wr * 64 + fr; const int col0 = u.pn * 128 + wc * 32 + 8 * fq;
        float isc_ = isc, uo = OUT16 ? isc : isc * osc, c448 = 448.f, nl2 = -1.4426950408889634f; asm volatile("" : "+v"(isc_), "+v"(uo), "+v"(c448), "+v"(nl2));
        float rsv[2][4];
        if (ssq) row_scales(rsv, ssq, row0, fr, fq);
        else {
#pragma unroll
            for (int ai = 0; ai < 2; ++ai)
#pragma unroll
                for (int m = 0; m < 4; ++m) rsv[ai][m] = 1.0f; }
#pragma unroll
        for (int ai = 0; ai < 2; ++ai)
#pragma unroll
            for (int m = 0; m < 4; ++m) {
                const float ri = rsv[ai][m] * isc_, rt = ri * nl2, rq = __builtin_amdgcn_rcpf(ri * (rsv[ai][m] * uo));
                const f32x4 o0 = swiglu4(acc[ai][0][m][0], acc[ai][1][m][0], rt, rq), o1 = swiglu4(acc[ai][0][m][1], acc[ai][1][m][1], rt, rq);
                if constexpr (OUT16) *(PG8_GAS u32x4*)((bf16_t*)O + (size_t)(row0 + ai * HALF + m * 16) * ldc + col0) = pack8(o0, o1);
                else { typedef unsigned u32x2 __attribute__((ext_vector_type(2)));
                u32x2 w; w.x = pk4_fp8(clamp8(o0, c448)); w.y = pk4_fp8(clamp8(o1, c448));
                *(PG8_GAS u32x2*)(O + (size_t)(row0 + ai * HALF + m * 16) * ldc + col0) = w; }
                __builtin_amdgcn_sched_barrier(0);
            }
#ifdef PROBE_EPI2
        }
#endif
    }
};
typedef EpiSwiGLU8T<false> EpiSwiGLU8;
typedef EpiSwiGLU8T<true> EpiSwiGLU8B;
struct EpiResid {
    static constexpr bool PERM = true, AFTER_DRAIN = false;
    const float* base32; bf16_t* h16; float isc; float* ssq; unsigned char* h8;
    __device__ __forceinline__ void operator()(const f32x4 (&acc)[2][2][4][2], const Unit& u, int wr, int wc, int fr, int fq) const {
        const int row0 = u.pm * BM + wr * 64 + fr; const int col0 = u.pn * BM + wc * 32 + 8 * fq;
        float isc_ = isc, c448 = 448.f; asm volatile("" : "+v"(isc_), "+v"(c448)); const int lane = fq * 16 + fr;
        auto rowof = [&](int gi) { return row0 + (gi >> 2) * HALF + (gi & 3) * 16; };
        auto finish = [&](int gi, const f32x4 (&cu)[2][2]) { const int ai = gi >> 2, m = gi & 3; const int row = rowof(gi);
            float ss = 0.f;
#pragma unroll
            for (int bj = 0; bj < 2; ++bj) { const f32x4 o0 = cu[bj][0] + acc[ai][bj][m][0] * isc_, o1 = cu[bj][1] + acc[ai][bj][m][1] * isc_;
                *(PG8_GAS u32x4*)(h16 + (size_t)row * DM + col0 + bj * HALF) = pack8(o0, o1);
                if (ssq) { const f32x4 q = o0 * o0 + o1 * o1; ss += (q[0] + q[1]) + (q[2] + q[3]); }
                if (h8) { typedef unsigned u32x2 __attribute__((ext_vector_type(2))); u32x2 w; w.x = pk4_fp8(clamp8(o0 * ASC_Z, c448)); w.y = pk4_fp8(clamp8(o1 * ASC_Z, c448)); *(PG8_GAS u32x2*)(h8 + (size_t)row * DM + col0 + bj * HALF) = w; } }
            if (ssq) { ss += __builtin_bit_cast(float, __builtin_amdgcn_ds_bpermute((lane ^ 16) << 2, __builtin_bit_cast(int, ss))); ss += __builtin_bit_cast(float, __builtin_amdgcn_ds_bpermute((lane ^ 32) << 2, __builtin_bit_cast(int, ss)));
                if (fq == 0) *(PG8_GAS float*)(ssq + (size_t)row * 16 + u.pn * 4 + wc) = ss; }
            __builtin_amdgcn_sched_barrier(0); };
        if (base32) {
#pragma unroll
            for (int hb = 0; hb < 2; ++hb) { f32x4 rf[4][2][2];
#pragma unroll
                for (int g = 0; g < 4; ++g)
#pragma unroll
                    for (int bj = 0; bj < 2; ++bj) { const size_t p = (size_t)rowof(4 * hb + g) * DM + col0 + bj * HALF; rf[g][bj][0] = *(const PG8_GAS f32x4*)(base32 + p); rf[g][bj][1] = *(const PG8_GAS f32x4*)(base32 + p + 4); }
                __builtin_amdgcn_sched_barrier(0);
#pragma unroll
                for (int g = 0; g < 4; ++g) finish(4 * hb + g, rf[g]); }
        } else {
            u32x4 rw[8][2];
#pragma unroll
            for (int gi = 0; gi < 8; ++gi)
#pragma unroll
                for (int bj = 0; bj < 2; ++bj) rw[gi][bj] = *(const PG8_GAS u32x4*)(h16 + (size_t)rowof(gi) * DM + col0 + bj * HALF);
            __builtin_amdgcn_sched_barrier(0);
#pragma unroll
            for (int gi = 0; gi < 8; ++gi) { f32x4 cu[2][2];
#pragma unroll
                for (int bj = 0; bj < 2; ++bj) { const u32x4 w = rw[gi][bj];
                    cu[bj][0] = (f32x4){__builtin_bit_cast(float, w.x << 16), __builtin_bit_cast(float, w.x & 0xffff0000u), __builtin_bit_cast(float, w.y << 16), __builtin_bit_cast(float, w.y & 0xffff0000u)};
                    cu[bj][1] = (f32x4){__builtin_bit_cast(float, w.z << 16), __builtin_bit_cast(float, w.z & 0xffff0000u), __builtin_bit_cast(float, w.w << 16), __builtin_bit_cast(float, w.w & 0xffff0000u)}; }
                finish(gi, cu); }
        }
    }
};
struct EpiRowGate {
    static constexpr bool PERM = true, AFTER_DRAIN = false;
    bf16_t* Y; const float* rowg; int ldc; float isc;
    __device__ __forceinline__ void operator()(const f32x4 (&acc)[2][2][4][2], const Unit& u, int wr, int wc, int fr, int fq) const {
        const int row0 = u.pm * BM + wr * 64 + fr; const int col0 = u.pn * BM + wc * 32 + 8 * fq;
        float isc_ = isc; asm volatile("" : "+v"(isc_));
        float rgv[2][4];
#pragma unroll
        for (int ai = 0; ai < 2; ++ai)
#pragma unroll
            for (int m = 0; m < 4; ++m) rgv[ai][m] = *(const PG8_GAS float*)(rowg + row0 + ai * HALF + m * 16);
#pragma unroll
        for (int ai = 0; ai < 2; ++ai)
#pragma unroll
            for (int m = 0; m < 4; ++m) { const int row = row0 + ai * HALF + m * 16; const float rg = rgv[ai][m] * isc_;
#pragma unroll
                for (int bj = 0; bj < 2; ++bj) *(PG8_GAS u32x4*)(Y + (size_t)row * ldc + col0 + bj * HALF) = pack8(acc[ai][bj][m][0] * rg, acc[ai][bj][m][1] * rg);
                __builtin_amdgcn_sched_barrier(0); }
    }
};

template <class Epi, class Sched, bool ALIGN_EPI = false, bool SP2 = false, bool F8 = false>
__device__ __forceinline__ void gemm_phase(PG8_LAS unsigned char* lds, const Gemm g, const Sched& S, const Epi& E, const int wave_in  ) {
    int lane; asm volatile("v_mbcnt_lo_u32_b32 %0, -1, 0\n\tv_mbcnt_hi_u32_b32 %0, -1, %0" : "=v"(lane));
    const int wid = wave_in, tid = wave_in * 64 + lane, wr = wid >> 2, wc = wid & 3, fr = lane & 15, fq = lane >> 4;
    const int Kb = g.Kb, nt = Kb / (BK * 2);
    unsigned voffA, voffB;
    { int R, C; stage_rc(tid * 16, R, C); const int Rb = Epi::PERM ? ((R & ~31) + perm32(R & 31)) : R; voffA = (unsigned)(R * Kb + C * 2); voffB = (unsigned)(Rb * Kb + C * 2); }
    const size_t pstep = (size_t)64 * Kb;
    const size_t kstep = (size_t)(BK * 2);
    const size_t hstep = (size_t)HALF * Kb;
    const size_t tstep = 2 * hstep;
    const unsigned ldsw = (unsigned)wid * 1024u;
    const unsigned lds0 = (unsigned)(uintptr_t)lds;
    const int aoff = lds_byte(wr * 64 + fr, fq * 8), boff = lds_byte(wc * 32 + fr, fq * 8);
    PG8_LAS unsigned char* pa = lds + aoff; PG8_LAS unsigned char* pb = lds + 4 * HTB + boff; asm volatile("" : "+v"(pa), "+v"(pb));
#define PG8_SA(b, h) (((b) * 2 + (h)) * HTB)
#define PG8_SB(b, h) ((4 + (b) * 2 + (h)) * HTB)
#define PG8_GLDS(voff32, gbase, ldsdst) do { unsigned keep_; asm volatile("s_mov_b32 %0, m0\n\ts_mov_b32 m0, %3\n\ts_nop 0\n\tglobal_load_lds_dwordx4 %1, %2\n\ts_mov_b32 m0, %0" \
        : "=&s"(keep_) : "v"(voff32), "s"(gbase), "s"(ldsdst) : "memory"); } while (0)
#define PG8_STAGE(bufoff, gbase, voff) do { _Pragma("unroll") for (int _i = 0; _i < 2; ++_i) \
        PG8_GLDS((voff), (const char*)(gbase) + _i * pstep, (unsigned)__builtin_amdgcn_readfirstlane((int)(lds0 + (unsigned)(bufoff) + ldsw + (unsigned)(_i * 8192)))); } while (0)
#define PG8_RDA(off) (*(const PG8_LAS v4i*)(pa + (off)))
#define PG8_RDB(off) (*(const PG8_LAS v4i*)(pb + (off)))
#define PG8_LDA(dst, b, h) do { _Pragma("unroll") for (int m = 0; m < 4; ++m) { \
        if constexpr (F8) dst##8[m] = __builtin_shufflevector(PG8_RDA(PG8_SA(b, h) + m * 2048), PG8_RDA(PG8_SA(b, h) + m * 2048 + 1024), 0, 1, 2, 3, 4, 5, 6, 7); \
        else { _Pragma("unroll") for (int k = 0; k < 2; ++k) dst[m][k] = *(const PG8_LAS bf16x8*)(pa + PG8_SA(b, h) + m * 2048 + k * 1024); } } } while (0)
#define PG8_LDB(dst, b, h) do { _Pragma("unroll") for (int n = 0; n < 2; ++n) { \
        if constexpr (F8) dst##8[n] = __builtin_shufflevector(PG8_RDB(PG8_SB(b, h) - 4 * HTB + n * 2048), PG8_RDB(PG8_SB(b, h) - 4 * HTB + n * 2048 + 1024), 0, 1, 2, 3, 4, 5, 6, 7); \
        else { _Pragma("unroll") for (int k = 0; k < 2; ++k) dst[n][k] = *(const PG8_LAS bf16x8*)(pb + PG8_SB(b, h) - 4 * HTB + n * 2048 + k * 1024); } } } while (0)
#define PG8_MMA(ai, bj, Af, Bf) do { __builtin_amdgcn_s_setprio(1); _Pragma("unroll") for (int m = 0; m < 4; ++m) _Pragma("unroll") for (int n = 0; n < 2; ++n) { \
        if constexpr (F8) acc[ai][bj][m][n] = __builtin_amdgcn_mfma_scale_f32_16x16x128_f8f6f4(Bf##8[n], Af##8[m], acc[ai][bj][m][n], 0, 0, 0, sc1_, 0, sc1_); \
        else { _Pragma("unroll") for (int k = 0; k < 2; ++k) acc[ai][bj][m][n] = __builtin_amdgcn_mfma_f32_16x16x32_bf16(Bf[n][k], Af[m][k], acc[ai][bj][m][n], 0, 0, 0); } } \
        __builtin_amdgcn_s_setprio(0); } while (0)
#define PG8_WAIT_V(n) asm volatile("s_waitcnt vmcnt(" #n ")" ::: "memory")
#define PG8_WAIT_L(n) asm volatile("s_waitcnt lgkmcnt(" #n ")" ::: "memory")
#define PG8_BAR __builtin_amdgcn_s_barrier()
#define PG8_SCHED __builtin_amdgcn_sched_barrier(0)
    int sc1_ = 0x7f7f7f7f; asm volatile("" : "+v"(sc1_));
    Unit cur, nxt; int ui = 0;
    if (!S.next(0, cur)) return;
    f32x4 acc[2][2][4][2];
#pragma unroll
    for (int a = 0; a < 2; ++a)
#pragma unroll
        for (int b = 0; b < 2; ++b)
#pragma unroll
            for (int m = 0; m < 4; ++m)
#pragma unroll
                for (int n = 0; n < 2; ++n) acc[a][b][m][n] = (f32x4){0.f, 0.f, 0.f, 0.f};
    bf16x8 At[4][2], B0[2][2], B1[2][2]; v8i At8[4], B08[2], B18[2];
    const char* cA = (const char*)g.A + (size_t)cur.pm * tstep; const char* cB = (const char*)g.Bt + (size_t)cur.g * g.gstride + (size_t)cur.pn * tstep;
    if constexpr (SP2) {
        PG8_STAGE(PG8_SB(0, 0), cB, voffB); PG8_STAGE(PG8_SB(0, 1), cB + hstep, voffB); PG8_STAGE(PG8_SA(0, 0), cA, voffA); PG8_STAGE(PG8_SA(0, 1), cA + hstep, voffA);
        if (wr == 1) PG8_BAR;
        PG8_WAIT_V(2); PG8_BAR;
        PG8_STAGE(PG8_SB(1, 0), cB + kstep, voffB); PG8_STAGE(PG8_SA(1, 0), cA + kstep, voffA); PG8_STAGE(PG8_SB(1, 1), cB + hstep + kstep, voffB);
        PG8_WAIT_V(6); PG8_BAR;
    } else {
        PG8_STAGE(PG8_SB(0, 0), cB, voffB); PG8_STAGE(PG8_SA(0, 0), cA, voffA); PG8_STAGE(PG8_SB(0, 1), cB + hstep, voffB); PG8_STAGE(PG8_SA(0, 1), cA + hstep, voffA);
        if (wr == 1) PG8_BAR;
        PG8_WAIT_V(4); PG8_BAR;
        PG8_STAGE(PG8_SB(1, 0), cB + kstep, voffB); PG8_STAGE(PG8_SA(1, 0), cA + kstep, voffA); PG8_STAGE(PG8_SB(1, 1), cB + hstep + kstep, voffB);
        PG8_WAIT_V(6); PG8_BAR;
    }
    for (;;) {
        const bool has_next = S.next(ui + 1, nxt);
        const char* nA = has_next ? (const char*)g.A + (size_t)nxt.pm * tstep : cA; const char* nB = has_next ? (const char*)g.Bt + (size_t)nxt.g * g.gstride + (size_t)nxt.pn * tstep : cB;
#pragma unroll 1
        for (int t = 0; t < nt; t += 2) {
            const bool last = (t == nt - 2);
            const char* a1 = cA + (size_t)(t + 1) * kstep;
            const char* a2 = last ? nA : cA + (size_t)(t + 2) * kstep; const char* b2 = last ? nB : cB + (size_t)(t + 2) * kstep;
            const char* a3 = a2 + kstep; const char* b3 = b2 + kstep;
            if constexpr (SP2) {
            PG8_LDB(B0, 0, 0); PG8_LDB(B1, 0, 1); PG8_SCHED; PG8_LDA(At, 0, 0); PG8_STAGE(PG8_SA(1, 1), a1 + hstep, voffA);
            PG8_WAIT_V(8); PG8_WAIT_L(0); PG8_BAR; PG8_MMA(0, 0, At, B0); PG8_MMA(0, 1, At, B1); PG8_BAR; PG8_SCHED;
            PG8_LDA(At, 0, 1); PG8_STAGE(PG8_SB(0, 0), b2, voffB); PG8_STAGE(PG8_SB(0, 1), b2 + hstep, voffB); PG8_STAGE(PG8_SA(0, 0), a2, voffA);
            PG8_WAIT_V(8); PG8_WAIT_L(0); PG8_BAR; PG8_MMA(1, 0, At, B0); PG8_MMA(1, 1, At, B1); PG8_BAR; PG8_SCHED;
            PG8_LDB(B0, 1, 0); PG8_LDB(B1, 1, 1); PG8_SCHED; PG8_LDA(At, 1, 0); PG8_STAGE(PG8_SA(0, 1), a2 + hstep, voffA);
            PG8_WAIT_V(8); PG8_WAIT_L(0); PG8_BAR; PG8_MMA(0, 0, At, B0); PG8_MMA(0, 1, At, B1); PG8_BAR; PG8_SCHED;
            PG8_LDA(At, 1, 1); PG8_STAGE(PG8_SB(1, 0), b3, voffB); PG8_STAGE(PG8_SB(1, 1), b3 + hstep, voffB); PG8_STAGE(PG8_SA(1, 0), a3, voffA);
            PG8_WAIT_V(8); PG8_WAIT_L(0); PG8_BAR; PG8_MMA(1, 0, At, B0); PG8_MMA(1, 1, At, B1); PG8_BAR; PG8_SCHED;
            } else {
            PG8_LDB(B0, 0, 0); PG8_SCHED; PG8_LDA(At, 0, 0); PG8_STAGE(PG8_SA(1, 1), a1 + hstep, voffA);
            PG8_WAIT_L(8); PG8_BAR; PG8_WAIT_L(0); PG8_MMA(0, 0, At, B0); PG8_BAR; PG8_SCHED;
            PG8_LDB(B1, 0, 1); PG8_STAGE(PG8_SB(0, 0), b2, voffB);
            PG8_BAR; PG8_WAIT_L(0); PG8_MMA(0, 1, At, B1); PG8_BAR;
            PG8_LDA(At, 0, 1); PG8_STAGE(PG8_SA(0, 0), a2, voffA);
            PG8_BAR; PG8_WAIT_L(0); PG8_MMA(1, 0, At, B0); PG8_BAR; PG8_SCHED;
            PG8_STAGE(PG8_SB(0, 1), b2 + hstep, voffB);
            PG8_WAIT_V(6); PG8_BAR; PG8_MMA(1, 1, At, B1); PG8_BAR;
            PG8_LDB(B0, 1, 0); PG8_SCHED; PG8_LDA(At, 1, 0); PG8_STAGE(PG8_SA(0, 1), a2 + hstep, voffA);
            PG8_WAIT_L(8); PG8_BAR; PG8_WAIT_L(0); PG8_MMA(0, 0, At, B0); PG8_BAR; PG8_SCHED;
            PG8_LDB(B1, 1, 1); PG8_STAGE(PG8_SB(1, 0), b3, voffB);
            PG8_BAR; PG8_WAIT_L(0); PG8_MMA(0, 1, At, B1); PG8_BAR;
            PG8_LDA(At, 1, 1); PG8_STAGE(PG8_SA(1, 0), a3, voffA);
            PG8_BAR; PG8_WAIT_L(0); PG8_MMA(1, 0, At, B0); PG8_BAR; PG8_SCHED;
            PG8_STAGE(PG8_SB(1, 1), b3 + hstep, voffB);
            PG8_WAIT_V(6); PG8_BAR; PG8_MMA(1, 1, At, B1); PG8_BAR;
            }
        }
        if constexpr (ALIGN_EPI) { if (wr == 0) PG8_BAR; }
        { int lz; asm volatile("v_mbcnt_lo_u32_b32 %0, -1, 0\n\tv_mbcnt_hi_u32_b32 %0, -1, %0" : "=v"(lz));
          E(acc, cur, wr, wc, lz & 15, lz >> 4); }
        if (!has_next) break;
#pragma unroll
        for (int a = 0; a < 2; ++a)
#pragma unroll
            for (int b = 0; b < 2; ++b)
#pragma unroll
                for (int m = 0; m < 4; ++m)
#pragma unroll
                    for (int n = 0; n < 2; ++n) { typedef double d2_t __attribute__((ext_vector_type(2))); d2_t z_;
                        asm volatile("v_mov_b64 %0, 0" : "=v"(z_.x)); asm volatile("v_mov_b64 %0, 0" : "=v"(z_.y)); acc[a][b][m][n] = __builtin_bit_cast(f32x4, z_); }
        cur = nxt; cA = nA; cB = nB; ++ui;
        if constexpr (ALIGN_EPI) { if (wr == 1) PG8_BAR; }
    }
    PG8_WAIT_V(0);
    if constexpr (!ALIGN_EPI) { if (wr == 0) PG8_BAR; }
    PG8_BAR;
#undef PG8_SA
#undef PG8_SB
#undef PG8_STAGE
#undef PG8_GLDS
#undef PG8_LDA
#undef PG8_LDB
#undef PG8_MMA
#undef PG8_RDA
#undef PG8_RDB
#undef PG8_WAIT_V
#undef PG8_WAIT_L
#undef PG8_BAR
#undef PG8_SCHED
}
}
namespace attn_body {
using bf16=__hip_bfloat16;
using bf16x8=__attribute__((ext_vector_type(8)))short;
using s16x4=__attribute__((ext_vector_type(4)))short;
using f32x16=__attribute__((ext_vector_type(16)))float;
using f32x4=__attribute__((ext_vector_type(4)))float;
using u32x4=__attribute__((ext_vector_type(4)))unsigned;
constexpr int D=64;
constexpr int NW=8,QBLK=32,QB=QBLK*NW,KVBLK=64;
__device__ __forceinline__ int crow(int r,int hi){return (r&3)+8*(r>>2)+4*hi;}
#define SBAR() __builtin_amdgcn_sched_barrier(0)
__device__ __forceinline__ void cmask(f32x16&p0,f32x16&p1,int jb,int qrel,int hi){
  const float NEG=lconst(-INFINITY); int kb=64*jb+4*hi;
  #pragma unroll
  for(int r=0;r<16;++r){int kv=kb+(r&3)+8*(r>>2); if(kv>qrel)p0[r]=NEG; if(kv+32>qrel)p1[r]=NEG;}
}
constexpr int NSLOT=3, SLOTB=8192;
constexpr int LDS_K=0, LDS_V=NSLOT*SLOTB, LDS_WS=2*NSLOT*SLOTB, LDS_OST=LDS_WS+NW*64*4, LDS_CB=LDS_OST+NW*4096, LDS_BYTES=LDS_CB+16384;
__device__ __forceinline__ void glds16(const void*gsrc,unsigned lds_dst){unsigned keep;
  asm volatile("s_mov_b32 %0, m0\n\ts_mov_b32 m0, %2\n\ts_nop 0\n\tglobal_load_lds_dwordx4 %1, off\n\ts_mov_b32 m0, %0":"=&s"(keep):"v"(gsrc),"s"(lds_dst):"memory");}
__device__ __forceinline__ float max3f(float a,float b,float c){float r;asm("v_max3_f32 %0, %1, %2, %3":"=v"(r):"v"(a),"v"(b),"v"(c));return r;}
__device__ __forceinline__ float max2f(float a,float b){float r;asm("v_max_f32_e32 %0, %1, %2":"=v"(r):"v"(a),"v"(b));return r;}
__device__ __forceinline__ float fadd_s(float a,float b){float r;asm("v_add_f32_e32 %0, %1, %2":"=v"(r):"v"(a),"v"(b));return r;}
__device__ __forceinline__ float fsub_s(float a,float b){float r;asm("v_sub_f32_e32 %0, %1, %2":"=v"(r):"v"(a),"v"(b));return r;}
typedef float f32x2_t __attribute__((ext_vector_type(2))); typedef __bf16 bf16x2_t __attribute__((ext_vector_type(2)));
__device__ __forceinline__ unsigned cvtpk_s(float lo,float hi){f32x2_t v={lo,hi};bf16x2_t b=__builtin_convertvector(v,bf16x2_t);return __builtin_bit_cast(unsigned,b);}
#define WAIT_BAR(N) asm volatile("s_waitcnt vmcnt(" #N ") lgkmcnt(0)\n\ts_barrier":::"memory")

__device__ __forceinline__ void qkt(f32x16&p0,f32x16&p1,const char*Kslot,const bf16x8*qr,int r32,int hi){
  const char*kb=Kslot+hi*1024+r32*16;
  #pragma unroll
  for(int d0=0;d0<4;++d0){
    const bf16x8 b0=*reinterpret_cast<const bf16x8*>(kb+d0*2048);
    const bf16x8 b1=*reinterpret_cast<const bf16x8*>(kb+d0*2048+512);
    p0=__builtin_amdgcn_mfma_f32_32x32x16_bf16(b0,qr[d0],p0,0,0,0);p1=__builtin_amdgcn_mfma_f32_32x32x16_bf16(b1,qr[d0],p1,0,0,0);}
}
typedef __attribute__((address_space(3))) const char* lds_cptr;
typedef short v4i16_t __attribute__((ext_vector_type(4)));
__device__ __forceinline__ void kload8(bf16x8*kf,lds_cptr kp){
  kf[0]=*(const __attribute__((address_space(3))) bf16x8*)(kp);      kf[1]=*(const __attribute__((address_space(3))) bf16x8*)(kp+512);
  kf[2]=*(const __attribute__((address_space(3))) bf16x8*)(kp+2048); kf[3]=*(const __attribute__((address_space(3))) bf16x8*)(kp+2560);
  kf[4]=*(const __attribute__((address_space(3))) bf16x8*)(kp+4096); kf[5]=*(const __attribute__((address_space(3))) bf16x8*)(kp+4608);
  kf[6]=*(const __attribute__((address_space(3))) bf16x8*)(kp+6144); kf[7]=*(const __attribute__((address_space(3))) bf16x8*)(kp+6656);
}
__device__ __forceinline__ void kload2(bf16x8*kf,lds_cptr kp,int j){ kf[2*j]=*(const __attribute__((address_space(3))) bf16x8*)(kp+j*2048); kf[2*j+1]=*(const __attribute__((address_space(3))) bf16x8*)(kp+j*2048+512); }
__device__ __forceinline__ s16x4 vtr(lds_cptr p){ return __builtin_bit_cast(s16x4,__builtin_amdgcn_ds_read_tr16_b64_v4i16((__attribute__((address_space(3))) v4i16_t*)p)); }
__device__ __forceinline__ float rowmax(const f32x16&p0,const f32x16&p1){
  float a=max3f(p0[0],p0[1],p1[0]),b=max3f(p0[2],p0[3],p1[1]);a=max3f(a,p1[2],p1[3]);
  #pragma unroll
  for(int r=4;r<16;r+=4){a=max3f(a,p0[r],p0[r+1]);b=max3f(b,p0[r+2],p0[r+3]);a=max3f(a,p1[r],p1[r+1]);b=max3f(b,p1[r+2],p1[r+3]);}
  const float m=max2f(a,b);
  auto rr=__builtin_amdgcn_permlane32_swap(__float_as_uint(m),__float_as_uint(m),false,false);
  return max2f(__uint_as_float(rr[0]),__uint_as_float(rr[1]));
}
__device__ __forceinline__ void pv(f32x16*o,int vb,bf16x8 pa0,bf16x8 pa1,bf16x8 pa2,bf16x8 pa3){
  #pragma unroll
  for(int d0=0;d0<2;++d0){s16x4 lo[4],hi[4];
    #pragma unroll
    for(int ks=0;ks<4;++ks){
      asm volatile("ds_read_b64_tr_b16 %0,%1 offset:%c2":"=&v"(lo[ks]):"v"(vb),"i"(d0*4096+ks*1024):"memory");
      asm volatile("ds_read_b64_tr_b16 %0,%1 offset:%c2":"=&v"(hi[ks]):"v"(vb),"i"(d0*4096+ks*1024+512):"memory");}
    asm volatile("s_waitcnt lgkmcnt(0)":::"memory");SBAR();
    #define PK(k) (bf16x8){lo[k][0],lo[k][1],lo[k][2],lo[k][3],hi[k][0],hi[k][1],hi[k][2],hi[k][3]}
    o[d0]=__builtin_amdgcn_mfma_f32_32x32x16_bf16(pa0,PK(0),o[d0],0,0,0);
    o[d0]=__builtin_amdgcn_mfma_f32_32x32x16_bf16(pa1,PK(1),o[d0],0,0,0);
    o[d0]=__builtin_amdgcn_mfma_f32_32x32x16_bf16(pa2,PK(2),o[d0],0,0,0);
    o[d0]=__builtin_amdgcn_mfma_f32_32x32x16_bf16(pa3,PK(3),o[d0],0,0,0);
    #undef PK
  }
}
template<bool BIAS> __device__ __forceinline__ void cinit(f32x16&c0,f32x16&c1,lds_cptr shm3,int t,int hi,float nmh){
  if constexpr(BIAS){
    const __attribute__((address_space(3))) f32x4* cb4=(const __attribute__((address_space(3))) f32x4*)(shm3+LDS_CB)+t*16+hi;
    #pragma unroll
    for(int g=0;g<4;++g){ const f32x4 b0=cb4[2*g], b1=cb4[8+2*g]; SBAR();
      c0[4*g]=nmh-b0[0]; c0[4*g+1]=nmh-b0[1]; c0[4*g+2]=nmh-b0[2]; c0[4*g+3]=nmh-b0[3];
      c1[4*g]=nmh-b1[0]; c1[4*g+1]=nmh-b1[1]; c1[4*g+2]=nmh-b1[2]; c1[4*g+3]=nmh-b1[3]; SBAR(); }
  } else {
    #pragma unroll
    for(int r=0;r<16;++r){c0[r]=nmh;c1[r]=nmh;}
  }
}
template<int THRL,bool CAUSAL,bool BIAS,int QP,int KP,int OP,bool FIXM=false> __device__ __forceinline__ void attn_unit(const bf16*Qu,const bf16*__restrict__ Ku,const bf16*__restrict__ Vu,bf16*Ou,const float*cbu,const int NT,char*shm,const int tid,const float mfix=0.f){
  const int lane=tid&63,r32=lane&31,hi=lane>>5; const int wid=__builtin_amdgcn_readfirstlane(tid>>6);
  const bf16*Qw=Qu+(long)(wid*QBLK)*QP;
  const unsigned lds0=(unsigned)(uintptr_t)shm;
  float*wsf=(float*)(shm+LDS_WS)+wid*64;
  const bf16*ksrc=Ku+(long)lane*KP+wid*8;
  const bf16*vsrc=Vu+(long)(16*(wid&3)+(lane>>2))*KP+(wid>>2)*32+(lane&3)*8;
  const unsigned kdst=lds0+LDS_K+wid*1024, vdst=lds0+LDS_V+wid*1024;
  #define DMA_K(t,slot) glds16(ksrc+(long)(t)*KVBLK*KP,(unsigned)__builtin_amdgcn_readfirstlane(kdst+(slot)))
  #define DMA_V(t,slot) glds16(vsrc+(long)(t)*KVBLK*KP,(unsigned)__builtin_amdgcn_readfirstlane(vdst+(slot)))
  const int vb0=(int)(lds0+LDS_V)+((lane>>4)&1)*32+(lane&3)*8+(4*hi+((lane&15)>>2))*64;
  const char*Kbase=shm+LDS_K; bf16x8 kf[8];
  const lds_cptr shm3=(lds_cptr)shm; const lds_cptr kp0=shm3+LDS_K+hi*1024+r32*16; const lds_cptr vp0=shm3+LDS_V+((lane>>4)&1)*32+(lane&3)*8+(4*hi+((lane&15)>>2))*64;
  f32x4 cbv0=(f32x4){0.f,0.f,0.f,0.f},cbv1=cbv0;
  if constexpr(BIAS){ const int ncb=NT*16; if(tid<ncb)cbv0=((const f32x4*)cbu)[tid]; if(tid+512<ncb)cbv1=((const f32x4*)cbu)[tid+512]; }
  float cbi_=0.f; if constexpr(BIAS&&FIXM) cbi_=cbu[NT*64-256+wid*QBLK+r32];
  DMA_K(0,0);DMA_V(0,0);DMA_K(1,SLOTB);
  bf16x8 qr[4];
  #pragma unroll
  for(int d0=0;d0<4;++d0)qr[d0]=*reinterpret_cast<const bf16x8*>(&Qw[(long)r32*QP+d0*16+hi*8]);
  { __attribute__((address_space(3))) bf16x8* qw_=(__attribute__((address_space(3))) bf16x8*)((__attribute__((address_space(3))) char*)shm+LDS_OST+wid*4096)+lane;
    qw_[0]=qr[0]; qw_[64]=qr[1]; qw_[128]=qr[2]; qw_[192]=qr[3]; }
  const __attribute__((address_space(3))) bf16x8* qst=(const __attribute__((address_space(3))) bf16x8*)(shm3+LDS_OST+wid*4096)+lane;
  #define QLD(d) qst[(d)*64]
  if constexpr(BIAS){ __attribute__((address_space(3))) f32x4* cbl=(__attribute__((address_space(3))) f32x4*)((__attribute__((address_space(3))) char*)shm+LDS_CB); const int ncb=NT*16; if(tid<ncb)cbl[tid]=cbv0; if(tid+512<ncb)cbl[tid+512]=cbv1; }
  float mhat,nmh,l_reg; asm volatile("v_mov_b32 %0, 0\n\tv_mov_b32 %1, 0\n\tv_mov_b32 %2, 0":"=v"(mhat),"=v"(nmh),"=v"(l_reg));
  if constexpr(FIXM){ mhat=mfix-cbi_; nmh=-mhat; }
  f32x16 o[2];o[0]=f32x16{};o[1]=f32x16{};
  const int qrel=wid*QBLK+r32;
  #define CMASK(P0,P1,t) do{ if(CAUSAL){int jb_=(t)-(NT-4); if(jb_>=0)cmask(P0,P1,jb_,qrel,hi);} }while(0)
  bool resc=false;
  #define START(P0,P1) do{ resc=false; if constexpr(!FIXM){ const float rm=rowmax(P0,P1); \
    { const float dl=rm; mhat=fadd_s(mhat,dl); \
      _Pragma("unroll") for(int r=0;r<16;++r){P0[r]=fsub_s(P0[r],dl);P1[r]=fsub_s(P1[r],dl);} \
      nmh=-mhat; } } \
    _Pragma("unroll") for(int r=0;r<16;++r)P0[r]=__builtin_amdgcn_exp2f(P0[r]); }while(0)
  #define RESC() do{ if(resc){ asm volatile("s_waitcnt lgkmcnt(0)":::"memory"); \
      _Pragma("unroll") for(int d_=0;d_<2;++d_) _Pragma("unroll") for(int r=0;r<16;++r)o[d_][r]*=wsf[crow(r,hi)]; } }while(0)
  f32x16 pA0,pA1,pB0,pB1;
  int sl_prev=0,sl_cur=0,sl_next=SLOTB;
  #define ROT() do{sl_prev=sl_cur;sl_cur=sl_next;sl_next=(sl_next==(NSLOT-1)*SLOTB)?0:sl_next+SLOTB;}while(0)
  DMA_K(2,2*SLOTB);
  WAIT_BAR(3);
  cinit<BIAS>(pA0,pA1,shm3,0,hi,nmh);qkt(pA0,pA1,Kbase,qr,r32,hi);asm volatile("s_nop 15\n\ts_nop 7":"+v"(pA0),"+v"(pA1));CMASK(pA0,pA1,0);
  START(pA0,pA1);
  _Pragma("unroll") for(int r=0;r<16;++r)pA1[r]=__builtin_amdgcn_exp2f(pA1[r]);
  WAIT_BAR(0);
  DMA_K(3,0);DMA_V(1,SLOTB);
  ROT();
  kload8(kf,kp0+sl_cur);
  WAIT_BAR(2);
  s16x4 vlo[8],vhi[8]; u32x4 pw0,pw1,pw2,pw3;
  #define PKW(P,B) cvtpk_s(P[B],P[B+1])
  #define PAF(k) __builtin_bit_cast(bf16x8,pw##k)
  #define VFR(i) (bf16x8){vlo[i][0],vlo[i][1],vlo[i][2],vlo[i][3],vhi[i][0],vhi[i][1],vhi[i][2],vhi[i][3]}
  #define PIN(x) asm volatile("":"+v"(x))
  #define MX3(a,b,c) __builtin_fmaxf(__builtin_fmaxf((a),(b)),(c))
  #define GAPA(MF,A0,A1,A2,A3,W0,W1,PW) do{ MF; sacc+=A0; sacc+=A1; sacc+=A2; sacc+=A3; PIN(sacc); W0; W1; PIN(PW); SBAR(); }while(0)
  #define EX(v) __builtin_amdgcn_exp2f(v)
  #define GAPB(MF,X,B) do{ MF; X[B]=EX(X[B]); X[B+1]=EX(X[B+1]); X[B+2]=EX(X[B+2]); X[B+3]=EX(X[B+3]); PIN(X); SBAR(); }while(0)
  #define VRD(i) do{ vlo[i]=vtr(vp_+(((i)>>2)*4096+((i)&3)*1024)); vhi[i]=vtr(vp_+(((i)>>2)*4096+((i)&3)*1024+512)); }while(0)
  #define KRD(G,j) do{ if(G){ kload2(kf,kp0+sl_next,j); SBAR(); } }while(0)
  #define STEP(C0,C1,P0,P1,t,GK,GV,GL) do{ SBAR(); \
    cinit<BIAS>(C0,C1,shm3,(t),hi,nmh); SBAR(); \
    const lds_cptr vp_=vp0+sl_prev; \
    bf16x8 qa_=QLD(0), qb_=QLD(1); \
    VRD(0); SBAR(); float sacc=(P0[0]+P0[1]); \
    GAPA(C0=__builtin_amdgcn_mfma_f32_32x32x16_bf16(kf[0],qa_,C0,0,0,0), P0[2],P0[3],P0[4],P0[5],     pw0[0]=PKW(P0,0), pw0[1]=PKW(P0,2), pw0); \
    VRD(4); SBAR(); GAPA(C1=__builtin_amdgcn_mfma_f32_32x32x16_bf16(kf[1],qa_,C1,0,0,0), P0[6],P0[7],P0[8],P0[9],     pw0[2]=PKW(P0,4), pw0[3]=PKW(P0,6), pw0); \
    qa_=QLD(2); VRD(1); SBAR(); GAPA(C0=__builtin_amdgcn_mfma_f32_32x32x16_bf16(kf[2],qb_,C0,0,0,0),   P0[10],P0[11],P0[12],P0[13], pw1[0]=PKW(P0,8), pw1[1]=PKW(P0,10), pw1); \
    VRD(5); SBAR(); GAPA(C1=__builtin_amdgcn_mfma_f32_32x32x16_bf16(kf[3],qb_,C1,0,0,0),   P0[14],P0[15],P1[0],P1[1],   pw1[2]=PKW(P0,12),pw1[3]=PKW(P0,14), pw1); \
    qb_=QLD(3); VRD(2); SBAR(); GAPA(C0=__builtin_amdgcn_mfma_f32_32x32x16_bf16(kf[4],qa_,C0,0,0,0),   P1[2],P1[3],P1[4],P1[5],     pw2[0]=PKW(P1,0), pw2[1]=PKW(P1,2), pw2); \
    VRD(6); SBAR(); GAPA(C1=__builtin_amdgcn_mfma_f32_32x32x16_bf16(kf[5],qa_,C1,0,0,0),   P1[6],P1[7],P1[8],P1[9],     pw2[2]=PKW(P1,4), pw2[3]=PKW(P1,6), pw2); \
    VRD(3); SBAR(); GAPA(C0=__builtin_amdgcn_mfma_f32_32x32x16_bf16(kf[6],qb_,C0,0,0,0),   P1[10],P1[11],P1[12],P1[13], pw3[0]=PKW(P1,8), pw3[1]=PKW(P1,10), pw3); \
    VRD(7); SBAR(); GAPA(C1=__builtin_amdgcn_mfma_f32_32x32x16_bf16(kf[7],qb_,C1,0,0,0),   P1[14],P1[15],0.f,0.f,       pw3[2]=PKW(P1,12),pw3[3]=PKW(P1,14), pw3); \
    l_reg+=sacc; \
    if(GK){DMA_K((t)+3,sl_cur);} if(GV){DMA_V((t)+1,sl_next);} \
    CMASK(C0,C1,t); \
    if constexpr(!FIXM) { float a=MX3(C0[0],C0[1],C1[0]),b=MX3(C0[2],C0[3],C1[1]); a=MX3(a,C1[2],C1[3]); \
      _Pragma("unroll") for(int r=4;r<16;r+=4){a=MX3(a,C0[r],C0[r+1]);b=MX3(b,C0[r+2],C0[r+3]);a=MX3(a,C1[r],C1[r+1]);b=MX3(b,C1[r+2],C1[r+3]);} \
      float rm=__builtin_fmaxf(a,b); { auto rr=__builtin_amdgcn_permlane32_swap(__float_as_uint(rm),__float_as_uint(rm),false,false); rm=__builtin_fmaxf(__uint_as_float(rr[0]),__uint_as_float(rr[1])); } \
      resc=false; \
      if(__builtin_expect(__any(rm>(float)THRL),0)){ const float dl=__builtin_fmaxf(rm,0.f); mhat+=dl; \
        _Pragma("unroll") for(int r=0;r<16;++r){C0[r]-=dl;C1[r]-=dl;} \
        nmh=-mhat; \
        const float f=__builtin_amdgcn_exp2f(-dl); l_reg*=f; if(hi==0)wsf[r32]=f; resc=true; } } \
    SBAR(); \
    GAPB(o[0]=__builtin_amdgcn_mfma_f32_32x32x16_bf16(PAF(0),VFR(0),o[0],0,0,0), C0,0); \
    GAPB(o[1]=__builtin_amdgcn_mfma_f32_32x32x16_bf16(PAF(0),VFR(4),o[1],0,0,0), C0,4); \
    KRD(GL,0); GAPB(o[0]=__builtin_amdgcn_mfma_f32_32x32x16_bf16(PAF(1),VFR(1),o[0],0,0,0), C0,8); \
    KRD(GL,1); GAPB(o[1]=__builtin_amdgcn_mfma_f32_32x32x16_bf16(PAF(1),VFR(5),o[1],0,0,0), C0,12); \
    KRD(GL,2); GAPB(o[0]=__builtin_amdgcn_mfma_f32_32x32x16_bf16(PAF(2),VFR(2),o[0],0,0,0), C1,0); \
    KRD(GL,3); GAPB(o[1]=__builtin_amdgcn_mfma_f32_32x32x16_bf16(PAF(2),VFR(6),o[1],0,0,0), C1,4); \
    GAPB(o[0]=__builtin_amdgcn_mfma_f32_32x32x16_bf16(PAF(3),VFR(3),o[0],0,0,0), C1,8); \
    GAPB(o[1]=__builtin_amdgcn_mfma_f32_32x32x16_bf16(PAF(3),VFR(7),o[1],0,0,0), C1,12); \
    }while(0)
  int t=1;
  #undef CMASK
  #define CMASK(P0,P1,t) do{}while(0)
  for(;t+5<NT;t+=2){
    STEP(pB0,pB1,pA0,pA1,t,true,true,true);     WAIT_BAR(2); RESC(); ROT();
    STEP(pA0,pA1,pB0,pB1,t+1,true,true,true);   WAIT_BAR(2); RESC(); ROT();
  }
  #undef CMASK
  #define CMASK(P0,P1,t) do{ if(CAUSAL){int jb_=(t)-(NT-4); if(jb_>=0)cmask(P0,P1,jb_,qrel,hi);} }while(0)
  #define ENDW(tt) do{ if((tt)+3<NT){WAIT_BAR(2);} else if((tt)+2<NT){WAIT_BAR(1);} else {WAIT_BAR(0);} }while(0)
  for(;t+1<NT;t+=2){
    STEP(pB0,pB1,pA0,pA1,t,(t+3<NT),(t+1<NT),(t+1<NT));       ENDW(t);   RESC(); ROT();
    STEP(pA0,pA1,pB0,pB1,t+1,(t+4<NT),(t+2<NT),(t+2<NT));     ENDW(t+1); RESC(); ROT();
  }
  STEP(pB0,pB1,pA0,pA1,NT-1,false,false,false); RESC();
  { float sacc=pB0[0]+pB0[1]; _Pragma("unroll") for(int r=2;r<16;++r)sacc+=pB0[r]; _Pragma("unroll") for(int r=0;r<16;++r)sacc+=pB1[r]; l_reg+=sacc;
    pw0=(u32x4){PKW(pB0,0),PKW(pB0,2),PKW(pB0,4),PKW(pB0,6)};pw1=(u32x4){PKW(pB0,8),PKW(pB0,10),PKW(pB0,12),PKW(pB0,14)};pw2=(u32x4){PKW(pB1,0),PKW(pB1,2),PKW(pB1,4),PKW(pB1,6)};pw3=(u32x4){PKW(pB1,8),PKW(pB1,10),PKW(pB1,12),PKW(pB1,14)};
    SBAR(); pv(o,vb0+sl_cur,PAF(0),PAF(1),PAF(2),PAF(3)); }
  #undef PKW
  #undef PAF
  #undef VFR
  #undef PIN
  #undef MX3
  #undef GAPA
  #undef GAPB
  #undef EX
  #undef VRD
  #undef KRD
  #undef STEP
  #undef ENDW
  {auto rr=__builtin_amdgcn_permlane32_swap(__float_as_uint(l_reg),__float_as_uint(l_reg),false,false);l_reg=__uint_as_float(rr[0])+__uint_as_float(rr[1]);}
  if(hi==0)wsf[32+r32]=l_reg;asm volatile("s_waitcnt lgkmcnt(0)":::"memory");
  float rli[16];
  #pragma unroll
  for(int r=0;r<16;++r)rli[r]=__builtin_amdgcn_rcpf(wsf[32+crow(r,hi)]);
  bf16*Ow=Ou+(long)(wid*QBLK)*OP;
  { bf16*stg=(bf16*)(shm+LDS_OST)+wid*2048;
    #pragma unroll
    for(int r=0;r<16;++r){const int orow=crow(r,hi);
      #pragma unroll
      for(int d0=0;d0<2;++d0)stg[orow*64+d0*32+r32]=__float2bfloat16(o[d0][r]*rli[r]);}
    asm volatile("s_waitcnt lgkmcnt(0)":::"memory");
    #pragma unroll
    for(int i=0;i<4;++i){const int row=i*8+(lane>>3),ch=lane&7; const u32x4 v=*(const u32x4*)(stg+row*64+ch*8); *(u32x4*)(Ow+(long)row*OP+ch*8)=v;} }
  asm volatile("s_waitcnt lgkmcnt(0)\n\ts_barrier":::"memory");
  #undef QLD
  #undef DMA_K
  #undef DMA_V
  #undef CMASK
  #undef START
  #undef RESC
  #undef ROT
}
#undef SBAR
#undef WAIT_BAR
}
constexpr int NWAVES = 8;
constexpr int RING_OFF = 0, RING_BYTES = 131072;
constexpr int LDSCTL_OFF = RING_BYTES, MISC_OFF = LDSCTL_OFF + 320;
constexpr int LDS_BYTES = 147456;
constexpr int ORDTAB_OFF = LDSCTL_OFF + 1024;
static_assert(MISC_OFF + 128 <= LDS_BYTES, "LDS map");
static_assert(attn_body::LDS_BYTES <= RING_BYTES && pg8::STAGE_BYTES <= RING_BYTES, "LDS map");

#define GAS __attribute__((address_space(1)))
#define LAS __attribute__((address_space(3)))
typedef unsigned short bf16;
typedef unsigned v4u __attribute__((ext_vector_type(4)));
typedef unsigned v2u __attribute__((ext_vector_type(2)));
typedef float f32x4 __attribute__((ext_vector_type(4)));
typedef GAS unsigned gu32;
#define RLX_AGENT __ATOMIC_RELAXED, __HIP_MEMORY_SCOPE_AGENT
#define LDS_WAIT() asm volatile("s_waitcnt lgkmcnt(0)" ::: "memory")
#define VM_WAIT() asm volatile("s_waitcnt vmcnt(0)" ::: "memory")
__device__ __forceinline__ unsigned f2bf(float f) { unsigned u = __builtin_bit_cast(unsigned, f); return (u + 0x7fffu + ((u >> 16) & 1u)) >> 16; }
__device__ __forceinline__ unsigned pk2(float lo, float hi) { unsigned r; asm volatile("v_cvt_pk_bf16_f32 %0, %1, %2" : "=v"(r) : "v"(lo), "v"(hi)); return r; }
__device__ __forceinline__ float bflo(unsigned w) { return __builtin_bit_cast(float, w << 16); }
__device__ __forceinline__ float bfhi(unsigned w) { return __builtin_bit_cast(float, w & 0xffff0000u); }

__device__ __forceinline__ unsigned pk4f8(float a, float b, float c, float d) { int p = __builtin_amdgcn_cvt_pk_fp8_f32(a, b, __builtin_bit_cast(int, a), false); p = __builtin_amdgcn_cvt_pk_fp8_f32(c, d, p, true); return (unsigned)p; }
__device__ __forceinline__ float clampf8(float x) { const float c = lconst(448.f); return __builtin_amdgcn_fmed3f(x, -c, c); }

#define XB_TMO      128
#define XB_XCNT(j)  (256  + 64 * (j))
#define XB_XSUB(j)  (1280 + 64 * (j))
#define XB_XGEN(j)  (2304 + 64 * (j))
#define XB_TOP      3328
#define XB_TOPGEN   3392
#define XCD_BAR_WORDS 3456
#define XB_SPIN_CAP (1u << 18)
__device__ __forceinline__ unsigned xb_ld(unsigned* p)              { return __hip_atomic_load(p, __ATOMIC_RELAXED, __HIP_MEMORY_SCOPE_AGENT); }
__device__ __forceinline__ unsigned xb_add(unsigned* p, unsigned v) { unsigned one_; asm volatile("v_mov_b32 %0, 1" : "=v"(one_)); (void)v;
    return __hip_atomic_fetch_add(p, one_, __ATOMIC_RELAXED, __HIP_MEMORY_SCOPE_AGENT); }
__device__ __forceinline__ unsigned ticket_take(gu32* ctr) { unsigned one_, z_; asm volatile("v_mov_b32 %0, 1\n\tv_mov_b32 %1, 0" : "=v"(one_), "=v"(z_));
    return __hip_atomic_fetch_add((gu32*)((GAS char*)ctr + z_), one_, RLX_AGENT); }
__device__ __forceinline__ unsigned xb_xcc_id() { return (unsigned)__builtin_amdgcn_s_getreg((3 << 11) | 20) & 0xFu; }
#define XB_SPIN(cond, bar) do { unsigned _sp = 0; while (cond) { __builtin_amdgcn_s_sleep(1); \
    if ((++_sp & 255u) == 0u) { if (xb_ld(&(bar)[XB_TMO])) break; if (_sp > XB_SPIN_CAP) { atomicAdd(&(bar)[XB_TMO], 1u); break; } } } } while (0)
struct XcdBarrier { unsigned* bar; unsigned x; volatile LAS unsigned* st; };
__device__ __forceinline__ XcdBarrier xcd_barrier_post(unsigned* bar, volatile LAS unsigned* st, const int tid) {
    XcdBarrier b; b.bar = bar; b.x = xb_xcc_id(); b.st = st;
    if (tid == 0) (void)xb_add(&bar[XB_XCNT(b.x)], 1u);
    return b;
}
__device__ __forceinline__ void xcd_barrier_complete(unsigned* bar, unsigned x, unsigned& nloc, unsigned& nx) {
    const unsigned G = gridDim.x * gridDim.y * gridDim.z;
    unsigned sum, cnt, mine, sp = 0u;
    for (;;) {
        sum = 0u; cnt = 0u; mine = 0u;
#pragma unroll
        for (unsigned j = 0; j < 16; ++j) { const unsigned c = xb_ld(&bar[XB_XCNT(j)]); sum += c; cnt += (c > 0u) ? 1u : 0u; }
        mine = xb_ld(&bar[XB_XCNT(x)]);
        if (sum == G) break;
        __builtin_amdgcn_s_sleep(1);
        if ((++sp & 255u) == 0u) { if (xb_ld(&bar[XB_TMO])) break; if (sp > XB_SPIN_CAP) { atomicAdd(&bar[XB_TMO], 1u); break; } }
    }
    nloc = mine > 0u ? mine : 1u; nx = cnt > 0u ? cnt : 1u;
}
__device__ __forceinline__ void xcd_barrier(const XcdBarrier& b, const int tid  ) {
    asm volatile("s_waitcnt vmcnt(0)" ::: "memory");
    __syncthreads();
    if (tid == 0) {
        unsigned* bar = b.bar;
        __builtin_amdgcn_s_waitcnt(0);
        unsigned nloc = b.st[0], nx = b.st[1];
        if (nloc == 0u) { xcd_barrier_complete(bar, b.x, nloc, nx); b.st[0] = nloc; b.st[1] = nx; }
        const unsigned old = xb_add(&bar[XB_XSUB(b.x)], 1u);
        const unsigned gen = old / nloc;
        if (old + 1u == (gen + 1u) * nloc) {
            __builtin_amdgcn_fence(__ATOMIC_RELEASE, "agent");
            asm volatile("s_waitcnt vmcnt(0)" ::: "memory");
            const unsigned og = xb_add(&bar[XB_TOP], 1u);
            const unsigned tg = og / nx;
            if (og + 1u == (tg + 1u) * nx) xb_add(&bar[XB_TOPGEN], 1u);
            else XB_SPIN(xb_ld(&bar[XB_TOPGEN]) == tg, bar);
            __builtin_amdgcn_fence(__ATOMIC_ACQUIRE, "agent");
            xb_add(&bar[XB_XGEN(b.x)], 1u);
            asm volatile("s_waitcnt vmcnt(0)" ::: "memory");
        } else {
            XB_SPIN(xb_ld(&bar[XB_XGEN(b.x)]) == gen, bar);
            __builtin_amdgcn_fence(__ATOMIC_ACQUIRE, "agent");
            asm volatile("s_waitcnt vmcnt(0)" ::: "memory");
        }
    }
    __syncthreads();
}

struct Args { const float* in[27]; float* out; unsigned char* ws; int ph_lo, ph_hi; unsigned mask; int pad; };
struct Frame {
    LAS unsigned char* lds;
    volatile LAS unsigned* MISC;
    gu32* ctl;
    int tid, lane, wave, vcu, G;
    unsigned char* ws;
    const __attribute__((address_space(4))) struct Args* A;
    float* out;
};
__device__ __forceinline__ float lane_xor_f(float v, int m, int lane) { return __builtin_bit_cast(float, __builtin_amdgcn_ds_bpermute((lane ^ m) << 2, __builtin_bit_cast(int, v))); }
__device__ __forceinline__ int lane_up_i(int v, int o, int lane) { return __builtin_amdgcn_ds_bpermute((lane >= o ? lane - o : lane) << 2, v); }
__device__ __forceinline__ double lane_up_d(double v, int o, int lane) { const unsigned long long u = __builtin_bit_cast(unsigned long long, v); const int a = (lane >= o ? lane - o : lane) << 2;
    const unsigned lo = (unsigned)__builtin_amdgcn_ds_bpermute(a, (int)(unsigned)u), hi = (unsigned)__builtin_amdgcn_ds_bpermute(a, (int)(unsigned)(u >> 32)); return __builtin_bit_cast(double, ((unsigned long long)hi << 32) | lo); }
__device__ __forceinline__ double lane_get_d(double v, int src) { const unsigned long long u = __builtin_bit_cast(unsigned long long, v);
    const unsigned lo = (unsigned)__builtin_amdgcn_readlane((int)(unsigned)u, src), hi = (unsigned)__builtin_amdgcn_readlane((int)(unsigned)(u >> 32), src); return __builtin_bit_cast(double, ((unsigned long long)hi << 32) | lo); }
#define DPP_ADD(v, ctrl) ((v) + __builtin_bit_cast(float, __builtin_amdgcn_update_dpp(__builtin_bit_cast(int, (v)), __builtin_bit_cast(int, (v)), (ctrl), 0xf, 0xf, false)))
__device__ __forceinline__ float wave_sum_l(float v, int  ) {
    v = DPP_ADD(v, 0xB1);
    v = DPP_ADD(v, 0x4E);
    v = DPP_ADD(v, 0x141);
    v = DPP_ADD(v, 0x140);
    const float r0 = __builtin_bit_cast(float, __builtin_amdgcn_readlane(__builtin_bit_cast(int, v), 0)), r1 = __builtin_bit_cast(float, __builtin_amdgcn_readlane(__builtin_bit_cast(int, v), 16));
    const float r2 = __builtin_bit_cast(float, __builtin_amdgcn_readlane(__builtin_bit_cast(int, v), 32)), r3 = __builtin_bit_cast(float, __builtin_amdgcn_readlane(__builtin_bit_cast(int, v), 48));
    return (r0 + r1) + (r2 + r3);
}
#define DPP_GET(v, ctrl) __builtin_bit_cast(float, __builtin_amdgcn_update_dpp(__builtin_bit_cast(int, (v)), __builtin_bit_cast(int, (v)), (ctrl), 0xf, 0xf, false))
__device__ __forceinline__ float wave_reduce32(const float (&v)[32], int lane) {
    float u[16], w[8], x[4], y[2];
#pragma unroll
    for (int i = 0; i < 16; ++i) { const auto rr = __builtin_amdgcn_permlane32_swap(__builtin_bit_cast(unsigned, v[i]), __builtin_bit_cast(unsigned, v[i + 16]), false, false);
        u[i] = __builtin_bit_cast(float, (unsigned)rr[0]) + __builtin_bit_cast(float, (unsigned)rr[1]); }
#pragma unroll
    for (int i = 0; i < 8; ++i) { const auto rr = __builtin_amdgcn_permlane16_swap(__builtin_bit_cast(unsigned, u[i]), __builtin_bit_cast(unsigned, u[i + 8]), false, false);
        w[i] = __builtin_bit_cast(float, (unsigned)rr[0]) + __builtin_bit_cast(float, (unsigned)rr[1]); }
    const bool b3 = (lane & 8) != 0, b2 = (lane & 4) != 0, b1 = (lane & 2) != 0;
#pragma unroll
    for (int i = 0; i < 4; ++i) { const float keep = b3 ? w[i + 4] : w[i], give = b3 ? w[i] : w[i + 4]; x[i] = keep + DPP_GET(give, 0x140); }
#pragma unroll
    for (int i = 0; i < 2; ++i) { const float keep = b2 ? x[i + 2] : x[i], give = b2 ? x[i] : x[i + 2]; y[i] = keep + DPP_GET(give, 0x141); }
    float z; { const float keep = b1 ? y[1] : y[0], give = b1 ? y[0] : y[1]; z = keep + DPP_GET(give, 0x4E); }
    z = z + DPP_GET(z, 0xB1);
    return z;
}
#define SWAP32_ADD(a, b) ([&]() { const auto rr_ = __builtin_amdgcn_permlane32_swap(__builtin_bit_cast(unsigned, (a)), __builtin_bit_cast(unsigned, (b)), false, false); return __builtin_bit_cast(float, (unsigned)rr_[0]) + __builtin_bit_cast(float, (unsigned)rr_[1]); }())
#define SWAP16_ADD(a, b) ([&]() { const auto rr_ = __builtin_amdgcn_permlane16_swap(__builtin_bit_cast(unsigned, (a)), __builtin_bit_cast(unsigned, (b)), false, false); return __builtin_bit_cast(float, (unsigned)rr_[0]) + __builtin_bit_cast(float, (unsigned)rr_[1]); }())
__device__ __forceinline__ float wave_reduce16(const float (&v)[16], int lane) {
    float u[8], w[4], x[2];
#pragma unroll
    for (int i = 0; i < 8; ++i) u[i] = SWAP32_ADD(v[i], v[i + 8]);
#pragma unroll
    for (int i = 0; i < 4; ++i) w[i] = SWAP16_ADD(u[i], u[i + 4]);
    const bool b3 = (lane & 8) != 0, b2 = (lane & 4) != 0;
#pragma unroll
    for (int i = 0; i < 2; ++i) { const float keep = b3 ? w[i + 2] : w[i], give = b3 ? w[i] : w[i + 2]; x[i] = keep + DPP_GET(give, 0x140); }
    float z; { const float keep = b2 ? x[1] : x[0], give = b2 ? x[0] : x[1]; z = keep + DPP_GET(give, 0x141); }
    z = z + DPP_GET(z, 0x4E); z = z + DPP_GET(z, 0xB1);
    return z;
}
__device__ __forceinline__ float wave_reduce8(const float (&v)[8], int lane) {
    float u[4], w[2];
#pragma unroll
    for (int i = 0; i < 4; ++i) u[i] = SWAP32_ADD(v[i], v[i + 4]);
#pragma unroll
    for (int i = 0; i < 2; ++i) w[i] = SWAP16_ADD(u[i], u[i + 2]);
    const bool b3 = (lane & 8) != 0;
    float z; { const float keep = b3 ? w[1] : w[0], give = b3 ? w[0] : w[1]; z = keep + DPP_GET(give, 0x140); }
    z = z + DPP_GET(z, 0x141); z = z + DPP_GET(z, 0x4E); z = z + DPP_GET(z, 0xB1);
    return z;
}
#if BRINGUP
__device__ __forceinline__ float wave_sum(float v) {
#pragma unroll
    for (int o = 1; o < 64; o <<= 1) v += __shfl_xor(v, o);
    return v;
}
#endif

__device__ __forceinline__ void cvt_finish16(const f32x4 (&t)[8], bf16* dst, int K, LAS float* scr, int lane, const float* gk  ) {
    { const int kr = lane >> 3, c4 = (lane & 7) * 4;
#pragma unroll
      for (int i = 0; i < 8; ++i) { const int kk = 8 * i + kr; const float gg = gk ? gk[kk] : 1.0f; LAS float* d = scr + kk * 33 + c4; d[0] = t[i].x * gg; d[1] = t[i].y * gg; d[2] = t[i].z * gg; d[3] = t[i].w * gg; } }
    LDS_WAIT(); asm volatile("" ::: "memory");
    const int c = lane & 7;
#pragma unroll
    for (int j = 0; j < 4; ++j) { const int n = (lane >> 3) + 8 * j; const LAS float* s = scr + (8 * c) * 33 + n;
        v4u o; o.x = pk2(s[0 * 33], s[1 * 33]); o.y = pk2(s[2 * 33], s[3 * 33]); o.z = pk2(s[4 * 33], s[5 * 33]); o.w = pk2(s[6 * 33], s[7 * 33]);
        *(GAS v4u*)(dst + (size_t)n * K + 8 * c) = o; }
    LDS_WAIT(); asm volatile("" ::: "memory");
}
__device__ __forceinline__ void cvt8_finish_g(const f32x4 (&t)[8], unsigned char* dst, int Kb, LAS float* scr, int lane, float qs, const float* gk) {
    { const int kr = lane >> 3, c4 = (lane & 7) * 4;
#pragma unroll
      for (int i = 0; i < 8; ++i) { const float gg = gk ? gk[8 * i + kr] : 1.0f; LAS float* d = scr + (8 * i + kr) * 33 + c4; d[0] = t[i].x * gg; d[1] = t[i].y * gg; d[2] = t[i].z * gg; d[3] = t[i].w * gg; } }
    LDS_WAIT(); asm volatile("" ::: "memory");
    const int n = lane >> 1, h = lane & 1; const LAS float* s = scr + (32 * h) * 33 + n;
    v4u o0, o1;
    o0.x = pk4f8(s[0 * 33] * qs, s[1 * 33] * qs, s[2 * 33] * qs, s[3 * 33] * qs);     o0.y = pk4f8(s[4 * 33] * qs, s[5 * 33] * qs, s[6 * 33] * qs, s[7 * 33] * qs);
    o0.z = pk4f8(s[8 * 33] * qs, s[9 * 33] * qs, s[10 * 33] * qs, s[11 * 33] * qs);   o0.w = pk4f8(s[12 * 33] * qs, s[13 * 33] * qs, s[14 * 33] * qs, s[15 * 33] * qs);
    o1.x = pk4f8(s[16 * 33] * qs, s[17 * 33] * qs, s[18 * 33] * qs, s[19 * 33] * qs); o1.y = pk4f8(s[20 * 33] * qs, s[21 * 33] * qs, s[22 * 33] * qs, s[23 * 33] * qs);
    o1.z = pk4f8(s[24 * 33] * qs, s[25 * 33] * qs, s[26 * 33] * qs, s[27 * 33] * qs); o1.w = pk4f8(s[28 * 33] * qs, s[29 * 33] * qs, s[30 * 33] * qs, s[31 * 33] * qs);
    GAS v4u* d = (GAS v4u*)(dst + (size_t)n * Kb + 32 * h); d[0] = o0; d[1] = o1;
    LDS_WAIT(); asm volatile("" ::: "memory");
}
__device__ __forceinline__ void cvt_block(const float* src, int ldw, bf16* dst, int K, LAS float* scr, int lane, const float* gk  ) {
    { const int kr = lane >> 3, c4 = (lane & 7) * 4; f32x4 t[8];
#pragma unroll
      for (int i = 0; i < 8; ++i) t[i] = *(const GAS f32x4*)(src + (size_t)(8 * i + kr) * ldw + c4);
#pragma unroll
      for (int i = 0; i < 8; ++i) { const int kk = 8 * i + kr; const float gg = gk ? gk[kk] : 1.0f; LAS float* d = scr + kk * 33 + c4; d[0] = t[i].x * gg; d[1] = t[i].y * gg; d[2] = t[i].z * gg; d[3] = t[i].w * gg; } }
    LDS_WAIT(); asm volatile("" ::: "memory");
    const int c = lane & 7;
#pragma unroll
    for (int j = 0; j < 4; ++j) { const int n = (lane >> 3) + 8 * j; const LAS float* s = scr + (8 * c) * 33 + n;
        v4u o; o.x = pk2(s[0 * 33], s[1 * 33]); o.y = pk2(s[2 * 33], s[3 * 33]); o.z = pk2(s[4 * 33], s[5 * 33]); o.w = pk2(s[6 * 33], s[7 * 33]);
        *(GAS v4u*)(dst + (size_t)n * K + 8 * c) = o; }
    LDS_WAIT(); asm volatile("" ::: "memory");
}
__device__ __forceinline__ void cvt_block8(const float* src, int ldw, unsigned char* dst, int Kb, LAS float* scr, int lane, float qs, const float* gk) {
    { const int kr = lane >> 3, c4 = (lane & 7) * 4; f32x4 t[8];
#pragma unroll
      for (int i = 0; i < 8; ++i) t[i] = *(const GAS f32x4*)(src + (size_t)(8 * i + kr) * ldw + c4);
#pragma unroll
      for (int i = 0; i < 8; ++i) { const float gg = gk ? gk[8 * i + kr] : 1.0f; LAS float* d = scr + (8 * i + kr) * 33 + c4; d[0] = t[i].x * gg; d[1] = t[i].y * gg; d[2] = t[i].z * gg; d[3] = t[i].w * gg; } }
    LDS_WAIT(); asm volatile("" ::: "memory");
    const int n = lane >> 1, h = lane & 1; const LAS float* s = scr + (32 * h) * 33 + n;
    v4u o0, o1;
    o0.x = pk4f8(s[0 * 33] * qs, s[1 * 33] * qs, s[2 * 33] * qs, s[3 * 33] * qs);     o0.y = pk4f8(s[4 * 33] * qs, s[5 * 33] * qs, s[6 * 33] * qs, s[7 * 33] * qs);
    o0.z = pk4f8(s[8 * 33] * qs, s[9 * 33] * qs, s[10 * 33] * qs, s[11 * 33] * qs);   o0.w = pk4f8(s[12 * 33] * qs, s[13 * 33] * qs, s[14 * 33] * qs, s[15 * 33] * qs);
    o1.x = pk4f8(s[16 * 33] * qs, s[17 * 33] * qs, s[18 * 33] * qs, s[19 * 33] * qs); o1.y = pk4f8(s[20 * 33] * qs, s[21 * 33] * qs, s[22 * 33] * qs, s[23 * 33] * qs);
    o1.z = pk4f8(s[24 * 33] * qs, s[25 * 33] * qs, s[26 * 33] * qs, s[27 * 33] * qs); o1.w = pk4f8(s[28 * 33] * qs, s[29 * 33] * qs, s[30 * 33] * qs, s[31 * 33] * qs);
    GAS v4u* d = (GAS v4u*)(dst + (size_t)n * Kb + 32 * h); d[0] = o0; d[1] = o1;
    LDS_WAIT(); asm volatile("" ::: "memory");
}
__device__ __forceinline__ void cvt8_load(f32x4 (&t)[8], const float* src, int ldw, int lane) {
    const int kr = lane >> 3, c4 = (lane & 7) * 4;
    const unsigned voff = (unsigned)(kr * ldw + c4) * 4u;
#pragma unroll
    for (int i = 0; i < 8; ++i) t[i] = *(const GAS f32x4*)((const GAS char*)(src + (size_t)(8 * i) * ldw) + voff);
}
__device__ __forceinline__ void cvt8_finish(const f32x4 (&t)[8], unsigned char* dst, int Kb, LAS float* scr, int lane, float qs) {
    { const int kr = lane >> 3, c4 = (lane & 7) * 4;
#pragma unroll
      for (int i = 0; i < 8; ++i) { LAS float* d = scr + (8 * i + kr) * 33 + c4; d[0] = t[i].x; d[1] = t[i].y; d[2] = t[i].z; d[3] = t[i].w; } }
    LDS_WAIT(); asm volatile("" ::: "memory");
    const int n = lane >> 1, h = lane & 1; const LAS float* s = scr + (32 * h) * 33 + n;
    v4u o0, o1;
    o0.x = pk4f8(s[0 * 33] * qs, s[1 * 33] * qs, s[2 * 33] * qs, s[3 * 33] * qs);     o0.y = pk4f8(s[4 * 33] * qs, s[5 * 33] * qs, s[6 * 33] * qs, s[7 * 33] * qs);
    o0.z = pk4f8(s[8 * 33] * qs, s[9 * 33] * qs, s[10 * 33] * qs, s[11 * 33] * qs);   o0.w = pk4f8(s[12 * 33] * qs, s[13 * 33] * qs, s[14 * 33] * qs, s[15 * 33] * qs);
    o1.x = pk4f8(s[16 * 33] * qs, s[17 * 33] * qs, s[18 * 33] * qs, s[19 * 33] * qs); o1.y = pk4f8(s[20 * 33] * qs, s[21 * 33] * qs, s[22 * 33] * qs, s[23 * 33] * qs);
    o1.z = pk4f8(s[24 * 33] * qs, s[25 * 33] * qs, s[26 * 33] * qs, s[27 * 33] * qs); o1.w = pk4f8(s[28 * 33] * qs, s[29 * 33] * qs, s[30 * 33] * qs, s[31 * 33] * qs);
    GAS v4u* d = (GAS v4u*)(dst + (size_t)n * Kb + 32 * h); d[0] = o0; d[1] = o1;
    LDS_WAIT(); asm volatile("" ::: "memory");
}
__device__ __forceinline__ void cvt_matrix(Frame& F, const float* src, const float* src2, int ldw, bf16* dst, int K, int N, int kind, int nrep, size_t sstride, size_t dstride, float qs = 0.f  , const float* gain = nullptr  , int* rot = nullptr  ) {
    LAS float* scr = (LAS float*)(F.lds + RING_OFF + F.wave * 16384);
    const int NGW = F.G * NWAVES;
    const int nb_n = N / 32, per = nb_n * (K / 64), total = per * nrep;
    int gw = F.vcu * NWAVES + F.wave; if (rot) { gw -= *rot % NGW; if (gw < 0) gw += NGW; *rot += total; }
    auto locate = [&](int it, const float*& sp, size_t& doff, int& kbo) {
        const int rep = it / per, loc = it - rep * per, kb = loc / nb_n, nb = loc - kb * nb_n;
        const int n0 = 32 * nb, pn = n0 >> 8, rho = n0 & 255, bj = rho >> 7, wc = (rho & 127) >> 5;
        const float* s = src; int col;
        if (kind == 0) col = n0;
        else if (kind == 1) { const int L = 256 * pn + 64 * wc + 32 * bj; col = L < 3 * FOXD ? L : L + NH; }
        else if (kind == 2) col = 256 * pn + 64 * wc + 32 * bj;
        else if (kind == 3) { col = 128 * pn + (rho & 127); if (bj) s = src2; }
        else { col = pn < 6 ? 128 * pn + (rho & 127) + (bj ? CONVD : 0) : 2 * CONVD + 64 * wc + 32 * bj; }
        sp = s + (size_t)rep * sstride + (size_t)(64 * kb) * ldw + col; doff = (size_t)rep * dstride + (size_t)n0 * K + 64 * kb; kbo = kb; };
    auto finish = [&](const f32x4 (&t)[8], size_t doff, int kb) {
        if (qs != 0.f) cvt8_finish_g(t, (unsigned char*)dst + doff, K, scr, F.lane, qs, gain ? gain + 64 * kb : nullptr);
        else cvt_finish16(t, dst + doff, K, scr, F.lane, gain ? gain + 64 * kb : nullptr); };
    for (int it = gw; it < total; it += 2 * NGW) {
        const int it2 = it + NGW; const bool two = it2 < total;
        const float* sA; size_t dA; int kA; locate(it, sA, dA, kA);
        const float* sB = sA; size_t dB = dA; int kB = kA; if (two) locate(it2, sB, dB, kB);
        f32x4 tA[8], tB[8]; cvt8_load(tA, sA, ldw, F.lane); cvt8_load(tB, sB, ldw, F.lane);
        finish(tA, dA, kA); if (two) finish(tB, dB, kB);
    }
}
__device__ __forceinline__ void convert_moe(Frame& F, int j) {
    cvt_matrix(F, F.A->in[24] + (size_t)j * NE * DM * EFF, F.A->in[25] + (size_t)j * NE * DM * EFF, EFF, (bf16*)(F.ws + WS_WMGU + (size_t)j * WS_WM_LAYER), DM, 2 * EFF, 3, NE, (size_t)DM * EFF, (size_t)2 * EFF * DM, WSC_GU);
    cvt_matrix(F, F.A->in[26] + (size_t)j * NE * EFF * DM, nullptr, DM, (bf16*)(F.ws + WS_WMD + (size_t)j * WS_WM_LAYER), EFF, DM, 0, NE, (size_t)EFF * DM, (size_t)DM * EFF, WSC_D);
}
constexpr int MOE_GU_ITEMS = NE * (2 * EFF / 32) * (DM / 64), MOE_D_ITEMS = NE * (DM / 32) * (EFF / 64), MOE_BATCH = 4;
__device__ __forceinline__ void convert_moe_queue(Frame& F, int j, gu32* ctr, int maxr = 1 << 30  ) {
    LAS float* scr = (LAS float*)(F.lds + RING_OFF + F.wave * 16384);
    const float* wg = F.A->in[24] + (size_t)j * NE * DM * EFF; const float* wu = F.A->in[25] + (size_t)j * NE * DM * EFF; const float* wd = F.A->in[26] + (size_t)j * NE * EFF * DM;
    unsigned char* dgu = F.ws + WS_WMGU + (size_t)j * WS_WM_LAYER; unsigned char* dd = F.ws + WS_WMD + (size_t)j * WS_WM_LAYER;
    LAS unsigned* tk = (LAS unsigned*)(F.lds + RING_OFF + 12288);
    constexpr unsigned NBATCH = (MOE_GU_ITEMS + MOE_D_ITEMS) / MOE_BATCH; static_assert(NBATCH % NWAVES == 0, "ticket shape");
    if (F.tid == 0) tk[0] = ticket_take(ctr);
    __syncthreads();
    for (int r = 0; r < maxr; ++r) {
        const unsigned t8 = (unsigned)__builtin_amdgcn_readfirstlane((int)tk[r & 1]);
        if (t8 * NWAVES >= NBATCH) break;
        unsigned nxt_ = 0; if (F.tid == 0 && r + 1 < maxr) nxt_ = ticket_take(ctr);
        const unsigned bt = t8 * NWAVES + (unsigned)F.wave;
        f32x4 tb[MOE_BATCH][8]; unsigned char* dp[MOE_BATCH]; int kbt[MOE_BATCH]; float qsb[MOE_BATCH];
        static_assert(MOE_BATCH == 4 && MOE_GU_ITEMS % 4 == 0 && MOE_D_ITEMS % 4 == 0, "batch shape");
#pragma unroll
        for (int k = 0; k < MOE_BATCH; ++k) { int b = (int)bt;
            if (b < MOE_GU_ITEMS / 4) {
                constexpr int nb_n = 2 * EFF / 32, perb = (nb_n / 2) * (DM / 128);
                const int rep = b / perb, loc = b - rep * perb, kb2 = loc / (nb_n / 2), nb2 = loc - kb2 * (nb_n / 2), kb = 2 * kb2 + (k >> 1), nb = 2 * nb2 + (k & 1), n0 = 32 * nb, pn = n0 >> 8, rho = n0 & 255, bj = rho >> 7;
                cvt8_load(tb[k], (bj ? wu : wg) + (size_t)rep * DM * EFF + (size_t)(64 * kb) * EFF + 128 * pn + (rho & 127), EFF, F.lane);
                dp[k] = dgu + (size_t)rep * (2 * EFF * DM) + (size_t)n0 * DM + 64 * kb; kbt[k] = DM; qsb[k] = WSC_GU;
            } else { b -= MOE_GU_ITEMS / 4;
                constexpr int nb_n = DM / 32, perb = (nb_n / 2) * (EFF / 128);
                const int rep = b / perb, loc = b - rep * perb, kb2 = loc / (nb_n / 2), nb2 = loc - kb2 * (nb_n / 2), kb = 2 * kb2 + (k >> 1), nb = 2 * nb2 + (k & 1), n0 = 32 * nb;
                cvt8_load(tb[k], wd + (size_t)rep * EFF * DM + (size_t)(64 * kb) * DM + n0, DM, F.lane);
                dp[k] = dd + (size_t)rep * (DM * EFF) + (size_t)n0 * EFF + 64 * kb; kbt[k] = EFF; qsb[k] = WSC_D; }
        }
        if (F.tid == 0) tk[(r + 1) & 1] = nxt_;
#pragma unroll
        for (int k = 0; k < MOE_BATCH; ++k) cvt8_finish(tb[k], dp[k], kbt[k], scr, F.lane, qsb[k]);
        __syncthreads();
    }
}
__device__ __forceinline__ void phase_prologue(Frame& F) {
    int rot = 0;
#pragma unroll 1
    for (int jq = 0; jq < 2; ++jq) { int j = jq; asm volatile("" : "+s"(j));
        if ((IN8L2 && j == 1) || (IN8L0 && j == 0)) cvt_matrix(F, F.A->in[8] + (size_t)j * DM * FOXIN, nullptr, FOXIN, (bf16*)(F.ws + WS_WINE + (size_t)j * 2560 * DM * 2), DM, 2560, 1, 1, 0, 0, WSC_GU, nullptr, &rot);
        else cvt_matrix(F, F.A->in[8] + (size_t)j * DM * FOXIN, nullptr, FOXIN, (bf16*)(F.ws + WS_WINE) + (size_t)j * 2560 * DM, DM, 2560, 1, 1, 0, 0, 0.f, nullptr, &rot);
        cvt_matrix(F, F.A->in[12] + (size_t)j * DM * DM, nullptr, DM, (bf16*)(F.ws + WS_WOUTE) + (size_t)j * DM * DM, DM, DM, 0, 1, 0, 0, 0.f, nullptr, &rot);
        if ((IN8ODD >> j) & 1) cvt_matrix(F, F.A->in[13] + (size_t)j * DM * CONVIN, nullptr, CONVIN, (bf16*)(F.ws + WS_WINO + (size_t)j * CONVIN * DM * 2), DM, CONVIN, 4, 1, 0, 0, WSC_GU, F.A->in[2] + (size_t)(2 * j + 1) * DM, &rot);
        else cvt_matrix(F, F.A->in[13] + (size_t)j * DM * CONVIN, nullptr, CONVIN, (bf16*)(F.ws + WS_WINO) + (size_t)j * CONVIN * DM, DM, CONVIN, 4, 1, 0, 0, 0.f, (FUSENORM && !BRINGUP) ? F.A->in[2] + (size_t)(2 * j + 1) * DM : nullptr, &rot);
        cvt_matrix(F, F.A->in[19] + (size_t)j * DM * DM, nullptr, DM, (bf16*)(F.ws + WS_WOUTO) + (size_t)j * DM * DM, DM, DM, 0, 1, 0, 0, 0.f, nullptr, &rot);
        const bool d8_ = DENSE8 == 1 || (DENSE8 == 2 && j == 1), u8_ = d8_ || (UP8L0 && j == 0);
        if (u8_) cvt_matrix(F, F.A->in[20] + (size_t)j * DM * FF, F.A->in[21] + (size_t)j * DM * FF, FF, (bf16*)(F.ws + WS_WGU + (size_t)j * 2 * FF * DM * 2), DM, 2 * FF, 3, 1, 0, 0, WSC_GU, (FUSENORM && !BRINGUP) ? F.A->in[4] + (size_t)(2 * j) * DM : nullptr, &rot);
        else cvt_matrix(F, F.A->in[20] + (size_t)j * DM * FF, F.A->in[21] + (size_t)j * DM * FF, FF, (bf16*)(F.ws + WS_WGU) + (size_t)j * 2 * FF * DM, DM, 2 * FF, 3, 1, 0, 0, 0.f, (FUSENORM && !BRINGUP) ? F.A->in[4] + (size_t)(2 * j) * DM : nullptr, &rot);
        if (d8_) cvt_matrix(F, F.A->in[22] + (size_t)j * FF * DM, nullptr, DM, (bf16*)(F.ws + WS_WD + (size_t)j * DM * FF * 2), FF, DM, 0, 1, 0, 0, WSC_D, nullptr, &rot);
        else cvt_matrix(F, F.A->in[22] + (size_t)j * FF * DM, nullptr, DM, (bf16*)(F.ws + WS_WD) + (size_t)j * DM * FF, FF, DM, 0, 1, 0, 0, 0.f, nullptr, &rot);
    }
    cvt_matrix(F, F.A->in[5], nullptr, 2 * MEMD, (bf16*)(F.ws + WS_WKV), DM, 2 * MEMD, 2, 4, (size_t)DM * 2 * MEMD, (size_t)2 * MEMD * DM, 0.f, nullptr, &rot);
#if !MOEQ
    convert_moe(F, 0); convert_moe(F, 1);
#endif
    if (F.vcu == 0) { float* gt = (float*)(F.ws + WS_GT);
        for (int idx = F.tid; idx < 4 * 3 * 64; idx += NWAVES * 64) { const int L = idx / 192, r = (idx / 64) % 3, c = idx & 63, jj = L >> 1;
            gt[idx] = r == 0 ? F.A->in[10][jj * HD + c] * C2 : (r == 1 ? F.A->in[11][jj * HD + c] : F.A->in[6][L * HD + c] * C2); }
        if (F.wave == 0) for (int jj = 0; jj < 2; ++jj) { float mq = fabsf(F.A->in[10][jj * HD + F.lane]), mk = fabsf(F.A->in[11][jj * HD + F.lane]);
#pragma unroll
            for (int o = 1; o < 64; o <<= 1) { mq = fmaxf(mq, lane_xor_f(mq, o, F.lane)); mk = fmaxf(mk, lane_xor_f(mk, o, F.lane)); }
            if (F.lane == 0) gt[1024 + jj] = 2.0f * (64.0f * C2 * mq * mk) + 40.0f; } }
    const int gw = F.vcu * NWAVES + F.wave, NGW = F.G * NWAVES;
    for (int r = gw; r < BATCH * ML; r += NGW) {
        const GAS f32x4* xr = (const GAS f32x4*)(F.A->in[1] + (size_t)r * DM) + F.lane;
        f32x4 v[4]; float ss = 0.f;
#pragma unroll
        for (int j = 0; j < 4; ++j) { v[j] = xr[64 * j]; ss += (v[j].x * v[j].x + v[j].y * v[j].y) + (v[j].z * v[j].z + v[j].w * v[j].w); }
        const float rs = __builtin_amdgcn_rsqf(wave_sum_l(ss, F.lane) * (1.0f / DM) + lconst(RMS_EPS));
        for (int i = 0; i < 4; ++i) {
            const f32x4* gp = (const f32x4*)(F.A->in[3] + (size_t)i * DM) + F.lane;
            GAS v2u* o8 = (GAS v2u*)((bf16*)(F.ws + WS_MEMN) + ((size_t)i * BATCH * ML + r) * DM) + F.lane;
#pragma unroll
            for (int j = 0; j < 4; ++j) { const f32x4 g = gp[64 * j]; v2u w; w.x = pk2(v[j].x * rs * g.x, v[j].y * rs * g.y); w.y = pk2(v[j].z * rs * g.z, v[j].w * rs * g.w); o8[64 * j] = w; }
        }
    }
}

__device__ __forceinline__ void phase_norm(Frame& F, const float* src32  , bf16* h16, const float* gain, int kind, bool combine, const float* wx  , const float* bf  , bool f8out = false) {
    LAS float* wl = (LAS float*)(F.lds + RING_OFF);
    LAS int* wcnt = (LAS int*)(F.lds + RING_OFF + 65536);
    __syncthreads();
    static_assert(DM == 2 * NWAVES * 64 && NH == 12 && NE == 8 && (FOXIN * 4) % 16 == 0 && (3 * FOXD * 4) % 16 == 0, "weight staging shape");
    if (kind == 1) { f32x4 r[2][3];
#pragma unroll
        for (int q = 0; q < 2; ++q) { const GAS f32x4* src = (const GAS f32x4*)(wx + (size_t)(F.tid + 512 * q) * FOXIN + 3 * FOXD);
#pragma unroll
            for (int c = 0; c < 3; ++c) r[q][c] = src[c]; }
#pragma unroll
        for (int q = 0; q < 2; ++q)
#pragma unroll
            for (int c = 0; c < 3; ++c)
#pragma unroll
                for (int e = 0; e < 4; ++e) wl[(4 * c + e) * DM + F.tid + 512 * q] = r[q][c][e]; }
    if (kind == 2) { f32x4 r[2][2];
#pragma unroll
        for (int q = 0; q < 2; ++q) { const GAS f32x4* src = (const GAS f32x4*)(wx + (size_t)(F.tid + 512 * q) * NE); r[q][0] = src[0]; r[q][1] = src[1]; }
#pragma unroll
        for (int q = 0; q < 2; ++q)
#pragma unroll
            for (int c = 0; c < 2; ++c)
#pragma unroll
                for (int e = 0; e < 4; ++e) wl[(4 * c + e) * DM + F.tid + 512 * q] = r[q][c][e]; }
    __syncthreads();
    f32x4 g[4];
#pragma unroll
    for (int j = 0; j < 4; ++j) g[j] = ((const f32x4*)gain)[64 * j + F.lane];
    bf16* UB = (bf16*)(F.ws + WS_UB);
    const bf16* Y = (const bf16*)(F.ws + WS_XS);
    const int* SLOT = (const int*)(F.ws + WS_SLOT);
    for (int chunk = F.vcu; chunk < T / 128; chunk += F.G) {
        int cnt[NE];
#pragma unroll
        for (int e = 0; e < NE; ++e) cnt[e] = 0;
        const int mb = chunk * 128 + F.wave * 16;
        f32x4 n32[4]; v2u n16[4], na[4], nb[4];
        auto issue = [&](int m, int s0, int s1) {
            if (src32) { const GAS f32x4* xr = (const GAS f32x4*)(src32 + (size_t)m * DM) + F.lane;
#pragma unroll
                for (int j = 0; j < 4; ++j) n32[j] = xr[64 * j]; }
            else { const GAS v2u* hr = (const GAS v2u*)(h16 + (size_t)m * DM) + F.lane;
#pragma unroll
                for (int j = 0; j < 4; ++j) n16[j] = hr[64 * j]; }
            if (combine) { const GAS v2u* y0 = (const GAS v2u*)(Y + (size_t)s0 * DM) + F.lane; const GAS v2u* y1 = (const GAS v2u*)(Y + (size_t)s1 * DM) + F.lane;
#pragma unroll
                for (int j = 0; j < 4; ++j) { na[j] = y0[64 * j]; nb[j] = y1[64 * j]; } } };
        const int l1 = F.lane & 1; int fv = 0;
        { int v0 = 0; if (combine) { v0 = ((const GAS int*)SLOT)[2 * mb + l1]; fv = ((const GAS int*)SLOT)[2 * mb + 2 + l1]; }
          issue(mb, __builtin_amdgcn_readlane(v0, 0), __builtin_amdgcn_readlane(v0, 1)); }
#pragma unroll 1
        for (int i = 0; i < 16; ++i) {
            const int m = mb + i;
            f32x4 v[4];
            if (src32) {
#pragma unroll
                for (int j = 0; j < 4; ++j) v[j] = n32[j]; }
            else {
#pragma unroll
                for (int j = 0; j < 4; ++j) v[j] = (f32x4){bflo(n16[j].x), bfhi(n16[j].x), bflo(n16[j].y), bfhi(n16[j].y)}; }
            v2u ca[4], cb_[4];
            if (combine) {
#pragma unroll
                for (int j = 0; j < 4; ++j) { ca[j] = na[j]; cb_[j] = nb[j]; } }
            if (i + 1 < 16) { const int vc = fv;
                if (combine && i + 2 < 16) fv = ((const GAS int*)SLOT)[2 * m + 4 + l1];
                issue(m + 1, __builtin_amdgcn_readlane(vc, 0), __builtin_amdgcn_readlane(vc, 1)); }
            if (combine) {
                GAS v2u* ho = (GAS v2u*)(h16 + (size_t)m * DM) + F.lane;
#pragma unroll
                for (int j = 0; j < 4; ++j) { const v2u a = ca[j], b = cb_[j];
                    v[j].x += bflo(a.x) + bflo(b.x); v[j].y += bfhi(a.x) + bfhi(b.x); v[j].z += bflo(a.y) + bflo(b.y); v[j].w += bfhi(a.y) + bfhi(b.y);
                    v2u w; w.x = pk2(v[j].x, v[j].y); w.y = pk2(v[j].z, v[j].w); ho[64 * j] = w;
                    v[j] = (f32x4){bflo(w.x), bfhi(w.x), bflo(w.y), bfhi(w.y)}; }
            }
            float ss = 0.f;
#pragma unroll
            for (int j = 0; j < 4; ++j) ss += (v[j].x * v[j].x + v[j].y * v[j].y) + (v[j].z * v[j].z + v[j].w * v[j].w);
            const float rs = __builtin_amdgcn_rsqf(wave_sum_l(ss, F.lane) * (1.0f / DM) + lconst(RMS_EPS));
            GAS v2u* o8 = (GAS v2u*)(UB + (size_t)m * DM) + F.lane; GAS unsigned* o4 = (GAS unsigned*)((unsigned char*)UB + (size_t)m * DM) + F.lane;
#pragma unroll
            for (int j = 0; j < 4; ++j) { v[j] = v[j] * rs * g[j];
                if (kind == 2 || f8out) o4[64 * j] = pk4f8(clampf8(v[j].x * ASC_Z), clampf8(v[j].y * ASC_Z), clampf8(v[j].z * ASC_Z), clampf8(v[j].w * ASC_Z));
                else { v2u w; w.x = pk2(v[j].x, v[j].y); w.y = pk2(v[j].z, v[j].w); o8[64 * j] = w; } }
            if (kind == 1) {
                float pv[16];
#pragma unroll
                for (int h = 0; h < NH; ++h) { float p = 0.f;
#pragma unroll
                    for (int j = 0; j < 4; ++j) { const f32x4 w = ((const LAS f32x4*)(wl + h * DM))[64 * j + F.lane]; p += (v[j].x * w.x + v[j].y * w.y) + (v[j].z * w.z + v[j].w * w.w); }
                    pv[h] = p; }
#pragma unroll
                for (int h = NH; h < 16; ++h) pv[h] = pv[h - NH];
                const float z = wave_reduce16(pv, F.lane); const int hh = F.lane >> 2;
                if ((F.lane & 3) == 0 && hh < NH) { const float x = z + bf[hh]; const float lf = fminf(x, 0.f) - 0.6931471805599453f * __builtin_amdgcn_logf(1.0f + __builtin_amdgcn_exp2f(-1.4426950408889634f * fabsf(x))); ((float*)(F.ws + WS_LOGF))[(size_t)m * NH + hh] = lf; }
            }
            if (kind == 2) {
                float lg[NE];
                { float pv[NE];
#pragma unroll
                  for (int e = 0; e < NE; ++e) { float p = 0.f;
#pragma unroll
                    for (int j = 0; j < 4; ++j) { const f32x4 w = ((const LAS f32x4*)(wl + e * DM))[64 * j + F.lane]; p += (v[j].x * w.x + v[j].y * w.y) + (v[j].z * w.z + v[j].w * w.w); }
                    pv[e] = p; }
                  const float z = wave_reduce8(pv, F.lane);
#pragma unroll
                  for (int e = 0; e < NE; ++e) lg[e] = __builtin_bit_cast(float, __builtin_amdgcn_readlane(__builtin_bit_cast(int, z), 8 * e)); }
                int e1 = 0; float l1 = lg[0];
#pragma unroll
                for (int e = 1; e < NE; ++e) if (lg[e] > l1) { l1 = lg[e]; e1 = e; }
                int e2 = -1; float l2 = -INFINITY;
#pragma unroll
                for (int e = 0; e < NE; ++e) if (e != e1 && lg[e] > l2) { l2 = lg[e]; e2 = e; }
                const float ex = __builtin_amdgcn_exp2f(1.4426950408889634f * (l2 - l1)), g1 = __builtin_amdgcn_rcpf(1.0f + ex), g2 = ex * g1;
                if (F.lane == 0) { int* te = (int*)(F.ws + WS_TOPE) + 2 * m; float* tg = (float*)(F.ws + WS_TOPG) + 2 * m; te[0] = e1; te[1] = e2; tg[0] = g1; tg[1] = g2; }
#pragma unroll
                for (int e = 0; e < NE; ++e) cnt[e] += (e == e1) + (e == e2);
            }
        }
        if (kind == 2) {
            __syncthreads();
            if (F.lane == 0) {
#pragma unroll
                for (int e = 0; e < NE; ++e) wcnt[F.wave * NE + e] = cnt[e];
            }
            __syncthreads();
            if (F.tid < NE) { int s = 0; for (int w = 0; w < NWAVES; ++w) s += wcnt[w * NE + F.tid]; ((int*)(F.ws + WS_CNT))[chunk * NE + F.tid] = s; }
        }
    }
}

__device__ __forceinline__ void phase_cumsum(Frame& F) {
    const float* LOGF = (const float*)(F.ws + WS_LOGF); float* CB = (float*)(F.ws + WS_CB);
    LAS double* wtot = (LAS double*)(F.lds + RING_OFF);
    for (int sq = F.vcu; sq < BATCH * NH; sq += F.G) {
        const int b = sq / NH, h = sq - b * NH; const int t0 = F.wave * 512;
        float x[8];
#pragma unroll
        for (int k = 0; k < 8; ++k) x[k] = LOGF[((size_t)b * SEQ + t0 + k * 64 + F.lane) * NH + h];
        double sc[8]; double carry = 0.0;
#pragma unroll
        for (int k = 0; k < 8; ++k) {
            double v = (double)x[k];
#pragma unroll
            for (int o = 1; o < 64; o <<= 1) { const double n = lane_up_d(v, o, F.lane); if (F.lane >= o) v += n; }
            v += carry; sc[k] = v; carry = lane_get_d(v, 63);
        }
        __syncthreads();
        if (F.lane == 0) wtot[F.wave] = carry;
        __syncthreads();
        double base = 0.0; for (int w = 0; w < F.wave; ++w) base += wtot[w];
#pragma unroll
        for (int k = 0; k < 8; ++k) CB[(size_t)sq * SEQ + t0 + k * 64 + F.lane] = (float)((sc[k] + base) * 1.4426950408889634);
    }
    __syncthreads();
}

__device__ __forceinline__ void glds16_s(unsigned voff32, const void* sbase, unsigned ldsdst) { unsigned keep_;
    asm volatile("s_mov_b32 %0, m0\n\ts_mov_b32 m0, %3\n\ts_nop 0\n\tglobal_load_lds_dwordx4 %1, %2\n\ts_mov_b32 m0, %0" : "=&s"(keep_) : "v"(voff32), "s"(sbase), "s"(ldsdst) : "memory"); }
__device__ __forceinline__ void gstore32_s(unsigned voff32, unsigned data, const void* sbase) { asm volatile("global_store_dword %0, %1, %2" :: "v"(voff32), "v"(data), "s"(sbase) : "memory"); }
typedef float f32x2p __attribute__((ext_vector_type(2)));
template <int R> __device__ __forceinline__ void conv_row(f32x2p (&o)[16], const f32x2p (&w)[CW], const unsigned (&xr)[46]) {
    const unsigned x = xr[R]; const f32x2p xv = {bflo(x), bfhi(x)};
#pragma unroll
    for (int j = 0; j < CW; ++j) { const int tt = R - j; if (tt >= 0 && tt < 16) o[tt] = __builtin_elementwise_fma(w[j], xv, o[tt]); }
    __builtin_amdgcn_sched_barrier(0);
}
template <int... Rs> __device__ __forceinline__ void conv_rows(std::integer_sequence<int, Rs...>, f32x2p (&o)[16], const f32x2p (&w)[CW], const LAS unsigned* p0, const LAS unsigned* p1, const LAS unsigned* p2) {
    unsigned xr[46];
    ((xr[Rs] = (((Rs + 2) >> 4) == 0 ? p0 : ((Rs + 2) >> 4) == 1 ? p1 : p2)[((Rs + 2) & 15) * 384]), ...);
    __builtin_amdgcn_sched_barrier(0);
    (conv_row<Rs>(o, w, xr), ...);
}
#ifndef CONV_LN_OLD
#define CONV_LN_OLD 0
#endif
__device__ __forceinline__ void phase_conv(Frame& F, const float* dw, const float* dwb, const float* lng, const float* lnb) {
    const bf16* GLU = (const bf16*)(F.ws + WS_GLU); bf16* MIX = (bf16*)(F.ws + WS_MIX);
    LAS unsigned* tile = (LAS unsigned*)(F.lds + RING_OFF);
    LAS float* red = (LAS float*)(F.lds + RING_OFF + 4 * 24576);
    const int tid = F.tid; const bool act = tid < 384; const int ct = act ? tid : tid - 128; const int c0 = 2 * ct;
    f32x2p w[CW]; float b0, b1, g0, g1, lb0, lb1; const unsigned co4 = (unsigned)c0 * 4u;
#pragma unroll
    for (int j = 0; j < CW; ++j) w[j] = *(const GAS f32x2p*)((const GAS char*)(dw + j * CONVD) + co4);
    { const f32x2p bb = *(const GAS f32x2p*)((const GAS char*)dwb + co4), gg = *(const GAS f32x2p*)((const GAS char*)lng + co4), ll = *(const GAS f32x2p*)((const GAS char*)lnb + co4); b0 = bb.x; b1 = bb.y; g0 = gg.x; g1 = gg.y; lb0 = ll.x; lb1 = ll.y; }
    const unsigned tile0 = (unsigned)(uintptr_t)tile;
    auto dma_block = [&](int b, int B) { const char* gb = (const char*)(GLU + ((size_t)b * SEQ + (size_t)B * 16) * CONVD); const unsigned dst = tile0 + (unsigned)(B & 3) * 24576u;
#pragma unroll
        for (int i = 0; i < 3; ++i) { const int c = F.wave + 8 * i; glds16_s((unsigned)(c * 1024 + F.lane * 16), gb, (unsigned)__builtin_amdgcn_readfirstlane((int)(dst + (unsigned)c * 1024u))); } };
    for (int run = F.vcu; run < T / 128; run += F.G) {
        const int b = run >> 5, B0 = (run & 31) * 8;
        __syncthreads();
        if (B0 == 0) {
            unsigned zz; asm volatile("v_mov_b32 %0, 0" : "=v"(zz));
#pragma unroll
            for (int i = 0; i < 6; ++i) { const int c = F.wave + 8 * i; *(LAS v4u*)((LAS unsigned char*)tile + 2 * 24576 + c * 1024 + F.lane * 16) = (v4u){zz, zz, zz, zz}; }
        } else { dma_block(b, B0 - 2); dma_block(b, B0 - 1); }
        dma_block(b, B0);
#pragma unroll 1
        for (int it = 0; it < 8; ++it) {
            const int B = B0 + it, t0 = B * 16;
            asm volatile("s_waitcnt vmcnt(0)" ::: "memory");
            __syncthreads();
            if (it < 7) dma_block(b, B + 1);
            f32x2p o[16];
#pragma unroll
            for (int tt = 0; tt < 16; ++tt) o[tt] = (f32x2p){b0, b1};
            conv_rows(std::make_integer_sequence<int, 46>{}, o, w, tile + ((B - 2) & 3) * 6144 + ct, tile + ((B - 1) & 3) * 6144 + ct, tile + (B & 3) * 6144 + ct);
            { float pv[32];
#pragma unroll
              for (int tt = 0; tt < 16; ++tt) { pv[2 * tt] = o[tt].x + o[tt].y; pv[2 * tt + 1] = o[tt].x * o[tt].x + o[tt].y * o[tt].y; }
              const float z = wave_reduce32(pv, F.lane);
              if ((F.lane & 1) == 0 && F.wave < 6) red[F.wave * 32 + (F.lane >> 1)] = z; }
            __syncthreads();
#if !CONV_LN_OLD
#ifndef CONV_VAR
#define CONV_VAR 0
#endif
            { const int tk = F.lane & 15; float s1, s2;
              { const f32x2p r2 = *(const LAS f32x2p*)(red + tk * 2); s1 = r2.x; s2 = r2.y; }
#pragma unroll
              for (int w6 = 1; w6 < 6; ++w6) { const f32x2p r2 = *(const LAS f32x2p*)(red + (w6 * 16 + tk) * 2); s1 += r2.x; s2 += r2.y; }
              const float mean = s1 * (1.0f / CONVD), var = fmaxf(s2 * (1.0f / CONVD) - mean * mean, 0.f), rstd = __builtin_amdgcn_rsqf(var + lconst(RMS_EPS));
              LAS f32x2p* st = (LAS f32x2p*)(red + 192) + F.wave * 16;
#if CONV_VAR == 3
              st[tk] = (f32x2p){rstd, -mean * rstd};
#else
              if (F.lane < 16) st[tk] = (f32x2p){rstd, -mean * rstd};
#endif
              asm volatile("s_waitcnt lgkmcnt(0)" ::: "memory");
#if CONV_VAR == 1
#pragma unroll 4
#elif CONV_VAR == 2
#pragma unroll 1
#else
#pragma unroll
#endif
              for (int tt = 0; tt < 16; ++tt) {
#if CONV_VAR == 4
                float a_ = ((const LAS float*)st)[2 * tt], b_ = ((const LAS float*)st)[2 * tt + 1]; asm volatile("" : "+v"(a_), "+v"(b_)); const f32x2p ab = {a_, b_};
#else
                const f32x2p ab = st[tt];
#endif
                const float y0 = (o[tt].x * ab.x + ab.y) * g0 + lb0, y1 = (o[tt].y * ab.x + ab.y) * g1 + lb1;
                const float z0 = y0 * __builtin_amdgcn_rcpf(1.0f + __builtin_amdgcn_exp2f(-1.4426950408889634f * y0)), z1 = y1 * __builtin_amdgcn_rcpf(1.0f + __builtin_amdgcn_exp2f(-1.4426950408889634f * y1));
                if (act) *(GAS unsigned*)((GAS char*)(MIX + ((size_t)b * SEQ + t0 + tt) * DM) + (co4 >> 1)) = pk2(z0, z1);
#if CONV_VAR == 5
                __builtin_amdgcn_sched_barrier(0);
#endif
              } }
#else
#pragma unroll
            for (int tt = 0; tt < 16; ++tt) { float s1 = 0.f, s2 = 0.f;
#pragma unroll
                for (int w6 = 0; w6 < 6; ++w6) { s1 += red[(w6 * 16 + tt) * 2]; s2 += red[(w6 * 16 + tt) * 2 + 1]; }
                const float mean = s1 * (1.0f / CONVD), var = fmaxf(s2 * (1.0f / CONVD) - mean * mean, 0.f), rstd = __builtin_amdgcn_rsqf(var + lconst(RMS_EPS));
                const float y0 = (o[tt].x - mean) * rstd * g0 + lb0, y1 = (o[tt].y - mean) * rstd * g1 + lb1;
                const float z0 = y0 * __builtin_amdgcn_rcpf(1.0f + __builtin_amdgcn_exp2f(-1.4426950408889634f * y0)), z1 = y1 * __builtin_amdgcn_rcpf(1.0f + __builtin_amdgcn_exp2f(-1.4426950408889634f * y1));
                if (act) *(GAS unsigned*)((GAS char*)(MIX + ((size_t)b * SEQ + t0 + tt) * DM) + (co4 >> 1)) = pk2(z0, z1); }
#endif
        }
    }
    __syncthreads();
}

__device__ __forceinline__ void phase_scatter(Frame& F) {
    LAS int* pre = (LAS int*)(F.lds + RING_OFF);
    LAS int* wtot = pre + 2048;
    LAS int* tot = wtot + 32;
    LAS int* wc2 = tot + 16;
    LAS int* rowl = wc2 + 32;
    const int* CNT = (const int*)(F.ws + WS_CNT); const int* TOPE = (const int*)(F.ws + WS_TOPE); const float* TOPG = (const float*)(F.ws + WS_TOPG);
    int* SLOT = (int*)(F.ws + WS_SLOT); float* ROWG = (float*)(F.ws + WS_ROWG); int* TAB = (int*)(F.ws + WS_TAB);
    const unsigned char* UB = (const unsigned char*)(F.ws + WS_UB); unsigned char* XS = (unsigned char*)(F.ws + WS_XS);
    const int tid = F.tid, lane = F.lane, wave = F.wave;
    int v[NE];
    if (tid < 256) {
#pragma unroll
        for (int e = 0; e < NE; ++e) v[e] = CNT[tid * NE + e];
        int inc[NE];
#pragma unroll
        for (int e = 0; e < NE; ++e) { int x = v[e];
#pragma unroll
            for (int o = 1; o < 64; o <<= 1) { const int n = lane_up_i(x, o, lane); if (lane >= o) x += n; }
            inc[e] = x; }
        if (lane == 63) {
#pragma unroll
            for (int e = 0; e < NE; ++e) wtot[wave * NE + e] = inc[e];
        }
#pragma unroll
        for (int e = 0; e < NE; ++e) v[e] = inc[e] - v[e];
    }
    __syncthreads();
    if (tid < 256) {
#pragma unroll
        for (int e = 0; e < NE; ++e) { int add = 0; for (int w = 0; w < wave; ++w) add += wtot[w * NE + e]; pre[tid * NE + e] = v[e] + add; }
    }
    if (tid < NE) { int s = 0; for (int w = 0; w < 4; ++w) s += wtot[w * NE + tid]; tot[tid] = s; }
    __syncthreads();
    if (tid == 0) { int ps; asm volatile("v_mov_b32 %0, 0" : "=v"(ps)); for (int e = 0; e < NE; ++e) { tot[8 + e] = ps; ps += (tot[e] + 255) & ~255; } }
    __syncthreads();
    for (int chunk = F.vcu; chunk < T / 128; chunk += F.G) {
        int e = 0, rank = 0; const int f = chunk * 256 + tid;
        if (tid < 256) {
            e = TOPE[f];
#pragma unroll
            for (int x = 0; x < NE; ++x) { const unsigned long long mask = __ballot(e == x); if (e == x) rank = __popcll(mask & ((1ull << lane) - 1ull)); if (lane == 0) wc2[wave * NE + x] = __popcll(mask); }
        }
        __syncthreads();
        if (tid < 256) {
            int base = tot[8 + e] + pre[chunk * NE + e]; for (int w = 0; w < wave; ++w) base += wc2[w * NE + e];
            const int row = base + rank; SLOT[f] = row; ROWG[row] = TOPG[f]; rowl[tid] = row;
        }
        __syncthreads();
#pragma unroll 1
        for (int i0 = 0; i0 < 32; i0 += 8) {
            v4u rw[4];
#pragma unroll
            for (int q = 0; q < 4; ++q) { const int tok = chunk * 128 + ((wave * 32 + i0) >> 1) + q; rw[q] = ((const GAS v4u*)(UB + (size_t)tok * DM) + lane)[0]; }
#pragma unroll
            for (int q = 0; q < 8; ++q) { const int row = rowl[wave * 32 + i0 + q]; ((GAS v4u*)(XS + (size_t)row * DM) + lane)[0] = rw[q >> 1]; } }
        __syncthreads();
    }
    for (int e = F.vcu; e < NE; e += F.G) { const int lo = tot[8 + e] + tot[e], hi = tot[8 + e] + ((tot[e] + 255) & ~255);
        unsigned zz; asm volatile("v_mov_b32 %0, 0" : "=v"(zz));
        for (int r = lo + wave; r < hi; r += NWAVES) { GAS v4u* d = (GAS v4u*)(XS + (size_t)r * DM) + lane; d[0] = (v4u){zz, zz, zz, zz}; if (lane == 0) ROWG[r] = 0.f; } }
    if (F.vcu == 0) {
        if (tid == 0) { int nrt = 0; for (int e = 0; e < NE; ++e) nrt += (tot[e] + 255) >> 8; TAB[0] = nrt; }
        if (tid < MAXRT) { int ex = NE - 1; for (int e = NE - 1; e >= 0; --e) if (tid * 256 < tot[8 + e] + ((tot[e] + 255) & ~255)) ex = e; TAB[16 + tid] = ex; }
    }
}

__device__ __forceinline__ void phase_final(Frame& F) {
    const bf16* Y = (const bf16*)(F.ws + WS_XS); const GAS int* SLOT = (const GAS int*)(F.ws + WS_SLOT); const bf16* H16 = (const bf16*)(F.ws + WS_H16);
    const int gw = F.vcu * NWAVES + F.wave, NGW = F.G * NWAVES;
    v2u nh[4], na[4], nb[4];
    auto issue = [&](int m, int s0, int s1) {
        const GAS v2u* hr = (const GAS v2u*)(H16 + (size_t)m * DM) + F.lane; const GAS v2u* y0 = (const GAS v2u*)(Y + (size_t)s0 * DM) + F.lane; const GAS v2u* y1 = (const GAS v2u*)(Y + (size_t)s1 * DM) + F.lane;
#pragma unroll
        for (int j = 0; j < 4; ++j) { nh[j] = hr[64 * j]; na[j] = y0[64 * j]; nb[j] = y1[64 * j]; } };
    const int l1 = F.lane & 1; int fv = 0;
#define SLOT2(v) __builtin_amdgcn_readlane((v), 0), __builtin_amdgcn_readlane((v), 1)
    if (gw < T) { const int v0 = SLOT[2 * gw + l1]; if (gw + NGW < T) fv = SLOT[2 * (gw + NGW) + l1]; issue(gw, SLOT2(v0)); }
#pragma unroll 1
    for (int m = gw; m < T; m += NGW) {
        GAS f32x4* xr = (GAS f32x4*)(F.out + (size_t)m * DM) + F.lane;
        v2u ch[4], ca[4], cb_[4];
#pragma unroll
        for (int j = 0; j < 4; ++j) { ch[j] = nh[j]; ca[j] = na[j]; cb_[j] = nb[j]; }
        if (m + NGW < T) { const int vc = fv; if (m + 2 * NGW < T) fv = SLOT[2 * (m + 2 * NGW) + l1]; issue(m + NGW, SLOT2(vc)); }
#pragma unroll
        for (int j = 0; j < 4; ++j) { const v2u h = ch[j], a = ca[j], b = cb_[j]; f32x4 v;
            v.x = bflo(h.x) + (bflo(a.x) + bflo(b.x)); v.y = bfhi(h.x) + (bfhi(a.x) + bfhi(b.x)); v.z = bflo(h.y) + (bflo(a.y) + bflo(b.y)); v.w = bfhi(h.y) + (bfhi(a.y) + bfhi(b.y)); xr[64 * j] = v; }
    }
}
#ifndef DIS_PRO
#define DIS_PRO 0
#endif
#ifndef DIS_NORM
#define DIS_NORM 0
#endif
#ifndef DIS_PMK
#define DIS_PMK 0
#endif
#ifndef DIS_CUM
#define DIS_CUM 0
#endif
#ifndef DIS_INE
#define DIS_INE 0
#endif
#ifndef DIS_INO
#define DIS_INO 0
#endif
#ifndef DIS_FOX
#define DIS_FOX 0
#endif
#ifndef DIS_CONV
#define DIS_CONV 0
#endif
#ifndef DIS_MEM
#define DIS_MEM 0
#endif
#ifndef DIS_OUT
#define DIS_OUT 0
#endif
#ifndef DIS_SCAT
#define DIS_SCAT 0
#endif
#ifndef DIS_UP
#define DIS_UP 0
#endif
#ifndef DIS_DOWN
#define DIS_DOWN 0
#endif
#ifndef DIS_FIN
#define DIS_FIN 0
#endif
#ifndef DIS_UPD
#define DIS_UPD 0
#endif
#ifndef DIS_UPM
#define DIS_UPM 0
#endif
#ifndef REP_GIN
#define REP_GIN 1
#endif
#ifndef REP_GOUT
#define REP_GOUT 1
#endif
#ifndef REP_GDENSE
#define REP_GDENSE 1
#endif
#ifndef REP_GMOE
#define REP_GMOE 1
#endif
#ifndef REP_N0C
#define REP_N0C 1
#endif
#ifndef REP_CONV
#define REP_CONV 1
#endif
#ifndef REP_PRO
#define REP_PRO 1
#endif
#ifndef REP_ATT
#define REP_ATT 1
#endif
#ifndef REP_THIN
#define REP_THIN 1
#endif
#ifndef REP_MEM
#define REP_MEM 1
#endif
struct AttnUnitId { int bh, qb; };
struct FoxOrder { int vcu, G;
    __device__ __forceinline__ bool next(int i, AttnUnitId& u) const { const int p = vcu + G * (i >> 1); if (p >= BATCH * NH * 8) return false; const int s = p & 7; u.bh = p >> 3; u.qb = (i & 1) ? 15 - s : s; return true; } };
struct MemOrder { int vcu, G;
    __device__ __forceinline__ bool next(int i, AttnUnitId& u) const { const int p = vcu + G * i; if (p >= BATCH * MEMH * 16) return false; u.bh = p >> 4; u.qb = p & 15; return true; } };

__global__ void __launch_bounds__(NWAVES * 64, 2) mega_fwd(Args args) {
    extern __shared__ __attribute__((aligned(16))) unsigned char lds[];
    Frame F;
    F.lds = (LAS unsigned char*)lds;
    F.MISC = (volatile LAS unsigned*)(F.lds + MISC_OFF);
    const int wave0 = __builtin_amdgcn_readfirstlane((int)threadIdx.x >> 6);
    F.tid = threadIdx.x; F.lane = F.tid & 63; F.wave = wave0;
    F.G = gridDim.x; { const int bx = blockIdx.x; F.vcu = (F.G % 8 == 0) ? (bx % 8) * (F.G / 8) + bx / 8 : bx; }
    const int vcu0 = F.vcu;
    F.ws = args.ws; F.out = args.out; F.ctl = (gu32*)(args.ws + WS_CTL);
    F.A = (const __attribute__((address_space(4))) Args*)__builtin_amdgcn_kernarg_segment_ptr();
    { unsigned z0_; asm volatile("v_mov_b32 %0, 0" : "=v"(z0_)); for (int u = F.tid; u < (LDS_BYTES - LDSCTL_OFF) / 4; u += NWAVES * 64) ((LAS unsigned*)(F.lds + LDSCTL_OFF))[u] = z0_; }
    __syncthreads();
#if BRINGUP
    const int lo = args.ph_lo, hi = args.ph_hi; const unsigned mask = args.mask;
#else
    constexpr int lo = 0, hi = NPH; constexpr unsigned mask = C_ALL;
#endif
    XcdBarrier bar; bar.bar = (unsigned*)(F.ctl + CW_BAR); bar.x = 0; bar.st = nullptr;
    if (hi - lo > 1) bar = xcd_barrier_post((unsigned*)(F.ctl + CW_BAR), F.MISC + 8, F.tid);
#define IN(k) (lo <= (k) && (k) < hi)
#define SLOT_VARS int Lq = L; asm volatile("" : "+s"(Lq)); const int pb = 1 + 9 * Lq, j = Lq >> 1; const bool odd = (Lq & 1) != 0; const float* hsrc = (Lq == 0) ? F.A->in[0] : nullptr; bf16* H16 = (bf16*)(F.ws + WS_H16); (void)j; (void)hsrc; (void)odd; (void)H16
#ifndef REP_BAR
#define REP_BAR 1
#endif
#ifdef PROBE_WAIT_SLOT
#define PW_T0(k) unsigned long long pw0_ = __builtin_amdgcn_s_memrealtime()
#define PW_AMP(k) do { if ((((k) - 1) % 9) == PROBE_WAIT_SLOT && (k) >= 1) { const unsigned long long pw1_ = __builtin_amdgcn_s_memrealtime(); const unsigned long long pwe_ = pw1_ + 4ull * (pw1_ - pw0_); while (__builtin_amdgcn_s_memrealtime() < pwe_) __builtin_amdgcn_s_sleep(8); __syncthreads(); } } while (0)
#else
#define PW_T0(k) do {} while (0)
#define PW_AMP(k) do {} while (0)
#endif
#define SEAM(k) do { if ((k) + 1 < hi) for (int rb_ = 0; rb_ < REP_BAR; ++rb_) { XcdBarrier bz_ = bar; { unsigned pl_ = (unsigned)(unsigned long long)bz_.bar, ph_ = (unsigned)((unsigned long long)bz_.bar >> 32); asm volatile("" : "+v"(pl_), "+v"(ph_)); bz_.bar = (unsigned*)(((unsigned long long)(unsigned)__builtin_amdgcn_readfirstlane((int)ph_) << 32) | (unsigned)__builtin_amdgcn_readfirstlane((int)pl_)); } int tb_; asm volatile("v_mbcnt_lo_u32_b32 %0, -1, 0\n\tv_mbcnt_hi_u32_b32 %0, -1, %0" : "=v"(tb_)); PW_T0(k); xcd_barrier(bz_, wave0 * 64 + tb_); PW_AMP(k); } } while (0)
    unsigned char* ws = args.ws; bf16 *UB, *MIX, *MQ, *QKV;
#define RS_FINISH() do { const int gt_ = F.vcu * (NWAVES * 64) + F.tid; if (gt_ < T) ((float*)(ws + WS_RS))[gt_] = pg8::row_rs((const float*)(ws + WS_SSQ), gt_); \
        XcdBarrier bz_ = bar; { unsigned long long pz_ = (unsigned long long)bz_.bar; asm volatile("" : "+s"(pz_)); bz_.bar = (unsigned*)pz_; } xcd_barrier(bz_, F.tid); } while (0)
#define PHASE_BEGIN() do { int tz_; asm volatile("v_mbcnt_lo_u32_b32 %0, -1, 0\n\tv_mbcnt_hi_u32_b32 %0, -1, %0" : "=v"(tz_)); { int w_ = wave0, c_ = vcu0, g_ = (int)gridDim.x; asm volatile("" : "+s"(w_), "+s"(c_), "+s"(g_)); F.lane = tz_; F.wave = w_; F.tid = w_ * 64 + tz_; F.vcu = c_; F.G = g_; }   \
        { unsigned wl_ = (unsigned)(unsigned long long)args.ws, wh_ = (unsigned)((unsigned long long)args.ws >> 32); asm volatile("" : "+v"(wl_), "+v"(wh_)); \
          ws = (unsigned char*)(((unsigned long long)(unsigned)__builtin_amdgcn_readfirstlane((int)wh_) << 32) | (unsigned)__builtin_amdgcn_readfirstlane((int)wl_)); F.ws = ws; } \
        { unsigned la_ = (unsigned)(uintptr_t)(LAS unsigned char*)lds; asm volatile("" : "+s"(la_)); LAS unsigned char* lp_ = (LAS unsigned char*)(uintptr_t)la_; F.lds = lp_; F.MISC = (volatile LAS unsigned*)(lp_ + MISC_OFF); } \
        { unsigned long long ka_ = (unsigned long long)__builtin_amdgcn_kernarg_segment_ptr(); asm volatile("" : "+s"(ka_)); F.A = (const __attribute__((address_space(4))) Args*)ka_; } \
        UB = (bf16*)(ws + WS_UB); MIX = (bf16*)(ws + WS_MIX); MQ = (bf16*)(ws + WS_MQ); QKV = (bf16*)(ws + WS_QKV); } while (0)

    if (IN(0)) { PHASE_BEGIN(); if ((mask & C_THIN) && !DIS_PRO) for (int rep_ = 0; rep_ < REP_PRO; ++rep_) { phase_prologue(F); __syncthreads(); } }

    for (int L = 0; L < 4; ++L) {
        { SLOT_VARS;
        if (IN(pb + 0) && !(FUSENORM && !BRINGUP && odd)) {
            PHASE_BEGIN();
            if (mask & C_THIN) {
                if (!DIS_NORM) for (int rn_ = 0; rn_ < ((Lq == 2) ? 1 : REP_N0C); ++rn_) phase_norm(F, hsrc, H16, F.A->in[2] + (size_t)Lq * DM, odd ? 0 : 1, (Lq == 2), odd ? nullptr : F.A->in[8] + (size_t)j * DM * FOXIN, odd ? nullptr : F.A->in[9] + (size_t)j * NH, (IN8L2 && Lq == 2) || (IN8L0 && Lq == 0));
            }
            SEAM(pb + 0);
        } }
        { SLOT_VARS;
        if (IN(pb + 1)) {
            PHASE_BEGIN();
            if (!odd) {
                if (Lq == 0 && (mask & C_PMK) && !DIS_PMK) {
                    pg8::Gemm g{ws + WS_MEMN, ws + WS_WKV, DM * 2, (size_t)2 * MEMD * DM * 2};
                    pg8::Order S; S.init(4 * BATCH * ML / 256, 2, F.G, (int)blockIdx.x, nullptr, BATCH * ML / 256); const pg8::OrderT ST = pg8::order_table(S, F.lds + ORDTAB_OFF, F.tid);
                    pg8::EpiMemKV E{(pg8::bf16_t*)(ws + WS_MKV), F.A->in[7]};
                    pg8::gemm_phase<pg8::EpiMemKV, pg8::OrderT, true, true>(F.lds + RING_OFF, g, ST, E, F.wave);
                }
                if ((mask & C_THIN) && !DIS_CUM) phase_cumsum(F);
                if ((mask & C_INPROJ) && !DIS_INE && ((IN8L2 && Lq == 2) || (IN8L0 && Lq == 0))) {
                    pg8::Gemm g{UB, ws + WS_WINE + (size_t)j * 2560 * DM * 2, DM, 0};
                    pg8::Order S; S.init(T / 256, 10, F.G, (int)blockIdx.x, nullptr, 0); const pg8::OrderT ST = pg8::order_table(S, F.lds + ORDTAB_OFF, F.tid);
                    pg8::EpiInEven E{QKV, MQ, (const float*)(ws + WS_GT) + Lq * 192, 1.0f / (ASC_Z * WSC_GU)};
                    for (int rg_ = 0; rg_ < REP_GIN; ++rg_) pg8::gemm_phase<pg8::EpiInEven, pg8::OrderT, true, true, true>(F.lds + RING_OFF, g, ST, E, F.wave);
                } else if ((mask & C_INPROJ) && !DIS_INE) {
                    pg8::Gemm g{UB, (const pg8::bf16_t*)(ws + WS_WINE) + (size_t)j * 2560 * DM, DM * 2, 0};
                    pg8::Order S; S.init(T / 256, 10, F.G, (int)blockIdx.x, nullptr, 0); const pg8::OrderT ST = pg8::order_table(S, F.lds + ORDTAB_OFF, F.tid);
                    pg8::EpiInEven E{QKV, MQ, (const float*)(ws + WS_GT) + Lq * 192};
                    for (int rg_ = 0; rg_ < REP_GIN; ++rg_) pg8::gemm_phase<pg8::EpiInEven, pg8::OrderT, true, true>(F.lds + RING_OFF, g, ST, E, F.wave);
#if MOEQ
                    if (Lq == 0 && (mask & C_THIN)) { pg8::Order Sp; Sp.init(4 * BATCH * ML / 256, 2, F.G, (int)blockIdx.x, nullptr, BATCH * ML / 256); pg8::Unit up_; if (!Sp.next(0, up_)) { __syncthreads(); convert_moe_queue(F, 0, (gu32*)(ws + WS_CTL) + CW_QUEUE, 2); } }
#endif
                }
            } else if ((mask & C_INPROJ) && !DIS_INO && ((IN8ODD >> j) & 1)) {
                pg8::Gemm g{UB, ws + WS_WINO + (size_t)j * CONVIN * DM * 2, DM, 0};
                pg8::Order S; S.init(T / 256, 7, F.G, (int)blockIdx.x, nullptr, 0); const pg8::OrderT ST = pg8::order_table(S, F.lds + ORDTAB_OFF, F.tid);
                pg8::EpiInOdd E{(pg8::bf16_t*)(ws + WS_GLU), MQ, F.A->in[14] + (size_t)j * 2 * CONVD, (const float*)(ws + WS_GT) + Lq * 192 + 128, (const float*)(ws + WS_SSQ), 1.0f / (ASC_Z * WSC_GU)};
                for (int rg_ = 0; rg_ < REP_GIN; ++rg_) pg8::gemm_phase<pg8::EpiInOdd, pg8::OrderT, true, true, true>(F.lds + RING_OFF, g, ST, E, F.wave);
            } else if ((mask & C_INPROJ) && !DIS_INO) {
                pg8::Gemm g{(FUSENORM && !BRINGUP) ? (const void*)(ws + WS_H16) : (const void*)UB, (const pg8::bf16_t*)(ws + WS_WINO) + (size_t)j * CONVIN * DM, DM * 2, 0};
                pg8::Order S; S.init(T / 256, 7, F.G, (int)blockIdx.x, nullptr, 0); const pg8::OrderT ST = pg8::order_table(S, F.lds + ORDTAB_OFF, F.tid);
                pg8::EpiInOdd E{(pg8::bf16_t*)(ws + WS_GLU), MQ, F.A->in[14] + (size_t)j * 2 * CONVD, (const float*)(ws + WS_GT) + Lq * 192 + 128, (FUSENORM && !BRINGUP) ? (const float*)(ws + WS_SSQ) : nullptr};
                for (int rg_ = 0; rg_ < REP_GIN; ++rg_) pg8::gemm_phase<pg8::EpiInOdd, pg8::OrderT, true, true>(F.lds + RING_OFF, g, ST, E, F.wave);
            }
            SEAM(pb + 1);
        } }
        { SLOT_VARS;
        if (IN(pb + 2)) {
            PHASE_BEGIN();
            if (!odd) {
                if ((mask & C_FOX) && !DIS_FOX) for (int rep_ = 0; rep_ < REP_ATT; ++rep_) {
                    const FoxOrder S{F.vcu, F.G}; AttnUnitId u;
                    int tfx_; asm volatile("v_mbcnt_lo_u32_b32 %0, -1, 0\n\tv_mbcnt_hi_u32_b32 %0, -1, %0" : "=v"(tfx_)); const int tidf = F.wave * 64 + tfx_;
                    const float xskip = ((const float*)(ws + WS_GT))[1024 + j];
                    float cqn = 0.f, ckn = 0.f; AttnUnitId un; bool hn = S.next(0, un);
                    auto bias_req = [&](const AttnUnitId& q) { const float* cbq = (const float*)(ws + WS_CB) + (size_t)q.bh * SEQ; const int NT = 4 * (q.qb + 1); const int jt = tfx_; cqn = ((const GAS float*)cbq)[q.qb * 256]; ckn = ((const GAS float*)cbq)[(jt < NT ? jt : NT - 1) * 64 + 63]; };
                    if (hn) bias_req(un);
                    for (int i = 0; hn; ++i) {
                        u = un; const float cq = cqn, ck = ckn;
                        hn = S.next(i + 1, un); if (hn) bias_req(un);
                        const int b = u.bh / NH, h = u.bh - b * NH; const size_t r0 = (size_t)b * SEQ;
                        const float* cbq = (const float*)(ws + WS_CB) + (size_t)u.bh * SEQ; const int NT = 4 * (u.qb + 1);
                        int j0; { const int jt = tfx_;
                            const unsigned long long live = __builtin_amdgcn_ballot_w64(jt < NT && (cq - ck >= -xskip));
                            j0 = live ? (int)__builtin_ctzll(live) : NT - 4; j0 = __builtin_amdgcn_readfirstlane(j0); if (j0 > NT - 4) j0 = NT - 4; j0 &= ~1; }
                        attn_body::attn_unit<24, true, true, 3 * FOXD, 3 * FOXD, DM, true>((const attn_body::bf16*)QKV + (r0 + (size_t)u.qb * 256) * (3 * FOXD) + h * HD,
                            (const attn_body::bf16*)QKV + (r0 + (size_t)j0 * 64) * (3 * FOXD) + FOXD + h * HD, (const attn_body::bf16*)QKV + (r0 + (size_t)j0 * 64) * (3 * FOXD) + 2 * FOXD + h * HD,
                            (attn_body::bf16*)MIX + (r0 + (size_t)u.qb * 256) * DM + h * HD, cbq + j0 * 64, NT - j0, (char*)lds + RING_OFF, tidf, fminf((xskip - 40.0f) * 0.505f + 0.25f, 60.0f));
                    }
                }
            } else if ((mask & C_THIN) && !DIS_CONV) for (int rn_ = 0; rn_ < REP_CONV; ++rn_) {
                phase_conv(F, F.A->in[15] + (size_t)j * CW * CONVD, F.A->in[16] + (size_t)j * CONVD, F.A->in[17] + (size_t)j * CONVD, F.A->in[18] + (size_t)j * CONVD);
            }
            if ((mask & C_MEMATT) && !DIS_MEM) for (int rep_ = 0; rep_ < REP_MEM; ++rep_) {
                int tmx_; asm volatile("v_mbcnt_lo_u32_b32 %0, -1, 0\n\tv_mbcnt_hi_u32_b32 %0, -1, %0" : "=v"(tmx_)); const int tidm = F.wave * 64 + tmx_;
                const MemOrder S{F.vcu, F.G}; AttnUnitId u; const attn_body::bf16* MKVL = (const attn_body::bf16*)(ws + WS_MKV) + (size_t)Lq * BATCH * ML * 2 * MEMD;
                for (int i = 0; S.next(i, u); ++i) {
                    const int b = u.bh / MEMH, h = u.bh - b * MEMH; const size_t r0 = (size_t)b * SEQ + (size_t)u.qb * 256;
                    attn_body::attn_unit<8, false, false, MEMD, 2 * MEMD, DM>((const attn_body::bf16*)MQ + r0 * MEMD + h * HD, MKVL + (size_t)b * ML * (2 * MEMD) + h * HD, MKVL + (size_t)b * ML * (2 * MEMD) + MEMD + h * HD,
                        (attn_body::bf16*)MIX + r0 * DM + FOXD + h * HD, nullptr, ML / 64, (char*)lds + RING_OFF, tidm);
                }
            }
#if MOEQ
#ifndef REP_MOEQ
#define REP_MOEQ 1
#endif
            if (!odd && (mask & C_THIN)) { for (int rq_ = 0; rq_ < REP_MOEQ; ++rq_) { __syncthreads(); convert_moe_queue(F, j, (gu32*)(ws + WS_CTL) + CW_QUEUE + 64 * j + 256 * rq_); } }
#endif
            SEAM(pb + 2);
        } }
        { SLOT_VARS;
        if (IN(pb + 3)) {
            PHASE_BEGIN();
            if ((mask & C_OUTPROJ) && !DIS_OUT) {
                pg8::Gemm g{MIX, (const pg8::bf16_t*)(ws + (odd ? WS_WOUTO : WS_WOUTE)) + (size_t)j * DM * DM, DM * 2, 0};
                pg8::Order S; S.init(T / 256, 4, F.G, (int)blockIdx.x, nullptr, 0); const pg8::OrderT ST = pg8::order_table(S, F.lds + ORDTAB_OFF, F.tid);
                pg8::EpiResid E{hsrc, (pg8::bf16_t*)(ws + WS_H16), 1.0f, (FUSENORM && !BRINGUP && !odd) ? (float*)(ws + WS_SSQ) : nullptr, (FUSENORM && !BRINGUP && !odd && (DENSE8 == 1 || (DENSE8 == 2 && Lq == 2) || (UP8L0 && Lq == 0))) ? (unsigned char*)UB : nullptr};
                for (int rg_ = 0; rg_ < REP_GOUT; ++rg_) { if (rg_) { E.isc = 0.f; E.base32 = nullptr; } pg8::gemm_phase<pg8::EpiResid, pg8::OrderT, true, true>(F.lds + RING_OFF, g, ST, E, F.wave); }
            }
            SEAM(pb + 3);
        } }
        { SLOT_VARS;
        if (IN(pb + 4) && !(FUSENORM && !BRINGUP && !odd)) {
            PHASE_BEGIN();
            if ((mask & C_THIN) && !DIS_NORM) for (int rep_ = 0; rep_ < REP_THIN; ++rep_) phase_norm(F, nullptr, H16, F.A->in[4] + (size_t)Lq * DM, odd ? 2 : 0, false, odd ? F.A->in[23] + (size_t)j * DM * NE : nullptr, nullptr, DENSE8 == 1 || (DENSE8 == 2 && Lq == 2));
            SEAM(pb + 4);
        } }
        { SLOT_VARS;
        if (odd && IN(pb + 5)) {
            PHASE_BEGIN();
            if ((mask & C_THIN) && !DIS_SCAT) for (int rep_ = 0; rep_ < REP_THIN; ++rep_) { phase_scatter(F); __syncthreads(); }
            SEAM(pb + 5);
        } }
        { SLOT_VARS;
        if (IN(pb + 6)) {
            PHASE_BEGIN();
            if ((mask & C_FFNUP) && !DIS_UP) {
                const bool d8 = DENSE8 == 1 || (DENSE8 == 2 && Lq == 2), u8 = d8 || (UP8L0 && Lq == 0);
                if (!odd && !u8 && !DIS_UPD) {
                    pg8::Gemm g{(FUSENORM && !BRINGUP) ? (const void*)(ws + WS_H16) : (const void*)UB, (const pg8::bf16_t*)(ws + WS_WGU) + (size_t)j * 2 * FF * DM, DM * 2, 0};
                    pg8::Order S; S.init(T / 256, 2 * FF / 256, F.G, (int)blockIdx.x, nullptr, 0); const pg8::OrderT ST = pg8::order_table(S, F.lds + ORDTAB_OFF, F.tid);
                    pg8::EpiSwiGLU E{(pg8::bf16_t*)(ws + WS_HIDD), FF, (FUSENORM && !BRINGUP) ? (const float*)(ws + WS_SSQ) : nullptr};
                    for (int rg_ = 0; rg_ < REP_GDENSE; ++rg_) pg8::gemm_phase<pg8::EpiSwiGLU, pg8::OrderT, true, true, false>(F.lds + RING_OFF, g, ST, E, F.wave);
                } else if (!odd && u8 && !d8) {
                    pg8::Gemm g{UB, ws + WS_WGU + (size_t)j * 2 * FF * DM * 2, DM, 0};
                    pg8::Order S; S.init(T / 256, 2 * FF / 256, F.G, (int)blockIdx.x, nullptr, 0); const pg8::OrderT ST = pg8::order_table(S, F.lds + ORDTAB_OFF, F.tid);
                    pg8::EpiSwiGLU8B E{ws + WS_HIDD, FF, 1.0f / (ASC_Z * WSC_GU), 1.0f, (FUSENORM && !BRINGUP) ? (const float*)(ws + WS_SSQ) : nullptr};
                    for (int rg_ = 0; rg_ < REP_GDENSE; ++rg_) pg8::gemm_phase<pg8::EpiSwiGLU8B, pg8::OrderT, true, true, true>(F.lds + RING_OFF, g, ST, E, F.wave);
                } else if (!odd && d8) {
                    pg8::Gemm g{UB, ws + WS_WGU + (size_t)j * 2 * FF * DM * 2, DM, 0};
                    pg8::Order S; S.init(T / 256, 2 * FF / 256, F.G, (int)blockIdx.x, nullptr, 0); const pg8::OrderT ST = pg8::order_table(S, F.lds + ORDTAB_OFF, F.tid);
                    pg8::EpiSwiGLU8 E{ws + WS_HIDD, FF, 1.0f / (ASC_Z * WSC_GU), ASC_H, (FUSENORM && !BRINGUP) ? (const float*)(ws + WS_SSQ) : nullptr};
                    for (int rg_ = 0; rg_ < REP_GDENSE; ++rg_) pg8::gemm_phase<pg8::EpiSwiGLU8, pg8::OrderT, true, true, true>(F.lds + RING_OFF, g, ST, E, F.wave);
                } else if (odd && !DIS_UPM) {
                    const int* TAB = (const int*)(ws + WS_TAB);
                    pg8::Gemm g{ws + WS_XS, ws + WS_WMGU + (size_t)j * WS_WM_LAYER, DM, (size_t)2 * EFF * DM};
                    pg8::Order S; S.init(__builtin_amdgcn_readfirstlane(TAB[0]), 2 * EFF / 256, F.G, (int)blockIdx.x, TAB + 16, 0); const pg8::OrderT ST = pg8::order_table(S, F.lds + ORDTAB_OFF, F.tid);
                    pg8::EpiSwiGLU8 E{ws + WS_HIDM, EFF, 1.0f / (ASC_Z * WSC_GU), ASC_H, nullptr};
                    for (int rg_ = 0; rg_ < REP_GMOE; ++rg_) pg8::gemm_phase<pg8::EpiSwiGLU8, pg8::OrderT, true, true, true>(F.lds + RING_OFF, g, ST, E, F.wave);
#if MOEQ
                    if (Lq == 1 && (mask & C_THIN)) { const int nu_ = __builtin_amdgcn_readfirstlane(TAB[0]) * (2 * EFF / 256); pg8::Unit ux_; if (!S.next(nu_ / F.G, ux_)) { __syncthreads(); convert_moe_queue(F, 1, (gu32*)(ws + WS_CTL) + CW_QUEUE + 64, 1); } }
#endif
                }
            }
            SEAM(pb + 6);
        } }
        { SLOT_VARS;
        if (IN(pb + 7)) {
            PHASE_BEGIN();
            if ((mask & C_FFNDOWN) && !DIS_DOWN) {
                if (!odd) {
                    const bool d8 = DENSE8 == 1 || (DENSE8 == 2 && Lq == 2);
                    if (d8) {
                    pg8::Gemm g{ws + WS_HIDD, ws + WS_WD + (size_t)j * DM * FF * 2, FF, 0};
                    pg8::Order S; S.init(T / 256, 4, F.G, (int)blockIdx.x, nullptr, 0); const pg8::OrderT ST = pg8::order_table(S, F.lds + ORDTAB_OFF, F.tid);
                    pg8::EpiResid E{nullptr, (pg8::bf16_t*)(ws + WS_H16), 1.0f / (ASC_H * WSC_D), (FUSENORM && !BRINGUP) ? (float*)(ws + WS_SSQ) : nullptr, ((IN8ODD >> j) & 1) ? (unsigned char*)UB : nullptr};
                    for (int rg_ = 0; rg_ < REP_GDENSE; ++rg_) { if (rg_) { E.isc = 0.f; E.base32 = nullptr; } pg8::gemm_phase<pg8::EpiResid, pg8::OrderT, true, true, true>(F.lds + RING_OFF, g, ST, E, F.wave); }
                    } else {
                    pg8::Gemm g{ws + WS_HIDD, (const pg8::bf16_t*)(ws + WS_WD) + (size_t)j * DM * FF, FF * 2, 0};
                    pg8::Order S; S.init(T / 256, 4, F.G, (int)blockIdx.x, nullptr, 0); const pg8::OrderT ST = pg8::order_table(S, F.lds + ORDTAB_OFF, F.tid);
                    pg8::EpiResid E{nullptr, (pg8::bf16_t*)(ws + WS_H16), 1.0f, (FUSENORM && !BRINGUP) ? (float*)(ws + WS_SSQ) : nullptr, ((IN8ODD >> j) & 1) ? (unsigned char*)UB : nullptr};
                    for (int rg_ = 0; rg_ < REP_GDENSE; ++rg_) { if (rg_) { E.isc = 0.f; E.base32 = nullptr; } pg8::gemm_phase<pg8::EpiResid, pg8::OrderT, true, true>(F.lds + RING_OFF, g, ST, E, F.wave); }
                    }
                } else {
                    const int* TAB = (const int*)(ws + WS_TAB);
                    pg8::Gemm g{ws + WS_HIDM, ws + WS_WMD + (size_t)j * WS_WM_LAYER, EFF, (size_t)DM * EFF};
                    const int nrt_ = __builtin_amdgcn_readfirstlane(TAB[0]); const bool reg_ = (F.G == 256) && (nrt_ >= 256) && (nrt_ <= 264) && !BRINGUP;
                    pg8::Order S; S.init(reg_ ? 256 : nrt_, 4, F.G, (int)blockIdx.x, TAB + 16, 0); const pg8::OrderT ST = pg8::order_table(S, F.lds + ORDTAB_OFF, F.tid);
                    const int rex_ = reg_ ? nrt_ - 256 : 0, kex_ = (int)blockIdx.x >> 3; const bool extra_ = reg_ && (((int)blockIdx.x & 7) == 0) && (kex_ < 4 * rex_);
                    { int pn_ = 0, r_ = extra_ ? kex_ : 0; if (extra_) { if (r_ >= rex_) { r_ -= rex_; pn_ = 1; } if (r_ >= rex_) { r_ -= rex_; pn_ = 2; } if (r_ >= rex_) { r_ -= rex_; pn_ = 3; } }
                      const int pm_ = 256 + r_, gx_ = __builtin_amdgcn_readfirstlane(TAB[16 + (pm_ < MAXRT ? pm_ : MAXRT - 1)]);
                      if (extra_ && F.tid == 0) { LAS int* tp_ = (LAS int*)(F.lds + ORDTAB_OFF) + 16; int one_; asm volatile("v_mov_b32 %0, 1" : "=v"(one_)); tp_[0] = pm_; tp_[1] = pn_; tp_[2] = gx_; tp_[3] = one_; }
                      if (extra_) __syncthreads(); }
                    pg8::EpiRowGate E{(pg8::bf16_t*)(ws + WS_XS), (const float*)(ws + WS_ROWG), DM, 1.0f / (ASC_H * WSC_D)};
                    for (int rg_ = 0; rg_ < REP_GMOE; ++rg_) pg8::gemm_phase<pg8::EpiRowGate, pg8::OrderT, true, true, true>(F.lds + RING_OFF, g, ST, E, F.wave);
#if MOEQ
                    if (Lq == 1 && (mask & C_THIN)) { pg8::Unit u5_; if (reg_ ? !extra_ : !S.next(4, u5_)) { __syncthreads(); convert_moe_queue(F, 1, (gu32*)(ws + WS_CTL) + CW_QUEUE + 64, 3); } }
#endif
                }
            }
            SEAM(pb + 7);
        } }
        { SLOT_VARS;
        if (Lq == 3 && IN(pb + 8)) { PHASE_BEGIN(); if ((mask & C_THIN) && !DIS_FIN) phase_final(F); } }
    }
#undef IN
#undef SEAM
}
#if BRINGUP
namespace naive {
typedef short bf16x8 __attribute__((ext_vector_type(8)));
typedef float f32x4 __attribute__((ext_vector_type(4)));
struct NG { const bf16* A; int lda; const float* W; const float* W2; int ldw; int wcol0, w2col0; int N, K; int mode;
            float* Cf; bf16* Cb; int ldc; int ccol0; const float* base; const float* bias1; const float* bias2; const float* rowg; const int* tab; size_t wstride; };
__global__ __launch_bounds__(256) void gemm(NG g) {
    __shared__ __attribute__((aligned(16))) bf16 sA[64][40];
    __shared__ __attribute__((aligned(16))) bf16 sB[64][40];
    __shared__ __attribute__((aligned(16))) bf16 sB2[64][40];
    const int ntn = g.N / 64, tn = blockIdx.x % ntn, tm = blockIdx.x / ntn;
    const float* W = g.W; const float* W2 = g.W2;
    if (g.tab) { const int rt = tm / 4; if (rt >= g.tab[0]) return; const int e = g.tab[16 + rt]; W += (size_t)e * g.wstride; if (W2) W2 += (size_t)e * g.wstride; }
    const int tid = threadIdx.x, wave = tid >> 6, lane = tid & 63, wr = wave >> 1, wc = wave & 1, fr = lane & 15, fq = lane >> 4;
    const bool dual = (g.mode == 2 || g.mode == 3);
    f32x4 acc[2][2], acc2[2][2];
    for (int a = 0; a < 2; ++a) for (int b = 0; b < 2; ++b) { acc[a][b] = (f32x4){0.f, 0.f, 0.f, 0.f}; acc2[a][b] = (f32x4){0.f, 0.f, 0.f, 0.f}; }
    for (int k0 = 0; k0 < g.K; k0 += 32) {
        { const int r = tid >> 2, kc = (tid & 3) * 8; *(v4u*)&sA[r][kc] = *(const v4u*)(g.A + (size_t)(tm * 64 + r) * g.lda + k0 + kc); }
        { const int k = tid >> 3, nc = (tid & 7) * 8; const float* p = W + (size_t)(k0 + k) * g.ldw + g.wcol0 + tn * 64 + nc;
          for (int i = 0; i < 8; ++i) sB[nc + i][k] = (bf16)f2bf(p[i]);
          if (dual) { const float* p2 = W2 + (size_t)(k0 + k) * g.ldw + g.w2col0 + tn * 64 + nc; for (int i = 0; i < 8; ++i) sB2[nc + i][k] = (bf16)f2bf(p2[i]); } }
        __syncthreads();
        bf16x8 a[2], b[2], b2[2];
        for (int i = 0; i < 2; ++i) { a[i] = *(const bf16x8*)&sA[wr * 32 + i * 16 + fr][fq * 8]; b[i] = *(const bf16x8*)&sB[wc * 32 + i * 16 + fr][fq * 8]; if (dual) b2[i] = *(const bf16x8*)&sB2[wc * 32 + i * 16 + fr][fq * 8]; }
        for (int mi = 0; mi < 2; ++mi) for (int ni = 0; ni < 2; ++ni) { acc[mi][ni] = __builtin_amdgcn_mfma_f32_16x16x32_bf16(a[mi], b[ni], acc[mi][ni], 0, 0, 0);
            if (dual) acc2[mi][ni] = __builtin_amdgcn_mfma_f32_16x16x32_bf16(a[mi], b2[ni], acc2[mi][ni], 0, 0, 0); }
        __syncthreads();
    }
    for (int mi = 0; mi < 2; ++mi) for (int ni = 0; ni < 2; ++ni) for (int jj = 0; jj < 4; ++jj) {
        const int row = tm * 64 + wr * 32 + mi * 16 + fq * 4 + jj, col = tn * 64 + wc * 32 + ni * 16 + fr; const float v = acc[mi][ni][jj], v2 = acc2[mi][ni][jj];
        const size_t o = (size_t)row * g.ldc + g.ccol0 + col;
        if (g.mode == 0) g.Cf[o] = v;
        else if (g.mode == 1) g.Cf[o] = g.base[o] + v;
        else if (g.mode == 2) g.Cb[o] = (bf16)f2bf(v / (1.0f + expf(-v)) * v2);
        else if (g.mode == 3) g.Cb[o] = (bf16)f2bf((v + g.bias1[col]) / (1.0f + expf(-(v2 + g.bias2[col]))));
        else g.Cb[o] = (bf16)f2bf(v * g.rowg[row]);
    }
}
__global__ void headnorm(const float* P, int ldp, int pcol0, int nheads, const float* gain, float sc, int norm, bf16* dst, int ldd, int dcol0, int rows) {
    const int idx = blockIdx.x * blockDim.x + threadIdx.x; if (idx >= rows * nheads) return;
    const int row = idx / nheads, h = idx - row * nheads; const float* p = P + (size_t)row * ldp + pcol0 + h * 64; bf16* d = dst + (size_t)row * ldd + dcol0 + h * 64;
    float r = 1.f;
    if (norm) { float ss = 0.f; for (int i = 0; i < 64; ++i) ss += p[i] * p[i]; r = sc / sqrtf(ss * (1.0f / 64.0f) + 1e-6f); }
    for (int i = 0; i < 64; ++i) d[i] = (bf16)f2bf(norm ? p[i] * r * gain[i] : p[i]);
}
__global__ __launch_bounds__(256) void attn(const bf16* Q, int qp, const bf16* K, const bf16* V, int kp, bf16* O, int op, const float* CB, int nheads, int sq, int skv, int causal) {
    const int lane = threadIdx.x & 63; const long gw = (long)blockIdx.x * 4 + (threadIdx.x >> 6);
    const int t = (int)(gw % sq); const int bh = (int)(gw / sq), h = bh % nheads, b = bh / nheads;
    float qf[64]; { const bf16* qrow = Q + ((size_t)b * sq + t) * qp + h * 64;
#pragma unroll
        for (int d = 0; d < 64; ++d) qf[d] = bflo((unsigned)qrow[d]); }
    const int nk = causal ? t + 1 : skv; float m = -INFINITY, l = 0.f, o = 0.f;
    for (int s0 = 0; s0 < nk; s0 += 64) {
        const int s = s0 + lane; float sc = -INFINITY;
        if (s < nk) { const bf16* krow = K + ((size_t)b * skv + s) * kp + h * 64; float dot = 0.f;
#pragma unroll
            for (int d = 0; d < 64; d += 2) { const unsigned w = *(const unsigned*)(krow + d); dot += qf[d] * bflo(w) + qf[d + 1] * bfhi(w); }
            sc = dot - (CB ? CB[(size_t)bh * skv + s] : 0.f); }
        float tm = sc; for (int x = 1; x < 64; x <<= 1) tm = fmaxf(tm, __shfl_xor(tm, x));
        const float mn = fmaxf(m, tm), alpha = exp2f(m - mn), p = (s < nk) ? exp2f(sc - mn) : 0.f;
        l = l * alpha + wave_sum(p); o *= alpha;
        const int lim = (nk - s0) < 64 ? (nk - s0) : 64;
        for (int jj = 0; jj < lim; ++jj) { const float pj = __shfl(p, jj); o += pj * bflo((unsigned)V[((size_t)b * skv + s0 + jj) * kp + h * 64 + lane]); }
        m = mn;
    }
    O[((size_t)b * sq + t) * op + h * 64 + lane] = (bf16)f2bf(o / l);
}
}
#endif

static void launch_mega(int grid, hipStream_t stream, Args a, int lo, int hi, unsigned mask) {
    a.ph_lo = lo; a.ph_hi = hi; a.mask = mask;
    hipLaunchKernelGGL(mega_fwd, dim3(grid), dim3(NWAVES * 64), LDS_BYTES, stream, a);
}
extern "C" void kernel_launch(void* const* d_in, const int* in_sizes, int n_in, void* d_out, int out_size, void* d_ws, size_t ws_size, hipStream_t stream) {
    static int grid = 0;
    if (grid == 0) {
        if (n_in != 27 || in_sizes[0] != T * DM || out_size != T * DM || ws_size < WS_END) { fprintf(stderr, "kernel_launch: unexpected shapes or workspace (n_in %d, ws %zu < %zu); nothing launched\n", n_in, ws_size, (size_t)WS_END); grid = -1; return; }
        int dev = 0, cus = 0, per_cu = 0;
        if (hipGetDevice(&dev) != hipSuccess || hipDeviceGetAttribute(&cus, hipDeviceAttributeMultiprocessorCount, dev) != hipSuccess) { grid = -1; return; }
        if (hipFuncSetAttribute((const void*)mega_fwd, hipFuncAttributeMaxDynamicSharedMemorySize, LDS_BYTES) != hipSuccess) { fprintf(stderr, "kernel_launch: hipFuncSetAttribute failed\n"); grid = -1; return; }
        if (hipOccupancyMaxActiveBlocksPerMultiprocessor(&per_cu, (const void*)mega_fwd, NWAVES * 64, LDS_BYTES) != hipSuccess || per_cu < 1) { fprintf(stderr, "kernel_launch: occupancy query reports %d\n", per_cu); }
        (void)hipGetLastError();
        grid = cus;
    }
    if (grid < 0) return;
#ifdef DIAG_ZERO_WS
    if (hipMemsetAsync((char*)d_ws, 0, WS_END, stream) != hipSuccess) return;
#endif
    if (hipMemsetAsync((char*)d_ws + WS_CTL, 0, CTL_ZERO_BYTES, stream) != hipSuccess) return;
    Args a{};
    for (int i = 0; i < 27; ++i) a.in[i] = (const float*)d_in[i];
    a.out = (float*)d_out; a.ws = (unsigned char*)d_ws;
#if !BRINGUP
    launch_mega(grid, stream, a, 0, NPH, C_ALL);
#else
    unsigned char* ws = (unsigned char*)d_ws; const float* const* in = a.in;
    const unsigned fast = FASTMASK;
    bf16* UB = (bf16*)(ws + WS_UB); bf16* MIX = (bf16*)(ws + WS_MIX); bf16* MQ = (bf16*)(ws + WS_MQ); bf16* QKV = (bf16*)(ws + WS_QKV); float* NT_ = (float*)(ws + WS_NTMP);
    auto ngemm = [&](naive::NG g, int rows) { hipLaunchKernelGGL(naive::gemm, dim3((rows / 64) * (g.N / 64)), dim3(256), 0, stream, g); };
    auto nhead = [&](const float* P, int ldp, int pcol0, int nheads, const float* gain, float sc, int norm, bf16* dst, int ldd, int dcol0, int rows) {
        hipLaunchKernelGGL(naive::headnorm, dim3((rows * nheads + 255) / 256), dim3(256), 0, stream, P, ldp, pcol0, nheads, gain, sc, norm, dst, ldd, dcol0, rows); };
    launch_mega(grid, stream, a, 0, 1, C_THIN);
#ifndef NLAYERS
#define NLAYERS 4
#endif
    for (int L = 0; L < NLAYERS; ++L) {
        const int pb = 1 + 9 * L, j = L >> 1; const bool odd = L & 1; const float* hsrc = L == 0 ? in[0] : (const float*)d_out;
        launch_mega(grid, stream, a, pb, pb + 1, C_THIN);
        if (!odd) {
            if (L == 0) {
                if (fast & C_PMK) launch_mega(grid, stream, a, pb + 1, pb + 2, C_PMK);
                else for (int i = 0; i < 4; ++i) {
                    naive::NG g{}; g.A = (const bf16*)(ws + WS_MEMN) + (size_t)i * 2048 * DM; g.lda = DM; g.W = in[5] + (size_t)i * DM * 512; g.ldw = 512; g.N = 512; g.K = DM; g.mode = 0; g.Cf = NT_; g.ldc = 512; ngemm(g, 2048);
                    nhead(NT_, 512, 0, 4, in[7] + i * 64, 1.0f, 1, (bf16*)(ws + WS_MKV) + (size_t)i * 2048 * 512, 512, 0, 2048);
                    nhead(NT_, 512, 256, 4, in[7], 1.0f, 0, (bf16*)(ws + WS_MKV) + (size_t)i * 2048 * 512, 512, 256, 2048);
                }
            }
            launch_mega(grid, stream, a, pb + 1, pb + 2, C_THIN);
            if (fast & C_INPROJ) launch_mega(grid, stream, a, pb + 1, pb + 2, C_INPROJ);
            else {
                naive::NG g{}; g.A = UB; g.lda = DM; g.W = in[8] + (size_t)j * DM * FOXIN; g.ldw = FOXIN; g.K = DM; g.mode = 0; g.Cf = NT_; g.ldc = 2560;
                g.wcol0 = 0; g.N = 2304; g.ccol0 = 0; ngemm(g, T);
                g.wcol0 = 2316; g.N = 256; g.ccol0 = 2304; ngemm(g, T);
                nhead(NT_, 2560, 0, 12, in[10] + j * 64, C2, 1, QKV, 2304, 0, T);
                nhead(NT_, 2560, 768, 12, in[11] + j * 64, 1.0f, 1, QKV, 2304, 768, T);
                nhead(NT_, 2560, 1536, 12, in[11], 1.0f, 0, QKV, 2304, 1536, T);
                nhead(NT_, 2560, 2304, 4, in[6] + L * 64, C2, 1, MQ, 256, 0, T);
            }
        } else {
            if (fast & C_INPROJ) launch_mega(grid, stream, a, pb + 1, pb + 2, C_INPROJ);
            else {
                naive::NG g{}; g.A = UB; g.lda = DM; g.W = in[13] + (size_t)j * DM * CONVIN; g.W2 = g.W; g.ldw = CONVIN; g.K = DM;
                g.mode = 3; g.wcol0 = 0; g.w2col0 = 768; g.N = 768; g.Cb = (bf16*)(ws + WS_GLU); g.ldc = 768; g.bias1 = in[14] + (size_t)j * 1536; g.bias2 = g.bias1 + 768; ngemm(g, T);
                naive::NG h{}; h.A = UB; h.lda = DM; h.W = g.W; h.ldw = CONVIN; h.K = DM; h.mode = 0; h.wcol0 = 1536; h.N = 256; h.Cf = NT_; h.ldc = 256; ngemm(h, T);
                nhead(NT_, 256, 0, 4, in[6] + L * 64, C2, 1, MQ, 256, 0, T);
            }
        }
        if (!odd) {
            if (fast & C_FOX) launch_mega(grid, stream, a, pb + 2, pb + 3, C_FOX);
            else hipLaunchKernelGGL(naive::attn, dim3(BATCH * NH * SEQ / 4), dim3(256), 0, stream, (const bf16*)QKV, 2304, (const bf16*)QKV + 768, (const bf16*)QKV + 1536, 2304, MIX, DM, (const float*)(ws + WS_CB), NH, SEQ, SEQ, 1);
        } else launch_mega(grid, stream, a, pb + 2, pb + 3, C_THIN);
        if (fast & C_MEMATT) launch_mega(grid, stream, a, pb + 2, pb + 3, C_MEMATT);
        else { const bf16* mkv = (const bf16*)(ws + WS_MKV) + (size_t)L * 2048 * 512;
            hipLaunchKernelGGL(naive::attn, dim3(BATCH * MEMH * SEQ / 4), dim3(256), 0, stream, (const bf16*)MQ, 256, mkv, mkv + 256, 512, MIX + 768, DM, (const float*)nullptr, MEMH, SEQ, ML, 0); }
        if (fast & C_OUTPROJ) launch_mega(grid, stream, a, pb + 3, pb + 4, C_OUTPROJ);
        else { naive::NG g{}; g.A = MIX; g.lda = DM; g.W = in[odd ? 19 : 12] + (size_t)j * DM * DM; g.ldw = DM; g.N = DM; g.K = DM; g.mode = 1; g.Cf = (float*)d_out; g.ldc = DM; g.base = hsrc; ngemm(g, T); }
        launch_mega(grid, stream, a, pb + 4, pb + 5, C_THIN);
        if (odd) launch_mega(grid, stream, a, pb + 5, pb + 6, C_THIN);
        if (fast & C_FFNUP) launch_mega(grid, stream, a, pb + 6, pb + 7, C_FFNUP);
        else if (!odd) { naive::NG g{}; g.A = UB; g.lda = DM; g.W = in[20] + (size_t)j * DM * FF; g.W2 = in[21] + (size_t)j * DM * FF; g.ldw = FF; g.N = FF; g.K = DM; g.mode = 2; g.Cb = (bf16*)(ws + WS_HIDD); g.ldc = FF; ngemm(g, T); }
        else { naive::NG g{}; g.A = (const bf16*)(ws + WS_XS); g.lda = DM; g.W = in[24] + (size_t)j * NE * DM * EFF; g.W2 = in[25] + (size_t)j * NE * DM * EFF; g.ldw = EFF; g.N = EFF; g.K = DM; g.mode = 2; g.Cb = (bf16*)(ws + WS_HIDM); g.ldc = EFF;
               g.tab = (const int*)(ws + WS_TAB); g.wstride = (size_t)DM * EFF; ngemm(g, MAXROWS); }
        if (fast & C_FFNDOWN) launch_mega(grid, stream, a, pb + 7, pb + 8, C_FFNDOWN);
        else if (!odd) { naive::NG g{}; g.A = (const bf16*)(ws + WS_HIDD); g.lda = FF; g.W = in[22] + (size_t)j * FF * DM; g.ldw = DM; g.N = DM; g.K = FF; g.mode = 1; g.Cf = (float*)d_out; g.ldc = DM; g.base = (const float*)d_out; ngemm(g, T); }
        else { naive::NG g{}; g.A = (const bf16*)(ws + WS_HIDM); g.lda = EFF; g.W = in[26] + (size_t)j * NE * EFF * DM; g.ldw = DM; g.N = DM; g.K = EFF; g.mode = 4; g.Cb = (bf16*)(ws + WS_XS); g.ldc = DM; g.rowg = (const float*)(ws + WS_ROWG);
               g.tab = (const int*)(ws + WS_TAB); g.wstride = (size_t)EFF * DM; ngemm(g, MAXROWS); }
        if (L == 3 || (odd && L == NLAYERS - 1)) launch_mega(grid, stream, a, 1 + 27 + 8, 1 + 27 + 9, C_THIN);
    }
#endif
}
```
